# Optimizing an MI355X kernel written in HIP

```python
import math
import jax
import jax.numpy as jnp
from jax import lax
import numpy as np

D_MODEL = 1024
BATCH = 4
SEQ = 8192
DEPTH = 2

GRID_W = 64
CTX_LEN = 256
ROPE_THETA = 10000.0
Q_BLOCK = 128
LN_EPS = 1e-6
RMS_EPS = 1e-6

MLA_HEADS = 8
MLA_Q_LORA = 384
MLA_KV_LORA = 256
MLA_NOPE = 64
MLA_ROPE = 32
MLA_V = 64
MLA_WIDTH = MLA_HEADS * MLA_V
MLA_SCALE = (MLA_NOPE + MLA_ROPE) ** -0.5

DIFF_HEADS = 4
DIFF_QK = 64
DIFF_V = 2 * DIFF_QK
DIFF_WIDTH = DIFF_HEADS * DIFF_V
DIFF_SCALE = DIFF_QK ** -0.5

ATTN_WIDTH = MLA_WIDTH + DIFF_WIDTH
EVEN_SPLITS = (MLA_Q_LORA, MLA_KV_LORA, MLA_ROPE,
               DIFF_HEADS * 2 * DIFF_QK, DIFF_HEADS * 2 * DIFF_QK, DIFF_WIDTH,
               ATTN_WIDTH)
EVEN_IN_WIDTH = sum(EVEN_SPLITS)

LRU_WIDTH = 1024
LRU_BLOCKS = 8
LRU_BLOCK_W = LRU_WIDTH // LRU_BLOCKS
LRU_C = 8.0
CONV_W = 4
CONV_PAD_L = CONV_W // 2
CONV_PAD_R = CONV_W - 1 - CONV_PAD_L

DEEPNORM_ALPHA = (2 * DEPTH) ** 0.25
DEEPNORM_BETA = (8 * DEPTH) ** -0.25

kernel_name = 'hybrid_mla_diffattn_rglru_prefix_dit'


def _layer_norm(x, g, b):
    x32 = x.astype(jnp.float32)
    mu = jnp.mean(x32, -1, keepdims=True)
    var = jnp.mean(jnp.square(x32 - mu), -1, keepdims=True)
    y = (x32 - mu) * lax.rsqrt(var + LN_EPS) * g.astype(jnp.float32) + b.astype(jnp.float32)
    return y.astype(x.dtype)


def _rms_norm(x, g):
    x32 = x.astype(jnp.float32)
    y = x32 * lax.rsqrt(jnp.mean(jnp.square(x32), -1, keepdims=True) + RMS_EPS)
    return (y * g.astype(jnp.float32)).astype(x.dtype)


def _adaln(cond, w, b):
    m = jax.nn.silu(cond) @ w + b
    return jnp.split(m, 3, axis=-1)


def _modulate(x, shift, scale):
    return x * (1 + scale) + shift


def _rope_tables(n, rot_dim):
    t = jnp.arange(n)
    rows = (t // GRID_W).astype(jnp.float32)
    cols = (t % GRID_W).astype(jnp.float32)
    n_freq = rot_dim // 4
    freqs = ROPE_THETA ** (-jnp.arange(n_freq, dtype=jnp.float32) / n_freq)
    ang = jnp.concatenate([rows[:, None] * freqs, cols[:, None] * freqs], -1)
    return jnp.cos(ang), jnp.sin(ang)


def _apply_rope(x, cos, sin):
    shape = (x.shape[1],) + (1,) * (x.ndim - 3) + (cos.shape[-1],)
    cos = cos.reshape(shape).astype(x.dtype)
    sin = sin.reshape(shape).astype(x.dtype)
    x1, x2 = jnp.split(x, 2, axis=-1)
    return jnp.concatenate([x1 * cos - x2 * sin, x2 * cos + x1 * sin], -1)


def _sweep_query_blocks(fn, qs):
    b, n = qs[0].shape[:2]
    nb = n // Q_BLOCK
    blocks = tuple(q.reshape((b, nb, Q_BLOCK) + q.shape[2:]).swapaxes(0, 1) for q in qs)
    out = lax.map(lambda qb: fn(*qb), blocks)
    out = out.swapaxes(0, 1)
    return out.reshape((b, n) + out.shape[3:])


def _softmax_attn(q, k, v, scale):
    s = jnp.einsum('bqhd,bkhd->bhqk', q, k).astype(jnp.float32) * scale
    p = jax.nn.softmax(s, axis=-1).astype(v.dtype)
    return jnp.einsum('bhqk,bkhd->bqhd', p, v)


def _diff_attn(q1, q2, k1, k2, v, lam, scale):
    s1 = jnp.einsum('bqhd,bkhd->bhqk', q1, k1).astype(jnp.float32) * scale
    s2 = jnp.einsum('bqhd,bkhd->bhqk', q2, k2).astype(jnp.float32) * scale
    p = (jax.nn.softmax(s1, axis=-1) - lam * jax.nn.softmax(s2, axis=-1)).astype(v.dtype)
    return jnp.einsum('bhqk,bkhd->bqhd', p, v)


def _project_even(z, q_norm_g, w_uq, kv_norm_g, w_ukv):
    idx = np.cumsum(EVEN_SPLITS)[:-1].tolist()
    cq, ckv, k_rope, dq, dk, dv, gate = jnp.split(z, idx, axis=-1)
    b, n = z.shape[:2]
    q = (_rms_norm(cq, q_norm_g) @ w_uq).reshape(b, n, MLA_HEADS, MLA_NOPE + MLA_ROPE)
    kv = (_rms_norm(ckv, kv_norm_g) @ w_ukv).reshape(b, n, MLA_HEADS, MLA_NOPE + MLA_V)
    return (q, kv[..., :MLA_NOPE], k_rope, kv[..., MLA_NOPE:],
            dq.reshape(b, n, DIFF_HEADS, 2, DIFF_QK),
            dk.reshape(b, n, DIFF_HEADS, 2, DIFF_QK),
            dv.reshape(b, n, DIFF_HEADS, DIFF_V), gate)


def _mla_keys(k_nope, k_rope):
    k_r = jnp.broadcast_to(k_rope[:, :, None, :], k_nope.shape[:3] + (MLA_ROPE,))
    return jnp.concatenate([k_nope, k_r], -1)


def _even_merge(o_a, o_b, gate, subln_g, lambda_init, w_out):
    b, n = o_a.shape[:2]
    o_b = _rms_norm(o_b, subln_g) * (1.0 - lambda_init)
    o = jnp.concatenate([o_a.reshape(b, n, MLA_WIDTH), o_b.reshape(b, n, DIFF_WIDTH)], -1)
    return (o * jax.nn.silu(gate)) @ w_out


def _even_layer(x, ctx, c, c_ctx, ada_w, ada_b, ln_g, ln_b, w_in, q_norm_g, w_uq, kv_norm_g, w_ukv,
                lam_q1, lam_k1, lam_q2, lam_k2, subln_g, w_out, lambda_init, need_ctx):
    n = x.shape[1]
    sh_x, sc_x, g_x = _adaln(c[:, None, :], ada_w, ada_b)
    sh_c, sc_c, g_c = _adaln(c_ctx[None, None, :], ada_w, ada_b)
    qx, knx, krx, vax, dqx, dkx, dvx, gx = _project_even(_modulate(x, sh_x, sc_x) @ w_in,
                                                          q_norm_g, w_uq, kv_norm_g, w_ukv)
    qc, knc, krc, vac, dqc, dkc, dvc, gc = _project_even(_modulate(ctx, sh_c, sc_c) @ w_in,
                                                          q_norm_g, w_uq, kv_norm_g, w_ukv)
    cos_a, sin_a = _rope_tables(n, MLA_ROPE)
    cos_b, sin_b = _rope_tables(n, DIFF_QK)
    qx = jnp.concatenate([qx[..., :MLA_NOPE], _apply_rope(qx[..., MLA_NOPE:], cos_a, sin_a)], -1)
    krx = _apply_rope(krx, cos_a, sin_a)
    dqx = _apply_rope(dqx, cos_b, sin_b)
    dkx = _apply_rope(dkx, cos_b, sin_b)
    kac = _mla_keys(knc, krc)
    ka_all = jnp.concatenate([_mla_keys(knx, krx), kac], 1)
    va_all = jnp.concatenate([vax, vac], 1)
    dk1_all = jnp.concatenate([dkx[..., 0, :], dkc[..., 0, :]], 1)
    dk2_all = jnp.concatenate([dkx[..., 1, :], dkc[..., 1, :]], 1)
    dv_all = jnp.concatenate([dvx, dvc], 1)
    lam = (jnp.exp(jnp.sum(lam_q1.astype(jnp.float32) * lam_k1.astype(jnp.float32)))
           - jnp.exp(jnp.sum(lam_q2.astype(jnp.float32) * lam_k2.astype(jnp.float32)))
           + lambda_init)
    o_a = _sweep_query_blocks(lambda qb: _softmax_attn(qb, ka_all, va_all, MLA_SCALE), (qx,))
    o_b = _sweep_query_blocks(
        lambda q1b, q2b: _diff_attn(q1b, q2b, dk1_all, dk2_all, dv_all, lam, DIFF_SCALE),
        (dqx[..., 0, :], dqx[..., 1, :]))
    y = _even_merge(o_a, o_b, gx, subln_g, lambda_init, w_out)
    x_new = _layer_norm(DEEPNORM_ALPHA * x + g_x * y, ln_g, ln_b)
    if not need_ctx:
        return x_new, None
    o_ac = _softmax_attn(qc, kac, vac, MLA_SCALE)
    o_bc = _diff_attn(dqc[..., 0, :], dqc[..., 1, :], dkc[..., 0, :], dkc[..., 1, :], dvc, lam, DIFF_SCALE)
    yc = _even_merge(o_ac, o_bc, gc, subln_g, lambda_init, w_out)
    ctx_new = _layer_norm(DEEPNORM_ALPHA * ctx + g_c * yc, ln_g, ln_b)
    return x_new, ctx_new


def _conv_centred(u, w, b):
    out = lax.conv_general_dilated(u, w[:, None, :].astype(u.dtype), window_strides=(1,),
                                   padding=[(CONV_PAD_L, CONV_PAD_R)],
                                   dimension_numbers=('NWC', 'WIO', 'NWC'),
                                   feature_group_count=u.shape[-1])
    return out + b


def _rglru_coeffs(u, wa, ba, wx, bx, lam):
    b, n, _ = u.shape
    ub = u.reshape(b, n, LRU_BLOCKS, LRU_BLOCK_W)
    r = jax.nn.sigmoid(jnp.einsum('bnki,kij->bnkj', ub, wa) + ba).reshape(b, n, LRU_WIDTH).astype(jnp.float32)
    i = jax.nn.sigmoid(jnp.einsum('bnki,kij->bnkj', ub, wx) + bx).reshape(b, n, LRU_WIDTH).astype(jnp.float32)
    log_a = -LRU_C * r * jax.nn.softplus(-lam.astype(jnp.float32))
    a = jnp.exp(log_a)
    gated = jnp.sqrt(-jnp.expm1(2.0 * log_a)) * (i * u.astype(jnp.float32))
    return a, gated


def _linear_scan(a, bx, h0):
    bx = bx.at[:, 0].add(a[:, 0] * h0)
    def combine(l, r):
        return (l[0] * r[0], r[0] * l[1] + r[1])
    return lax.associative_scan(combine, (a, bx), axis=1)[1]


def _rglru_direction(ux, uc, wa, ba, wx, bx, lam):
    a_c, b_c = _rglru_coeffs(uc, wa, ba, wx, bx, lam)
    a_x, b_x = _rglru_coeffs(ux, wa, ba, wx, bx, lam)
    h_c = _linear_scan(a_c, b_c, jnp.zeros((uc.shape[0], LRU_WIDTH), jnp.float32))
    h_x = _linear_scan(a_x, b_x, h_c[:, -1])
    return h_x, h_c


def _odd_layer(x, ctx, c, c_ctx, ada_w, ada_b, ln_g, ln_b, w_in, conv_w, conv_b,
               ga_w, ga_b, gx_w, gx_b, lru_lambda, w_out, need_ctx):
    sh_x, sc_x, g_x = _adaln(c[:, None, :], ada_w, ada_b)
    sh_c, sc_c, g_c = _adaln(c_ctx[None, None, :], ada_w, ada_b)
    ux, gate_x = jnp.split(_modulate(x, sh_x, sc_x) @ w_in, 2, axis=-1)
    uc, gate_c = jnp.split(_modulate(ctx, sh_c, sc_c) @ w_in, 2, axis=-1)
    ux = _conv_centred(ux, conv_w, conv_b)
    uc = _conv_centred(uc, conv_w, conv_b)
    hx_f, hc_f = _rglru_direction(ux, uc, ga_w[0], ga_b[0], gx_w[0], gx_b[0], lru_lambda[0])
    hx_b, hc_b = _rglru_direction(ux[:, ::-1], uc[:, ::-1], ga_w[1], ga_b[1], gx_w[1], gx_b[1], lru_lambda[1])
    hx = (hx_f + hx_b[:, ::-1]).astype(x.dtype)
    y = (hx * jax.nn.silu(gate_x)) @ w_out
    x_new = _layer_norm(DEEPNORM_ALPHA * x + g_x * y, ln_g, ln_b)
    if not need_ctx:
        return x_new, None
    hc = (hc_f + hc_b[:, ::-1]).astype(ctx.dtype)
    yc = (hc * jax.nn.silu(gate_c)) @ w_out
    ctx_new = _layer_norm(DEEPNORM_ALPHA * ctx + g_c * yc, ln_g, ln_b)
    return x_new, ctx_new


def setup_inputs(seed: int = 0) -> dict:
    key = jax.random.key(seed)
    ks = jax.random.split(key, 32)
    n_even = (DEPTH + 1) // 2
    n_odd = DEPTH // 2

    def nrm(k, shape, scale):
        return jax.random.normal(k, shape, jnp.float32) * scale

    u = jax.random.uniform(ks[27], (n_odd, 2, LRU_WIDTH), jnp.float32, 0.9, 0.999)
    a0 = u ** (1.0 / LRU_C)
    return {
        'x': nrm(ks[0], (BATCH, SEQ, D_MODEL), 1.0),
        'c': nrm(ks[1], (BATCH, D_MODEL), 1.0),
        'ctx': nrm(ks[2], (BATCH, CTX_LEN, D_MODEL), 1.0),
        'c_ctx': nrm(ks[3], (D_MODEL,), 1.0),
        'ada_w': nrm(ks[4], (DEPTH, D_MODEL, 3 * D_MODEL), 0.5 * D_MODEL ** -0.5),
        'ada_b': nrm(ks[5], (DEPTH, 3 * D_MODEL), 0.02),
        'post_ln_g': 1.0 + nrm(ks[6], (DEPTH, D_MODEL), 0.02),
        'post_ln_b': nrm(ks[7], (DEPTH, D_MODEL), 0.02),
        'e_w_in': nrm(ks[8], (n_even, D_MODEL, EVEN_IN_WIDTH), D_MODEL ** -0.5),
        'e_q_norm_g': 1.0 + nrm(ks[9], (n_even, MLA_Q_LORA), 0.02),
        'e_w_uq': nrm(ks[10], (n_even, MLA_Q_LORA, MLA_HEADS * (MLA_NOPE + MLA_ROPE)), MLA_Q_LORA ** -0.5),
        'e_kv_norm_g': 1.0 + nrm(ks[11], (n_even, MLA_KV_LORA), 0.02),
        'e_w_ukv': nrm(ks[12], (n_even, MLA_KV_LORA, MLA_HEADS * (MLA_NOPE + MLA_V)), MLA_KV_LORA ** -0.5),
        'e_lam_q1': nrm(ks[13], (n_even, DIFF_QK), 0.1),
        'e_lam_k1': nrm(ks[14], (n_even, DIFF_QK), 0.1),
        'e_lam_q2': nrm(ks[15], (n_even, DIFF_QK), 0.1),
        'e_lam_k2': nrm(ks[16], (n_even, DIFF_QK), 0.1),
        'e_subln_g': 1.0 + nrm(ks[17], (n_even, DIFF_V), 0.02),
        'e_w_out': nrm(ks[18], (n_even, ATTN_WIDTH, D_MODEL), ATTN_WIDTH ** -0.5 * DEEPNORM_BETA),
        'o_w_in': nrm(ks[19], (n_odd, D_MODEL, 2 * LRU_WIDTH), D_MODEL ** -0.5),
        'o_conv_w': nrm(ks[20], (n_odd, CONV_W, LRU_WIDTH), CONV_W ** -0.5),
        'o_conv_b': nrm(ks[21], (n_odd, LRU_WIDTH), 0.02),
        'o_gate_a_w': nrm(ks[22], (n_odd, 2, LRU_BLOCKS, LRU_BLOCK_W, LRU_BLOCK_W), LRU_BLOCK_W ** -0.5),
        'o_gate_a_b': nrm(ks[23], (n_odd, 2, LRU_BLOCKS, LRU_BLOCK_W), 0.02),
        'o_gate_x_w': nrm(ks[24], (n_odd, 2, LRU_BLOCKS, LRU_BLOCK_W, LRU_BLOCK_W), LRU_BLOCK_W ** -0.5),
        'o_gate_x_b': nrm(ks[25], (n_odd, 2, LRU_BLOCKS, LRU_BLOCK_W), 0.02),
        'o_lru_lambda': jnp.log(a0) - jnp.log1p(-a0),
        'o_w_out': nrm(ks[26], (n_odd, LRU_WIDTH, D_MODEL), LRU_WIDTH ** -0.5 * DEEPNORM_BETA),
    }


def reference(x, c, ctx, c_ctx, ada_w, ada_b, post_ln_g, post_ln_b,
              e_w_in, e_q_norm_g, e_w_uq, e_kv_norm_g, e_w_ukv,
              e_lam_q1, e_lam_k1, e_lam_q2, e_lam_k2, e_subln_g, e_w_out,
              o_w_in, o_conv_w, o_conv_b, o_gate_a_w, o_gate_a_b, o_gate_x_w, o_gate_x_b,
              o_lru_lambda, o_w_out):
    for i in range(DEPTH):
        need_ctx = i < DEPTH - 1
        j = i // 2
        if i % 2 == 0:
            lambda_init = 0.8 - 0.6 * math.exp(-0.3 * i)
            x, ctx = _even_layer(x, ctx, c, c_ctx, ada_w[i], ada_b[i], post_ln_g[i], post_ln_b[i],
                                 e_w_in[j], e_q_norm_g[j], e_w_uq[j], e_kv_norm_g[j], e_w_ukv[j],
                                 e_lam_q1[j], e_lam_k1[j], e_lam_q2[j], e_lam_k2[j], e_subln_g[j],
                                 e_w_out[j], lambda_init, need_ctx)
        else:
            x, ctx = _odd_layer(x, ctx, c, c_ctx, ada_w[i], ada_b[i], post_ln_g[i], post_ln_b[i],
                                o_w_in[j], o_conv_w[j], o_conv_b[j], o_gate_a_w[j], o_gate_a_b[j],
                                o_gate_x_w[j], o_gate_x_b[j], o_lru_lambda[j], o_w_out[j], need_ctx)
    return x
```

```cpp
#include <hip/hip_runtime.h>
#include <hip/hip_bf16.h>
#include <stdint.h>

typedef unsigned short bfr;

constexpr int B_ = 4, NLAT = 8192, NCTX = 256, SEQA = NLAT + NCTX, RTOT = B_ * SEQA, DM = 1024;
constexpr float ALPHA = 1.4142135623730951f;
constexpr float LOG2E = 1.4426950408889634f;
constexpr float QSC_A = 0.10206207261596577f * LOG2E;
constexpr float QSC_D = 0.125f * LOG2E;

constexpr size_t SZ1024 = (size_t)RTOT * 1024 * 2;
constexpr size_t SZ512  = (size_t)RTOT * 512 * 2;
constexpr size_t SZ768  = (size_t)RTOT * 768 * 2;
constexpr size_t OFF_MOD = 0;
constexpr size_t OFF_LAM = 122880;
constexpr size_t OFF_RA = (size_t)24 << 20;
constexpr size_t OFF_RB = OFF_RA + SZ1024;
constexpr size_t OFF_RC = OFF_RB + SZ1024;
constexpr size_t OFF_RE = OFF_RC + 3 * SZ512;
constexpr size_t OFF_RD = OFF_RE + SZ1024;
constexpr size_t WS_END = OFF_RD + 2 * SZ1024;

__device__ __forceinline__ float bf2f(bfr h) { return __uint_as_float(((unsigned)h) << 16); }
__device__ __forceinline__ bfr f2bf(float f) { unsigned u = __float_as_uint(f); u += 0x7fffu + ((u >> 16) & 1u); return (bfr)(u >> 16); }
__device__ __forceinline__ float silu_f(float x) { return x / (1.f + expf(-x)); }
__device__ __forceinline__ float sigmoid_f(float x) { return 1.f / (1.f + expf(-x)); }
__device__ __forceinline__ const float* xrow(const float* x, const float* ctx, int r) {
  int b = r / SEQA, p = r - b * SEQA;
  return p < NLAT ? x + ((size_t)(b * NLAT + p)) * DM : ctx + ((size_t)(b * NCTX + (p - NLAT))) * DM;
}
__device__ __forceinline__ int modrow(int r) { int b = r / SEQA, p = r - b * SEQA; return p < NLAT ? b : 4; }

__global__ __launch_bounds__(256) void k_mod(const float* c, const float* c_ctx, const float* ada_w, const float* ada_b, float* mod) {
  __shared__ float sc[1024];
  int l = blockIdx.z, mr = blockIdx.y, j = blockIdx.x * 256 + threadIdx.x;
  const float* cond = mr < 4 ? c + mr * 1024 : c_ctx;
  for (int k = threadIdx.x; k < 1024; k += 256) sc[k] = silu_f(cond[k]);
  __syncthreads();
  const float* w = ada_w + (size_t)l * 1024 * 3072 + j;
  float acc = 0;
  for (int k = 0; k < 1024; ++k) acc += sc[k] * w[(size_t)k * 3072];
  mod[(l * 5 + mr) * 3072 + j] = acc + ada_b[l * 3072 + j];
}
__global__ void k_lam(const float* q1, const float* k1, const float* q2, const float* k2, float* lam) {
  if (threadIdx.x == 0 && blockIdx.x == 0) {
    float s1 = 0, s2 = 0;
    for (int i = 0; i < 64; ++i) { s1 += q1[i] * k1[i]; s2 += q2[i] * k2[i]; }
    lam[0] = expf(s1) - expf(s2) + 0.2f;
  }
}
__global__ __launch_bounds__(256) void k_modulate0(const float* x, const float* ctx, const float* mod, bfr* XM) {
  size_t idx = (size_t)blockIdx.x * 256 + threadIdx.x;
  int r = (int)(idx >> 8), c4 = (int)(idx & 255) * 4;
  const float* src = xrow(x, ctx, r) + c4; int mr = modrow(r);
  const float* sh = mod + mr * 3072 + c4; const float* sc = sh + 1024;
  float4 v = *(const float4*)src, s4 = *(const float4*)sh, c4v = *(const float4*)sc;
  uint2 o;
  o.x = (unsigned)f2bf(v.x * (1.f + c4v.x) + s4.x) | ((unsigned)f2bf(v.y * (1.f + c4v.y) + s4.y) << 16);
  o.y = (unsigned)f2bf(v.z * (1.f + c4v.z) + s4.z) | ((unsigned)f2bf(v.w * (1.f + c4v.w) + s4.w) << 16);
  *(uint2*)(XM + (size_t)r * 1024 + c4) = o;
}

template <class Epi>
__global__ __launch_bounds__(256) void k_gemm_naive(const bfr* A, int lda, const float* W, int ldw, int M, int N, int K, Epi epi) {
  __shared__ float As[16][68], Ws[16][68];
  const int tid = threadIdx.x, tx = tid & 15, ty = tid >> 4;
  const int m0 = blockIdx.y * 64, n0 = blockIdx.x * 64;
  epi.setz(blockIdx.z);
  A += epi.aoff(blockIdx.z); W += epi.woff(blockIdx.z);
  float acc[4][4] = {};
  for (int k0 = 0; k0 < K; k0 += 16) {
    { int row = tid >> 2, kk = (tid & 3) * 4;
      uint2 a = *(const uint2*)(A + (size_t)(m0 + row) * lda + k0 + kk);
      As[kk + 0][row] = bf2f((bfr)(a.x & 0xffff)); As[kk + 1][row] = bf2f((bfr)(a.x >> 16));
      As[kk + 2][row] = bf2f((bfr)(a.y & 0xffff)); As[kk + 3][row] = bf2f((bfr)(a.y >> 16)); }
    { int kk = tid >> 4, n = (tid & 15) * 4;
      for (int j = 0; j < 4; ++j) Ws[kk][n + j] = (n0 + n + j < N) ? W[(size_t)(k0 + kk) * ldw + n0 + n + j] : 0.f; }
    __syncthreads();
#pragma unroll
    for (int kk = 0; kk < 16; ++kk) {
      float a[4], b[4];
#pragma unroll
      for (int i = 0; i < 4; ++i) { a[i] = As[kk][ty * 4 + i]; b[i] = Ws[kk][tx * 4 + i]; }
#pragma unroll
      for (int i = 0; i < 4; ++i)
#pragma unroll
        for (int j = 0; j < 4; ++j) acc[i][j] += a[i] * b[j];
    }
    __syncthreads();
  }
  for (int i = 0; i < 4; ++i) for (int j = 0; j < 4; ++j) {
    int row = m0 + ty * 4 + i, col = n0 + tx * 4 + j;
    if (col < N) epi(row, col, acc[i][j]);
  }
}
struct EpiBase { __device__ void setz(int) {} __device__ size_t aoff(int) { return 0; } __device__ size_t woff(int) { return 0; } };
struct EpiZ : EpiBase {
  bfr *Zc, *DQ, *DK, *DV, *SG0; float* KRraw;
  __device__ void operator()(int r, int c, float v) {
    if (c < 640) Zc[(size_t)r * 640 + c] = f2bf(v);
    else if (c < 672) KRraw[(size_t)r * 32 + c - 640] = v;
    else if (c < 1184) DQ[(size_t)r * 512 + c - 672] = f2bf(v);
    else if (c < 1696) DK[(size_t)r * 512 + c - 1184] = f2bf(v);
    else if (c < 2208) DV[(size_t)r * 512 + c - 1696] = f2bf(v);
    else SG0[(size_t)r * 1024 + c - 2208] = f2bf(silu_f(v));
  }
};
struct EpiQ : EpiBase { bfr* QA; __device__ void operator()(int r, int c, float v) { QA[(size_t)r * 768 + c] = f2bf(v); } };
struct EpiKV : EpiBase { bfr *KA, *VA;
  __device__ void operator()(int r, int c, float v) { int h = c >> 7, j = c & 127;
    if (j < 64) KA[(size_t)r * 768 + h * 96 + j] = f2bf(v); else VA[(size_t)r * 512 + h * 64 + j - 64] = f2bf(v); } };
struct EpiStore : EpiBase { bfr* C; int ldc; __device__ void operator()(int r, int c, float v) { C[(size_t)r * ldc + c] = f2bf(v); } };

__global__ __launch_bounds__(256) void k_rms_fix(bfr* Zc, const float* gq, const float* gkv) {
  __shared__ float red[8];
  int r = blockIdx.x, t = threadIdx.x;
  bfr* z = Zc + (size_t)r * 640;
  float v0 = bf2f(z[t]), v1 = (t < 128) ? bf2f(z[256 + t]) : 0.f, v2 = bf2f(z[384 + t]);
  float sq = v0 * v0 + v1 * v1, sk = v2 * v2;
  for (int o = 32; o; o >>= 1) { sq += __shfl_xor(sq, o); sk += __shfl_xor(sk, o); }
  if ((t & 63) == 0) { red[t >> 6] = sq; red[4 + (t >> 6)] = sk; }
  __syncthreads();
  float tq = red[0] + red[1] + red[2] + red[3], tk = red[4] + red[5] + red[6] + red[7];
  float rq = rsqrtf(tq / 384.f + 1e-6f), rk = rsqrtf(tk / 256.f + 1e-6f);
  z[t] = f2bf(v0 * rq * gq[t]);
  if (t < 128) z[256 + t] = f2bf(v1 * rq * gq[256 + t]);
  z[384 + t] = f2bf(v2 * rk * gkv[t]);
}
__global__ __launch_bounds__(256) void k_fix_dqk(bfr* DQ, bfr* DK, const float* KRraw, bfr* KA) {
  int r = blockIdx.x, t = threadIdx.x;
  int p = r % SEQA; bool lat = p < NLAT;
  int i = t & 31; int g = t >> 5;
  float cs = 1.f, sn = 0.f;
  if (lat) { float pos = (i < 16) ? (float)(p >> 6) : (float)(p & 63);
    float fr = powf(10000.f, -(float)(i & 15) / 16.f); float ang = pos * fr; sincosf(ang, &sn, &cs); }
  { bfr* q = DQ + (size_t)r * 512 + g * 64; float x1 = bf2f(q[i]), x2 = bf2f(q[i + 32]);
    q[i] = f2bf((x1 * cs - x2 * sn) * QSC_D); q[i + 32] = f2bf((x2 * cs + x1 * sn) * QSC_D); }
  { bfr* k = DK + (size_t)r * 512 + g * 64; float x1 = bf2f(k[i]), x2 = bf2f(k[i + 32]);
    k[i] = f2bf(x1 * cs - x2 * sn); k[i + 32] = f2bf(x2 * cs + x1 * sn); }
  if (t < 16) {
    float c2 = 1.f, s2 = 0.f;
    if (lat) { float pos = (t < 8) ? (float)(p >> 6) : (float)(p & 63);
      float fr = powf(10000.f, -(float)(t & 7) / 8.f); sincosf(pos * fr, &s2, &c2); }
    float x1 = KRraw[(size_t)r * 32 + t], x2 = KRraw[(size_t)r * 32 + t + 16];
    bfr o1 = f2bf(x1 * c2 - x2 * s2), o2 = f2bf(x2 * c2 + x1 * s2);
    for (int h = 0; h < 8; ++h) { KA[(size_t)r * 768 + h * 96 + 64 + t] = o1; KA[(size_t)r * 768 + h * 96 + 80 + t] = o2; }
  }
}
__global__ __launch_bounds__(256) void k_fix_q(bfr* QA) {
  int r = blockIdx.x, t = threadIdx.x;
  int p = r % SEQA; bool lat = p < NLAT;
  bfr* q = QA + (size_t)r * 768;
  for (int e = t; e < 512; e += 256) { int h = e >> 6, j = e & 63; q[h * 96 + j] = f2bf(bf2f(q[h * 96 + j]) * QSC_A); }
  if (t < 128) { int h = t >> 4, i = t & 15;
    float cs = 1.f, sn = 0.f;
    if (lat) { float pos = (i < 8) ? (float)(p >> 6) : (float)(p & 63);
      float fr = powf(10000.f, -(float)(i & 7) / 8.f); sincosf(pos * fr, &sn, &cs); }
    float x1 = bf2f(q[h * 96 + 64 + i]), x2 = bf2f(q[h * 96 + 80 + i]);
    q[h * 96 + 64 + i] = f2bf((x1 * cs - x2 * sn) * QSC_A); q[h * 96 + 80 + i] = f2bf((x2 * cs + x1 * sn) * QSC_A); }
}

__device__ __forceinline__ void unpack8(uint4 u, float* f) {
  f[0] = __uint_as_float(u.x << 16); f[1] = __uint_as_float(u.x & 0xffff0000u);
  f[2] = __uint_as_float(u.y << 16); f[3] = __uint_as_float(u.y & 0xffff0000u);
  f[4] = __uint_as_float(u.z << 16); f[5] = __uint_as_float(u.z & 0xffff0000u);
  f[6] = __uint_as_float(u.w << 16); f[7] = __uint_as_float(u.w & 0xffff0000u);
}
__global__ __launch_bounds__(256) void k_attn_mla_naive(const bfr* QA, const bfr* KA, const bfr* VA, const bfr* SG0, bfr* OG) {
  int tile = blockIdx.x, h = blockIdx.y;
  int b = tile / 33, tt = tile % 33;
  int r = b * SEQA + tt * 256 + threadIdx.x;
  int k0 = (tt < 32) ? b * SEQA : b * SEQA + NLAT, k1 = b * SEQA + SEQA;
  float q[96], o[64];
#pragma unroll
  for (int c = 0; c < 12; ++c) unpack8(*(const uint4*)(QA + (size_t)r * 768 + h * 96 + c * 8), q + c * 8);
#pragma unroll
  for (int d = 0; d < 64; ++d) o[d] = 0.f;
  float m = -INFINITY, l = 0.f;
  for (int kr = k0; kr < k1; ++kr) {
    const uint4* kp = (const uint4*)(KA + (size_t)kr * 768 + h * 96);
    float s = 0.f;
#pragma unroll
    for (int c = 0; c < 12; ++c) { float kf[8]; unpack8(kp[c], kf);
#pragma unroll
      for (int e = 0; e < 8; ++e) s += q[c * 8 + e] * kf[e]; }
    if (s > m) { float al = exp2f(m - s); l *= al;
#pragma unroll
      for (int d = 0; d < 64; ++d) o[d] *= al;
      m = s; }
    float pr = exp2f(s - m); l += pr;
    const uint4* vp = (const uint4*)(VA + (size_t)kr * 512 + h * 64);
#pragma unroll
    for (int c = 0; c < 8; ++c) { float vf[8]; unpack8(vp[c], vf);
#pragma unroll
      for (int e = 0; e < 8; ++e) o[c * 8 + e] += pr * vf[e]; }
  }
  float il = 1.f / l;
#pragma unroll
  for (int d = 0; d < 64; ++d) { size_t idx = (size_t)r * 1024 + h * 64 + d; OG[idx] = f2bf(o[d] * il * bf2f(SG0[idx])); }
}
__global__ __launch_bounds__(256) void k_attn_diff_naive(const bfr* DQ, const bfr* DK, const bfr* DV, const float* lamp, float* Oraw) {
  int tile = blockIdx.x, h = blockIdx.y, vq = blockIdx.z;
  int b = tile / 33, tt = tile % 33;
  int r = b * SEQA + tt * 256 + threadIdx.x;
  int k0 = (tt < 32) ? b * SEQA : b * SEQA + NLAT, k1 = b * SEQA + SEQA;
  float lam = lamp[0];
  float q[64], o[32], o1[32];
  for (int mp = 0; mp < 2; ++mp) {
#pragma unroll
    for (int c = 0; c < 8; ++c) unpack8(*(const uint4*)(DQ + (size_t)r * 512 + h * 128 + mp * 64 + c * 8), q + c * 8);
#pragma unroll
    for (int d = 0; d < 32; ++d) o[d] = 0.f;
    float m = -INFINITY, l = 0.f;
    for (int kr = k0; kr < k1; ++kr) {
      const uint4* kp = (const uint4*)(DK + (size_t)kr * 512 + h * 128 + mp * 64);
      float s = 0.f;
#pragma unroll
      for (int c = 0; c < 8; ++c) { float kf[8]; unpack8(kp[c], kf);
#pragma unroll
        for (int e = 0; e < 8; ++e) s += q[c * 8 + e] * kf[e]; }
      if (s > m) { float al = exp2f(m - s); l *= al;
#pragma unroll
        for (int d = 0; d < 32; ++d) o[d] *= al;
        m = s; }
      float pr = exp2f(s - m); l += pr;
      const uint4* vp = (const uint4*)(DV + (size_t)kr * 512 + h * 128 + vq * 32);
#pragma unroll
      for (int c = 0; c < 4; ++c) { float vf[8]; unpack8(vp[c], vf);
#pragma unroll
        for (int e = 0; e < 8; ++e) o[c * 8 + e] += pr * vf[e]; }
    }
    float il = 1.f / l;
    if (mp == 0) {
#pragma unroll
      for (int d = 0; d < 32; ++d) o1[d] = o[d] * il;
    } else {
#pragma unroll
      for (int d = 0; d < 32; ++d) Oraw[(size_t)r * 512 + h * 128 + vq * 32 + d] = o1[d] - lam * o[d] * il;
    }
  }
}
__global__ __launch_bounds__(256) void k_fix_attn(const float* Oraw, const float* subg, const bfr* SG0, bfr* OG) {
  int r = blockIdx.x, h = threadIdx.x >> 6, lane = threadIdx.x & 63;
  float v0 = Oraw[(size_t)r * 512 + h * 128 + lane * 2], v1 = Oraw[(size_t)r * 512 + h * 128 + lane * 2 + 1];
  float ss = v0 * v0 + v1 * v1;
  for (int o = 32; o; o >>= 1) ss += __shfl_xor(ss, o);
  float rs = rsqrtf(ss / 128.f + 1e-6f) * 0.8f;
  size_t idx = (size_t)r * 1024 + 512 + h * 128 + lane * 2;
  OG[idx] = f2bf(v0 * rs * subg[lane * 2] * bf2f(SG0[idx]));
  OG[idx + 1] = f2bf(v1 * rs * subg[lane * 2 + 1] * bf2f(SG0[idx + 1]));
}

__global__ __launch_bounds__(256) void k_ln0(const float* x, const float* ctx, const bfr* Y, const float* mod, const float* lng, const float* lnb,
                                             float* out, bfr* XM1) {
  int r = blockIdx.x * 4 + (threadIdx.x >> 6), lane = threadIdx.x & 63;
  int b = r / SEQA, p = r - b * SEQA; int mr = p < NLAT ? b : 4;
  const float* xin = xrow(x, ctx, r);
  const float* g = mod + mr * 3072 + 2048;
  float v[16]; float s = 0.f;
#pragma unroll
  for (int i = 0; i < 16; ++i) { int c = i * 64 + lane; v[i] = ALPHA * xin[c] + g[c] * bf2f(Y[(size_t)r * 1024 + c]); s += v[i]; }
  for (int o = 32; o; o >>= 1) s += __shfl_xor(s, o);
  float mu = s / 1024.f, q = 0.f;
#pragma unroll
  for (int i = 0; i < 16; ++i) { float d = v[i] - mu; q += d * d; }
  for (int o = 32; o; o >>= 1) q += __shfl_xor(q, o);
  float rs = rsqrtf(q / 1024.f + 1e-6f);
  const float* sh1 = mod + (5 + mr) * 3072; const float* sc1 = sh1 + 1024;
#pragma unroll
  for (int i = 0; i < 16; ++i) { int c = i * 64 + lane; float y = (v[i] - mu) * rs * lng[c] + lnb[c];
    if (p < NLAT) out[((size_t)(b * NLAT + p)) * 1024 + c] = y;
    XM1[(size_t)r * 1024 + c] = f2bf(y * (1.f + sc1[c]) + sh1[c]); }
}
__global__ __launch_bounds__(256) void k_ln1(const bfr* Y, const float* mod, const float* lng, const float* lnb, float* out) {
  int lr = blockIdx.x * 4 + (threadIdx.x >> 6), lane = threadIdx.x & 63;
  int b = lr / NLAT;
  const float* g = mod + (5 + b) * 3072 + 2048;
  float* xo = out + (size_t)lr * 1024;
  float v[16]; float s = 0.f;
#pragma unroll
  for (int i = 0; i < 16; ++i) { int c = i * 64 + lane; v[i] = ALPHA * xo[c] + g[c] * bf2f(Y[(size_t)lr * 1024 + c]); s += v[i]; }
  for (int o = 32; o; o >>= 1) s += __shfl_xor(s, o);
  float mu = s / 1024.f, q = 0.f;
#pragma unroll
  for (int i = 0; i < 16; ++i) { float d = v[i] - mu; q += d * d; }
  for (int o = 32; o; o >>= 1) q += __shfl_xor(q, o);
  float rs = rsqrtf(q / 1024.f + 1e-6f);
#pragma unroll
  for (int i = 0; i < 16; ++i) { int c = i * 64 + lane; xo[c] = (v[i] - mu) * rs * lng[c] + lnb[c]; }
}

__global__ __launch_bounds__(256) void k_conv(const bfr* UG, const float* cw, const float* cb, bfr* UC) {
  size_t idx = (size_t)blockIdx.x * 256 + threadIdx.x;
  int r = (int)(idx >> 10), c = (int)(idx & 1023);
  int p = r % SEQA; int lo = p < NLAT ? 0 : NLAT, hi = p < NLAT ? NLAT : SEQA;
  float acc = cb[c];
  for (int j = 0; j < 4; ++j) { int pp = p + j - 2; if (pp >= lo && pp < hi) acc += cw[j * 1024 + c] * bf2f(UG[(size_t)(r + j - 2) * 2048 + c]); }
  UC[(size_t)r * 1024 + c] = f2bf(acc);
}
__global__ __launch_bounds__(256) void k_scan_naive(int dir, const bfr* G, const bfr* UC, const bfr* UG, const float* ba, const float* bx,
                                                    const float* lambda, bfr* HG) {
  int b = blockIdx.y, ch = blockIdx.x * 256 + threadIdx.x;
  float sp = log1pf(expf(-lambda[dir * 1024 + ch]));
  float bba = ba[dir * 1024 + ch], bbx = bx[dir * 1024 + ch];
  float h = 0.f;
  for (int step = 0; step < SEQA; ++step) {
    int p;
    if (dir == 0) p = step < NCTX ? NLAT + step : step - NCTX;
    else p = step < NCTX ? SEQA - 1 - step : NLAT - 1 - (step - NCTX);
    size_t r = (size_t)b * SEQA + p;
    float rr = sigmoid_f(bf2f(G[r * 1024 + ch]) + bba);
    float ii = sigmoid_f(bf2f(G[((size_t)RTOT + r) * 1024 + ch]) + bbx);
    float la = -8.f * rr * sp;
    float a = expf(la);
    float bb = sqrtf(-expm1f(2.f * la)) * ii * bf2f(UC[r * 1024 + ch]);
    h = a * h + bb;
    if (p < NLAT) { size_t o = ((size_t)b * NLAT + p) * 1024 + ch;
      if (dir == 0) HG[o] = f2bf(h);
      else { float hs = bf2f(HG[o]) + h; HG[o] = f2bf(hs * silu_f(bf2f(UG[r * 2048 + 1024 + ch]))); } }
  }
}

extern "C" void kernel_launch(void* const* d_in, const int* in_sizes, int n_in, void* d_out, int out_size, void* d_ws, size_t ws_size, hipStream_t stream) {
  const float* x = (const float*)d_in[0]; const float* c = (const float*)d_in[1]; const float* ctx = (const float*)d_in[2]; const float* c_ctx = (const float*)d_in[3];
  const float* ada_w = (const float*)d_in[4]; const float* ada_b = (const float*)d_in[5]; const float* ln_g = (const float*)d_in[6]; const float* ln_b = (const float*)d_in[7];
  const float* e_w_in = (const float*)d_in[8]; const float* e_qg = (const float*)d_in[9]; const float* e_w_uq = (const float*)d_in[10];
  const float* e_kvg = (const float*)d_in[11]; const float* e_w_ukv = (const float*)d_in[12];
  const float* lq1 = (const float*)d_in[13]; const float* lk1 = (const float*)d_in[14]; const float* lq2 = (const float*)d_in[15]; const float* lk2 = (const float*)d_in[16];
  const float* subg = (const float*)d_in[17]; const float* e_w_out = (const float*)d_in[18];
  const float* o_w_in = (const float*)d_in[19]; const float* conv_w = (const float*)d_in[20]; const float* conv_b = (const float*)d_in[21];
  const float* ga_w = (const float*)d_in[22]; const float* ga_b = (const float*)d_in[23]; const float* gx_w = (const float*)d_in[24]; const float* gx_b = (const float*)d_in[25];
  const float* lru_l = (const float*)d_in[26]; const float* o_w_out = (const float*)d_in[27];
  float* out = (float*)d_out; char* ws = (char*)d_ws;
  if (ws_size < WS_END) return;
  float* mod = (float*)(ws + OFF_MOD); float* lam = (float*)(ws + OFF_LAM);
  bfr* RA = (bfr*)(ws + OFF_RA); bfr* RB = (bfr*)(ws + OFF_RB); bfr* RC = (bfr*)(ws + OFF_RC); bfr* RE = (bfr*)(ws + OFF_RE); bfr* RD = (bfr*)(ws + OFF_RD);
  bfr* XM = RA; bfr* OG = RA; bfr* XM1 = RA; bfr* HG = RA;
  bfr* SG0 = RB; bfr* UC = RB;
  bfr* DQ = RC; bfr* DK = RC + (size_t)RTOT * 512; bfr* DV = RC + (size_t)RTOT * 1024; bfr* Y0 = RC; bfr* G = RC;
  bfr* Zc = RE; float* KRraw = (float*)(ws + OFF_RE + ((size_t)48 << 20)); float* Oraw = (float*)RE;
  bfr* QA = RD; bfr* KA = RD + (size_t)RTOT * 768; bfr* VA = RD + (size_t)RTOT * 1536; bfr* UG = RD;
  bfr* Y1 = RB;

  k_mod<<<dim3(12, 5, 2), 256, 0, stream>>>(c, c_ctx, ada_w, ada_b, mod);
  k_lam<<<1, 64, 0, stream>>>(lq1, lk1, lq2, lk2, lam);
  k_modulate0<<<RTOT, 256, 0, stream>>>(x, ctx, mod, XM);
  { EpiZ e; e.Zc = Zc; e.DQ = DQ; e.DK = DK; e.DV = DV; e.SG0 = SG0; e.KRraw = KRraw;
    k_gemm_naive<<<dim3(51, RTOT / 64, 1), 256, 0, stream>>>(XM, 1024, e_w_in, 3232, RTOT, 3232, 1024, e); }
  k_rms_fix<<<RTOT, 256, 0, stream>>>(Zc, e_qg, e_kvg);
  k_fix_dqk<<<RTOT, 256, 0, stream>>>(DQ, DK, KRraw, KA);
  { EpiQ e; e.QA = QA; k_gemm_naive<<<dim3(12, RTOT / 64, 1), 256, 0, stream>>>(Zc, 640, e_w_uq, 768, RTOT, 768, 384, e); }
  { EpiKV e; e.KA = KA; e.VA = VA; k_gemm_naive<<<dim3(16, RTOT / 64, 1), 256, 0, stream>>>(Zc + 384, 640, e_w_ukv, 1024, RTOT, 1024, 256, e); }
  k_fix_q<<<RTOT, 256, 0, stream>>>(QA);
  k_attn_mla_naive<<<dim3(132, 8), 256, 0, stream>>>(QA, KA, VA, SG0, OG);
  k_attn_diff_naive<<<dim3(132, 4, 4), 256, 0, stream>>>(DQ, DK, DV, lam, Oraw);
  k_fix_attn<<<RTOT, 256, 0, stream>>>(Oraw, subg, SG0, OG);
  { EpiStore e; e.C = Y0; e.ldc = 1024; k_gemm_naive<<<dim3(16, RTOT / 64, 1), 256, 0, stream>>>(OG, 1024, e_w_out, 1024, RTOT, 1024, 1024, e); }
  k_ln0<<<RTOT / 4, 256, 0, stream>>>(x, ctx, Y0, mod, ln_g, ln_b, out, XM1);
  { EpiStore e; e.C = UG; e.ldc = 2048; k_gemm_naive<<<dim3(32, RTOT / 64, 1), 256, 0, stream>>>(XM1, 1024, o_w_in, 2048, RTOT, 2048, 1024, e); }
  k_conv<<<RTOT * 4, 256, 0, stream>>>(UG, conv_w, conv_b, UC);
  for (int dir = 0; dir < 2; ++dir) {
    for (int gate = 0; gate < 2; ++gate) {
      const float* w = (gate == 0 ? ga_w : gx_w) + (size_t)dir * 8 * 128 * 128;
      for (int blk = 0; blk < 8; ++blk) {
        EpiStore es; es.C = G + (size_t)gate * RTOT * 1024 + blk * 128; es.ldc = 1024;
        k_gemm_naive<<<dim3(2, RTOT / 64, 1), 256, 0, stream>>>(UC + blk * 128, 1024, w + (size_t)blk * 128 * 128, 128, RTOT, 128, 128, es);
      }
    }
    k_scan_naive<<<dim3(4, 4), 256, 0, stream>>>(dir, G, UC, UG, ga_b, gx_b, lru_l, HG);
  }
  { EpiStore e; e.C = Y1; e.ldc = 1024; k_gemm_naive<<<dim3(16, (B_ * NLAT) / 64, 1), 256, 0, stream>>>(HG, 1024, o_w_out, 1024, B_ * NLAT, 1024, 1024, e); }
  k_ln1<<<(B_ * NLAT) / 4, 256, 0, stream>>>(Y1, mod, ln_g + 1024, ln_b + 1024, out);
}
```

```cpp
#include <hip/hip_runtime.h>
#include <hip/hip_bf16.h>
#include <stdint.h>

typedef unsigned short bfr;

constexpr int B_ = 4, NLAT = 8192, NCTX = 256, SEQA = NLAT + NCTX, RTOT = B_ * SEQA, DM = 1024;
constexpr float ALPHA = 1.4142135623730951f;
constexpr float LOG2E = 1.4426950408889634f;
constexpr float QSC_A = 0.10206207261596577f * LOG2E;
constexpr float QSC_D = 0.125f * LOG2E;

constexpr size_t SZ1024 = (size_t)RTOT * 1024 * 2;
constexpr size_t SZ512  = (size_t)RTOT * 512 * 2;
constexpr size_t SZ768  = (size_t)RTOT * 768 * 2;
constexpr size_t OFF_MOD = 0;
constexpr size_t OFF_LAM = 122880;
constexpr size_t OFF_RA = (size_t)24 << 20;
constexpr size_t OFF_RB = OFF_RA + SZ1024;
constexpr size_t OFF_RC = OFF_RB + SZ1024;
constexpr size_t OFF_RE = OFF_RC + 3 * SZ512;
constexpr size_t OFF_RD = OFF_RE + SZ1024;
constexpr size_t WS_END = OFF_RD + 2 * SZ1024;

__device__ __forceinline__ float bf2f(bfr h) { return __uint_as_float(((unsigned)h) << 16); }
__device__ __forceinline__ bfr f2bf(float f) { unsigned u = __float_as_uint(f); u += 0x7fffu + ((u >> 16) & 1u); return (bfr)(u >> 16); }
__device__ __forceinline__ float silu_f(float x) { return x / (1.f + expf(-x)); }
__device__ __forceinline__ float sigmoid_f(float x) { return 1.f / (1.f + expf(-x)); }
__device__ __forceinline__ const float* xrow(const float* x, const float* ctx, int r) {
  int b = r / SEQA, p = r - b * SEQA;
  return p < NLAT ? x + ((size_t)(b * NLAT + p)) * DM : ctx + ((size_t)(b * NCTX + (p - NLAT))) * DM;
}
__device__ __forceinline__ int modrow(int r) { int b = r / SEQA, p = r - b * SEQA; return p < NLAT ? b : 4; }

__global__ __launch_bounds__(256) void k_mod(const float* c, const float* c_ctx, const float* ada_w, const float* ada_b, float* mod) {
  __shared__ float sc[1024];
  int l = blockIdx.z, mr = blockIdx.y, j = blockIdx.x * 256 + threadIdx.x;
  const float* cond = mr < 4 ? c + mr * 1024 : c_ctx;
  for (int k = threadIdx.x; k < 1024; k += 256) sc[k] = silu_f(cond[k]);
  __syncthreads();
  const float* w = ada_w + (size_t)l * 1024 * 3072 + j;
  float acc = 0;
  for (int k = 0; k < 1024; ++k) acc += sc[k] * w[(size_t)k * 3072];
  mod[(l * 5 + mr) * 3072 + j] = acc + ada_b[l * 3072 + j];
}
__global__ void k_lam(const float* q1, const float* k1, const float* q2, const float* k2, float* lam) {
  if (threadIdx.x == 0 && blockIdx.x == 0) {
    float s1 = 0, s2 = 0;
    for (int i = 0; i < 64; ++i) { s1 += q1[i] * k1[i]; s2 += q2[i] * k2[i]; }
    lam[0] = expf(s1) - expf(s2) + 0.2f;
  }
}
__global__ __launch_bounds__(256) void k_modulate0(const float* x, const float* ctx, const float* mod, bfr* XM) {
  size_t idx = (size_t)blockIdx.x * 256 + threadIdx.x;
  int r = (int)(idx >> 8), c4 = (int)(idx & 255) * 4;
  const float* src = xrow(x, ctx, r) + c4; int mr = modrow(r);
  const float* sh = mod + mr * 3072 + c4; const float* sc = sh + 1024;
  float4 v = *(const float4*)src, s4 = *(const float4*)sh, c4v = *(const float4*)sc;
  uint2 o;
  o.x = (unsigned)f2bf(v.x * (1.f + c4v.x) + s4.x) | ((unsigned)f2bf(v.y * (1.f + c4v.y) + s4.y) << 16);
  o.y = (unsigned)f2bf(v.z * (1.f + c4v.z) + s4.z) | ((unsigned)f2bf(v.w * (1.f + c4v.w) + s4.w) << 16);
  *(uint2*)(XM + (size_t)r * 1024 + c4) = o;
}

template <class Epi>
__global__ __launch_bounds__(256) void k_gemm_naive(const bfr* A, int lda, const float* W, int ldw, int M, int N, int K, Epi epi) {
  __shared__ float As[16][68], Ws[16][68];
  const int tid = threadIdx.x, tx = tid & 15, ty = tid >> 4;
  const int m0 = blockIdx.y * 64, n0 = blockIdx.x * 64;
  epi.setz(blockIdx.z);
  A += epi.aoff(blockIdx.z); W += epi.woff(blockIdx.z);
  float acc[4][4] = {};
  for (int k0 = 0; k0 < K; k0 += 16) {
    { int row = tid >> 2, kk = (tid & 3) * 4;
      uint2 a = *(const uint2*)(A + (size_t)(m0 + row) * lda + k0 + kk);
      As[kk + 0][row] = bf2f((bfr)(a.x & 0xffff)); As[kk + 1][row] = bf2f((bfr)(a.x >> 16));
      As[kk + 2][row] = bf2f((bfr)(a.y & 0xffff)); As[kk + 3][row] = bf2f((bfr)(a.y >> 16)); }
    { int kk = tid >> 4, n = (tid & 15) * 4;
      for (int j = 0; j < 4; ++j) Ws[kk][n + j] = (n0 + n + j < N) ? W[(size_t)(k0 + kk) * ldw + n0 + n + j] : 0.f; }
    __syncthreads();
#pragma unroll
    for (int kk = 0; kk < 16; ++kk) {
      float a[4], b[4];
#pragma unroll
      for (int i = 0; i < 4; ++i) { a[i] = As[kk][ty * 4 + i]; b[i] = Ws[kk][tx * 4 + i]; }
#pragma unroll
      for (int i = 0; i < 4; ++i)
#pragma unroll
        for (int j = 0; j < 4; ++j) acc[i][j] += a[i] * b[j];
    }
    __syncthreads();
  }
  for (int i = 0; i < 4; ++i) for (int j = 0; j < 4; ++j) {
    int row = m0 + ty * 4 + i, col = n0 + tx * 4 + j;
    if (col < N) epi(row, col, acc[i][j]);
  }
}
struct EpiBase { __device__ void setz(int) {} __device__ size_t aoff(int) { return 0; } __device__ size_t woff(int) { return 0; } };
struct EpiZ : EpiBase {
  bfr *Zc, *DQ, *DK, *DV, *SG0; float* KRraw;
  __device__ void operator()(int r, int c, float v) {
    if (c < 640) Zc[(size_t)r * 640 + c] = f2bf(v);
    else if (c < 672) KRraw[(size_t)r * 32 + c - 640] = v;
    else if (c < 1184) DQ[(size_t)r * 512 + c - 672] = f2bf(v);
    else if (c < 1696) DK[(size_t)r * 512 + c - 1184] = f2bf(v);
    else if (c < 2208) DV[(size_t)r * 512 + c - 1696] = f2bf(v);
    else SG0[(size_t)r * 1024 + c - 2208] = f2bf(silu_f(v));
  }
};
struct EpiQ : EpiBase { bfr* QA; __device__ void operator()(int r, int c, float v) { QA[(size_t)r * 768 + c] = f2bf(v); } };
struct EpiKV : EpiBase { bfr *KA, *VA;
  __device__ void operator()(int r, int c, float v) { int h = c >> 7, j = c & 127;
    if (j < 64) KA[(size_t)r * 768 + h * 96 + j] = f2bf(v); else VA[(size_t)r * 512 + h * 64 + j - 64] = f2bf(v); } };
struct EpiStore : EpiBase { bfr* C; int ldc; __device__ void operator()(int r, int c, float v) { C[(size_t)r * ldc + c] = f2bf(v); } };

__global__ __launch_bounds__(256) void k_rms_fix(bfr* Zc, const float* gq, const float* gkv) {
  __shared__ float red[8];
  int r = blockIdx.x, t = threadIdx.x;
  bfr* z = Zc + (size_t)r * 640;
  float v0 = bf2f(z[t]), v1 = (t < 128) ? bf2f(z[256 + t]) : 0.f, v2 = bf2f(z[384 + t]);
  float sq = v0 * v0 + v1 * v1, sk = v2 * v2;
  for (int o = 32; o; o >>= 1) { sq += __shfl_xor(sq, o); sk += __shfl_xor(sk, o); }
  if ((t & 63) == 0) { red[t >> 6] = sq; red[4 + (t >> 6)] = sk; }
  __syncthreads();
  float tq = red[0] + red[1] + red[2] + red[3], tk = red[4] + red[5] + red[6] + red[7];
  float rq = rsqrtf(tq / 384.f + 1e-6f), rk = rsqrtf(tk / 256.f + 1e-6f);
  z[t] = f2bf(v0 * rq * gq[t]);
  if (t < 128) z[256 + t] = f2bf(v1 * rq * gq[256 + t]);
  z[384 + t] = f2bf(v2 * rk * gkv[t]);
}
__global__ __launch_bounds__(256) void k_fix_dqk(bfr* DQ, bfr* DK, const float* KRraw, bfr* KA) {
  int r = blockIdx.x, t = threadIdx.x;
  int p = r % SEQA; bool lat = p < NLAT;
  int i = t & 31; int g = t >> 5;
  float cs = 1.f, sn = 0.f;
  if (lat) { float pos = (i < 16) ? (float)(p >> 6) : (float)(p & 63);
    float fr = powf(10000.f, -(float)(i & 15) / 16.f); float ang = pos * fr; sincosf(ang, &sn, &cs); }
  { bfr* q = DQ + (size_t)r * 512 + g * 64; float x1 = bf2f(q[i]), x2 = bf2f(q[i + 32]);
    q[i] = f2bf((x1 * cs - x2 * sn) * QSC_D); q[i + 32] = f2bf((x2 * cs + x1 * sn) * QSC_D); }
  { bfr* k = DK + (size_t)r * 512 + g * 64; float x1 = bf2f(k[i]), x2 = bf2f(k[i + 32]);
    k[i] = f2bf(x1 * cs - x2 * sn); k[i + 32] = f2bf(x2 * cs + x1 * sn); }
  if (t < 16) {
    float c2 = 1.f, s2 = 0.f;
    if (lat) { float pos = (t < 8) ? (float)(p >> 6) : (float)(p & 63);
      float fr = powf(10000.f, -(float)(t & 7) / 8.f); sincosf(pos * fr, &s2, &c2); }
    float x1 = KRraw[(size_t)r * 32 + t], x2 = KRraw[(size_t)r * 32 + t + 16];
    bfr o1 = f2bf(x1 * c2 - x2 * s2), o2 = f2bf(x2 * c2 + x1 * s2);
    for (int h = 0; h < 8; ++h) { KA[(size_t)r * 768 + h * 96 + 64 + t] = o1; KA[(size_t)r * 768 + h * 96 + 80 + t] = o2; }
  }
}
__global__ __launch_bounds__(256) void k_fix_q(bfr* QA) {
  int r = blockIdx.x, t = threadIdx.x;
  int p = r % SEQA; bool lat = p < NLAT;
  bfr* q = QA + (size_t)r * 768;
  for (int e = t; e < 512; e += 256) { int h = e >> 6, j = e & 63; q[h * 96 + j] = f2bf(bf2f(q[h * 96 + j]) * QSC_A); }
  if (t < 128) { int h = t >> 4, i = t & 15;
    float cs = 1.f, sn = 0.f;
    if (lat) { float pos = (i < 8) ? (float)(p >> 6) : (float)(p & 63);
      float fr = powf(10000.f, -(float)(i & 7) / 8.f); sincosf(pos * fr, &sn, &cs); }
    float x1 = bf2f(q[h * 96 + 64 + i]), x2 = bf2f(q[h * 96 + 80 + i]);
    q[h * 96 + 64 + i] = f2bf((x1 * cs - x2 * sn) * QSC_A); q[h * 96 + 80 + i] = f2bf((x2 * cs + x1 * sn) * QSC_A); }
}

__device__ __forceinline__ void unpack8(uint4 u, float* f) {
  f[0] = __uint_as_float(u.x << 16); f[1] = __uint_as_float(u.x & 0xffff0000u);
  f[2] = __uint_as_float(u.y << 16); f[3] = __uint_as_float(u.y & 0xffff0000u);
  f[4] = __uint_as_float(u.z << 16); f[5] = __uint_as_float(u.z & 0xffff0000u);
  f[6] = __uint_as_float(u.w << 16); f[7] = __uint_as_float(u.w & 0xffff0000u);
}
__global__ __launch_bounds__(256) void k_attn_mla_naive(const bfr* QA, const bfr* KA, const bfr* VA, const bfr* SG0, bfr* OG) {
  int tile = blockIdx.x, h = blockIdx.y;
  int b = tile / 33, tt = tile % 33;
  int r = b * SEQA + tt * 256 + threadIdx.x;
  int k0 = (tt < 32) ? b * SEQA : b * SEQA + NLAT, k1 = b * SEQA + SEQA;
  float q[96], o[64];
#pragma unroll
  for (int c = 0; c < 12; ++c) unpack8(*(const uint4*)(QA + (size_t)r * 768 + h * 96 + c * 8), q + c * 8);
#pragma unroll
  for (int d = 0; d < 64; ++d) o[d] = 0.f;
  float m = -INFINITY, l = 0.f;
  for (int kr = k0; kr < k1; ++kr) {
    const uint4* kp = (const uint4*)(KA + (size_t)kr * 768 + h * 96);
    float s = 0.f;
#pragma unroll
    for (int c = 0; c < 12; ++c) { float kf[8]; unpack8(kp[c], kf);
#pragma unroll
      for (int e = 0; e < 8; ++e) s += q[c * 8 + e] * kf[e]; }
    if (s > m) { float al = exp2f(m - s); l *= al;
#pragma unroll
      for (int d = 0; d < 64; ++d) o[d] *= al;
      m = s; }
    float pr = exp2f(s - m); l += pr;
    const uint4* vp = (const uint4*)(VA + (size_t)kr * 512 + h * 64);
#pragma unroll
    for (int c = 0; c < 8; ++c) { float vf[8]; unpack8(vp[c], vf);
#pragma unroll
      for (int e = 0; e < 8; ++e) o[c * 8 + e] += pr * vf[e]; }
  }
  float il = 1.f / l;
#pragma unroll
  for (int d = 0; d < 64; ++d) { size_t idx = (size_t)r * 1024 + h * 64 + d; OG[idx] = f2bf(o[d] * il * bf2f(SG0[idx])); }
}
__global__ __launch_bounds__(256) void k_attn_diff_naive(const bfr* DQ, const bfr* DK, const bfr* DV, const float* lamp, float* Oraw) {
  int tile = blockIdx.x, h = blockIdx.y, vq = blockIdx.z;
  int b = tile / 33, tt = tile % 33;
  int r = b * SEQA + tt * 256 + threadIdx.x;
  int k0 = (tt < 32) ? b * SEQA : b * SEQA + NLAT, k1 = b * SEQA + SEQA;
  float lam = lamp[0];
  float q[64], o[32], o1[32];
  for (int mp = 0; mp < 2; ++mp) {
#pragma unroll
    for (int c = 0; c < 8; ++c) unpack8(*(const uint4*)(DQ + (size_t)r * 512 + h * 128 + mp * 64 + c * 8), q + c * 8);
#pragma unroll
    for (int d = 0; d < 32; ++d) o[d] = 0.f;
    float m = -INFINITY, l = 0.f;
    for (int kr = k0; kr < k1; ++kr) {
      const uint4* kp = (const uint4*)(DK + (size_t)kr * 512 + h * 128 + mp * 64);
      float s = 0.f;
#pragma unroll
      for (int c = 0; c < 8; ++c) { float kf[8]; unpack8(kp[c], kf);
#pragma unroll
        for (int e = 0; e < 8; ++e) s += q[c * 8 + e] * kf[e]; }
      if (s > m) { float al = exp2f(m - s); l *= al;
#pragma unroll
        for (int d = 0; d < 32; ++d) o[d] *= al;
        m = s; }
      float pr = exp2f(s - m); l += pr;
      const uint4* vp = (const uint4*)(DV + (size_t)kr * 512 + h * 128 + vq * 32);
#pragma unroll
      for (int c = 0; c < 4; ++c) { float vf[8]; unpack8(vp[c], vf);
#pragma unroll
        for (int e = 0; e < 8; ++e) o[c * 8 + e] += pr * vf[e]; }
    }
    float il = 1.f / l;
    if (mp == 0) {
#pragma unroll
      for (int d = 0; d < 32; ++d) o1[d] = o[d] * il;
    } else {
#pragma unroll
      for (int d = 0; d < 32; ++d) Oraw[(size_t)r * 512 + h * 128 + vq * 32 + d] = o1[d] - lam * o[d] * il;
    }
  }
}
__global__ __launch_bounds__(256) void k_fix_attn(const float* Oraw, const float* subg, const bfr* SG0, bfr* OG) {
  int r = blockIdx.x, h = threadIdx.x >> 6, lane = threadIdx.x & 63;
  float v0 = Oraw[(size_t)r * 512 + h * 128 + lane * 2], v1 = Oraw[(size_t)r * 512 + h * 128 + lane * 2 + 1];
  float ss = v0 * v0 + v1 * v1;
  for (int o = 32; o; o >>= 1) ss += __shfl_xor(ss, o);
  float rs = rsqrtf(ss / 128.f + 1e-6f) * 0.8f;
  size_t idx = (size_t)r * 1024 + 512 + h * 128 + lane * 2;
  OG[idx] = f2bf(v0 * rs * subg[lane * 2] * bf2f(SG0[idx]));
  OG[idx + 1] = f2bf(v1 * rs * subg[lane * 2 + 1] * bf2f(SG0[idx + 1]));
}

__global__ __launch_bounds__(256) void k_ln0(const float* x, const float* ctx, const bfr* Y, const float* mod, const float* lng, const float* lnb,
                                             float* out, bfr* XM1) {
  int r = blockIdx.x * 4 + (threadIdx.x >> 6), lane = threadIdx.x & 63;
  int b = r / SEQA, p = r - b * SEQA; int mr = p < NLAT ? b : 4;
  const float* xin = xrow(x, ctx, r);
  const float* g = mod + mr * 3072 + 2048;
  float v[16]; float s = 0.f;
#pragma unroll
  for (int i = 0; i < 16; ++i) { int c = i * 64 + lane; v[i] = ALPHA * xin[c] + g[c] * bf2f(Y[(size_t)r * 1024 + c]); s += v[i]; }
  for (int o = 32; o; o >>= 1) s += __shfl_xor(s, o);
  float mu = s / 1024.f, q = 0.f;
#pragma unroll
  for (int i = 0; i < 16; ++i) { float d = v[i] - mu; q += d * d; }
  for (int o = 32; o; o >>= 1) q += __shfl_xor(q, o);
  float rs = rsqrtf(q / 1024.f + 1e-6f);
  const float* sh1 = mod + (5 + mr) * 3072; const float* sc1 = sh1 + 1024;
#pragma unroll
  for (int i = 0; i < 16; ++i) { int c = i * 64 + lane; float y = (v[i] - mu) * rs * lng[c] + lnb[c];
    if (p < NLAT) out[((size_t)(b * NLAT + p)) * 1024 + c] = y;
    XM1[(size_t)r * 1024 + c] = f2bf(y * (1.f + sc1[c]) + sh1[c]); }
}
__global__ __launch_bounds__(256) void k_ln1(const bfr* Y, const float* mod, const float* lng, const float* lnb, float* out) {
  int lr = blockIdx.x * 4 + (threadIdx.x >> 6), lane = threadIdx.x & 63;
  int b = lr / NLAT;
  const float* g = mod + (5 + b) * 3072 + 2048;
  float* xo = out + (size_t)lr * 1024;
  float v[16]; float s = 0.f;
#pragma unroll
  for (int i = 0; i < 16; ++i) { int c = i * 64 + lane; v[i] = ALPHA * xo[c] + g[c] * bf2f(Y[(size_t)lr * 1024 + c]); s += v[i]; }
  for (int o = 32; o; o >>= 1) s += __shfl_xor(s, o);
  float mu = s / 1024.f, q = 0.f;
#pragma unroll
  for (int i = 0; i < 16; ++i) { float d = v[i] - mu; q += d * d; }
  for (int o = 32; o; o >>= 1) q += __shfl_xor(q, o);
  float rs = rsqrtf(q / 1024.f + 1e-6f);
#pragma unroll
  for (int i = 0; i < 16; ++i) { int c = i * 64 + lane; xo[c] = (v[i] - mu) * rs * lng[c] + lnb[c]; }
}

__global__ __launch_bounds__(256) void k_conv(const bfr* UG, int ldu, const float* cw, const float* cb, bfr* UC) {
  size_t idx = (size_t)blockIdx.x * 256 + threadIdx.x;
  int r = (int)(idx >> 10), c = (int)(idx & 1023);
  int p = r % SEQA; int lo = p < NLAT ? 0 : NLAT, hi = p < NLAT ? NLAT : SEQA;
  float acc = cb[c];
  for (int j = 0; j < 4; ++j) { int pp = p + j - 2; if (pp >= lo && pp < hi) acc += cw[j * 1024 + c] * bf2f(UG[(size_t)(r + j - 2) * ldu + c]); }
  UC[(size_t)r * 1024 + c] = f2bf(acc);
}
__global__ __launch_bounds__(256) void k_scan_naive(int dir, const bfr* G, const bfr* UC, const bfr* GT, int ldg, int gsilu, const float* ba, const float* bx,
                                                    const float* lambda, bfr* HG) {
  int b = blockIdx.y, ch = blockIdx.x * 256 + threadIdx.x;
  float sp = log1pf(expf(-lambda[dir * 1024 + ch]));
  float bba = ba[dir * 1024 + ch], bbx = bx[dir * 1024 + ch];
  float h = 0.f;
  for (int step = 0; step < SEQA; ++step) {
    int p;
    if (dir == 0) p = step < NCTX ? NLAT + step : step - NCTX;
    else p = step < NCTX ? SEQA - 1 - step : NLAT - 1 - (step - NCTX);
    size_t r = (size_t)b * SEQA + p;
    float rr = sigmoid_f(bf2f(G[r * 1024 + ch]) + bba);
    float ii = sigmoid_f(bf2f(G[((size_t)RTOT + r) * 1024 + ch]) + bbx);
    float la = -8.f * rr * sp;
    float a = expf(la);
    float bb = sqrtf(-expm1f(2.f * la)) * ii * bf2f(UC[r * 1024 + ch]);
    h = a * h + bb;
    if (p < NLAT) { size_t o = ((size_t)b * NLAT + p) * 1024 + ch;
      if (dir == 0) HG[o] = f2bf(h);
      else { float hs = bf2f(HG[o]) + h; float gv = bf2f(GT[r * ldg + ch]); HG[o] = f2bf(hs * (gsilu ? gv : silu_f(gv))); } }
  }
}


using bf16x8 = __attribute__((ext_vector_type(8))) short;
using s16x4  = __attribute__((ext_vector_type(4))) short;
using f32x16 = __attribute__((ext_vector_type(16))) float;
using u32x4  = __attribute__((ext_vector_type(4))) unsigned;
constexpr int NTHR = 512;
constexpr size_t OFF_ROPED = (size_t)1 << 20;
constexpr size_t OFF_ROPEA = (size_t)3 << 20;
constexpr size_t OFF_WT    = (size_t)4 << 20;
constexpr size_t OFF_WIN0  = OFF_WT;
constexpr size_t OFF_WUQ   = OFF_WIN0 + (size_t)3328 * 1024 * 2;
constexpr size_t OFF_WUKV  = OFF_WUQ + (size_t)768 * 384 * 2;
constexpr size_t OFF_WOUT0 = OFF_WUKV + (size_t)1024 * 256 * 2;
constexpr size_t OFF_WIN1  = OFF_WOUT0 + (size_t)1024 * 1024 * 2;
constexpr size_t OFF_WG    = OFF_WIN1 + (size_t)2048 * 1024 * 2;
constexpr size_t OFF_WOUT1 = OFF_WG + (size_t)32 * 128 * 128 * 2;
static_assert(OFF_WOUT1 + (size_t)1024 * 1024 * 2 <= OFF_RA, "weights overflow");
constexpr size_t SMEM_BYTES = 2 * (256 * 72 + 128 * 72) * 2;

__device__ __forceinline__ int crow(int r, int hi) { return (r & 3) + 8 * (r >> 2) + 4 * hi; }

struct Params {
  const float *x, *c, *ctx, *c_ctx, *ada_w, *ada_b, *ln_g, *ln_b, *e_w_in, *e_qg, *e_w_uq, *e_kvg, *e_w_ukv, *lq1, *lk1, *lq2, *lk2, *subg, *e_w_out,
      *o_w_in, *conv_w, *conv_b, *ga_w, *ga_b, *gx_w, *gx_b, *lru_l, *o_w_out;
  float* out; char* ws;
};

template <int MODE>
__device__ void wt_convert(const float* __restrict__ src, int K, int ldsrc, int Nd, bfr* __restrict__ dst, const float* __restrict__ kscale,
                           float* lds, int bid, int nb) {
  const int tid = threadIdx.x, tk = K >> 6, tn = Nd >> 6;
  for (int t = bid; t < tk * tn; t += nb) {
    const int k0 = (t % tk) << 6, n0 = (t / tk) << 6;
    for (int e = tid; e < 4096; e += NTHR) { int i = e >> 6, j = e & 63; int nd = n0 + j; float v;
      if (MODE == 1) { int ns = nd < 640 ? nd : (nd < 3200 ? nd + 32 : nd - 3200 + 640); v = nd < 3232 ? src[(size_t)(k0 + i) * ldsrc + ns] : 0.f; }
      else v = src[(size_t)(k0 + i) * ldsrc + nd];
      if (kscale) v *= kscale[k0 + i];
      lds[j * 65 + i] = v; }
    __syncthreads();
    for (int e = tid; e < 4096; e += NTHR) { int j = e >> 6, i = e & 63; dst[(size_t)(n0 + j) * K + k0 + i] = f2bf(lds[j * 65 + i]); }
    __syncthreads();
  }
}
__device__ void prep_phase(const Params& p, char* smem, int bid, int nb) {
  float* lds = (float*)smem; char* ws = p.ws;
  wt_convert<1>(p.e_w_in, 1024, 3232, 3328, (bfr*)(ws + OFF_WIN0), nullptr, lds, bid, nb);
  wt_convert<0>(p.e_w_uq, 384, 768, 768, (bfr*)(ws + OFF_WUQ), p.e_qg, lds, bid, nb);
  wt_convert<0>(p.e_w_ukv, 256, 1024, 1024, (bfr*)(ws + OFF_WUKV), p.e_kvg, lds, bid, nb);
  wt_convert<0>(p.e_w_out, 1024, 1024, 1024, (bfr*)(ws + OFF_WOUT0), nullptr, lds, bid, nb);
  wt_convert<0>(p.o_w_in, 1024, 2048, 2048, (bfr*)(ws + OFF_WIN1), nullptr, lds, bid, nb);
  wt_convert<0>(p.o_w_out, 1024, 1024, 1024, (bfr*)(ws + OFF_WOUT1), nullptr, lds, bid, nb);
  for (int m = 0; m < 32; ++m) {
    int dir = m >> 4, gate = (m >> 3) & 1, blk = m & 7;
    const float* src = (gate ? p.gx_w : p.ga_w) + ((size_t)dir * 8 + blk) * 128 * 128;
    wt_convert<0>(src, 128, 128, 128, (bfr*)(ws + OFF_WG) + (size_t)m * 128 * 128, nullptr, lds, bid, nb);
  }
  float2* rd = (float2*)(ws + OFF_ROPED); float2* ra = (float2*)(ws + OFF_ROPEA);
  for (int e = bid * NTHR + threadIdx.x; e < 8192 * 32; e += nb * NTHR) { int pos = e >> 5, i = e & 31;
    float pp = (i < 16) ? (float)(pos >> 6) : (float)(pos & 63); float fr = powf(10000.f, -(float)(i & 15) / 16.f);
    float sn, cs; sincosf(pp * fr, &sn, &cs); rd[e] = make_float2(cs, sn); }
  for (int e = bid * NTHR + threadIdx.x; e < 8192 * 16; e += nb * NTHR) { int pos = e >> 4, i = e & 15;
    float pp = (i < 8) ? (float)(pos >> 6) : (float)(pos & 63); float fr = powf(10000.f, -(float)(i & 7) / 8.f);
    float sn, cs; sincosf(pp * fr, &sn, &cs); ra[e] = make_float2(cs, sn); }
}

template <class Epi>
__device__ __forceinline__ void gemm_tile(const bfr* __restrict__ A, int lda, const bfr* __restrict__ Bt, int ldb, int K, int m0, int n0, Epi& epi, char* smem) {
  const int tid = threadIdx.x, wid = tid >> 6, lane = tid & 63, wm = wid >> 1, wn = wid & 1, r32 = lane & 31, hi = lane >> 5;
  bfr* sa = (bfr*)smem; bfr* sb = sa + 2 * 256 * 72;
  f32x16 acc[2][2];
#pragma unroll
  for (int i = 0; i < 2; ++i)
#pragma unroll
    for (int j = 0; j < 2; ++j)
#pragma unroll
      for (int r = 0; r < 16; ++r) acc[i][j][r] = 0.f;
  uint4 ra0, ra1, ra2, ra3, rb0, rb1;
  const int lrow = tid >> 3, lck = (tid & 7) * 8;
  const bfr* Ap = A + (size_t)(m0 + lrow) * lda + lck;
  const bfr* Bp = Bt + (size_t)(n0 + lrow) * ldb + lck;
  const size_t a64 = (size_t)64 * lda, b64 = (size_t)64 * ldb;
  const int nk = K >> 6;
  bfr* swa = sa + lrow * 72 + lck; bfr* swb = sb + lrow * 72 + lck;
#define GLOAD(kt) do { const bfr* ap_ = Ap + (kt) * 64; const bfr* bp_ = Bp + (kt) * 64; \
    ra0 = *(const uint4*)(ap_); ra1 = *(const uint4*)(ap_ + a64); ra2 = *(const uint4*)(ap_ + 2 * a64); ra3 = *(const uint4*)(ap_ + 3 * a64); \
    rb0 = *(const uint4*)(bp_); rb1 = *(const uint4*)(bp_ + b64); } while (0)
#define SWRITE(buf) do { bfr* wa_ = swa + (buf) * 256 * 72; bfr* wb_ = swb + (buf) * 128 * 72; \
    *(uint4*)(wa_) = ra0; *(uint4*)(wa_ + 64 * 72) = ra1; *(uint4*)(wa_ + 128 * 72) = ra2; *(uint4*)(wa_ + 192 * 72) = ra3; \
    *(uint4*)(wb_) = rb0; *(uint4*)(wb_ + 64 * 72) = rb1; } while (0)
  GLOAD(0); SWRITE(0); __syncthreads();
  for (int kt = 0; kt < nk; ++kt) {
    const int cur = kt & 1;
    if (kt + 1 < nk) GLOAD(kt + 1);
    const bfr* pa = sa + cur * 256 * 72 + (wm * 64 + r32) * 72 + hi * 8;
    const bfr* pb = sb + cur * 128 * 72 + (wn * 64 + r32) * 72 + hi * 8;
#pragma unroll
    for (int ks = 0; ks < 4; ++ks) {
      bf16x8 a0 = *(const bf16x8*)(pa + ks * 16), a1 = *(const bf16x8*)(pa + 32 * 72 + ks * 16);
      bf16x8 b0 = *(const bf16x8*)(pb + ks * 16), b1 = *(const bf16x8*)(pb + 32 * 72 + ks * 16);
      acc[0][0] = __builtin_amdgcn_mfma_f32_32x32x16_bf16(a0, b0, acc[0][0], 0, 0, 0);
      acc[0][1] = __builtin_amdgcn_mfma_f32_32x32x16_bf16(a0, b1, acc[0][1], 0, 0, 0);
      acc[1][0] = __builtin_amdgcn_mfma_f32_32x32x16_bf16(a1, b0, acc[1][0], 0, 0, 0);
      acc[1][1] = __builtin_amdgcn_mfma_f32_32x32x16_bf16(a1, b1, acc[1][1], 0, 0, 0);
    }
    if (kt + 1 < nk) SWRITE(cur ^ 1);
    __syncthreads();
  }
#undef GLOAD
#undef SWRITE
  epi(m0 + wm * 64, n0 + wn * 64, acc, r32, hi);
}
template <class Epi>
__device__ void gemm_phase(const bfr* A, int lda, const bfr* Bt, int ldb, int K, int mtiles, int ntiles, Epi& epi, char* smem, int bid, int nb) {
  for (int t = bid; t < mtiles * ntiles; t += nb) { int mt = t / ntiles, nt = t - mt * ntiles; gemm_tile(A, lda, Bt, ldb, K, mt * 256, nt * 128, epi, smem); }
}
struct FEpiStore { bfr* C; int ldc;
  __device__ __forceinline__ void operator()(int m0, int n0, f32x16 (&acc)[2][2], int r32, int hi) {
#pragma unroll
    for (int mt = 0; mt < 2; ++mt)
#pragma unroll
      for (int nt = 0; nt < 2; ++nt)
#pragma unroll
        for (int r = 0; r < 16; ++r) C[(size_t)(m0 + mt * 32 + crow(r, hi)) * ldc + n0 + nt * 32 + r32] = f2bf(acc[mt][nt][r]);
  } };
struct FEpiUG { bfr *U, *SG1;
  __device__ __forceinline__ void operator()(int m0, int n0, f32x16 (&acc)[2][2], int r32, int hi) {
    const bool g = n0 >= 1024; bfr* C = g ? SG1 : U; const int nn = g ? n0 - 1024 : n0;
#pragma unroll
    for (int mt = 0; mt < 2; ++mt)
#pragma unroll
      for (int nt = 0; nt < 2; ++nt)
#pragma unroll
        for (int r = 0; r < 16; ++r) { float v = acc[mt][nt][r]; if (g) v = silu_f(v);
          C[(size_t)(m0 + mt * 32 + crow(r, hi)) * 1024 + nn + nt * 32 + r32] = f2bf(v); }
  } };
struct FEpiZ { bfr *Zc, *DQ, *DK, *DV, *SG0, *KA; const float2 *ropeD, *ropeA;
  __device__ __forceinline__ void operator()(int m0, int n0, f32x16 (&acc)[2][2], int r32, int hi) {
    const int p0 = m0 % SEQA; const bool lat = p0 < NLAT;
    if (n0 < 640) {
#pragma unroll
      for (int mt = 0; mt < 2; ++mt)
#pragma unroll
        for (int nt = 0; nt < 2; ++nt)
#pragma unroll
          for (int r = 0; r < 16; ++r) Zc[(size_t)(m0 + mt * 32 + crow(r, hi)) * 640 + n0 + nt * 32 + r32] = f2bf(acc[mt][nt][r]);
    } else if (n0 < 1664) {
      const bool isq = n0 < 1152; bfr* C = isq ? DQ : DK; const int nn = isq ? n0 - 640 : n0 - 1152; const float sc = isq ? QSC_D : 1.f;
#pragma unroll
      for (int mt = 0; mt < 2; ++mt)
#pragma unroll
        for (int r = 0; r < 16; ++r) { const int rr = mt * 32 + crow(r, hi);
          float cs = 1.f, sn = 0.f; if (lat) { float2 t = ropeD[(p0 + rr) * 32 + r32]; cs = t.x; sn = t.y; }
          float x1 = acc[mt][0][r], x2 = acc[mt][1][r];
          bfr* d = C + (size_t)(m0 + rr) * 512 + nn + r32;
          d[0] = f2bf((x1 * cs - x2 * sn) * sc); d[32] = f2bf((x2 * cs + x1 * sn) * sc); }
    } else if (n0 < 2176) {
#pragma unroll
      for (int mt = 0; mt < 2; ++mt)
#pragma unroll
        for (int nt = 0; nt < 2; ++nt)
#pragma unroll
          for (int r = 0; r < 16; ++r) DV[(size_t)(m0 + mt * 32 + crow(r, hi)) * 512 + n0 - 1664 + nt * 32 + r32] = f2bf(acc[mt][nt][r]);
    } else if (n0 < 3200) {
#pragma unroll
      for (int mt = 0; mt < 2; ++mt)
#pragma unroll
        for (int nt = 0; nt < 2; ++nt)
#pragma unroll
          for (int r = 0; r < 16; ++r) SG0[(size_t)(m0 + mt * 32 + crow(r, hi)) * 1024 + n0 - 2176 + nt * 32 + r32] = f2bf(silu_f(acc[mt][nt][r]));
    } else if (n0 == 3200) {
#pragma unroll
      for (int mt = 0; mt < 2; ++mt)
#pragma unroll
        for (int r = 0; r < 16; ++r) { const int rr = mt * 32 + crow(r, hi);
          float cs = 1.f, sn = 0.f; if (lat) { float2 t = ropeA[(p0 + rr) * 16 + (r32 & 15)]; cs = t.x; sn = t.y; }
          float xv = acc[mt][0][r]; float pv = __shfl_xor(xv, 16);
          float o = (r32 < 16) ? (xv * cs - pv * sn) : (xv * cs + pv * sn);
          bfr ob = f2bf(o); bfr* d = KA + (size_t)(m0 + rr) * 768 + 64 + r32;
#pragma unroll
          for (int h = 0; h < 8; ++h) d[h * 96] = ob; }
    }
  } };
struct FEpiQ { bfr* QA; const float2* ropeA; const float* rfac;
  __device__ __forceinline__ void operator()(int m0, int n0, f32x16 (&acc)[2][2], int r32, int hi) {
    const int p0 = m0 % SEQA; const bool lat = p0 < NLAT; const int mloc = m0 & 255;
#pragma unroll
    for (int nt = 0; nt < 2; ++nt) { const int s32 = (n0 >> 5) + nt; const bool rope = (s32 % 3) == 2;
#pragma unroll
      for (int mt = 0; mt < 2; ++mt)
#pragma unroll
        for (int r = 0; r < 16; ++r) { const int rr = mt * 32 + crow(r, hi);
          float v = acc[mt][nt][r] * rfac[mloc + rr];
          if (rope) { float cs = 1.f, sn = 0.f; if (lat) { float2 t = ropeA[(p0 + rr) * 16 + (r32 & 15)]; cs = t.x; sn = t.y; }
            float pv = __shfl_xor(v, 16); v = (r32 < 16) ? (v * cs - pv * sn) : (v * cs + pv * sn); }
          QA[(size_t)(m0 + rr) * 768 + s32 * 32 + r32] = f2bf(v * QSC_A); } }
  } };
struct FEpiKV { bfr *KA, *VA; const float* rfac;
  __device__ __forceinline__ void operator()(int m0, int n0, f32x16 (&acc)[2][2], int r32, int hi) {
    const int mloc = m0 & 255;
#pragma unroll
    for (int nt = 0; nt < 2; ++nt) { const int s32 = (n0 >> 5) + nt, h = s32 >> 2, part = s32 & 3;
      bfr* C = part < 2 ? KA + h * 96 + part * 32 : VA + h * 64 + (part - 2) * 32; const int ldc = part < 2 ? 768 : 512;
#pragma unroll
      for (int mt = 0; mt < 2; ++mt)
#pragma unroll
        for (int r = 0; r < 16; ++r) { const int rr = mt * 32 + crow(r, hi);
          C[(size_t)(m0 + rr) * ldc + r32] = f2bf(acc[mt][nt][r] * rfac[mloc + rr]); } }
  } };
__device__ void upproj_phase(const Params& p, char* smem, int bid, int nb) {
  char* ws = p.ws; const bfr* Zc = (const bfr*)(ws + OFF_RE);
  float* rfac = (float*)(smem + SMEM_BYTES);
  bfr* QA = (bfr*)(ws + OFF_RD); bfr* KA = QA + (size_t)RTOT * 768; bfr* VA = QA + (size_t)RTOT * 1536;
  FEpiQ eq; eq.QA = QA; eq.ropeA = (const float2*)(ws + OFF_ROPEA); eq.rfac = rfac;
  FEpiKV ek; ek.KA = KA; ek.VA = VA; ek.rfac = rfac;
  const int tid = threadIdx.x;
  for (int t = bid; t < 132 * 14; t += nb) {
    const int mt = t / 14, j = t - mt * 14; const bool isq = j < 6; const int m0 = mt * 256;
    {
      const int row = tid >> 1, half = tid & 1; const int ncol = isq ? 192 : 128;
      const bfr* z = Zc + (size_t)(m0 + row) * 640 + (isq ? 0 : 384) + half * ncol;
      float ss = 0.f;
      for (int c = 0; c < ncol; c += 8) { uint4 u = *(const uint4*)(z + c); float f[8]; unpack8(u, f);
#pragma unroll
        for (int e = 0; e < 8; ++e) ss += f[e] * f[e]; }
      ss += __shfl_xor(ss, 1);
      if (half == 0) rfac[row] = rsqrtf(ss / (isq ? 384.f : 256.f) + 1e-6f);
    }
    __syncthreads();
    if (isq) gemm_tile(Zc, 640, (const bfr*)(ws + OFF_WUQ), 384, 384, m0, j * 128, eq, smem);
    else gemm_tile(Zc + 384, 640, (const bfr*)(ws + OFF_WUKV), 256, 256, m0, (j - 6) * 128, ek, smem);
    __syncthreads();
  }
}

extern __shared__ __attribute__((aligned(16))) char dyn_smem[];
__global__ __launch_bounds__(512, 2) void kf_prep(Params p) { prep_phase(p, dyn_smem, blockIdx.x, gridDim.x); }
__global__ __launch_bounds__(512, 2) void kf_gemm_z(Params p) {
  char* ws = p.ws; FEpiZ e{}; e.Zc = (bfr*)(ws + OFF_RE); e.DQ = (bfr*)(ws + OFF_RC); e.DK = e.DQ + (size_t)RTOT * 512; e.DV = e.DQ + (size_t)RTOT * 1024;
  e.SG0 = (bfr*)(ws + OFF_RB); e.KA = (bfr*)(ws + OFF_RD) + (size_t)RTOT * 768; e.ropeD = (const float2*)(ws + OFF_ROPED); e.ropeA = (const float2*)(ws + OFF_ROPEA);
  gemm_phase((const bfr*)(ws + OFF_RA), 1024, (const bfr*)(ws + OFF_WIN0), 1024, 1024, 132, 26, e, dyn_smem, blockIdx.x, gridDim.x);
}
__global__ __launch_bounds__(512, 2) void kf_upproj(Params p) { upproj_phase(p, dyn_smem, blockIdx.x, gridDim.x); }
__global__ __launch_bounds__(512, 2) void kf_gemm_store(const bfr* A, const bfr* Bt, bfr* C, int mtiles, int ntiles, int K) {
  FEpiStore e{}; e.C = C; e.ldc = ntiles * 128;
  gemm_phase(A, K, Bt, K, K, mtiles, ntiles, e, dyn_smem, blockIdx.x, gridDim.x);
}
__global__ __launch_bounds__(512, 2) void kf_gemm_ug(Params p) {
  char* ws = p.ws; FEpiUG e; e.U = (bfr*)(ws + OFF_RD); e.SG1 = e.U + (size_t)RTOT * 1024;
  gemm_phase((const bfr*)(ws + OFF_RA), 1024, (const bfr*)(ws + OFF_WIN1), 1024, 1024, 132, 16, e, dyn_smem, blockIdx.x, gridDim.x);
}

#define FAST_S1 1
#define FAST_G3 1
#define FAST_Q2 1
#define FAST_G5 1
constexpr size_t SMEM_TOTAL = SMEM_BYTES + 1024;
extern "C" void kernel_launch(void* const* d_in, const int* in_sizes, int n_in, void* d_out, int out_size, void* d_ws, size_t ws_size, hipStream_t stream) {
  Params P{};
  { const float** pp = (const float**)&P; for (int i = 0; i < 28; ++i) pp[i] = (const float*)d_in[i]; }
  P.out = (float*)d_out; P.ws = (char*)d_ws;
  const float *x = P.x, *c = P.c, *ctx = P.ctx, *c_ctx = P.c_ctx, *ada_w = P.ada_w, *ada_b = P.ada_b, *ln_g = P.ln_g, *ln_b = P.ln_b, *e_w_in = P.e_w_in, *e_qg = P.e_qg,
              *e_w_uq = P.e_w_uq, *e_kvg = P.e_kvg, *e_w_ukv = P.e_w_ukv, *lq1 = P.lq1, *lk1 = P.lk1, *lq2 = P.lq2, *lk2 = P.lk2, *subg = P.subg, *e_w_out = P.e_w_out,
              *o_w_in = P.o_w_in, *conv_w = P.conv_w, *conv_b = P.conv_b, *ga_w = P.ga_w, *ga_b = P.ga_b, *gx_w = P.gx_w, *gx_b = P.gx_b, *lru_l = P.lru_l, *o_w_out = P.o_w_out;
  float* out = (float*)d_out; char* ws = (char*)d_ws;
  if (ws_size < WS_END) return;
  static int attr_done = 0;
  if (!attr_done) {
    hipFuncSetAttribute((const void*)kf_prep, hipFuncAttributeMaxDynamicSharedMemorySize, (int)SMEM_TOTAL);
    hipFuncSetAttribute((const void*)kf_gemm_z, hipFuncAttributeMaxDynamicSharedMemorySize, (int)SMEM_TOTAL);
    hipFuncSetAttribute((const void*)kf_upproj, hipFuncAttributeMaxDynamicSharedMemorySize, (int)SMEM_TOTAL);
    hipFuncSetAttribute((const void*)kf_gemm_store, hipFuncAttributeMaxDynamicSharedMemorySize, (int)SMEM_TOTAL);
    hipFuncSetAttribute((const void*)kf_gemm_ug, hipFuncAttributeMaxDynamicSharedMemorySize, (int)SMEM_TOTAL);
    attr_done = 1;
  }
  const int NB = 256;
  float* mod = (float*)(ws + OFF_MOD); float* lam = (float*)(ws + OFF_LAM);
  bfr* RA = (bfr*)(ws + OFF_RA); bfr* RB = (bfr*)(ws + OFF_RB); bfr* RC = (bfr*)(ws + OFF_RC); bfr* RE = (bfr*)(ws + OFF_RE); bfr* RD = (bfr*)(ws + OFF_RD);
  bfr* XM = RA; bfr* OG = RA; bfr* XM1 = RA; bfr* HG = RA;
  bfr* SG0 = RB; bfr* UC = RB;
  bfr* DQ = RC; bfr* DK = RC + (size_t)RTOT * 512; bfr* DV = RC + (size_t)RTOT * 1024; bfr* Y0 = RC; bfr* G = RC;
  bfr* Zc = RE; float* KRraw = (float*)(ws + OFF_RE + ((size_t)48 << 20)); float* Oraw = (float*)RE;
  bfr* QA = RD; bfr* KA = RD + (size_t)RTOT * 768; bfr* VA = RD + (size_t)RTOT * 1536; bfr* UG = RD;
  bfr* Y1 = RB;

  k_mod<<<dim3(12, 5, 2), 256, 0, stream>>>(c, c_ctx, ada_w, ada_b, mod);
  k_lam<<<1, 64, 0, stream>>>(lq1, lk1, lq2, lk2, lam);
  kf_prep<<<NB, NTHR, SMEM_TOTAL, stream>>>(P);
  k_modulate0<<<RTOT, 256, 0, stream>>>(x, ctx, mod, XM);
#if FAST_S1
  kf_gemm_z<<<NB, NTHR, SMEM_TOTAL, stream>>>(P);
  kf_upproj<<<NB, NTHR, SMEM_TOTAL, stream>>>(P);
#else
  { EpiZ e{}; e.Zc = Zc; e.DQ = DQ; e.DK = DK; e.DV = DV; e.SG0 = SG0; e.KRraw = KRraw;
    k_gemm_naive<<<dim3(51, RTOT / 64, 1), 256, 0, stream>>>(XM, 1024, e_w_in, 3232, RTOT, 3232, 1024, e); }
  k_rms_fix<<<RTOT, 256, 0, stream>>>(Zc, e_qg, e_kvg);
  k_fix_dqk<<<RTOT, 256, 0, stream>>>(DQ, DK, KRraw, KA);
  { EpiQ e{}; e.QA = QA; k_gemm_naive<<<dim3(12, RTOT / 64, 1), 256, 0, stream>>>(Zc, 640, e_w_uq, 768, RTOT, 768, 384, e); }
  { EpiKV e{}; e.KA = KA; e.VA = VA; k_gemm_naive<<<dim3(16, RTOT / 64, 1), 256, 0, stream>>>(Zc + 384, 640, e_w_ukv, 1024, RTOT, 1024, 256, e); }
  k_fix_q<<<RTOT, 256, 0, stream>>>(QA);
#endif
  k_attn_mla_naive<<<dim3(132, 8), 256, 0, stream>>>(QA, KA, VA, SG0, OG);
  k_attn_diff_naive<<<dim3(132, 4, 4), 256, 0, stream>>>(DQ, DK, DV, lam, Oraw);
  k_fix_attn<<<RTOT, 256, 0, stream>>>(Oraw, subg, SG0, OG);
#if FAST_G3
  kf_gemm_store<<<NB, NTHR, SMEM_TOTAL, stream>>>(OG, (const bfr*)(ws + OFF_WOUT0), Y0, 132, 8, 1024);
#else
  { EpiStore e{}; e.C = Y0; e.ldc = 1024; k_gemm_naive<<<dim3(16, RTOT / 64, 1), 256, 0, stream>>>(OG, 1024, e_w_out, 1024, RTOT, 1024, 1024, e); }
#endif
  k_ln0<<<RTOT / 4, 256, 0, stream>>>(x, ctx, Y0, mod, ln_g, ln_b, out, XM1);
#if FAST_Q2
  kf_gemm_ug<<<NB, NTHR, SMEM_TOTAL, stream>>>(P);
  const bfr* Uu = RD; const int ldu = 1024; const bfr* GT = RD + (size_t)RTOT * 1024; const int ldg = 1024, gsilu = 1;
#else
  { EpiStore e{}; e.C = UG; e.ldc = 2048; k_gemm_naive<<<dim3(32, RTOT / 64, 1), 256, 0, stream>>>(XM1, 1024, o_w_in, 2048, RTOT, 2048, 1024, e); }
  const bfr* Uu = UG; const int ldu = 2048; const bfr* GT = UG + 1024; const int ldg = 2048, gsilu = 0;
#endif
  k_conv<<<RTOT * 4, 256, 0, stream>>>(Uu, ldu, conv_w, conv_b, UC);
  for (int dir = 0; dir < 2; ++dir) {
    for (int gate = 0; gate < 2; ++gate) {
      const float* w = (gate == 0 ? ga_w : gx_w) + (size_t)dir * 8 * 128 * 128;
      for (int blk = 0; blk < 8; ++blk) {
        EpiStore es{}; es.C = G + (size_t)gate * RTOT * 1024 + blk * 128; es.ldc = 1024;
        k_gemm_naive<<<dim3(2, RTOT / 64, 1), 256, 0, stream>>>(UC + blk * 128, 1024, w + (size_t)blk * 128 * 128, 128, RTOT, 128, 128, es);
      }
    }
    k_scan_naive<<<dim3(4, 4), 256, 0, stream>>>(dir, G, UC, GT, ldg, gsilu, ga_b, gx_b, lru_l, HG);
  }
#if FAST_G5
  kf_gemm_store<<<NB, NTHR, SMEM_TOTAL, stream>>>(HG, (const bfr*)(ws + OFF_WOUT1), Y1, 128, 8, 1024);
#else
  { EpiStore e{}; e.C = Y1; e.ldc = 1024; k_gemm_naive<<<dim3(16, (B_ * NLAT) / 64, 1), 256, 0, stream>>>(HG, 1024, o_w_out, 1024, B_ * NLAT, 1024, 1024, e); }
#endif
  k_ln1<<<(B_ * NLAT) / 4, 256, 0, stream>>>(Y1, mod, ln_g + 1024, ln_b + 1024, out);
}
```

```cpp
#include <hip/hip_runtime.h>
#include <hip/hip_bf16.h>
#include <stdint.h>

typedef unsigned short bfr;

constexpr int B_ = 4, NLAT = 8192, NCTX = 256, SEQA = NLAT + NCTX, RTOT = B_ * SEQA, DM = 1024;
constexpr float ALPHA = 1.4142135623730951f;
constexpr float LOG2E = 1.4426950408889634f;
constexpr float QSC_A = 0.10206207261596577f * LOG2E;
constexpr float QSC_D = 0.125f * LOG2E;

constexpr size_t SZ1024 = (size_t)RTOT * 1024 * 2;
constexpr size_t SZ512  = (size_t)RTOT * 512 * 2;
constexpr size_t SZ768  = (size_t)RTOT * 768 * 2;
constexpr size_t OFF_MOD = 0;
constexpr size_t OFF_LAM = 122880;
constexpr size_t OFF_RA = (size_t)24 << 20;
constexpr size_t OFF_RB = OFF_RA + SZ1024;
constexpr size_t OFF_RC = OFF_RB + SZ1024;
constexpr size_t OFF_RE = OFF_RC + 3 * SZ512;
constexpr size_t OFF_RD = OFF_RE + SZ1024;
constexpr size_t WS_END = OFF_RD + 2 * SZ1024;

__device__ __forceinline__ float bf2f(bfr h) { return __uint_as_float(((unsigned)h) << 16); }
__device__ __forceinline__ bfr f2bf(float f) { unsigned u = __float_as_uint(f); u += 0x7fffu + ((u >> 16) & 1u); return (bfr)(u >> 16); }
__device__ __forceinline__ float silu_f(float x) { return x / (1.f + expf(-x)); }
__device__ __forceinline__ float sigmoid_f(float x) { return 1.f / (1.f + expf(-x)); }
__device__ __forceinline__ const float* xrow(const float* x, const float* ctx, int r) {
  int b = r / SEQA, p = r - b * SEQA;
  return p < NLAT ? x + ((size_t)(b * NLAT + p)) * DM : ctx + ((size_t)(b * NCTX + (p - NLAT))) * DM;
}
__device__ __forceinline__ int modrow(int r) { int b = r / SEQA, p = r - b * SEQA; return p < NLAT ? b : 4; }

__global__ __launch_bounds__(256) void k_mod(const float* c, const float* c_ctx, const float* ada_w, const float* ada_b, float* mod) {
  __shared__ float sc[1024];
  int l = blockIdx.z, mr = blockIdx.y, j = blockIdx.x * 256 + threadIdx.x;
  const float* cond = mr < 4 ? c + mr * 1024 : c_ctx;
  for (int k = threadIdx.x; k < 1024; k += 256) sc[k] = silu_f(cond[k]);
  __syncthreads();
  const float* w = ada_w + (size_t)l * 1024 * 3072 + j;
  float acc = 0;
  for (int k = 0; k < 1024; ++k) acc += sc[k] * w[(size_t)k * 3072];
  mod[(l * 5 + mr) * 3072 + j] = acc + ada_b[l * 3072 + j];
}
__global__ void k_lam(const float* q1, const float* k1, const float* q2, const float* k2, float* lam) {
  if (threadIdx.x == 0 && blockIdx.x == 0) {
    float s1 = 0, s2 = 0;
    for (int i = 0; i < 64; ++i) { s1 += q1[i] * k1[i]; s2 += q2[i] * k2[i]; }
    lam[0] = expf(s1) - expf(s2) + 0.2f;
  }
}
__global__ __launch_bounds__(256) void k_modulate0(const float* x, const float* ctx, const float* mod, bfr* XM) {
  size_t idx = (size_t)blockIdx.x * 256 + threadIdx.x;
  int r = (int)(idx >> 8), c4 = (int)(idx & 255) * 4;
  const float* src = xrow(x, ctx, r) + c4; int mr = modrow(r);
  const float* sh = mod + mr * 3072 + c4; const float* sc = sh + 1024;
  float4 v = *(const float4*)src, s4 = *(const float4*)sh, c4v = *(const float4*)sc;
  uint2 o;
  o.x = (unsigned)f2bf(v.x * (1.f + c4v.x) + s4.x) | ((unsigned)f2bf(v.y * (1.f + c4v.y) + s4.y) << 16);
  o.y = (unsigned)f2bf(v.z * (1.f + c4v.z) + s4.z) | ((unsigned)f2bf(v.w * (1.f + c4v.w) + s4.w) << 16);
  *(uint2*)(XM + (size_t)r * 1024 + c4) = o;
}

template <class Epi>
__global__ __launch_bounds__(256) void k_gemm_naive(const bfr* A, int lda, const float* W, int ldw, int M, int N, int K, Epi epi) {
  __shared__ float As[16][68], Ws[16][68];
  const int tid = threadIdx.x, tx = tid & 15, ty = tid >> 4;
  const int m0 = blockIdx.y * 64, n0 = blockIdx.x * 64;
  epi.setz(blockIdx.z);
  A += epi.aoff(blockIdx.z); W += epi.woff(blockIdx.z);
  float acc[4][4] = {};
  for (int k0 = 0; k0 < K; k0 += 16) {
    { int row = tid >> 2, kk = (tid & 3) * 4;
      uint2 a = *(const uint2*)(A + (size_t)(m0 + row) * lda + k0 + kk);
      As[kk + 0][row] = bf2f((bfr)(a.x & 0xffff)); As[kk + 1][row] = bf2f((bfr)(a.x >> 16));
      As[kk + 2][row] = bf2f((bfr)(a.y & 0xffff)); As[kk + 3][row] = bf2f((bfr)(a.y >> 16)); }
    { int kk = tid >> 4, n = (tid & 15) * 4;
      for (int j = 0; j < 4; ++j) Ws[kk][n + j] = (n0 + n + j < N) ? W[(size_t)(k0 + kk) * ldw + n0 + n + j] : 0.f; }
    __syncthreads();
#pragma unroll
    for (int kk = 0; kk < 16; ++kk) {
      float a[4], b[4];
#pragma unroll
      for (int i = 0; i < 4; ++i) { a[i] = As[kk][ty * 4 + i]; b[i] = Ws[kk][tx * 4 + i]; }
#pragma unroll
      for (int i = 0; i < 4; ++i)
#pragma unroll
        for (int j = 0; j < 4; ++j) acc[i][j] += a[i] * b[j];
    }
    __syncthreads();
  }
  for (int i = 0; i < 4; ++i) for (int j = 0; j < 4; ++j) {
    int row = m0 + ty * 4 + i, col = n0 + tx * 4 + j;
    if (col < N) epi(row, col, acc[i][j]);
  }
}
struct EpiBase { __device__ void setz(int) {} __device__ size_t aoff(int) { return 0; } __device__ size_t woff(int) { return 0; } };
struct EpiZ : EpiBase {
  bfr *Zc, *DQ, *DK, *DV, *SG0; float* KRraw;
  __device__ void operator()(int r, int c, float v) {
    if (c < 640) Zc[(size_t)r * 640 + c] = f2bf(v);
    else if (c < 672) KRraw[(size_t)r * 32 + c - 640] = v;
    else if (c < 1184) DQ[(size_t)r * 512 + c - 672] = f2bf(v);
    else if (c < 1696) DK[(size_t)r * 512 + c - 1184] = f2bf(v);
    else if (c < 2208) DV[(size_t)r * 512 + c - 1696] = f2bf(v);
    else SG0[(size_t)r * 1024 + c - 2208] = f2bf(silu_f(v));
  }
};
struct EpiQ : EpiBase { bfr* QA; __device__ void operator()(int r, int c, float v) { QA[(size_t)r * 768 + c] = f2bf(v); } };
struct EpiKV : EpiBase { bfr *KA, *VA;
  __device__ void operator()(int r, int c, float v) { int h = c >> 7, j = c & 127;
    if (j < 64) KA[(size_t)r * 768 + h * 96 + j] = f2bf(v); else VA[(size_t)r * 512 + h * 64 + j - 64] = f2bf(v); } };
struct EpiStore : EpiBase { bfr* C; int ldc; __device__ void operator()(int r, int c, float v) { C[(size_t)r * ldc + c] = f2bf(v); } };

__global__ __launch_bounds__(256) void k_rms_fix(bfr* Zc, const float* gq, const float* gkv) {
  __shared__ float red[8];
  int r = blockIdx.x, t = threadIdx.x;
  bfr* z = Zc + (size_t)r * 640;
  float v0 = bf2f(z[t]), v1 = (t < 128) ? bf2f(z[256 + t]) : 0.f, v2 = bf2f(z[384 + t]);
  float sq = v0 * v0 + v1 * v1, sk = v2 * v2;
  for (int o = 32; o; o >>= 1) { sq += __shfl_xor(sq, o); sk += __shfl_xor(sk, o); }
  if ((t & 63) == 0) { red[t >> 6] = sq; red[4 + (t >> 6)] = sk; }
  __syncthreads();
  float tq = red[0] + red[1] + red[2] + red[3], tk = red[4] + red[5] + red[6] + red[7];
  float rq = rsqrtf(tq / 384.f + 1e-6f), rk = rsqrtf(tk / 256.f + 1e-6f);
  z[t] = f2bf(v0 * rq * gq[t]);
  if (t < 128) z[256 + t] = f2bf(v1 * rq * gq[256 + t]);
  z[384 + t] = f2bf(v2 * rk * gkv[t]);
}
__global__ __launch_bounds__(256) void k_fix_dqk(bfr* DQ, bfr* DK, const float* KRraw, bfr* KA) {
  int r = blockIdx.x, t = threadIdx.x;
  int p = r % SEQA; bool lat = p < NLAT;
  int i = t & 31; int g = t >> 5;
  float cs = 1.f, sn = 0.f;
  if (lat) { float pos = (i < 16) ? (float)(p >> 6) : (float)(p & 63);
    float fr = powf(10000.f, -(float)(i & 15) / 16.f); float ang = pos * fr; sincosf(ang, &sn, &cs); }
  { bfr* q = DQ + (size_t)r * 512 + g * 64; float x1 = bf2f(q[i]), x2 = bf2f(q[i + 32]);
    q[i] = f2bf((x1 * cs - x2 * sn) * QSC_D); q[i + 32] = f2bf((x2 * cs + x1 * sn) * QSC_D); }
  { bfr* k = DK + (size_t)r * 512 + g * 64; float x1 = bf2f(k[i]), x2 = bf2f(k[i + 32]);
    k[i] = f2bf(x1 * cs - x2 * sn); k[i + 32] = f2bf(x2 * cs + x1 * sn); }
  if (t < 16) {
    float c2 = 1.f, s2 = 0.f;
    if (lat) { float pos = (t < 8) ? (float)(p >> 6) : (float)(p & 63);
      float fr = powf(10000.f, -(float)(t & 7) / 8.f); sincosf(pos * fr, &s2, &c2); }
    float x1 = KRraw[(size_t)r * 32 + t], x2 = KRraw[(size_t)r * 32 + t + 16];
    bfr o1 = f2bf(x1 * c2 - x2 * s2), o2 = f2bf(x2 * c2 + x1 * s2);
    for (int h = 0; h < 8; ++h) { KA[(size_t)r * 768 + h * 96 + 64 + t] = o1; KA[(size_t)r * 768 + h * 96 + 80 + t] = o2; }
  }
}
__global__ __launch_bounds__(256) void k_fix_q(bfr* QA) {
  int r = blockIdx.x, t = threadIdx.x;
  int p = r % SEQA; bool lat = p < NLAT;
  bfr* q = QA + (size_t)r * 768;
  for (int e = t; e < 512; e += 256) { int h = e >> 6, j = e & 63; q[h * 96 + j] = f2bf(bf2f(q[h * 96 + j]) * QSC_A); }
  if (t < 128) { int h = t >> 4, i = t & 15;
    float cs = 1.f, sn = 0.f;
    if (lat) { float pos = (i < 8) ? (float)(p >> 6) : (float)(p & 63);
      float fr = powf(10000.f, -(float)(i & 7) / 8.f); sincosf(pos * fr, &sn, &cs); }
    float x1 = bf2f(q[h * 96 + 64 + i]), x2 = bf2f(q[h * 96 + 80 + i]);
    q[h * 96 + 64 + i] = f2bf((x1 * cs - x2 * sn) * QSC_A); q[h * 96 + 80 + i] = f2bf((x2 * cs + x1 * sn) * QSC_A); }
}

__device__ __forceinline__ void unpack8(uint4 u, float* f) {
  f[0] = __uint_as_float(u.x << 16); f[1] = __uint_as_float(u.x & 0xffff0000u);
  f[2] = __uint_as_float(u.y << 16); f[3] = __uint_as_float(u.y & 0xffff0000u);
  f[4] = __uint_as_float(u.z << 16); f[5] = __uint_as_float(u.z & 0xffff0000u);
  f[6] = __uint_as_float(u.w << 16); f[7] = __uint_as_float(u.w & 0xffff0000u);
}
__global__ __launch_bounds__(256) void k_attn_mla_naive(const bfr* QA, const bfr* KA, const bfr* VA, const bfr* SG0, bfr* OG) {
  int tile = blockIdx.x, h = blockIdx.y;
  int b = tile / 33, tt = tile % 33;
  int r = b * SEQA + tt * 256 + threadIdx.x;
  int k0 = (tt < 32) ? b * SEQA : b * SEQA + NLAT, k1 = b * SEQA + SEQA;
  float q[96], o[64];
#pragma unroll
  for (int c = 0; c < 12; ++c) unpack8(*(const uint4*)(QA + (size_t)r * 768 + h * 96 + c * 8), q + c * 8);
#pragma unroll
  for (int d = 0; d < 64; ++d) o[d] = 0.f;
  float m = -INFINITY, l = 0.f;
  for (int kr = k0; kr < k1; ++kr) {
    const uint4* kp = (const uint4*)(KA + (size_t)kr * 768 + h * 96);
    float s = 0.f;
#pragma unroll
    for (int c = 0; c < 12; ++c) { float kf[8]; unpack8(kp[c], kf);
#pragma unroll
      for (int e = 0; e < 8; ++e) s += q[c * 8 + e] * kf[e]; }
    if (s > m) { float al = exp2f(m - s); l *= al;
#pragma unroll
      for (int d = 0; d < 64; ++d) o[d] *= al;
      m = s; }
    float pr = exp2f(s - m); l += pr;
    const uint4* vp = (const uint4*)(VA + (size_t)kr * 512 + h * 64);
#pragma unroll
    for (int c = 0; c < 8; ++c) { float vf[8]; unpack8(vp[c], vf);
#pragma unroll
      for (int e = 0; e < 8; ++e) o[c * 8 + e] += pr * vf[e]; }
  }
  float il = 1.f / l;
#pragma unroll
  for (int d = 0; d < 64; ++d) { size_t idx = (size_t)r * 1024 + h * 64 + d; OG[idx] = f2bf(o[d] * il * bf2f(SG0[idx])); }
}
__global__ __launch_bounds__(256) void k_attn_diff_naive(const bfr* DQ, const bfr* DK, const bfr* DV, const float* lamp, float* Oraw) {
  int tile = blockIdx.x, h = blockIdx.y, vq = blockIdx.z;
  int b = tile / 33, tt = tile % 33;
  int r = b * SEQA + tt * 256 + threadIdx.x;
  int k0 = (tt < 32) ? b * SEQA : b * SEQA + NLAT, k1 = b * SEQA + SEQA;
  float lam = lamp[0];
  float q[64], o[32], o1[32];
  for (int mp = 0; mp < 2; ++mp) {
#pragma unroll
    for (int c = 0; c < 8; ++c) unpack8(*(const uint4*)(DQ + (size_t)r * 512 + h * 128 + mp * 64 + c * 8), q + c * 8);
#pragma unroll
    for (int d = 0; d < 32; ++d) o[d] = 0.f;
    float m = -INFINITY, l = 0.f;
    for (int kr = k0; kr < k1; ++kr) {
      const uint4* kp = (const uint4*)(DK + (size_t)kr * 512 + h * 128 + mp * 64);
      float s = 0.f;
#pragma unroll
      for (int c = 0; c < 8; ++c) { float kf[8]; unpack8(kp[c], kf);
#pragma unroll
        for (int e = 0; e < 8; ++e) s += q[c * 8 + e] * kf[e]; }
      if (s > m) { float al = exp2f(m - s); l *= al;
#pragma unroll
        for (int d = 0; d < 32; ++d) o[d] *= al;
        m = s; }
      float pr = exp2f(s - m); l += pr;
      const uint4* vp = (const uint4*)(DV + (size_t)kr * 512 + h * 128 + vq * 32);
#pragma unroll
      for (int c = 0; c < 4; ++c) { float vf[8]; unpack8(vp[c], vf);
#pragma unroll
        for (int e = 0; e < 8; ++e) o[c * 8 + e] += pr * vf[e]; }
    }
    float il = 1.f / l;
    if (mp == 0) {
#pragma unroll
      for (int d = 0; d < 32; ++d) o1[d] = o[d] * il;
    } else {
#pragma unroll
      for (int d = 0; d < 32; ++d) Oraw[(size_t)r * 512 + h * 128 + vq * 32 + d] = o1[d] - lam * o[d] * il;
    }
  }
}
__global__ __launch_bounds__(256) void k_fix_attn(const float* Oraw, const float* subg, const bfr* SG0, bfr* OG) {
  int r = blockIdx.x, h = threadIdx.x >> 6, lane = threadIdx.x & 63;
  float v0 = Oraw[(size_t)r * 512 + h * 128 + lane * 2], v1 = Oraw[(size_t)r * 512 + h * 128 + lane * 2 + 1];
  float ss = v0 * v0 + v1 * v1;
  for (int o = 32; o; o >>= 1) ss += __shfl_xor(ss, o);
  float rs = rsqrtf(ss / 128.f + 1e-6f) * 0.8f;
  size_t idx = (size_t)r * 1024 + 512 + h * 128 + lane * 2;
  OG[idx] = f2bf(v0 * rs * subg[lane * 2] * bf2f(SG0[idx]));
  OG[idx + 1] = f2bf(v1 * rs * subg[lane * 2 + 1] * bf2f(SG0[idx + 1]));
}

__global__ __launch_bounds__(256) void k_ln0(const float* x, const float* ctx, const bfr* Y, const float* mod, const float* lng, const float* lnb,
                                             float* out, bfr* XM1) {
  int r = blockIdx.x * 4 + (threadIdx.x >> 6), lane = threadIdx.x & 63;
  int b = r / SEQA, p = r - b * SEQA; int mr = p < NLAT ? b : 4;
  const float* xin = xrow(x, ctx, r);
  const float* g = mod + mr * 3072 + 2048;
  float v[16]; float s = 0.f;
#pragma unroll
  for (int i = 0; i < 16; ++i) { int c = i * 64 + lane; v[i] = ALPHA * xin[c] + g[c] * bf2f(Y[(size_t)r * 1024 + c]); s += v[i]; }
  for (int o = 32; o; o >>= 1) s += __shfl_xor(s, o);
  float mu = s / 1024.f, q = 0.f;
#pragma unroll
  for (int i = 0; i < 16; ++i) { float d = v[i] - mu; q += d * d; }
  for (int o = 32; o; o >>= 1) q += __shfl_xor(q, o);
  float rs = rsqrtf(q / 1024.f + 1e-6f);
  const float* sh1 = mod + (5 + mr) * 3072; const float* sc1 = sh1 + 1024;
#pragma unroll
  for (int i = 0; i < 16; ++i) { int c = i * 64 + lane; float y = (v[i] - mu) * rs * lng[c] + lnb[c];
    if (p < NLAT) out[((size_t)(b * NLAT + p)) * 1024 + c] = y;
    XM1[(size_t)r * 1024 + c] = f2bf(y * (1.f + sc1[c]) + sh1[c]); }
}
__global__ __launch_bounds__(256) void k_ln1(const bfr* Y, const float* mod, const float* lng, const float* lnb, float* out) {
  int lr = blockIdx.x * 4 + (threadIdx.x >> 6), lane = threadIdx.x & 63;
  int b = lr / NLAT;
  const float* g = mod + (5 + b) * 3072 + 2048;
  float* xo = out + (size_t)lr * 1024;
  float v[16]; float s = 0.f;
#pragma unroll
  for (int i = 0; i < 16; ++i) { int c = i * 64 + lane; v[i] = ALPHA * xo[c] + g[c] * bf2f(Y[(size_t)lr * 1024 + c]); s += v[i]; }
  for (int o = 32; o; o >>= 1) s += __shfl_xor(s, o);
  float mu = s / 1024.f, q = 0.f;
#pragma unroll
  for (int i = 0; i < 16; ++i) { float d = v[i] - mu; q += d * d; }
  for (int o = 32; o; o >>= 1) q += __shfl_xor(q, o);
  float rs = rsqrtf(q / 1024.f + 1e-6f);
#pragma unroll
  for (int i = 0; i < 16; ++i) { int c = i * 64 + lane; xo[c] = (v[i] - mu) * rs * lng[c] + lnb[c]; }
}

__global__ __launch_bounds__(256) void k_conv(const bfr* UG, int ldu, const float* cw, const float* cb, bfr* UC) {
  size_t idx = (size_t)blockIdx.x * 256 + threadIdx.x;
  int r = (int)(idx >> 10), c = (int)(idx & 1023);
  int p = r % SEQA; int lo = p < NLAT ? 0 : NLAT, hi = p < NLAT ? NLAT : SEQA;
  float acc = cb[c];
  for (int j = 0; j < 4; ++j) { int pp = p + j - 2; if (pp >= lo && pp < hi) acc += cw[j * 1024 + c] * bf2f(UG[(size_t)(r + j - 2) * ldu + c]); }
  UC[(size_t)r * 1024 + c] = f2bf(acc);
}
__global__ __launch_bounds__(256) void k_scan_naive(int dir, const bfr* G, const bfr* UC, const bfr* GT, int ldg, int gsilu, const float* ba, const float* bx,
                                                    const float* lambda, bfr* HG) {
  int b = blockIdx.y, ch = blockIdx.x * 256 + threadIdx.x;
  float sp = log1pf(expf(-lambda[dir * 1024 + ch]));
  float bba = ba[dir * 1024 + ch], bbx = bx[dir * 1024 + ch];
  float h = 0.f;
  for (int step = 0; step < SEQA; ++step) {
    int p;
    if (dir == 0) p = step < NCTX ? NLAT + step : step - NCTX;
    else p = step < NCTX ? SEQA - 1 - step : NLAT - 1 - (step - NCTX);
    size_t r = (size_t)b * SEQA + p;
    float rr = sigmoid_f(bf2f(G[r * 1024 + ch]) + bba);
    float ii = sigmoid_f(bf2f(G[((size_t)RTOT + r) * 1024 + ch]) + bbx);
    float la = -8.f * rr * sp;
    float a = expf(la);
    float bb = sqrtf(-expm1f(2.f * la)) * ii * bf2f(UC[r * 1024 + ch]);
    h = a * h + bb;
    if (p < NLAT) { size_t o = ((size_t)b * NLAT + p) * 1024 + ch;
      if (dir == 0) HG[o] = f2bf(h);
      else { float hs = bf2f(HG[o]) + h; float gv = bf2f(GT[r * ldg + ch]); HG[o] = f2bf(hs * (gsilu ? gv : silu_f(gv))); } }
  }
}


using bf16x8 = __attribute__((ext_vector_type(8))) short;
using s16x4  = __attribute__((ext_vector_type(4))) short;
using f32x16 = __attribute__((ext_vector_type(16))) float;
using u32x4  = __attribute__((ext_vector_type(4))) unsigned;
constexpr int NTHR = 512;
constexpr size_t OFF_ROPED = (size_t)1 << 20;
constexpr size_t OFF_ROPEA = (size_t)3 << 20;
constexpr size_t OFF_WT    = (size_t)4 << 20;
constexpr size_t OFF_WIN0  = OFF_WT;
constexpr size_t OFF_WUQ   = OFF_WIN0 + (size_t)3328 * 1024 * 2;
constexpr size_t OFF_WUKV  = OFF_WUQ + (size_t)768 * 384 * 2;
constexpr size_t OFF_WOUT0 = OFF_WUKV + (size_t)1024 * 256 * 2;
constexpr size_t OFF_WIN1  = OFF_WOUT0 + (size_t)1024 * 1024 * 2;
constexpr size_t OFF_WG    = OFF_WIN1 + (size_t)2048 * 1024 * 2;
constexpr size_t OFF_WOUT1 = OFF_WG + (size_t)32 * 128 * 128 * 2;
static_assert(OFF_WOUT1 + (size_t)1024 * 1024 * 2 <= OFF_RA, "weights overflow");
constexpr size_t SMEM_BYTES = 2 * (256 * 72 + 128 * 72) * 2;

__device__ __forceinline__ int crow(int r, int hi) { return (r & 3) + 8 * (r >> 2) + 4 * hi; }

struct Params {
  const float *x, *c, *ctx, *c_ctx, *ada_w, *ada_b, *ln_g, *ln_b, *e_w_in, *e_qg, *e_w_uq, *e_kvg, *e_w_ukv, *lq1, *lk1, *lq2, *lk2, *subg, *e_w_out,
      *o_w_in, *conv_w, *conv_b, *ga_w, *ga_b, *gx_w, *gx_b, *lru_l, *o_w_out;
  float* out; char* ws;
};

template <int MODE>
__device__ void wt_convert(const float* __restrict__ src, int K, int ldsrc, int Nd, bfr* __restrict__ dst, const float* __restrict__ kscale,
                           float* lds, int bid, int nb) {
  const int tid = threadIdx.x, tk = K >> 6, tn = Nd >> 6;
  for (int t = bid; t < tk * tn; t += nb) {
    const int k0 = (t % tk) << 6, n0 = (t / tk) << 6;
    for (int e = tid; e < 4096; e += NTHR) { int i = e >> 6, j = e & 63; int nd = n0 + j; float v;
      if (MODE == 1) { int ns = nd < 640 ? nd : (nd < 3200 ? nd + 32 : nd - 3200 + 640); v = nd < 3232 ? src[(size_t)(k0 + i) * ldsrc + ns] : 0.f; }
      else v = src[(size_t)(k0 + i) * ldsrc + nd];
      if (kscale) v *= kscale[k0 + i];
      lds[j * 65 + i] = v; }
    __syncthreads();
    for (int e = tid; e < 4096; e += NTHR) { int j = e >> 6, i = e & 63; dst[(size_t)(n0 + j) * K + k0 + i] = f2bf(lds[j * 65 + i]); }
    __syncthreads();
  }
}
__device__ void prep_phase(const Params& p, char* smem, int bid, int nb) {
  float* lds = (float*)smem; char* ws = p.ws;
  wt_convert<1>(p.e_w_in, 1024, 3232, 3328, (bfr*)(ws + OFF_WIN0), nullptr, lds, bid, nb);
  wt_convert<0>(p.e_w_uq, 384, 768, 768, (bfr*)(ws + OFF_WUQ), p.e_qg, lds, bid, nb);
  wt_convert<0>(p.e_w_ukv, 256, 1024, 1024, (bfr*)(ws + OFF_WUKV), p.e_kvg, lds, bid, nb);
  wt_convert<0>(p.e_w_out, 1024, 1024, 1024, (bfr*)(ws + OFF_WOUT0), nullptr, lds, bid, nb);
  wt_convert<0>(p.o_w_in, 1024, 2048, 2048, (bfr*)(ws + OFF_WIN1), nullptr, lds, bid, nb);
  wt_convert<0>(p.o_w_out, 1024, 1024, 1024, (bfr*)(ws + OFF_WOUT1), nullptr, lds, bid, nb);
  for (int m = 0; m < 32; ++m) {
    int dir = m >> 4, gate = (m >> 3) & 1, blk = m & 7;
    const float* src = (gate ? p.gx_w : p.ga_w) + ((size_t)dir * 8 + blk) * 128 * 128;
    wt_convert<0>(src, 128, 128, 128, (bfr*)(ws + OFF_WG) + (size_t)m * 128 * 128, nullptr, lds, bid, nb);
  }
  float2* rd = (float2*)(ws + OFF_ROPED); float2* ra = (float2*)(ws + OFF_ROPEA);
  for (int e = bid * NTHR + threadIdx.x; e < 8192 * 32; e += nb * NTHR) { int pos = e >> 5, i = e & 31;
    float pp = (i < 16) ? (float)(pos >> 6) : (float)(pos & 63); float fr = powf(10000.f, -(float)(i & 15) / 16.f);
    float sn, cs; sincosf(pp * fr, &sn, &cs); rd[e] = make_float2(cs, sn); }
  for (int e = bid * NTHR + threadIdx.x; e < 8192 * 16; e += nb * NTHR) { int pos = e >> 4, i = e & 15;
    float pp = (i < 8) ? (float)(pos >> 6) : (float)(pos & 63); float fr = powf(10000.f, -(float)(i & 7) / 8.f);
    float sn, cs; sincosf(pp * fr, &sn, &cs); ra[e] = make_float2(cs, sn); }
}

template <class Epi>
__device__ __forceinline__ void gemm_tile(const bfr* __restrict__ A, int lda, const bfr* __restrict__ Bt, int ldb, int K, int m0, int n0, Epi& epi, char* smem) {
  const int tid = threadIdx.x, wid = tid >> 6, lane = tid & 63, wm = wid >> 1, wn = wid & 1, r32 = lane & 31, hi = lane >> 5;
  bfr* sa = (bfr*)smem; bfr* sb = sa + 2 * 256 * 72;
  f32x16 acc[2][2];
#pragma unroll
  for (int i = 0; i < 2; ++i)
#pragma unroll
    for (int j = 0; j < 2; ++j)
#pragma unroll
      for (int r = 0; r < 16; ++r) acc[i][j][r] = 0.f;
  uint4 ra0, ra1, ra2, ra3, rb0, rb1;
  const int lrow = tid >> 3, lck = (tid & 7) * 8;
  const bfr* Ap = A + (size_t)(m0 + lrow) * lda + lck;
  const bfr* Bp = Bt + (size_t)(n0 + lrow) * ldb + lck;
  const size_t a64 = (size_t)64 * lda, b64 = (size_t)64 * ldb;
  const int nk = K >> 6;
  bfr* swa = sa + lrow * 72 + lck; bfr* swb = sb + lrow * 72 + lck;
#define GLOAD(kt) do { const bfr* ap_ = Ap + (kt) * 64; const bfr* bp_ = Bp + (kt) * 64; \
    ra0 = *(const uint4*)(ap_); ra1 = *(const uint4*)(ap_ + a64); ra2 = *(const uint4*)(ap_ + 2 * a64); ra3 = *(const uint4*)(ap_ + 3 * a64); \
    rb0 = *(const uint4*)(bp_); rb1 = *(const uint4*)(bp_ + b64); } while (0)
#define SWRITE(buf) do { bfr* wa_ = swa + (buf) * 256 * 72; bfr* wb_ = swb + (buf) * 128 * 72; \
    *(uint4*)(wa_) = ra0; *(uint4*)(wa_ + 64 * 72) = ra1; *(uint4*)(wa_ + 128 * 72) = ra2; *(uint4*)(wa_ + 192 * 72) = ra3; \
    *(uint4*)(wb_) = rb0; *(uint4*)(wb_ + 64 * 72) = rb1; } while (0)
  GLOAD(0); SWRITE(0); __syncthreads();
  for (int kt = 0; kt < nk; ++kt) {
    const int cur = kt & 1;
    if (kt + 1 < nk) GLOAD(kt + 1);
    const bfr* pa = sa + cur * 256 * 72 + (wm * 64 + r32) * 72 + hi * 8;
    const bfr* pb = sb + cur * 128 * 72 + (wn * 64 + r32) * 72 + hi * 8;
#pragma unroll
    for (int ks = 0; ks < 4; ++ks) {
      bf16x8 a0 = *(const bf16x8*)(pa + ks * 16), a1 = *(const bf16x8*)(pa + 32 * 72 + ks * 16);
      bf16x8 b0 = *(const bf16x8*)(pb + ks * 16), b1 = *(const bf16x8*)(pb + 32 * 72 + ks * 16);
      acc[0][0] = __builtin_amdgcn_mfma_f32_32x32x16_bf16(a0, b0, acc[0][0], 0, 0, 0);
      acc[0][1] = __builtin_amdgcn_mfma_f32_32x32x16_bf16(a0, b1, acc[0][1], 0, 0, 0);
      acc[1][0] = __builtin_amdgcn_mfma_f32_32x32x16_bf16(a1, b0, acc[1][0], 0, 0, 0);
      acc[1][1] = __builtin_amdgcn_mfma_f32_32x32x16_bf16(a1, b1, acc[1][1], 0, 0, 0);
    }
    if (kt + 1 < nk) SWRITE(cur ^ 1);
    __syncthreads();
  }
#undef GLOAD
#undef SWRITE
  epi(m0 + wm * 64, n0 + wn * 64, acc, r32, hi);
}
template <class Epi>
__device__ void gemm_phase(const bfr* A, int lda, const bfr* Bt, int ldb, int K, int mtiles, int ntiles, Epi& epi, char* smem, int bid, int nb) {
  for (int t = bid; t < mtiles * ntiles; t += nb) { int mt = t / ntiles, nt = t - mt * ntiles; gemm_tile(A, lda, Bt, ldb, K, mt * 256, nt * 128, epi, smem); }
}
struct FEpiStore { bfr* C; int ldc;
  __device__ __forceinline__ void operator()(int m0, int n0, f32x16 (&acc)[2][2], int r32, int hi) {
#pragma unroll
    for (int mt = 0; mt < 2; ++mt)
#pragma unroll
      for (int nt = 0; nt < 2; ++nt)
#pragma unroll
        for (int r = 0; r < 16; ++r) C[(size_t)(m0 + mt * 32 + crow(r, hi)) * ldc + n0 + nt * 32 + r32] = f2bf(acc[mt][nt][r]);
  } };
struct FEpiUG { bfr *U, *SG1;
  __device__ __forceinline__ void operator()(int m0, int n0, f32x16 (&acc)[2][2], int r32, int hi) {
    const bool g = n0 >= 1024; bfr* C = g ? SG1 : U; const int nn = g ? n0 - 1024 : n0;
#pragma unroll
    for (int mt = 0; mt < 2; ++mt)
#pragma unroll
      for (int nt = 0; nt < 2; ++nt)
#pragma unroll
        for (int r = 0; r < 16; ++r) { float v = acc[mt][nt][r]; if (g) v = silu_f(v);
          C[(size_t)(m0 + mt * 32 + crow(r, hi)) * 1024 + nn + nt * 32 + r32] = f2bf(v); }
  } };
struct FEpiZ { bfr *Zc, *DQ, *DK, *DV, *SG0, *KA; const float2 *ropeD, *ropeA;
  __device__ __forceinline__ void operator()(int m0, int n0, f32x16 (&acc)[2][2], int r32, int hi) {
    const int p0 = m0 % SEQA; const bool lat = p0 < NLAT;
    if (n0 < 640) {
#pragma unroll
      for (int mt = 0; mt < 2; ++mt)
#pragma unroll
        for (int nt = 0; nt < 2; ++nt)
#pragma unroll
          for (int r = 0; r < 16; ++r) Zc[(size_t)(m0 + mt * 32 + crow(r, hi)) * 640 + n0 + nt * 32 + r32] = f2bf(acc[mt][nt][r]);
    } else if (n0 < 1664) {
      const bool isq = n0 < 1152; bfr* C = isq ? DQ : DK; const int nn = isq ? n0 - 640 : n0 - 1152; const float sc = isq ? QSC_D : 1.f;
#pragma unroll
      for (int mt = 0; mt < 2; ++mt)
#pragma unroll
        for (int r = 0; r < 16; ++r) { const int rr = mt * 32 + crow(r, hi);
          float cs = 1.f, sn = 0.f; if (lat) { float2 t = ropeD[(p0 + rr) * 32 + r32]; cs = t.x; sn = t.y; }
          float x1 = acc[mt][0][r], x2 = acc[mt][1][r];
          bfr* d = C + (size_t)(m0 + rr) * 512 + nn + r32;
          d[0] = f2bf((x1 * cs - x2 * sn) * sc); d[32] = f2bf((x2 * cs + x1 * sn) * sc); }
    } else if (n0 < 2176) {
#pragma unroll
      for (int mt = 0; mt < 2; ++mt)
#pragma unroll
        for (int nt = 0; nt < 2; ++nt)
#pragma unroll
          for (int r = 0; r < 16; ++r) DV[(size_t)(m0 + mt * 32 + crow(r, hi)) * 512 + n0 - 1664 + nt * 32 + r32] = f2bf(acc[mt][nt][r]);
    } else if (n0 < 3200) {
#pragma unroll
      for (int mt = 0; mt < 2; ++mt)
#pragma unroll
        for (int nt = 0; nt < 2; ++nt)
#pragma unroll
          for (int r = 0; r < 16; ++r) SG0[(size_t)(m0 + mt * 32 + crow(r, hi)) * 1024 + n0 - 2176 + nt * 32 + r32] = f2bf(silu_f(acc[mt][nt][r]));
    } else if (n0 == 3200) {
#pragma unroll
      for (int mt = 0; mt < 2; ++mt)
#pragma unroll
        for (int r = 0; r < 16; ++r) { const int rr = mt * 32 + crow(r, hi);
          float cs = 1.f, sn = 0.f; if (lat) { float2 t = ropeA[(p0 + rr) * 16 + (r32 & 15)]; cs = t.x; sn = t.y; }
          float xv = acc[mt][0][r]; float pv = __shfl_xor(xv, 16);
          float o = (r32 < 16) ? (xv * cs - pv * sn) : (xv * cs + pv * sn);
          bfr ob = f2bf(o); bfr* d = KA + (size_t)(m0 + rr) * 768 + 64 + r32;
#pragma unroll
          for (int h = 0; h < 8; ++h) d[h * 96] = ob; }
    }
  } };
struct FEpiQ { bfr* QA; const float2* ropeA; const float* rfac;
  __device__ __forceinline__ void operator()(int m0, int n0, f32x16 (&acc)[2][2], int r32, int hi) {
    const int p0 = m0 % SEQA; const bool lat = p0 < NLAT; const int mloc = m0 & 255;
#pragma unroll
    for (int nt = 0; nt < 2; ++nt) { const int s32 = (n0 >> 5) + nt; const bool rope = (s32 % 3) == 2;
#pragma unroll
      for (int mt = 0; mt < 2; ++mt)
#pragma unroll
        for (int r = 0; r < 16; ++r) { const int rr = mt * 32 + crow(r, hi);
          float v = acc[mt][nt][r] * rfac[mloc + rr];
          if (rope) { float cs = 1.f, sn = 0.f; if (lat) { float2 t = ropeA[(p0 + rr) * 16 + (r32 & 15)]; cs = t.x; sn = t.y; }
            float pv = __shfl_xor(v, 16); v = (r32 < 16) ? (v * cs - pv * sn) : (v * cs + pv * sn); }
          QA[(size_t)(m0 + rr) * 768 + s32 * 32 + r32] = f2bf(v * QSC_A); } }
  } };
struct FEpiKV { bfr *KA, *VA; const float* rfac;
  __device__ __forceinline__ void operator()(int m0, int n0, f32x16 (&acc)[2][2], int r32, int hi) {
    const int mloc = m0 & 255;
#pragma unroll
    for (int nt = 0; nt < 2; ++nt) { const int s32 = (n0 >> 5) + nt, h = s32 >> 2, part = s32 & 3;
      bfr* C = part < 2 ? KA + h * 96 + part * 32 : VA + h * 64 + (part - 2) * 32; const int ldc = part < 2 ? 768 : 512;
#pragma unroll
      for (int mt = 0; mt < 2; ++mt)
#pragma unroll
        for (int r = 0; r < 16; ++r) { const int rr = mt * 32 + crow(r, hi);
          C[(size_t)(m0 + rr) * ldc + r32] = f2bf(acc[mt][nt][r] * rfac[mloc + rr]); } }
  } };
__device__ void upproj_phase(const Params& p, char* smem, int bid, int nb) {
  char* ws = p.ws; const bfr* Zc = (const bfr*)(ws + OFF_RE);
  float* rfac = (float*)(smem + SMEM_BYTES);
  bfr* QA = (bfr*)(ws + OFF_RD); bfr* KA = QA + (size_t)RTOT * 768; bfr* VA = QA + (size_t)RTOT * 1536;
  FEpiQ eq; eq.QA = QA; eq.ropeA = (const float2*)(ws + OFF_ROPEA); eq.rfac = rfac;
  FEpiKV ek; ek.KA = KA; ek.VA = VA; ek.rfac = rfac;
  const int tid = threadIdx.x;
  for (int t = bid; t < 132 * 14; t += nb) {
    const int mt = t / 14, j = t - mt * 14; const bool isq = j < 6; const int m0 = mt * 256;
    {
      const int row = tid >> 1, half = tid & 1; const int ncol = isq ? 192 : 128;
      const bfr* z = Zc + (size_t)(m0 + row) * 640 + (isq ? 0 : 384) + half * ncol;
      float ss = 0.f;
      for (int c = 0; c < ncol; c += 8) { uint4 u = *(const uint4*)(z + c); float f[8]; unpack8(u, f);
#pragma unroll
        for (int e = 0; e < 8; ++e) ss += f[e] * f[e]; }
      ss += __shfl_xor(ss, 1);
      if (half == 0) rfac[row] = rsqrtf(ss / (isq ? 384.f : 256.f) + 1e-6f);
    }
    __syncthreads();
    if (isq) gemm_tile(Zc, 640, (const bfr*)(ws + OFF_WUQ), 384, 384, m0, j * 128, eq, smem);
    else gemm_tile(Zc + 384, 640, (const bfr*)(ws + OFF_WUKV), 256, 256, m0, (j - 6) * 128, ek, smem);
    __syncthreads();
  }
}


constexpr int SHM_KV = 64 * 256;
constexpr float THR2 = 11.5f;
#define KSWZ(row, colB) ((row) * 256 + ((colB) ^ (((row) & 7) << 4)))
#define SBAR() __builtin_amdgcn_sched_barrier(0)
__device__ __forceinline__ unsigned cvtpk(float lo, float hi) { unsigned r; asm volatile("v_cvt_pk_bf16_f32 %0, %1, %2" : "=v"(r) : "v"(lo), "v"(hi)); return r; }
__device__ __forceinline__ void partialSM(f32x16& p0, f32x16& p1, float& m_reg, float& mn, float& alpha) {
  float pmax = p0[0];
#pragma unroll
  for (int r = 1; r < 16; ++r) pmax = fmaxf(pmax, p0[r]);
#pragma unroll
  for (int r = 0; r < 16; ++r) pmax = fmaxf(pmax, p1[r]);
  { auto rr = __builtin_amdgcn_permlane32_swap(__float_as_uint(pmax), __float_as_uint(pmax), false, false);
    pmax = fmaxf(__uint_as_float(rr[0]), __uint_as_float(rr[1])); }
  if (__builtin_expect(__all(pmax - m_reg <= THR2), 1)) { mn = m_reg; alpha = 1.f; }
  else { mn = fmaxf(m_reg, pmax); alpha = __builtin_amdgcn_exp2f(m_reg - mn); m_reg = mn; }
#pragma unroll
  for (int r = 0; r < 16; ++r) p0[r] = p0[r] - mn;
#pragma unroll
  for (int r = 0; r < 16; ++r) p1[r] = p1[r] - mn;
#pragma unroll
  for (int r = 0; r < 16; ++r) p0[r] = __builtin_amdgcn_exp2f(p0[r]);
}
__device__ __forceinline__ void finishSM(f32x16& p0, f32x16& p1, float alpha, float& l_reg, bf16x8& pa0, bf16x8& pa1, bf16x8& pa2, bf16x8& pa3) {
#pragma unroll
  for (int r = 0; r < 16; ++r) p1[r] = __builtin_amdgcn_exp2f(p1[r]);
  float ps = 0;
#pragma unroll
  for (int r = 0; r < 16; ++r) ps += p0[r];
#pragma unroll
  for (int r = 0; r < 16; ++r) ps += p1[r];
  { auto rr = __builtin_amdgcn_permlane32_swap(__float_as_uint(ps), __float_as_uint(ps), false, false);
    ps = __uint_as_float(rr[0]) + __uint_as_float(rr[1]); }
  l_reg = l_reg * alpha + ps;
#define PK4(P, BASE, OUT) do { unsigned a0 = cvtpk(P[BASE + 0], P[BASE + 1]), a1 = cvtpk(P[BASE + 2], P[BASE + 3]);   \
    unsigned b0 = cvtpk(P[BASE + 4], P[BASE + 5]), b1 = cvtpk(P[BASE + 6], P[BASE + 7]);                              \
    auto r0 = __builtin_amdgcn_permlane32_swap(a0, b0, false, false); auto r1 = __builtin_amdgcn_permlane32_swap(a1, b1, false, false); \
    u32x4 w = {r0[0], r1[0], r0[1], r1[1]}; OUT = *reinterpret_cast<bf16x8*>(&w); } while (0)
  PK4(p0, 0, pa0); PK4(p0, 8, pa1); PK4(p1, 0, pa2); PK4(p1, 8, pa3);
#undef PK4
}
template <int NKS>
__device__ __forceinline__ void qkt(f32x16& p0, f32x16& p1, const char* Ks, const bf16x8* qr, int r32, int hi, int qcolB) {
#pragma unroll
  for (int r = 0; r < 16; ++r) { p0[r] = 0.f; p1[r] = 0.f; }
#pragma unroll
  for (int d0 = 0; d0 < NKS; ++d0) { int cb = qcolB + (d0 * 16 + hi * 8) * 2;
    bf16x8 b0 = *reinterpret_cast<const bf16x8*>(Ks + KSWZ(r32, cb));
    bf16x8 b1 = *reinterpret_cast<const bf16x8*>(Ks + KSWZ(32 + r32, cb));
    p0 = __builtin_amdgcn_mfma_f32_32x32x16_bf16(b0, qr[d0], p0, 0, 0, 0);
    p1 = __builtin_amdgcn_mfma_f32_32x32x16_bf16(b1, qr[d0], p1, 0, 0, 0); }
}
__device__ __forceinline__ int v_st(int k, int c) { const int kk = (k & ~0xC) | ((k & 4) << 1) | ((k & 8) >> 1); return ((kk >> 3) * 4 + (c >> 5)) * 512 + ((kk & 7) * 32 + (c & 31)) * 2; }
__device__ __forceinline__ int v_rd_base(int lane) { return ((lane & 3) << 3) | (((lane >> 2) & 3) << 6) | (((lane >> 4) & 1) << 5) | (((lane >> 5) & 1) << 8); }
constexpr int v_rd_off(int d0, int ks, int half) { return d0 * 512 + ks * 4096 + half * 2048; }
template <int OFF> __device__ __forceinline__ s16x4 tr_read(int vb) {
  s16x4 r; asm volatile("ds_read_b64_tr_b16 %0, %1 offset:%2" : "=&v"(r) : "v"(vb), "i"(OFF) : "memory"); return r;
}
template <int D0> __device__ __forceinline__ void pv_one(f32x16& od, int vb, bf16x8 pa0, bf16x8 pa1, bf16x8 pa2, bf16x8 pa3) {
  const s16x4 l0 = tr_read<v_rd_off(D0, 0, 0)>(vb), h0 = tr_read<v_rd_off(D0, 0, 1)>(vb), l1 = tr_read<v_rd_off(D0, 1, 0)>(vb), h1 = tr_read<v_rd_off(D0, 1, 1)>(vb);
  const s16x4 l2 = tr_read<v_rd_off(D0, 2, 0)>(vb), h2 = tr_read<v_rd_off(D0, 2, 1)>(vb), l3 = tr_read<v_rd_off(D0, 3, 0)>(vb), h3 = tr_read<v_rd_off(D0, 3, 1)>(vb);
  asm volatile("s_waitcnt lgkmcnt(0)" ::: "memory"); SBAR();
#define PK(L, H) (bf16x8){L[0], L[1], L[2], L[3], H[0], H[1], H[2], H[3]}
  od = __builtin_amdgcn_mfma_f32_32x32x16_bf16(pa0, PK(l0, h0), od, 0, 0, 0);
  od = __builtin_amdgcn_mfma_f32_32x32x16_bf16(pa1, PK(l1, h1), od, 0, 0, 0);
  od = __builtin_amdgcn_mfma_f32_32x32x16_bf16(pa2, PK(l2, h2), od, 0, 0, 0);
  od = __builtin_amdgcn_mfma_f32_32x32x16_bf16(pa3, PK(l3, h3), od, 0, 0, 0);
#undef PK
}
template <int NVB> __device__ __forceinline__ void pv_all(f32x16* o, int vb, bf16x8 pa0, bf16x8 pa1, bf16x8 pa2, bf16x8 pa3) {
  pv_one<0>(o[0], vb, pa0, pa1, pa2, pa3); pv_one<1>(o[1], vb, pa0, pa1, pa2, pa3);
  if constexpr (NVB == 4) { pv_one<2>(o[2], vb, pa0, pa1, pa2, pa3); pv_one<3>(o[3], vb, pa0, pa1, pa2, pa3); }
}
template <int TYPE>
__device__ __forceinline__ void attn_item(const Params& p, char* lds, int h, int qrow0, int krow0, int NT, float lam) {
  constexpr int NKS = TYPE ? 4 : 6, NVB = TYPE ? 4 : 2;
  constexpr int LDQ = TYPE ? 512 : 768, LDK = TYPE ? 512 : 768, LDV = 512;
  constexpr int KCOLS = TYPE ? 128 : 96, VCOLS = TYPE ? 128 : 64;
  const int tid = threadIdx.x, wid = tid >> 6, lane = tid & 63, r32 = lane & 31, hi = lane >> 5;
  const int map = TYPE ? (wid >> 2) : 0, wq = TYPE ? (wid & 3) : wid;
  char* ws = p.ws;
  const bfr* Qb = TYPE ? (const bfr*)(ws + OFF_RC) + (size_t)(qrow0 + wq * 32 + r32) * 512 + h * 128 + map * 64 + hi * 8
                       : (const bfr*)(ws + OFF_RD) + (size_t)(qrow0 + wq * 32 + r32) * 768 + h * 96 + hi * 8;
  const bfr* Kh = TYPE ? (const bfr*)(ws + OFF_RC) + (size_t)RTOT * 512 + (size_t)krow0 * 512 + h * 128
                       : (const bfr*)(ws + OFF_RD) + (size_t)RTOT * 768 + (size_t)krow0 * 768 + h * 96;
  const bfr* Vh = TYPE ? (const bfr*)(ws + OFF_RC) + (size_t)RTOT * 1024 + (size_t)krow0 * 512 + h * 128
                       : (const bfr*)(ws + OFF_RD) + (size_t)RTOT * 1536 + (size_t)krow0 * 512 + h * 64;
  const bfr* SG0 = (const bfr*)(ws + OFF_RB); bfr* OG = (bfr*)(ws + OFF_RA);
  const int qcolB = map * 128;
  char* V_lds = lds; char* K_lds = lds + 2 * SHM_KV;
  float* wsc = (float*)(lds + 4 * SHM_KV) + wid * 64; float* li_l = wsc; float* al_l = wsc + 32;
  float m_reg = -1e30f, l_reg = 0.f; f32x16 o[NVB]; bf16x8 qr[NKS];
#pragma unroll
  for (int d = 0; d < NVB; ++d)
#pragma unroll
    for (int r = 0; r < 16; ++r) o[d][r] = 0.f;
#pragma unroll
  for (int d0 = 0; d0 < NKS; ++d0) qr[d0] = *reinterpret_cast<const bf16x8*>(Qb + d0 * 16);
  const int sr = tid >> 4, sc = (tid & 15) * 8, vst0 = v_st(sr, sc), vst1 = v_st(32 + sr, sc);
  const bool kval = sc < KCOLS, vval = sc < VCOLS;
  const int vb0 = (int)(uintptr_t)V_lds + v_rd_base(lane);
  bf16x8 e_vs0, e_vs1, e_ks0, e_ks1, o_vs0, o_vs1, o_ks0, o_ks1;
#define LD8(ptr) (*reinterpret_cast<const bf16x8*>(ptr))
#define SLOAD_E(k0) do { if (vval) { e_vs0 = LD8(&Vh[(size_t)((k0) + sr) * LDV + sc]); e_vs1 = LD8(&Vh[(size_t)((k0) + 32 + sr) * LDV + sc]); } \
    if (kval) { e_ks0 = LD8(&Kh[(size_t)((k0) + sr) * LDK + sc]); e_ks1 = LD8(&Kh[(size_t)((k0) + 32 + sr) * LDK + sc]); } } while (0)
#define SLOAD_O(k0) do { if (vval) { o_vs0 = LD8(&Vh[(size_t)((k0) + sr) * LDV + sc]); o_vs1 = LD8(&Vh[(size_t)((k0) + 32 + sr) * LDV + sc]); } \
    if (kval) { o_ks0 = LD8(&Kh[(size_t)((k0) + sr) * LDK + sc]); o_ks1 = LD8(&Kh[(size_t)((k0) + 32 + sr) * LDK + sc]); } } while (0)
#define SWRITE_E(b) do { if (vval) { *(bf16x8*)(V_lds + (b) * SHM_KV + vst0) = e_vs0; *(bf16x8*)(V_lds + (b) * SHM_KV + vst1) = e_vs1; } \
    if (kval) { int kc = sc * 2; *(bf16x8*)(K_lds + (b) * SHM_KV + KSWZ(sr, kc)) = e_ks0; *(bf16x8*)(K_lds + (b) * SHM_KV + KSWZ(32 + sr, kc)) = e_ks1; } } while (0)
#define SWRITE_O(b) do { if (vval) { *(bf16x8*)(V_lds + (b) * SHM_KV + vst0) = o_vs0; *(bf16x8*)(V_lds + (b) * SHM_KV + vst1) = o_vs1; } \
    if (kval) { int kc = sc * 2; *(bf16x8*)(K_lds + (b) * SHM_KV + KSWZ(sr, kc)) = o_ks0; *(bf16x8*)(K_lds + (b) * SHM_KV + KSWZ(32 + sr, kc)) = o_ks1; } } while (0)
#define SWAIT() asm volatile("s_waitcnt vmcnt(4)" ::: "memory")
#define RESC(a) do { if (__any((a) < 1.f)) { if (hi == 0) al_l[r32] = (a); asm volatile("s_waitcnt lgkmcnt(0)" ::: "memory"); \
    _Pragma("unroll") for (int d = 0; d < NVB; ++d) _Pragma("unroll") for (int r = 0; r < 16; ++r) o[d][r] *= al_l[crow(r, hi)]; } } while (0)
  f32x16 pA0, pA1, pB0, pB1; float mnA, mnB, alA, alB; bf16x8 pa0, pa1, pa2, pa3;
  SLOAD_E(0); asm volatile("s_waitcnt vmcnt(0)" ::: "memory"); SWRITE_E(0); __syncthreads();
  qkt<NKS>(pA0, pA1, K_lds, qr, r32, hi, qcolB); partialSM(pA0, pA1, m_reg, mnA, alA);
  SLOAD_O(64); if (2 < NT) SLOAD_E(2 * 64);
  SWAIT(); SWRITE_O(1); __syncthreads();
  for (int j = 1; j + 1 < NT; j += 2) {
    SBAR(); qkt<NKS>(pB0, pB1, K_lds + SHM_KV, qr, r32, hi, qcolB);
    finishSM(pA0, pA1, alA, l_reg, pa0, pa1, pa2, pa3); SBAR();
    SLOAD_O((j + 2) * 64); SBAR();
    pv_all<NVB>(o, vb0, pa0, pa1, pa2, pa3); partialSM(pB0, pB1, m_reg, mnB, alB);
    __syncthreads(); SWAIT(); SWRITE_E(0);
    RESC(alB); __syncthreads();
    SBAR(); qkt<NKS>(pA0, pA1, K_lds, qr, r32, hi, qcolB);
    finishSM(pB0, pB1, alB, l_reg, pa0, pa1, pa2, pa3); SBAR();
    if (j + 3 < NT) SLOAD_E((j + 3) * 64); SBAR();
    pv_all<NVB>(o, vb0 + SHM_KV, pa0, pa1, pa2, pa3); partialSM(pA0, pA1, m_reg, mnA, alA);
    __syncthreads(); SWAIT(); SWRITE_O(1);
    RESC(alA); __syncthreads();
  }
  SBAR(); qkt<NKS>(pB0, pB1, K_lds + SHM_KV, qr, r32, hi, qcolB);
  finishSM(pA0, pA1, alA, l_reg, pa0, pa1, pa2, pa3); SBAR();
  pv_all<NVB>(o, vb0, pa0, pa1, pa2, pa3); partialSM(pB0, pB1, m_reg, mnB, alB);
  __syncthreads(); RESC(alB);
  finishSM(pB0, pB1, alB, l_reg, pa0, pa1, pa2, pa3); SBAR();
  pv_all<NVB>(o, vb0 + SHM_KV, pa0, pa1, pa2, pa3);
  if (hi == 0) li_l[r32] = l_reg; asm volatile("s_waitcnt lgkmcnt(0)" ::: "memory");
  float rli[16];
#pragma unroll
  for (int r = 0; r < 16; ++r) rli[r] = __builtin_amdgcn_rcpf(li_l[crow(r, hi)]);
  if constexpr (TYPE == 0) {
#pragma unroll
    for (int r = 0; r < 16; ++r) { const size_t row = (size_t)(qrow0 + wq * 32 + crow(r, hi)) * 1024;
#pragma unroll
      for (int d0 = 0; d0 < NVB; ++d0) { const size_t idx = row + h * 64 + d0 * 32 + r32; OG[idx] = f2bf(o[d0][r] * rli[r] * bf2f(SG0[idx])); } }
    __syncthreads();
  } else {
    float* xch = (float*)lds;
    __syncthreads();
    if (map == 1) {
#pragma unroll
      for (int r = 0; r < 16; ++r) { const float f = rli[r] * lam;
#pragma unroll
        for (int d0 = 0; d0 < 4; ++d0) xch[(wq * 32 + crow(r, hi)) * 128 + d0 * 32 + r32] = o[d0][r] * f; }
    }
    __syncthreads();
    if (map == 0) {
      const float* subg = p.subg;
#pragma unroll
      for (int r = 0; r < 16; ++r) { float ss = 0.f;
#pragma unroll
        for (int d0 = 0; d0 < 4; ++d0) { float v = o[d0][r] * rli[r] - xch[(wq * 32 + crow(r, hi)) * 128 + d0 * 32 + r32]; o[d0][r] = v; ss += v * v; }
        ss += __shfl_xor(ss, 16); ss += __shfl_xor(ss, 8); ss += __shfl_xor(ss, 4); ss += __shfl_xor(ss, 2); ss += __shfl_xor(ss, 1);
        const float rs = rsqrtf(ss * (1.f / 128.f) + 1e-6f) * 0.8f;
        const size_t row = (size_t)(qrow0 + wq * 32 + crow(r, hi)) * 1024;
#pragma unroll
        for (int d0 = 0; d0 < 4; ++d0) { const size_t idx = row + 512 + h * 128 + d0 * 32 + r32;
          OG[idx] = f2bf(o[d0][r] * rs * subg[d0 * 32 + r32] * bf2f(SG0[idx])); } }
    }
    __syncthreads();
  }
#undef LD8
#undef SLOAD_E
#undef SLOAD_O
#undef SWRITE_E
#undef SWRITE_O
#undef SWAIT
#undef RESC
}
__device__ void attn_phase(const Params& p, char* smem, int bid, int nb) {
  const float lam = *(const float*)(p.ws + OFF_LAM);
  for (int it = bid; it < 2112; it += nb) {
    const int rd = it >> 8, j = it & 255;
    int type, h, qrow0, krow0, NT;
    if (rd < 4) { const int b = rd; type = 0; h = j & 7; qrow0 = b * SEQA + (j >> 3) * 256; krow0 = b * SEQA; NT = 132; }
    else if (rd < 8) { const int pair = (j & 7) + 8 * ((rd - 4) >> 1), b = pair >> 2, qt = 2 * (j >> 3) + ((rd - 4) & 1);
      type = 1; h = pair & 3; qrow0 = b * SEQA + qt * 128; krow0 = b * SEQA; NT = 132; }
    else if (j < 32) { const int b = j >> 3; type = 0; h = j & 7; qrow0 = b * SEQA + NLAT; krow0 = qrow0; NT = 4; }
    else if (j < 64) { const int pair = (j - 32) >> 1, b = pair >> 2, qt = (j - 32) & 1;
      type = 1; h = pair & 3; krow0 = b * SEQA + NLAT; qrow0 = krow0 + qt * 128; NT = 4; }
    else continue;
#ifndef ONLY_T1
    if (type == 0) attn_item<0>(p, smem, h, qrow0, krow0, NT, lam);
#endif
#ifndef ONLY_T0
    if (type == 1) attn_item<1>(p, smem, h, qrow0, krow0, NT, lam);
#endif
  }
}

extern __shared__ __attribute__((aligned(16))) char dyn_smem[];
__global__ __launch_bounds__(512, 2) void kf_prep(Params p) { prep_phase(p, dyn_smem, blockIdx.x, gridDim.x); }
__global__ __launch_bounds__(512, 2) void kf_gemm_z(Params p) {
  char* ws = p.ws; FEpiZ e{}; e.Zc = (bfr*)(ws + OFF_RE); e.DQ = (bfr*)(ws + OFF_RC); e.DK = e.DQ + (size_t)RTOT * 512; e.DV = e.DQ + (size_t)RTOT * 1024;
  e.SG0 = (bfr*)(ws + OFF_RB); e.KA = (bfr*)(ws + OFF_RD) + (size_t)RTOT * 768; e.ropeD = (const float2*)(ws + OFF_ROPED); e.ropeA = (const float2*)(ws + OFF_ROPEA);
  gemm_phase((const bfr*)(ws + OFF_RA), 1024, (const bfr*)(ws + OFF_WIN0), 1024, 1024, 132, 26, e, dyn_smem, blockIdx.x, gridDim.x);
}
__global__ __launch_bounds__(512, 2) void kf_attn(Params p) { attn_phase(p, dyn_smem, blockIdx.x, gridDim.x); }
__global__ __launch_bounds__(512, 2) void kf_upproj(Params p) { upproj_phase(p, dyn_smem, blockIdx.x, gridDim.x); }
__global__ __launch_bounds__(512, 2) void kf_gemm_store(const bfr* A, const bfr* Bt, bfr* C, int mtiles, int ntiles, int K) {
  FEpiStore e{}; e.C = C; e.ldc = ntiles * 128;
  gemm_phase(A, K, Bt, K, K, mtiles, ntiles, e, dyn_smem, blockIdx.x, gridDim.x);
}
__global__ __launch_bounds__(512, 2) void kf_gemm_ug(Params p) {
  char* ws = p.ws; FEpiUG e; e.U = (bfr*)(ws + OFF_RD); e.SG1 = e.U + (size_t)RTOT * 1024;
  gemm_phase((const bfr*)(ws + OFF_RA), 1024, (const bfr*)(ws + OFF_WIN1), 1024, 1024, 132, 16, e, dyn_smem, blockIdx.x, gridDim.x);
}

#define FAST_S1 1
#define FAST_G3 1
#define FAST_ATTN 1
#define FAST_Q2 1
#define FAST_G5 1
constexpr size_t SMEM_TOTAL = SMEM_BYTES + 1024;
extern "C" void kernel_launch(void* const* d_in, const int* in_sizes, int n_in, void* d_out, int out_size, void* d_ws, size_t ws_size, hipStream_t stream) {
  Params P{};
  { const float** pp = (const float**)&P; for (int i = 0; i < 28; ++i) pp[i] = (const float*)d_in[i]; }
  P.out = (float*)d_out; P.ws = (char*)d_ws;
  const float *x = P.x, *c = P.c, *ctx = P.ctx, *c_ctx = P.c_ctx, *ada_w = P.ada_w, *ada_b = P.ada_b, *ln_g = P.ln_g, *ln_b = P.ln_b, *e_w_in = P.e_w_in, *e_qg = P.e_qg,
              *e_w_uq = P.e_w_uq, *e_kvg = P.e_kvg, *e_w_ukv = P.e_w_ukv, *lq1 = P.lq1, *lk1 = P.lk1, *lq2 = P.lq2, *lk2 = P.lk2, *subg = P.subg, *e_w_out = P.e_w_out,
              *o_w_in = P.o_w_in, *conv_w = P.conv_w, *conv_b = P.conv_b, *ga_w = P.ga_w, *ga_b = P.ga_b, *gx_w = P.gx_w, *gx_b = P.gx_b, *lru_l = P.lru_l, *o_w_out = P.o_w_out;
  float* out = (float*)d_out; char* ws = (char*)d_ws;
  if (ws_size < WS_END) return;
  static int attr_done = 0;
  if (!attr_done) {
    hipFuncSetAttribute((const void*)kf_prep, hipFuncAttributeMaxDynamicSharedMemorySize, (int)SMEM_TOTAL);
    hipFuncSetAttribute((const void*)kf_gemm_z, hipFuncAttributeMaxDynamicSharedMemorySize, (int)SMEM_TOTAL);
    hipFuncSetAttribute((const void*)kf_upproj, hipFuncAttributeMaxDynamicSharedMemorySize, (int)SMEM_TOTAL);
    hipFuncSetAttribute((const void*)kf_gemm_store, hipFuncAttributeMaxDynamicSharedMemorySize, (int)SMEM_TOTAL);
    hipFuncSetAttribute((const void*)kf_attn, hipFuncAttributeMaxDynamicSharedMemorySize, (int)SMEM_TOTAL);
    hipFuncSetAttribute((const void*)kf_gemm_ug, hipFuncAttributeMaxDynamicSharedMemorySize, (int)SMEM_TOTAL);
    attr_done = 1;
  }
  const int NB = 256;
  float* mod = (float*)(ws + OFF_MOD); float* lam = (float*)(ws + OFF_LAM);
  bfr* RA = (bfr*)(ws + OFF_RA); bfr* RB = (bfr*)(ws + OFF_RB); bfr* RC = (bfr*)(ws + OFF_RC); bfr* RE = (bfr*)(ws + OFF_RE); bfr* RD = (bfr*)(ws + OFF_RD);
  bfr* XM = RA; bfr* OG = RA; bfr* XM1 = RA; bfr* HG = RA;
  bfr* SG0 = RB; bfr* UC = RB;
  bfr* DQ = RC; bfr* DK = RC + (size_t)RTOT * 512; bfr* DV = RC + (size_t)RTOT * 1024; bfr* Y0 = RC; bfr* G = RC;
  bfr* Zc = RE; float* KRraw = (float*)(ws + OFF_RE + ((size_t)48 << 20)); float* Oraw = (float*)RE;
  bfr* QA = RD; bfr* KA = RD + (size_t)RTOT * 768; bfr* VA = RD + (size_t)RTOT * 1536; bfr* UG = RD;
  bfr* Y1 = RB;

  k_mod<<<dim3(12, 5, 2), 256, 0, stream>>>(c, c_ctx, ada_w, ada_b, mod);
  k_lam<<<1, 64, 0, stream>>>(lq1, lk1, lq2, lk2, lam);
  kf_prep<<<NB, NTHR, SMEM_TOTAL, stream>>>(P);
  k_modulate0<<<RTOT, 256, 0, stream>>>(x, ctx, mod, XM);
#if FAST_S1
  kf_gemm_z<<<NB, NTHR, SMEM_TOTAL, stream>>>(P);
  kf_upproj<<<NB, NTHR, SMEM_TOTAL, stream>>>(P);
#else
  { EpiZ e{}; e.Zc = Zc; e.DQ = DQ; e.DK = DK; e.DV = DV; e.SG0 = SG0; e.KRraw = KRraw;
    k_gemm_naive<<<dim3(51, RTOT / 64, 1), 256, 0, stream>>>(XM, 1024, e_w_in, 3232, RTOT, 3232, 1024, e); }
  k_rms_fix<<<RTOT, 256, 0, stream>>>(Zc, e_qg, e_kvg);
  k_fix_dqk<<<RTOT, 256, 0, stream>>>(DQ, DK, KRraw, KA);
  { EpiQ e{}; e.QA = QA; k_gemm_naive<<<dim3(12, RTOT / 64, 1), 256, 0, stream>>>(Zc, 640, e_w_uq, 768, RTOT, 768, 384, e); }
  { EpiKV e{}; e.KA = KA; e.VA = VA; k_gemm_naive<<<dim3(16, RTOT / 64, 1), 256, 0, stream>>>(Zc + 384, 640, e_w_ukv, 1024, RTOT, 1024, 256, e); }
  k_fix_q<<<RTOT, 256, 0, stream>>>(QA);
#endif
#if FAST_ATTN
  kf_attn<<<NB, NTHR, SMEM_TOTAL, stream>>>(P);
#else
  k_attn_mla_naive<<<dim3(132, 8), 256, 0, stream>>>(QA, KA, VA, SG0, OG);
  k_attn_diff_naive<<<dim3(132, 4, 4), 256, 0, stream>>>(DQ, DK, DV, lam, Oraw);
  k_fix_attn<<<RTOT, 256, 0, stream>>>(Oraw, subg, SG0, OG);
#endif
#if FAST_G3
  kf_gemm_store<<<NB, NTHR, SMEM_TOTAL, stream>>>(OG, (const bfr*)(ws + OFF_WOUT0), Y0, 132, 8, 1024);
#else
  { EpiStore e{}; e.C = Y0; e.ldc = 1024; k_gemm_naive<<<dim3(16, RTOT / 64, 1), 256, 0, stream>>>(OG, 1024, e_w_out, 1024, RTOT, 1024, 1024, e); }
#endif
  k_ln0<<<RTOT / 4, 256, 0, stream>>>(x, ctx, Y0, mod, ln_g, ln_b, out, XM1);
#if FAST_Q2
  kf_gemm_ug<<<NB, NTHR, SMEM_TOTAL, stream>>>(P);
  const bfr* Uu = RD; const int ldu = 1024; const bfr* GT = RD + (size_t)RTOT * 1024; const int ldg = 1024, gsilu = 1;
#else
  { EpiStore e{}; e.C = UG; e.ldc = 2048; k_gemm_naive<<<dim3(32, RTOT / 64, 1), 256, 0, stream>>>(XM1, 1024, o_w_in, 2048, RTOT, 2048, 1024, e); }
  const bfr* Uu = UG; const int ldu = 2048; const bfr* GT = UG + 1024; const int ldg = 2048, gsilu = 0;
#endif
  k_conv<<<RTOT * 4, 256, 0, stream>>>(Uu, ldu, conv_w, conv_b, UC);
  for (int dir = 0; dir < 2; ++dir) {
    for (int gate = 0; gate < 2; ++gate) {
      const float* w = (gate == 0 ? ga_w : gx_w) + (size_t)dir * 8 * 128 * 128;
      for (int blk = 0; blk < 8; ++blk) {
        EpiStore es{}; es.C = G + (size_t)gate * RTOT * 1024 + blk * 128; es.ldc = 1024;
        k_gemm_naive<<<dim3(2, RTOT / 64, 1), 256, 0, stream>>>(UC + blk * 128, 1024, w + (size_t)blk * 128 * 128, 128, RTOT, 128, 128, es);
      }
    }
    k_scan_naive<<<dim3(4, 4), 256, 0, stream>>>(dir, G, UC, GT, ldg, gsilu, ga_b, gx_b, lru_l, HG);
  }
#if FAST_G5
  kf_gemm_store<<<NB, NTHR, SMEM_TOTAL, stream>>>(HG, (const bfr*)(ws + OFF_WOUT1), Y1, 128, 8, 1024);
#else
  { EpiStore e{}; e.C = Y1; e.ldc = 1024; k_gemm_naive<<<dim3(16, (B_ * NLAT) / 64, 1), 256, 0, stream>>>(HG, 1024, o_w_out, 1024, B_ * NLAT, 1024, 1024, e); }
#endif
  k_ln1<<<(B_ * NLAT) / 4, 256, 0, stream>>>(Y1, mod, ln_g + 1024, ln_b + 1024, out);
}
```

```cpp
#include <hip/hip_runtime.h>
#include <hip/hip_bf16.h>
#include <stdint.h>

typedef unsigned short bfr;

constexpr int B_ = 4, NLAT = 8192, NCTX = 256, SEQA = NLAT + NCTX, RTOT = B_ * SEQA, DM = 1024;
constexpr float ALPHA = 1.4142135623730951f;
constexpr float LOG2E = 1.4426950408889634f;
constexpr float QSC_A = 0.10206207261596577f * LOG2E;
constexpr float QSC_D = 0.125f * LOG2E;

constexpr size_t SZ1024 = (size_t)RTOT * 1024 * 2;
constexpr size_t SZ512  = (size_t)RTOT * 512 * 2;
constexpr size_t SZ768  = (size_t)RTOT * 768 * 2;
constexpr size_t OFF_MOD = 0;
constexpr size_t OFF_LAM = 122880;
constexpr size_t OFF_RA = (size_t)24 << 20;
constexpr size_t OFF_RB = OFF_RA + SZ1024;
constexpr size_t OFF_RC = OFF_RB + SZ1024;
constexpr size_t OFF_RE = OFF_RC + 3 * SZ512;
constexpr size_t OFF_RD = OFF_RE + SZ1024;
constexpr size_t WS_END = OFF_RD + 2 * SZ1024;

__device__ __forceinline__ float bf2f(bfr h) { return __uint_as_float(((unsigned)h) << 16); }
__device__ __forceinline__ bfr f2bf(float f) { unsigned u = __float_as_uint(f); u += 0x7fffu + ((u >> 16) & 1u); return (bfr)(u >> 16); }
__device__ __forceinline__ float silu_f(float x) { return x / (1.f + expf(-x)); }
__device__ __forceinline__ float sigmoid_f(float x) { return 1.f / (1.f + expf(-x)); }
__device__ __forceinline__ const float* xrow(const float* x, const float* ctx, int r) {
  int b = r / SEQA, p = r - b * SEQA;
  return p < NLAT ? x + ((size_t)(b * NLAT + p)) * DM : ctx + ((size_t)(b * NCTX + (p - NLAT))) * DM;
}
__device__ __forceinline__ int modrow(int r) { int b = r / SEQA, p = r - b * SEQA; return p < NLAT ? b : 4; }

__global__ __launch_bounds__(256) void k_mod(const float* c, const float* c_ctx, const float* ada_w, const float* ada_b, float* mod) {
  __shared__ float sc[1024];
  int l = blockIdx.z, mr = blockIdx.y, j = blockIdx.x * 256 + threadIdx.x;
  const float* cond = mr < 4 ? c + mr * 1024 : c_ctx;
  for (int k = threadIdx.x; k < 1024; k += 256) sc[k] = silu_f(cond[k]);
  __syncthreads();
  const float* w = ada_w + (size_t)l * 1024 * 3072 + j;
  float acc = 0;
  for (int k = 0; k < 1024; ++k) acc += sc[k] * w[(size_t)k * 3072];
  mod[(l * 5 + mr) * 3072 + j] = acc + ada_b[l * 3072 + j];
}
__global__ void k_lam(const float* q1, const float* k1, const float* q2, const float* k2, float* lam) {
  if (threadIdx.x == 0 && blockIdx.x == 0) {
    float s1 = 0, s2 = 0;
    for (int i = 0; i < 64; ++i) { s1 += q1[i] * k1[i]; s2 += q2[i] * k2[i]; }
    lam[0] = expf(s1) - expf(s2) + 0.2f;
  }
}
__global__ __launch_bounds__(256) void k_modulate0(const float* x, const float* ctx, const float* mod, bfr* XM) {
  size_t idx = (size_t)blockIdx.x * 256 + threadIdx.x;
  int r = (int)(idx >> 8), c4 = (int)(idx & 255) * 4;
  const float* src = xrow(x, ctx, r) + c4; int mr = modrow(r);
  const float* sh = mod + mr * 3072 + c4; const float* sc = sh + 1024;
  float4 v = *(const float4*)src, s4 = *(const float4*)sh, c4v = *(const float4*)sc;
  uint2 o;
  o.x = (unsigned)f2bf(v.x * (1.f + c4v.x) + s4.x) | ((unsigned)f2bf(v.y * (1.f + c4v.y) + s4.y) << 16);
  o.y = (unsigned)f2bf(v.z * (1.f + c4v.z) + s4.z) | ((unsigned)f2bf(v.w * (1.f + c4v.w) + s4.w) << 16);
  *(uint2*)(XM + (size_t)r * 1024 + c4) = o;
}

template <class Epi>
__global__ __launch_bounds__(256) void k_gemm_naive(const bfr* A, int lda, const float* W, int ldw, int M, int N, int K, Epi epi) {
  __shared__ float As[16][68], Ws[16][68];
  const int tid = threadIdx.x, tx = tid & 15, ty = tid >> 4;
  const int m0 = blockIdx.y * 64, n0 = blockIdx.x * 64;
  epi.setz(blockIdx.z);
  A += epi.aoff(blockIdx.z); W += epi.woff(blockIdx.z);
  float acc[4][4] = {};
  for (int k0 = 0; k0 < K; k0 += 16) {
    { int row = tid >> 2, kk = (tid & 3) * 4;
      uint2 a = *(const uint2*)(A + (size_t)(m0 + row) * lda + k0 + kk);
      As[kk + 0][row] = bf2f((bfr)(a.x & 0xffff)); As[kk + 1][row] = bf2f((bfr)(a.x >> 16));
      As[kk + 2][row] = bf2f((bfr)(a.y & 0xffff)); As[kk + 3][row] = bf2f((bfr)(a.y >> 16)); }
    { int kk = tid >> 4, n = (tid & 15) * 4;
      for (int j = 0; j < 4; ++j) Ws[kk][n + j] = (n0 + n + j < N) ? W[(size_t)(k0 + kk) * ldw + n0 + n + j] : 0.f; }
    __syncthreads();
#pragma unroll
    for (int kk = 0; kk < 16; ++kk) {
      float a[4], b[4];
#pragma unroll
      for (int i = 0; i < 4; ++i) { a[i] = As[kk][ty * 4 + i]; b[i] = Ws[kk][tx * 4 + i]; }
#pragma unroll
      for (int i = 0; i < 4; ++i)
#pragma unroll
        for (int j = 0; j < 4; ++j) acc[i][j] += a[i] * b[j];
    }
    __syncthreads();
  }
  for (int i = 0; i < 4; ++i) for (int j = 0; j < 4; ++j) {
    int row = m0 + ty * 4 + i, col = n0 + tx * 4 + j;
    if (col < N) epi(row, col, acc[i][j]);
  }
}
struct EpiBase { __device__ void setz(int) {} __device__ size_t aoff(int) { return 0; } __device__ size_t woff(int) { return 0; } };
struct EpiZ : EpiBase {
  bfr *Zc, *DQ, *DK, *DV, *SG0; float* KRraw;
  __device__ void operator()(int r, int c, float v) {
    if (c < 640) Zc[(size_t)r * 640 + c] = f2bf(v);
    else if (c < 672) KRraw[(size_t)r * 32 + c - 640] = v;
    else if (c < 1184) DQ[(size_t)r * 512 + c - 672] = f2bf(v);
    else if (c < 1696) DK[(size_t)r * 512 + c - 1184] = f2bf(v);
    else if (c < 2208) DV[(size_t)r * 512 + c - 1696] = f2bf(v);
    else SG0[(size_t)r * 1024 + c - 2208] = f2bf(silu_f(v));
  }
};
struct EpiQ : EpiBase { bfr* QA; __device__ void operator()(int r, int c, float v) { QA[(size_t)r * 768 + c] = f2bf(v); } };
struct EpiKV : EpiBase { bfr *KA, *VA;
  __device__ void operator()(int r, int c, float v) { int h = c >> 7, j = c & 127;
    if (j < 64) KA[(size_t)r * 768 + h * 96 + j] = f2bf(v); else VA[(size_t)r * 512 + h * 64 + j - 64] = f2bf(v); } };
struct EpiStore : EpiBase { bfr* C; int ldc; __device__ void operator()(int r, int c, float v) { C[(size_t)r * ldc + c] = f2bf(v); } };

__global__ __launch_bounds__(256) void k_rms_fix(bfr* Zc, const float* gq, const float* gkv) {
  __shared__ float red[8];
  int r = blockIdx.x, t = threadIdx.x;
  bfr* z = Zc + (size_t)r * 640;
  float v0 = bf2f(z[t]), v1 = (t < 128) ? bf2f(z[256 + t]) : 0.f, v2 = bf2f(z[384 + t]);
  float sq = v0 * v0 + v1 * v1, sk = v2 * v2;
  for (int o = 32; o; o >>= 1) { sq += __shfl_xor(sq, o); sk += __shfl_xor(sk, o); }
  if ((t & 63) == 0) { red[t >> 6] = sq; red[4 + (t >> 6)] = sk; }
  __syncthreads();
  float tq = red[0] + red[1] + red[2] + red[3], tk = red[4] + red[5] + red[6] + red[7];
  float rq = rsqrtf(tq / 384.f + 1e-6f), rk = rsqrtf(tk / 256.f + 1e-6f);
  z[t] = f2bf(v0 * rq * gq[t]);
  if (t < 128) z[256 + t] = f2bf(v1 * rq * gq[256 + t]);
  z[384 + t] = f2bf(v2 * rk * gkv[t]);
}
__global__ __launch_bounds__(256) void k_fix_dqk(bfr* DQ, bfr* DK, const float* KRraw, bfr* KA) {
  int r = blockIdx.x, t = threadIdx.x;
  int p = r % SEQA; bool lat = p < NLAT;
  int i = t & 31; int g = t >> 5;
  float cs = 1.f, sn = 0.f;
  if (lat) { float pos = (i < 16) ? (float)(p >> 6) : (float)(p & 63);
    float fr = powf(10000.f, -(float)(i & 15) / 16.f); float ang = pos * fr; sincosf(ang, &sn, &cs); }
  { bfr* q = DQ + (size_t)r * 512 + g * 64; float x1 = bf2f(q[i]), x2 = bf2f(q[i + 32]);
    q[i] = f2bf((x1 * cs - x2 * sn) * QSC_D); q[i + 32] = f2bf((x2 * cs + x1 * sn) * QSC_D); }
  { bfr* k = DK + (size_t)r * 512 + g * 64; float x1 = bf2f(k[i]), x2 = bf2f(k[i + 32]);
    k[i] = f2bf(x1 * cs - x2 * sn); k[i + 32] = f2bf(x2 * cs + x1 * sn); }
  if (t < 16) {
    float c2 = 1.f, s2 = 0.f;
    if (lat) { float pos = (t < 8) ? (float)(p >> 6) : (float)(p & 63);
      float fr = powf(10000.f, -(float)(t & 7) / 8.f); sincosf(pos * fr, &s2, &c2); }
    float x1 = KRraw[(size_t)r * 32 + t], x2 = KRraw[(size_t)r * 32 + t + 16];
    bfr o1 = f2bf(x1 * c2 - x2 * s2), o2 = f2bf(x2 * c2 + x1 * s2);
    for (int h = 0; h < 8; ++h) { KA[(size_t)r * 768 + h * 96 + 64 + t] = o1; KA[(size_t)r * 768 + h * 96 + 80 + t] = o2; }
  }
}
__global__ __launch_bounds__(256) void k_fix_q(bfr* QA) {
  int r = blockIdx.x, t = threadIdx.x;
  int p = r % SEQA; bool lat = p < NLAT;
  bfr* q = QA + (size_t)r * 768;
  for (int e = t; e < 512; e += 256) { int h = e >> 6, j = e & 63; q[h * 96 + j] = f2bf(bf2f(q[h * 96 + j]) * QSC_A); }
  if (t < 128) { int h = t >> 4, i = t & 15;
    float cs = 1.f, sn = 0.f;
    if (lat) { float pos = (i < 8) ? (float)(p >> 6) : (float)(p & 63);
      float fr = powf(10000.f, -(float)(i & 7) / 8.f); sincosf(pos * fr, &sn, &cs); }
    float x1 = bf2f(q[h * 96 + 64 + i]), x2 = bf2f(q[h * 96 + 80 + i]);
    q[h * 96 + 64 + i] = f2bf((x1 * cs - x2 * sn) * QSC_A); q[h * 96 + 80 + i] = f2bf((x2 * cs + x1 * sn) * QSC_A); }
}

__device__ __forceinline__ void unpack8(uint4 u, float* f) {
  f[0] = __uint_as_float(u.x << 16); f[1] = __uint_as_float(u.x & 0xffff0000u);
  f[2] = __uint_as_float(u.y << 16); f[3] = __uint_as_float(u.y & 0xffff0000u);
  f[4] = __uint_as_float(u.z << 16); f[5] = __uint_as_float(u.z & 0xffff0000u);
  f[6] = __uint_as_float(u.w << 16); f[7] = __uint_as_float(u.w & 0xffff0000u);
}
__global__ __launch_bounds__(256) void k_attn_mla_naive(const bfr* QA, const bfr* KA, const bfr* VA, const bfr* SG0, bfr* OG) {
  int tile = blockIdx.x, h = blockIdx.y;
  int b = tile / 33, tt = tile % 33;
  int r = b * SEQA + tt * 256 + threadIdx.x;
  int k0 = (tt < 32) ? b * SEQA : b * SEQA + NLAT, k1 = b * SEQA + SEQA;
  float q[96], o[64];
#pragma unroll
  for (int c = 0; c < 12; ++c) unpack8(*(const uint4*)(QA + (size_t)r * 768 + h * 96 + c * 8), q + c * 8);
#pragma unroll
  for (int d = 0; d < 64; ++d) o[d] = 0.f;
  float m = -INFINITY, l = 0.f;
  for (int kr = k0; kr < k1; ++kr) {
    const uint4* kp = (const uint4*)(KA + (size_t)kr * 768 + h * 96);
    float s = 0.f;
#pragma unroll
    for (int c = 0; c < 12; ++c) { float kf[8]; unpack8(kp[c], kf);
#pragma unroll
      for (int e = 0; e < 8; ++e) s += q[c * 8 + e] * kf[e]; }
    if (s > m) { float al = exp2f(m - s); l *= al;
#pragma unroll
      for (int d = 0; d < 64; ++d) o[d] *= al;
      m = s; }
    float pr = exp2f(s - m); l += pr;
    const uint4* vp = (const uint4*)(VA + (size_t)kr * 512 + h * 64);
#pragma unroll
    for (int c = 0; c < 8; ++c) { float vf[8]; unpack8(vp[c], vf);
#pragma unroll
      for (int e = 0; e < 8; ++e) o[c * 8 + e] += pr * vf[e]; }
  }
  float il = 1.f / l;
#pragma unroll
  for (int d = 0; d < 64; ++d) { size_t idx = (size_t)r * 1024 + h * 64 + d; OG[idx] = f2bf(o[d] * il * bf2f(SG0[idx])); }
}
__global__ __launch_bounds__(256) void k_attn_diff_naive(const bfr* DQ, const bfr* DK, const bfr* DV, const float* lamp, float* Oraw) {
  int tile = blockIdx.x, h = blockIdx.y, vq = blockIdx.z;
  int b = tile / 33, tt = tile % 33;
  int r = b * SEQA + tt * 256 + threadIdx.x;
  int k0 = (tt < 32) ? b * SEQA : b * SEQA + NLAT, k1 = b * SEQA + SEQA;
  float lam = lamp[0];
  float q[64], o[32], o1[32];
  for (int mp = 0; mp < 2; ++mp) {
#pragma unroll
    for (int c = 0; c < 8; ++c) unpack8(*(const uint4*)(DQ + (size_t)r * 512 + h * 128 + mp * 64 + c * 8), q + c * 8);
#pragma unroll
    for (int d = 0; d < 32; ++d) o[d] = 0.f;
    float m = -INFINITY, l = 0.f;
    for (int kr = k0; kr < k1; ++kr) {
      const uint4* kp = (const uint4*)(DK + (size_t)kr * 512 + h * 128 + mp * 64);
      float s = 0.f;
#pragma unroll
      for (int c = 0; c < 8; ++c) { float kf[8]; unpack8(kp[c], kf);
#pragma unroll
        for (int e = 0; e < 8; ++e) s += q[c * 8 + e] * kf[e]; }
      if (s > m) { float al = exp2f(m - s); l *= al;
#pragma unroll
        for (int d = 0; d < 32; ++d) o[d] *= al;
        m = s; }
      float pr = exp2f(s - m); l += pr;
      const uint4* vp = (const uint4*)(DV + (size_t)kr * 512 + h * 128 + vq * 32);
#pragma unroll
      for (int c = 0; c < 4; ++c) { float vf[8]; unpack8(vp[c], vf);
#pragma unroll
        for (int e = 0; e < 8; ++e) o[c * 8 + e] += pr * vf[e]; }
    }
    float il = 1.f / l;
    if (mp == 0) {
#pragma unroll
      for (int d = 0; d < 32; ++d) o1[d] = o[d] * il;
    } else {
#pragma unroll
      for (int d = 0; d < 32; ++d) Oraw[(size_t)r * 512 + h * 128 + vq * 32 + d] = o1[d] - lam * o[d] * il;
    }
  }
}
__global__ __launch_bounds__(256) void k_fix_attn(const float* Oraw, const float* subg, const bfr* SG0, bfr* OG) {
  int r = blockIdx.x, h = threadIdx.x >> 6, lane = threadIdx.x & 63;
  float v0 = Oraw[(size_t)r * 512 + h * 128 + lane * 2], v1 = Oraw[(size_t)r * 512 + h * 128 + lane * 2 + 1];
  float ss = v0 * v0 + v1 * v1;
  for (int o = 32; o; o >>= 1) ss += __shfl_xor(ss, o);
  float rs = rsqrtf(ss / 128.f + 1e-6f) * 0.8f;
  size_t idx = (size_t)r * 1024 + 512 + h * 128 + lane * 2;
  OG[idx] = f2bf(v0 * rs * subg[lane * 2] * bf2f(SG0[idx]));
  OG[idx + 1] = f2bf(v1 * rs * subg[lane * 2 + 1] * bf2f(SG0[idx + 1]));
}

__global__ __launch_bounds__(256) void k_ln0(const float* x, const float* ctx, const bfr* Y, const float* mod, const float* lng, const float* lnb,
                                             float* out, bfr* XM1) {
  int r = blockIdx.x * 4 + (threadIdx.x >> 6), lane = threadIdx.x & 63;
  int b = r / SEQA, p = r - b * SEQA; int mr = p < NLAT ? b : 4;
  const float* xin = xrow(x, ctx, r);
  const float* g = mod + mr * 3072 + 2048;
  float v[16]; float s = 0.f;
#pragma unroll
  for (int i = 0; i < 16; ++i) { int c = i * 64 + lane; v[i] = ALPHA * xin[c] + g[c] * bf2f(Y[(size_t)r * 1024 + c]); s += v[i]; }
  for (int o = 32; o; o >>= 1) s += __shfl_xor(s, o);
  float mu = s / 1024.f, q = 0.f;
#pragma unroll
  for (int i = 0; i < 16; ++i) { float d = v[i] - mu; q += d * d; }
  for (int o = 32; o; o >>= 1) q += __shfl_xor(q, o);
  float rs = rsqrtf(q / 1024.f + 1e-6f);
  const float* sh1 = mod + (5 + mr) * 3072; const float* sc1 = sh1 + 1024;
#pragma unroll
  for (int i = 0; i < 16; ++i) { int c = i * 64 + lane; float y = (v[i] - mu) * rs * lng[c] + lnb[c];
    if (p < NLAT) out[((size_t)(b * NLAT + p)) * 1024 + c] = y;
    XM1[(size_t)r * 1024 + c] = f2bf(y * (1.f + sc1[c]) + sh1[c]); }
}
__global__ __launch_bounds__(256) void k_ln1(const bfr* Y, const float* mod, const float* lng, const float* lnb, float* out) {
  int lr = blockIdx.x * 4 + (threadIdx.x >> 6), lane = threadIdx.x & 63;
  int b = lr / NLAT;
  const float* g = mod + (5 + b) * 3072 + 2048;
  float* xo = out + (size_t)lr * 1024;
  float v[16]; float s = 0.f;
#pragma unroll
  for (int i = 0; i < 16; ++i) { int c = i * 64 + lane; v[i] = ALPHA * xo[c] + g[c] * bf2f(Y[(size_t)lr * 1024 + c]); s += v[i]; }
  for (int o = 32; o; o >>= 1) s += __shfl_xor(s, o);
  float mu = s / 1024.f, q = 0.f;
#pragma unroll
  for (int i = 0; i < 16; ++i) { float d = v[i] - mu; q += d * d; }
  for (int o = 32; o; o >>= 1) q += __shfl_xor(q, o);
  float rs = rsqrtf(q / 1024.f + 1e-6f);
#pragma unroll
  for (int i = 0; i < 16; ++i) { int c = i * 64 + lane; xo[c] = (v[i] - mu) * rs * lng[c] + lnb[c]; }
}

__global__ __launch_bounds__(256) void k_conv(const bfr* UG, int ldu, const float* cw, const float* cb, bfr* UC) {
  size_t idx = (size_t)blockIdx.x * 256 + threadIdx.x;
  int r = (int)(idx >> 10), c = (int)(idx & 1023);
  int p = r % SEQA; int lo = p < NLAT ? 0 : NLAT, hi = p < NLAT ? NLAT : SEQA;
  float acc = cb[c];
  for (int j = 0; j < 4; ++j) { int pp = p + j - 2; if (pp >= lo && pp < hi) acc += cw[j * 1024 + c] * bf2f(UG[(size_t)(r + j - 2) * ldu + c]); }
  UC[(size_t)r * 1024 + c] = f2bf(acc);
}
__global__ __launch_bounds__(256) void k_scan_naive(int dir, const bfr* G, const bfr* UC, const bfr* GT, int ldg, int gsilu, const float* ba, const float* bx,
                                                    const float* lambda, bfr* HG) {
  int b = blockIdx.y, ch = blockIdx.x * 256 + threadIdx.x;
  float sp = log1pf(expf(-lambda[dir * 1024 + ch]));
  float bba = ba[dir * 1024 + ch], bbx = bx[dir * 1024 + ch];
  float h = 0.f;
  for (int step = 0; step < SEQA; ++step) {
    int p;
    if (dir == 0) p = step < NCTX ? NLAT + step : step - NCTX;
    else p = step < NCTX ? SEQA - 1 - step : NLAT - 1 - (step - NCTX);
    size_t r = (size_t)b * SEQA + p;
    float rr = sigmoid_f(bf2f(G[r * 1024 + ch]) + bba);
    float ii = sigmoid_f(bf2f(G[((size_t)RTOT + r) * 1024 + ch]) + bbx);
    float la = -8.f * rr * sp;
    float a = expf(la);
    float bb = sqrtf(-expm1f(2.f * la)) * ii * bf2f(UC[r * 1024 + ch]);
    h = a * h + bb;
    if (p < NLAT) { size_t o = ((size_t)b * NLAT + p) * 1024 + ch;
      if (dir == 0) HG[o] = f2bf(h);
      else { float hs = bf2f(HG[o]) + h; float gv = bf2f(GT[r * ldg + ch]); HG[o] = f2bf(hs * (gsilu ? gv : silu_f(gv))); } }
  }
}


using bf16x8 = __attribute__((ext_vector_type(8))) short;
using s16x4  = __attribute__((ext_vector_type(4))) short;
using f32x16 = __attribute__((ext_vector_type(16))) float;
using u32x4  = __attribute__((ext_vector_type(4))) unsigned;
constexpr int NTHR = 512;
constexpr size_t OFF_ROPED = (size_t)1 << 20;
constexpr size_t OFF_ROPEA = (size_t)3 << 20;
constexpr size_t OFF_WT    = (size_t)4 << 20;
constexpr size_t OFF_WIN0  = OFF_WT;
constexpr size_t OFF_WUQ   = OFF_WIN0 + (size_t)3328 * 1024 * 2;
constexpr size_t OFF_WUKV  = OFF_WUQ + (size_t)768 * 384 * 2;
constexpr size_t OFF_WOUT0 = OFF_WUKV + (size_t)1024 * 256 * 2;
constexpr size_t OFF_WIN1  = OFF_WOUT0 + (size_t)1024 * 1024 * 2;
constexpr size_t OFF_WG    = OFF_WIN1 + (size_t)2048 * 1024 * 2;
constexpr size_t OFF_WOUT1 = OFF_WG + (size_t)32 * 128 * 128 * 2;
static_assert(OFF_WOUT1 + (size_t)1024 * 1024 * 2 <= OFF_RA, "weights overflow");
constexpr size_t SMEM_BYTES = 2 * (256 * 72 + 128 * 72) * 2;

__device__ __forceinline__ int crow(int r, int hi) { return (r & 3) + 8 * (r >> 2) + 4 * hi; }

struct Params {
  const float *x, *c, *ctx, *c_ctx, *ada_w, *ada_b, *ln_g, *ln_b, *e_w_in, *e_qg, *e_w_uq, *e_kvg, *e_w_ukv, *lq1, *lk1, *lq2, *lk2, *subg, *e_w_out,
      *o_w_in, *conv_w, *conv_b, *ga_w, *ga_b, *gx_w, *gx_b, *lru_l, *o_w_out;
  float* out; char* ws;
};

template <int MODE>
__device__ void wt_convert(const float* __restrict__ src, int K, int ldsrc, int Nd, bfr* __restrict__ dst, const float* __restrict__ kscale,
                           float* lds, int bid, int nb) {
  const int tid = threadIdx.x, tk = K >> 6, tn = Nd >> 6;
  for (int t = bid; t < tk * tn; t += nb) {
    const int k0 = (t % tk) << 6, n0 = (t / tk) << 6;
    for (int e = tid; e < 4096; e += NTHR) { int i = e >> 6, j = e & 63; int nd = n0 + j; float v;
      if (MODE == 1) { int ns = nd < 640 ? nd : (nd < 3200 ? nd + 32 : nd - 3200 + 640); v = nd < 3232 ? src[(size_t)(k0 + i) * ldsrc + ns] : 0.f; }
      else v = src[(size_t)(k0 + i) * ldsrc + nd];
      if (kscale) v *= kscale[k0 + i];
      lds[j * 65 + i] = v; }
    __syncthreads();
    for (int e = tid; e < 4096; e += NTHR) { int j = e >> 6, i = e & 63; dst[(size_t)(n0 + j) * K + k0 + i] = f2bf(lds[j * 65 + i]); }
    __syncthreads();
  }
}
__device__ void prep_phase(const Params& p, char* smem, int bid, int nb) {
  float* lds = (float*)smem; char* ws = p.ws;
  wt_convert<1>(p.e_w_in, 1024, 3232, 3328, (bfr*)(ws + OFF_WIN0), nullptr, lds, bid, nb);
  wt_convert<0>(p.e_w_uq, 384, 768, 768, (bfr*)(ws + OFF_WUQ), p.e_qg, lds, bid, nb);
  wt_convert<0>(p.e_w_ukv, 256, 1024, 1024, (bfr*)(ws + OFF_WUKV), p.e_kvg, lds, bid, nb);
  wt_convert<0>(p.e_w_out, 1024, 1024, 1024, (bfr*)(ws + OFF_WOUT0), nullptr, lds, bid, nb);
  wt_convert<0>(p.o_w_in, 1024, 2048, 2048, (bfr*)(ws + OFF_WIN1), nullptr, lds, bid, nb);
  wt_convert<0>(p.o_w_out, 1024, 1024, 1024, (bfr*)(ws + OFF_WOUT1), nullptr, lds, bid, nb);
  for (int m = 0; m < 32; ++m) {
    int dir = m >> 4, gate = (m >> 3) & 1, blk = m & 7;
    const float* src = (gate ? p.gx_w : p.ga_w) + ((size_t)dir * 8 + blk) * 128 * 128;
    wt_convert<0>(src, 128, 128, 128, (bfr*)(ws + OFF_WG) + (size_t)m * 128 * 128, nullptr, lds, bid, nb);
  }
  float2* rd = (float2*)(ws + OFF_ROPED); float2* ra = (float2*)(ws + OFF_ROPEA);
  for (int e = bid * NTHR + threadIdx.x; e < 8192 * 32; e += nb * NTHR) { int pos = e >> 5, i = e & 31;
    float pp = (i < 16) ? (float)(pos >> 6) : (float)(pos & 63); float fr = powf(10000.f, -(float)(i & 15) / 16.f);
    float sn, cs; sincosf(pp * fr, &sn, &cs); rd[e] = make_float2(cs, sn); }
  for (int e = bid * NTHR + threadIdx.x; e < 8192 * 16; e += nb * NTHR) { int pos = e >> 4, i = e & 15;
    float pp = (i < 8) ? (float)(pos >> 6) : (float)(pos & 63); float fr = powf(10000.f, -(float)(i & 7) / 8.f);
    float sn, cs; sincosf(pp * fr, &sn, &cs); ra[e] = make_float2(cs, sn); }
}

template <class Epi>
__device__ __forceinline__ void gemm_tile(const bfr* __restrict__ A, int lda, const bfr* __restrict__ Bt, int ldb, int K, int m0, int n0, Epi& epi, char* smem) {
  const int tid = threadIdx.x, wid = tid >> 6, lane = tid & 63, wm = wid >> 1, wn = wid & 1, r32 = lane & 31, hi = lane >> 5;
  bfr* sa = (bfr*)smem; bfr* sb = sa + 2 * 256 * 72;
  f32x16 acc[2][2];
#pragma unroll
  for (int i = 0; i < 2; ++i)
#pragma unroll
    for (int j = 0; j < 2; ++j)
#pragma unroll
      for (int r = 0; r < 16; ++r) acc[i][j][r] = 0.f;
  uint4 ra0, ra1, ra2, ra3, rb0, rb1;
  const int lrow = tid >> 3, lck = (tid & 7) * 8;
  const bfr* Ap = A + (size_t)(m0 + lrow) * lda + lck;
  const bfr* Bp = Bt + (size_t)(n0 + lrow) * ldb + lck;
  const size_t a64 = (size_t)64 * lda, b64 = (size_t)64 * ldb;
  const int nk = K >> 6;
  bfr* swa = sa + lrow * 72 + lck; bfr* swb = sb + lrow * 72 + lck;
#define GLOAD(kt) do { const bfr* ap_ = Ap + (kt) * 64; const bfr* bp_ = Bp + (kt) * 64; \
    ra0 = *(const uint4*)(ap_); ra1 = *(const uint4*)(ap_ + a64); ra2 = *(const uint4*)(ap_ + 2 * a64); ra3 = *(const uint4*)(ap_ + 3 * a64); \
    rb0 = *(const uint4*)(bp_); rb1 = *(const uint4*)(bp_ + b64); } while (0)
#define SWRITE(buf) do { bfr* wa_ = swa + (buf) * 256 * 72; bfr* wb_ = swb + (buf) * 128 * 72; \
    *(uint4*)(wa_) = ra0; *(uint4*)(wa_ + 64 * 72) = ra1; *(uint4*)(wa_ + 128 * 72) = ra2; *(uint4*)(wa_ + 192 * 72) = ra3; \
    *(uint4*)(wb_) = rb0; *(uint4*)(wb_ + 64 * 72) = rb1; } while (0)
  GLOAD(0); SWRITE(0); __syncthreads();
  for (int kt = 0; kt < nk; ++kt) {
    const int cur = kt & 1;
    if (kt + 1 < nk) GLOAD(kt + 1);
    const bfr* pa = sa + cur * 256 * 72 + (wm * 64 + r32) * 72 + hi * 8;
    const bfr* pb = sb + cur * 128 * 72 + (wn * 64 + r32) * 72 + hi * 8;
#pragma unroll
    for (int ks = 0; ks < 4; ++ks) {
      bf16x8 a0 = *(const bf16x8*)(pa + ks * 16), a1 = *(const bf16x8*)(pa + 32 * 72 + ks * 16);
      bf16x8 b0 = *(const bf16x8*)(pb + ks * 16), b1 = *(const bf16x8*)(pb + 32 * 72 + ks * 16);
      acc[0][0] = __builtin_amdgcn_mfma_f32_32x32x16_bf16(a0, b0, acc[0][0], 0, 0, 0);
      acc[0][1] = __builtin_amdgcn_mfma_f32_32x32x16_bf16(a0, b1, acc[0][1], 0, 0, 0);
      acc[1][0] = __builtin_amdgcn_mfma_f32_32x32x16_bf16(a1, b0, acc[1][0], 0, 0, 0);
      acc[1][1] = __builtin_amdgcn_mfma_f32_32x32x16_bf16(a1, b1, acc[1][1], 0, 0, 0);
    }
    if (kt + 1 < nk) SWRITE(cur ^ 1);
    __syncthreads();
  }
#undef GLOAD
#undef SWRITE
  epi(m0 + wm * 64, n0 + wn * 64, acc, r32, hi);
}
template <class Epi>
__device__ void gemm_phase(const bfr* A, int lda, const bfr* Bt, int ldb, int K, int mtiles, int ntiles, Epi& epi, char* smem, int bid, int nb) {
  for (int t = bid; t < mtiles * ntiles; t += nb) { int mt = t / ntiles, nt = t - mt * ntiles; gemm_tile(A, lda, Bt, ldb, K, mt * 256, nt * 128, epi, smem); }
}
struct FEpiStore { bfr* C; int ldc;
  __device__ __forceinline__ void operator()(int m0, int n0, f32x16 (&acc)[2][2], int r32, int hi) {
#pragma unroll
    for (int mt = 0; mt < 2; ++mt)
#pragma unroll
      for (int nt = 0; nt < 2; ++nt)
#pragma unroll
        for (int r = 0; r < 16; ++r) C[(size_t)(m0 + mt * 32 + crow(r, hi)) * ldc + n0 + nt * 32 + r32] = f2bf(acc[mt][nt][r]);
  } };
struct FEpiUG { bfr *U, *SG1;
  __device__ __forceinline__ void operator()(int m0, int n0, f32x16 (&acc)[2][2], int r32, int hi) {
    const bool g = n0 >= 1024; bfr* C = g ? SG1 : U; const int nn = g ? n0 - 1024 : n0;
#pragma unroll
    for (int mt = 0; mt < 2; ++mt)
#pragma unroll
      for (int nt = 0; nt < 2; ++nt)
#pragma unroll
        for (int r = 0; r < 16; ++r) { float v = acc[mt][nt][r]; if (g) v = silu_f(v);
          C[(size_t)(m0 + mt * 32 + crow(r, hi)) * 1024 + nn + nt * 32 + r32] = f2bf(v); }
  } };
struct FEpiZ { bfr *Zc, *DQ, *DK, *DV, *SG0, *KA; const float2 *ropeD, *ropeA;
  __device__ __forceinline__ void operator()(int m0, int n0, f32x16 (&acc)[2][2], int r32, int hi) {
    const int p0 = m0 % SEQA; const bool lat = p0 < NLAT;
    if (n0 < 640) {
#pragma unroll
      for (int mt = 0; mt < 2; ++mt)
#pragma unroll
        for (int nt = 0; nt < 2; ++nt)
#pragma unroll
          for (int r = 0; r < 16; ++r) Zc[(size_t)(m0 + mt * 32 + crow(r, hi)) * 640 + n0 + nt * 32 + r32] = f2bf(acc[mt][nt][r]);
    } else if (n0 < 1664) {
      const bool isq = n0 < 1152; bfr* C = isq ? DQ : DK; const int nn = isq ? n0 - 640 : n0 - 1152; const float sc = isq ? QSC_D : 1.f;
#pragma unroll
      for (int mt = 0; mt < 2; ++mt)
#pragma unroll
        for (int r = 0; r < 16; ++r) { const int rr = mt * 32 + crow(r, hi);
          float cs = 1.f, sn = 0.f; if (lat) { float2 t = ropeD[(p0 + rr) * 32 + r32]; cs = t.x; sn = t.y; }
          float x1 = acc[mt][0][r], x2 = acc[mt][1][r];
          bfr* d = C + (size_t)(m0 + rr) * 512 + nn + r32;
          d[0] = f2bf((x1 * cs - x2 * sn) * sc); d[32] = f2bf((x2 * cs + x1 * sn) * sc); }
    } else if (n0 < 2176) {
#pragma unroll
      for (int mt = 0; mt < 2; ++mt)
#pragma unroll
        for (int nt = 0; nt < 2; ++nt)
#pragma unroll
          for (int r = 0; r < 16; ++r) DV[(size_t)(m0 + mt * 32 + crow(r, hi)) * 512 + n0 - 1664 + nt * 32 + r32] = f2bf(acc[mt][nt][r]);
    } else if (n0 < 3200) {
#pragma unroll
      for (int mt = 0; mt < 2; ++mt)
#pragma unroll
        for (int nt = 0; nt < 2; ++nt)
#pragma unroll
          for (int r = 0; r < 16; ++r) SG0[(size_t)(m0 + mt * 32 + crow(r, hi)) * 1024 + n0 - 2176 + nt * 32 + r32] = f2bf(silu_f(acc[mt][nt][r]));
    } else if (n0 == 3200) {
#pragma unroll
      for (int mt = 0; mt < 2; ++mt)
#pragma unroll
        for (int r = 0; r < 16; ++r) { const int rr = mt * 32 + crow(r, hi);
          float cs = 1.f, sn = 0.f; if (lat) { float2 t = ropeA[(p0 + rr) * 16 + (r32 & 15)]; cs = t.x; sn = t.y; }
          float xv = acc[mt][0][r]; float pv = __shfl_xor(xv, 16);
          float o = (r32 < 16) ? (xv * cs - pv * sn) : (xv * cs + pv * sn);
          bfr ob = f2bf(o); bfr* d = KA + (size_t)(m0 + rr) * 768 + 64 + r32;
#pragma unroll
          for (int h = 0; h < 8; ++h) d[h * 96] = ob; }
    }
  } };
struct FEpiQ { bfr* QA; const float2* ropeA; const float* rfac;
  __device__ __forceinline__ void operator()(int m0, int n0, f32x16 (&acc)[2][2], int r32, int hi) {
    const int p0 = m0 % SEQA; const bool lat = p0 < NLAT; const int mloc = m0 & 255;
#pragma unroll
    for (int nt = 0; nt < 2; ++nt) { const int s32 = (n0 >> 5) + nt; const bool rope = (s32 % 3) == 2;
#pragma unroll
      for (int mt = 0; mt < 2; ++mt)
#pragma unroll
        for (int r = 0; r < 16; ++r) { const int rr = mt * 32 + crow(r, hi);
          float v = acc[mt][nt][r] * rfac[mloc + rr];
          if (rope) { float cs = 1.f, sn = 0.f; if (lat) { float2 t = ropeA[(p0 + rr) * 16 + (r32 & 15)]; cs = t.x; sn = t.y; }
            float pv = __shfl_xor(v, 16); v = (r32 < 16) ? (v * cs - pv * sn) : (v * cs + pv * sn); }
          QA[(size_t)(m0 + rr) * 768 + s32 * 32 + r32] = f2bf(v * QSC_A); } }
  } };
struct FEpiKV { bfr *KA, *VA; const float* rfac;
  __device__ __forceinline__ void operator()(int m0, int n0, f32x16 (&acc)[2][2], int r32, int hi) {
    const int mloc = m0 & 255;
#pragma unroll
    for (int nt = 0; nt < 2; ++nt) { const int s32 = (n0 >> 5) + nt, h = s32 >> 2, part = s32 & 3;
      bfr* C = part < 2 ? KA + h * 96 + part * 32 : VA + h * 64 + (part - 2) * 32; const int ldc = part < 2 ? 768 : 512;
#pragma unroll
      for (int mt = 0; mt < 2; ++mt)
#pragma unroll
        for (int r = 0; r < 16; ++r) { const int rr = mt * 32 + crow(r, hi);
          C[(size_t)(m0 + rr) * ldc + r32] = f2bf(acc[mt][nt][r] * rfac[mloc + rr]); } }
  } };
__device__ void upproj_phase(const Params& p, char* smem, int bid, int nb) {
  char* ws = p.ws; const bfr* Zc = (const bfr*)(ws + OFF_RE);
  float* rfac = (float*)(smem + SMEM_BYTES);
  bfr* QA = (bfr*)(ws + OFF_RD); bfr* KA = QA + (size_t)RTOT * 768; bfr* VA = QA + (size_t)RTOT * 1536;
  FEpiQ eq; eq.QA = QA; eq.ropeA = (const float2*)(ws + OFF_ROPEA); eq.rfac = rfac;
  FEpiKV ek; ek.KA = KA; ek.VA = VA; ek.rfac = rfac;
  const int tid = threadIdx.x;
  for (int t = bid; t < 132 * 14; t += nb) {
    const int mt = t / 14, j = t - mt * 14; const bool isq = j < 6; const int m0 = mt * 256;
    {
      const int row = tid >> 1, half = tid & 1; const int ncol = isq ? 192 : 128;
      const bfr* z = Zc + (size_t)(m0 + row) * 640 + (isq ? 0 : 384) + half * ncol;
      float ss = 0.f;
      for (int c = 0; c < ncol; c += 8) { uint4 u = *(const uint4*)(z + c); float f[8]; unpack8(u, f);
#pragma unroll
        for (int e = 0; e < 8; ++e) ss += f[e] * f[e]; }
      ss += __shfl_xor(ss, 1);
      if (half == 0) rfac[row] = rsqrtf(ss / (isq ? 384.f : 256.f) + 1e-6f);
    }
    __syncthreads();
    if (isq) gemm_tile(Zc, 640, (const bfr*)(ws + OFF_WUQ), 384, 384, m0, j * 128, eq, smem);
    else gemm_tile(Zc + 384, 640, (const bfr*)(ws + OFF_WUKV), 256, 256, m0, (j - 6) * 128, ek, smem);
    __syncthreads();
  }
}


constexpr int SHM_KV = 64 * 256;
constexpr float THR2 = 11.5f;
#define KSWZ(row, colB) ((row) * 256 + ((colB) ^ (((row) & 7) << 4)))
#define SBAR() __builtin_amdgcn_sched_barrier(0)
__device__ __forceinline__ unsigned cvtpk(float lo, float hi) { unsigned r; asm volatile("v_cvt_pk_bf16_f32 %0, %1, %2" : "=v"(r) : "v"(lo), "v"(hi)); return r; }
__device__ __forceinline__ void partialSM(f32x16& p0, f32x16& p1, float& m_reg, float& mn, float& alpha) {
  float pmax = p0[0];
#pragma unroll
  for (int r = 1; r < 16; ++r) pmax = fmaxf(pmax, p0[r]);
#pragma unroll
  for (int r = 0; r < 16; ++r) pmax = fmaxf(pmax, p1[r]);
  { auto rr = __builtin_amdgcn_permlane32_swap(__float_as_uint(pmax), __float_as_uint(pmax), false, false);
    pmax = fmaxf(__uint_as_float(rr[0]), __uint_as_float(rr[1])); }
  if (__builtin_expect(__all(pmax - m_reg <= THR2), 1)) { mn = m_reg; alpha = 1.f; }
  else { mn = fmaxf(m_reg, pmax); alpha = __builtin_amdgcn_exp2f(m_reg - mn); m_reg = mn; }
#pragma unroll
  for (int r = 0; r < 16; ++r) p0[r] = p0[r] - mn;
#pragma unroll
  for (int r = 0; r < 16; ++r) p1[r] = p1[r] - mn;
#pragma unroll
  for (int r = 0; r < 16; ++r) p0[r] = __builtin_amdgcn_exp2f(p0[r]);
}
__device__ __forceinline__ void finishSM(f32x16& p0, f32x16& p1, float alpha, float& l_reg, bf16x8& pa0, bf16x8& pa1, bf16x8& pa2, bf16x8& pa3) {
#pragma unroll
  for (int r = 0; r < 16; ++r) p1[r] = __builtin_amdgcn_exp2f(p1[r]);
  float ps = 0;
#pragma unroll
  for (int r = 0; r < 16; ++r) ps += p0[r];
#pragma unroll
  for (int r = 0; r < 16; ++r) ps += p1[r];
  { auto rr = __builtin_amdgcn_permlane32_swap(__float_as_uint(ps), __float_as_uint(ps), false, false);
    ps = __uint_as_float(rr[0]) + __uint_as_float(rr[1]); }
  l_reg = l_reg * alpha + ps;
#define PK4(P, BASE, OUT) do { unsigned a0 = cvtpk(P[BASE + 0], P[BASE + 1]), a1 = cvtpk(P[BASE + 2], P[BASE + 3]);   \
    unsigned b0 = cvtpk(P[BASE + 4], P[BASE + 5]), b1 = cvtpk(P[BASE + 6], P[BASE + 7]);                              \
    auto r0 = __builtin_amdgcn_permlane32_swap(a0, b0, false, false); auto r1 = __builtin_amdgcn_permlane32_swap(a1, b1, false, false); \
    u32x4 w = {r0[0], r1[0], r0[1], r1[1]}; OUT = *reinterpret_cast<bf16x8*>(&w); } while (0)
  PK4(p0, 0, pa0); PK4(p0, 8, pa1); PK4(p1, 0, pa2); PK4(p1, 8, pa3);
#undef PK4
}
template <int NKS>
__device__ __forceinline__ void qkt(f32x16& p0, f32x16& p1, const char* Ks, const bf16x8* qr, int r32, int hi, int qcolB) {
#pragma unroll
  for (int r = 0; r < 16; ++r) { p0[r] = 0.f; p1[r] = 0.f; }
#pragma unroll
  for (int d0 = 0; d0 < NKS; ++d0) { int cb = qcolB + (d0 * 16 + hi * 8) * 2;
    bf16x8 b0 = *reinterpret_cast<const bf16x8*>(Ks + KSWZ(r32, cb));
    bf16x8 b1 = *reinterpret_cast<const bf16x8*>(Ks + KSWZ(32 + r32, cb));
    p0 = __builtin_amdgcn_mfma_f32_32x32x16_bf16(b0, qr[d0], p0, 0, 0, 0);
    p1 = __builtin_amdgcn_mfma_f32_32x32x16_bf16(b1, qr[d0], p1, 0, 0, 0); }
}
__device__ __forceinline__ int v_st(int k, int c) { const int kk = (k & ~0xC) | ((k & 4) << 1) | ((k & 8) >> 1); return ((kk >> 3) * 4 + (c >> 5)) * 512 + ((kk & 7) * 32 + (c & 31)) * 2; }
__device__ __forceinline__ int v_rd_base(int lane) { return ((lane & 3) << 3) | (((lane >> 2) & 3) << 6) | (((lane >> 4) & 1) << 5) | (((lane >> 5) & 1) << 8); }
constexpr int v_rd_off(int d0, int ks, int half) { return d0 * 512 + ks * 4096 + half * 2048; }
template <int OFF> __device__ __forceinline__ s16x4 tr_read(int vb) {
  s16x4 r; asm volatile("ds_read_b64_tr_b16 %0, %1 offset:%2" : "=&v"(r) : "v"(vb), "i"(OFF) : "memory"); return r;
}
template <int D0> __device__ __forceinline__ void pv_one(f32x16& od, int vb, bf16x8 pa0, bf16x8 pa1, bf16x8 pa2, bf16x8 pa3) {
  const s16x4 l0 = tr_read<v_rd_off(D0, 0, 0)>(vb), h0 = tr_read<v_rd_off(D0, 0, 1)>(vb), l1 = tr_read<v_rd_off(D0, 1, 0)>(vb), h1 = tr_read<v_rd_off(D0, 1, 1)>(vb);
  const s16x4 l2 = tr_read<v_rd_off(D0, 2, 0)>(vb), h2 = tr_read<v_rd_off(D0, 2, 1)>(vb), l3 = tr_read<v_rd_off(D0, 3, 0)>(vb), h3 = tr_read<v_rd_off(D0, 3, 1)>(vb);
  asm volatile("s_waitcnt lgkmcnt(0)" ::: "memory"); SBAR();
#define PK(L, H) (bf16x8){L[0], L[1], L[2], L[3], H[0], H[1], H[2], H[3]}
  od = __builtin_amdgcn_mfma_f32_32x32x16_bf16(pa0, PK(l0, h0), od, 0, 0, 0);
  od = __builtin_amdgcn_mfma_f32_32x32x16_bf16(pa1, PK(l1, h1), od, 0, 0, 0);
  od = __builtin_amdgcn_mfma_f32_32x32x16_bf16(pa2, PK(l2, h2), od, 0, 0, 0);
  od = __builtin_amdgcn_mfma_f32_32x32x16_bf16(pa3, PK(l3, h3), od, 0, 0, 0);
#undef PK
}
template <int NVB> __device__ __forceinline__ void pv_all(f32x16* o, int vb, bf16x8 pa0, bf16x8 pa1, bf16x8 pa2, bf16x8 pa3) {
  pv_one<0>(o[0], vb, pa0, pa1, pa2, pa3); pv_one<1>(o[1], vb, pa0, pa1, pa2, pa3);
  if constexpr (NVB == 4) { pv_one<2>(o[2], vb, pa0, pa1, pa2, pa3); pv_one<3>(o[3], vb, pa0, pa1, pa2, pa3); }
}
template <int TYPE>
__device__ __forceinline__ void attn_item(const Params& p, char* lds, int h, int qrow0, int krow0, int NT, float lam) {
  constexpr int NKS = TYPE ? 4 : 6, NVB = TYPE ? 4 : 2;
  constexpr int LDQ = TYPE ? 512 : 768, LDK = TYPE ? 512 : 768, LDV = 512;
  constexpr int KCOLS = TYPE ? 128 : 96, VCOLS = TYPE ? 128 : 64;
  const int tid = threadIdx.x, wid = tid >> 6, lane = tid & 63, r32 = lane & 31, hi = lane >> 5;
  const int map = TYPE ? (wid >> 2) : 0, wq = TYPE ? (wid & 3) : wid;
  char* ws = p.ws;
  const bfr* Qb = TYPE ? (const bfr*)(ws + OFF_RC) + (size_t)(qrow0 + wq * 32 + r32) * 512 + h * 128 + map * 64 + hi * 8
                       : (const bfr*)(ws + OFF_RD) + (size_t)(qrow0 + wq * 32 + r32) * 768 + h * 96 + hi * 8;
  const bfr* Kh = TYPE ? (const bfr*)(ws + OFF_RC) + (size_t)RTOT * 512 + (size_t)krow0 * 512 + h * 128
                       : (const bfr*)(ws + OFF_RD) + (size_t)RTOT * 768 + (size_t)krow0 * 768 + h * 96;
  const bfr* Vh = TYPE ? (const bfr*)(ws + OFF_RC) + (size_t)RTOT * 1024 + (size_t)krow0 * 512 + h * 128
                       : (const bfr*)(ws + OFF_RD) + (size_t)RTOT * 1536 + (size_t)krow0 * 512 + h * 64;
  const bfr* SG0 = (const bfr*)(ws + OFF_RB); bfr* OG = (bfr*)(ws + OFF_RA);
  const int qcolB = map * 128;
  char* V_lds = lds; char* K_lds = lds + 2 * SHM_KV;
  float* wsc = (float*)(lds + 4 * SHM_KV) + wid * 64; float* li_l = wsc; float* al_l = wsc + 32;
  float m_reg = -1e30f, l_reg = 0.f; f32x16 o[NVB]; bf16x8 qr[NKS];
#pragma unroll
  for (int d = 0; d < NVB; ++d)
#pragma unroll
    for (int r = 0; r < 16; ++r) o[d][r] = 0.f;
#pragma unroll
  for (int d0 = 0; d0 < NKS; ++d0) qr[d0] = *reinterpret_cast<const bf16x8*>(Qb + d0 * 16);
  const int sr = tid >> 4, sc = (tid & 15) * 8, vst0 = v_st(sr, sc), vst1 = v_st(32 + sr, sc);
  const bool kval = sc < KCOLS, vval = sc < VCOLS;
  const int vb0 = (int)(uintptr_t)V_lds + v_rd_base(lane);
  bf16x8 e_vs0, e_vs1, e_ks0, e_ks1, o_vs0, o_vs1, o_ks0, o_ks1;
#define LD8(ptr) (*reinterpret_cast<const bf16x8*>(ptr))
#define SLOAD_E(k0) do { if (vval) { e_vs0 = LD8(&Vh[(size_t)((k0) + sr) * LDV + sc]); e_vs1 = LD8(&Vh[(size_t)((k0) + 32 + sr) * LDV + sc]); } \
    if (kval) { e_ks0 = LD8(&Kh[(size_t)((k0) + sr) * LDK + sc]); e_ks1 = LD8(&Kh[(size_t)((k0) + 32 + sr) * LDK + sc]); } } while (0)
#define SLOAD_O(k0) do { if (vval) { o_vs0 = LD8(&Vh[(size_t)((k0) + sr) * LDV + sc]); o_vs1 = LD8(&Vh[(size_t)((k0) + 32 + sr) * LDV + sc]); } \
    if (kval) { o_ks0 = LD8(&Kh[(size_t)((k0) + sr) * LDK + sc]); o_ks1 = LD8(&Kh[(size_t)((k0) + 32 + sr) * LDK + sc]); } } while (0)
#define SWRITE_E(b) do { if (vval) { *(bf16x8*)(V_lds + (b) * SHM_KV + vst0) = e_vs0; *(bf16x8*)(V_lds + (b) * SHM_KV + vst1) = e_vs1; } \
    if (kval) { int kc = sc * 2; *(bf16x8*)(K_lds + (b) * SHM_KV + KSWZ(sr, kc)) = e_ks0; *(bf16x8*)(K_lds + (b) * SHM_KV + KSWZ(32 + sr, kc)) = e_ks1; } } while (0)
#define SWRITE_O(b) do { if (vval) { *(bf16x8*)(V_lds + (b) * SHM_KV + vst0) = o_vs0; *(bf16x8*)(V_lds + (b) * SHM_KV + vst1) = o_vs1; } \
    if (kval) { int kc = sc * 2; *(bf16x8*)(K_lds + (b) * SHM_KV + KSWZ(sr, kc)) = o_ks0; *(bf16x8*)(K_lds + (b) * SHM_KV + KSWZ(32 + sr, kc)) = o_ks1; } } while (0)
#define SWAIT() asm volatile("s_waitcnt vmcnt(4)" ::: "memory")
#define RESC(a) do { if (__any((a) < 1.f)) { if (hi == 0) al_l[r32] = (a); asm volatile("s_waitcnt lgkmcnt(0)" ::: "memory"); \
    _Pragma("unroll") for (int d = 0; d < NVB; ++d) _Pragma("unroll") for (int r = 0; r < 16; ++r) o[d][r] *= al_l[crow(r, hi)]; } } while (0)
  f32x16 pA0, pA1, pB0, pB1; float mnA, mnB, alA, alB; bf16x8 pa0, pa1, pa2, pa3;
  SLOAD_E(0); asm volatile("s_waitcnt vmcnt(0)" ::: "memory"); SWRITE_E(0); __syncthreads();
  qkt<NKS>(pA0, pA1, K_lds, qr, r32, hi, qcolB); partialSM(pA0, pA1, m_reg, mnA, alA);
  SLOAD_O(64); if (2 < NT) SLOAD_E(2 * 64);
  SWAIT(); SWRITE_O(1); __syncthreads();
  for (int j = 1; j + 1 < NT; j += 2) {
    SBAR(); qkt<NKS>(pB0, pB1, K_lds + SHM_KV, qr, r32, hi, qcolB);
    finishSM(pA0, pA1, alA, l_reg, pa0, pa1, pa2, pa3); SBAR();
    SLOAD_O((j + 2) * 64); SBAR();
    pv_all<NVB>(o, vb0, pa0, pa1, pa2, pa3); partialSM(pB0, pB1, m_reg, mnB, alB);
    __syncthreads(); SWAIT(); SWRITE_E(0);
    RESC(alB); __syncthreads();
    SBAR(); qkt<NKS>(pA0, pA1, K_lds, qr, r32, hi, qcolB);
    finishSM(pB0, pB1, alB, l_reg, pa0, pa1, pa2, pa3); SBAR();
    if (j + 3 < NT) SLOAD_E((j + 3) * 64); SBAR();
    pv_all<NVB>(o, vb0 + SHM_KV, pa0, pa1, pa2, pa3); partialSM(pA0, pA1, m_reg, mnA, alA);
    __syncthreads(); SWAIT(); SWRITE_O(1);
    RESC(alA); __syncthreads();
  }
  SBAR(); qkt<NKS>(pB0, pB1, K_lds + SHM_KV, qr, r32, hi, qcolB);
  finishSM(pA0, pA1, alA, l_reg, pa0, pa1, pa2, pa3); SBAR();
  pv_all<NVB>(o, vb0, pa0, pa1, pa2, pa3); partialSM(pB0, pB1, m_reg, mnB, alB);
  __syncthreads(); RESC(alB);
  finishSM(pB0, pB1, alB, l_reg, pa0, pa1, pa2, pa3); SBAR();
  pv_all<NVB>(o, vb0 + SHM_KV, pa0, pa1, pa2, pa3);
  if (hi == 0) li_l[r32] = l_reg; asm volatile("s_waitcnt lgkmcnt(0)" ::: "memory");
  float rli[16];
#pragma unroll
  for (int r = 0; r < 16; ++r) rli[r] = __builtin_amdgcn_rcpf(li_l[crow(r, hi)]);
  if constexpr (TYPE == 0) {
#pragma unroll
    for (int r = 0; r < 16; ++r) { const size_t row = (size_t)(qrow0 + wq * 32 + crow(r, hi)) * 1024;
#pragma unroll
      for (int d0 = 0; d0 < NVB; ++d0) { const size_t idx = row + h * 64 + d0 * 32 + r32; OG[idx] = f2bf(o[d0][r] * rli[r] * bf2f(SG0[idx])); } }
    __syncthreads();
  } else {
    float* xch = (float*)lds;
    __syncthreads();
    if (map == 1) {
#pragma unroll
      for (int r = 0; r < 16; ++r) { const float f = rli[r] * lam;
#pragma unroll
        for (int d0 = 0; d0 < 4; ++d0) xch[(wq * 32 + crow(r, hi)) * 128 + d0 * 32 + r32] = o[d0][r] * f; }
    }
    __syncthreads();
    if (map == 0) {
      const float* subg = p.subg;
#pragma unroll
      for (int r = 0; r < 16; ++r) { float ss = 0.f;
#pragma unroll
        for (int d0 = 0; d0 < 4; ++d0) { float v = o[d0][r] * rli[r] - xch[(wq * 32 + crow(r, hi)) * 128 + d0 * 32 + r32]; o[d0][r] = v; ss += v * v; }
        ss += __shfl_xor(ss, 16); ss += __shfl_xor(ss, 8); ss += __shfl_xor(ss, 4); ss += __shfl_xor(ss, 2); ss += __shfl_xor(ss, 1);
        const float rs = rsqrtf(ss * (1.f / 128.f) + 1e-6f) * 0.8f;
        const size_t row = (size_t)(qrow0 + wq * 32 + crow(r, hi)) * 1024;
#pragma unroll
        for (int d0 = 0; d0 < 4; ++d0) { const size_t idx = row + 512 + h * 128 + d0 * 32 + r32;
          OG[idx] = f2bf(o[d0][r] * rs * subg[d0 * 32 + r32] * bf2f(SG0[idx])); } }
    }
    __syncthreads();
  }
#undef LD8
#undef SLOAD_E
#undef SLOAD_O
#undef SWRITE_E
#undef SWRITE_O
#undef SWAIT
#undef RESC
}
__device__ void attn_phase(const Params& p, char* smem, int bid, int nb) {
  const float lam = *(const float*)(p.ws + OFF_LAM);
  for (int it = bid; it < 2112; it += nb) {
    const int rd = it >> 8, j = it & 255;
    int type, h, qrow0, krow0, NT;
    if (rd < 4) { const int b = rd; type = 0; h = j & 7; qrow0 = b * SEQA + (j >> 3) * 256; krow0 = b * SEQA; NT = 132; }
    else if (rd < 8) { const int pair = (j & 7) + 8 * ((rd - 4) >> 1), b = pair >> 2, qt = 2 * (j >> 3) + ((rd - 4) & 1);
      type = 1; h = pair & 3; qrow0 = b * SEQA + qt * 128; krow0 = b * SEQA; NT = 132; }
    else if (j < 32) { const int b = j >> 3; type = 0; h = j & 7; qrow0 = b * SEQA + NLAT; krow0 = qrow0; NT = 4; }
    else if (j < 64) { const int pair = (j - 32) >> 1, b = pair >> 2, qt = (j - 32) & 1;
      type = 1; h = pair & 3; krow0 = b * SEQA + NLAT; qrow0 = krow0 + qt * 128; NT = 4; }
    else continue;
#ifndef ONLY_T1
    if (type == 0) attn_item<0>(p, smem, h, qrow0, krow0, NT, lam);
#endif
#ifndef ONLY_T0
    if (type == 1) attn_item<1>(p, smem, h, qrow0, krow0, NT, lam);
#endif
  }
}


constexpr size_t CARRY_SZ = (size_t)2 * 4 * 132 * 1024 * 4;
constexpr size_t OFF_CA = OFF_RC, OFF_CB = OFF_RC + CARRY_SZ, OFF_HIN = OFF_RC + 2 * CARRY_SZ;
constexpr int AT_LD = 264;
constexpr size_t SCAN_UF_OFF = 64 * AT_LD * 2;

template <int PASS>
__device__ __forceinline__ void scan_item(const Params& p, char* lds, int b, int c, int cg) {
  const int tid = threadIdx.x, wid = tid >> 6, lane = tid & 63, r32 = lane & 31, hi = lane >> 5;
  char* ws = p.ws;
  const bfr* U = (const bfr*)(ws + OFF_RD); const bfr* SG1 = U + (size_t)RTOT * 1024;
  bfr* AT = (bfr*)lds; float* UF = (float*)(lds + SCAN_UF_OFF);
  const int row0 = b * SEQA + c * 64;
  const int lo = c < 128 ? 0 : NLAT, hiP = c < 128 ? NLAT : SEQA;
  {
    const int k8 = tid & 31, ch = cg * 256 + k8 * 8;
    float w[4][8], bia[8];
#pragma unroll
    for (int j = 0; j < 4; ++j) { float4 t0 = *(const float4*)(p.conv_w + j * 1024 + ch), t1 = *(const float4*)(p.conv_w + j * 1024 + ch + 4);
      w[j][0] = t0.x; w[j][1] = t0.y; w[j][2] = t0.z; w[j][3] = t0.w; w[j][4] = t1.x; w[j][5] = t1.y; w[j][6] = t1.z; w[j][7] = t1.w; }
    { float4 t0 = *(const float4*)(p.conv_b + ch), t1 = *(const float4*)(p.conv_b + ch + 4);
      bia[0] = t0.x; bia[1] = t0.y; bia[2] = t0.z; bia[3] = t0.w; bia[4] = t1.x; bia[5] = t1.y; bia[6] = t1.z; bia[7] = t1.w; }
#pragma unroll
    for (int i = 0; i < 4; ++i) { const int t = (tid >> 5) + i * 16; const int pt = c * 64 + t;
      float acc[8];
#pragma unroll
      for (int e = 0; e < 8; ++e) acc[e] = bia[e];
#pragma unroll
      for (int j = 0; j < 4; ++j) { const int pp = pt + j - 2;
        if (pp >= lo && pp < hiP) { uint4 u = *(const uint4*)(U + (size_t)(row0 + t + j - 2) * 1024 + ch); float f[8]; unpack8(u, f);
#pragma unroll
          for (int e = 0; e < 8; ++e) acc[e] += w[j][e] * f[e]; } }
      u32x4 pk; pk[0] = cvtpk(acc[0], acc[1]); pk[1] = cvtpk(acc[2], acc[3]); pk[2] = cvtpk(acc[4], acc[5]); pk[3] = cvtpk(acc[6], acc[7]);
      *(u32x4*)(AT + t * AT_LD + k8 * 8) = pk;
      *(float4*)(UF + t * 256 + k8 * 8) = make_float4(acc[0], acc[1], acc[2], acc[3]);
      *(float4*)(UF + t * 256 + k8 * 8 + 4) = make_float4(acc[4], acc[5], acc[6], acc[7]); }
  }
  __syncthreads();
  const int blkl = wid >> 2, blk = cg * 2 + blkl, j0 = (wid & 3) * 32;
  const int ch = cg * 256 + wid * 32 + r32;
  float hsum[2][16];
#pragma unroll
  for (int dir = 0; dir < 2; ++dir) {
    f32x16 ga[2], gx[2];
#pragma unroll
    for (int mt = 0; mt < 2; ++mt)
#pragma unroll
      for (int r = 0; r < 16; ++r) { ga[mt][r] = 0.f; gx[mt][r] = 0.f; }
    const bfr* wa = (const bfr*)(ws + OFF_WG) + (size_t)(dir * 16 + blk) * 16384 + (size_t)(j0 + r32) * 128 + hi * 8;
    const bfr* wx = wa + (size_t)8 * 16384;
    const bfr* ap = AT + r32 * AT_LD + blkl * 128 + hi * 8;
#pragma unroll 2
    for (int ks = 0; ks < 8; ++ks) {
      bf16x8 a0 = *(const bf16x8*)(ap + ks * 16), a1 = *(const bf16x8*)(ap + 32 * AT_LD + ks * 16);
      bf16x8 ba_ = *(const bf16x8*)(wa + ks * 16), bx_ = *(const bf16x8*)(wx + ks * 16);
      ga[0] = __builtin_amdgcn_mfma_f32_32x32x16_bf16(a0, ba_, ga[0], 0, 0, 0);
      ga[1] = __builtin_amdgcn_mfma_f32_32x32x16_bf16(a1, ba_, ga[1], 0, 0, 0);
      gx[0] = __builtin_amdgcn_mfma_f32_32x32x16_bf16(a0, bx_, gx[0], 0, 0, 0);
      gx[1] = __builtin_amdgcn_mfma_f32_32x32x16_bf16(a1, bx_, gx[1], 0, 0, 0);
    }
    const float sp = log1pf(expf(-p.lru_l[dir * 1024 + ch]));
    const float kA = -8.f * sp * LOG2E, biasA = p.ga_b[dir * 1024 + ch], biasX = p.gx_b[dir * 1024 + ch];
#pragma unroll
    for (int mt = 0; mt < 2; ++mt)
#pragma unroll
      for (int r = 0; r < 16; ++r) {
        const float rr = __builtin_amdgcn_rcpf(1.f + __builtin_amdgcn_exp2f(-(ga[mt][r] + biasA) * LOG2E));
        const float ii = __builtin_amdgcn_rcpf(1.f + __builtin_amdgcn_exp2f(-(gx[mt][r] + biasX) * LOG2E));
        const float a = __builtin_amdgcn_exp2f(kA * rr);
        const float uc = UF[(mt * 32 + crow(r, hi)) * 256 + wid * 32 + r32];
        ga[mt][r] = a; gx[mt][r] = __builtin_amdgcn_sqrtf(fmaxf(1.f - a * a, 0.f)) * ii * uc;
      }
    float sA[8], sB[8];
#pragma unroll
    for (int sgi = 0; sgi < 8; ++sgi) { const int mt = sgi >> 2, g = sgi & 3; float A = 1.f, Bv = 0.f;
#pragma unroll
      for (int e = 0; e < 4; ++e) { const int r = g * 4 + (dir ? 3 - e : e); A *= ga[mt][r]; Bv = ga[mt][r] * Bv + gx[mt][r]; }
      sA[sgi] = A; sB[sgi] = Bv; }
    const bool ownFirst = (dir == 0) == (hi == 0);
    float st, stA = 1.f;
    if (PASS == 1) st = *(const float*)(ws + OFF_HIN + ((size_t)((dir * 4 + b) * 132 + c) * 1024 + ch) * 4); else st = 0.f;
#pragma unroll
    for (int q = 0; q < 8; ++q) { const int sgi = dir ? 7 - q : q;
      const float oA = sA[sgi], oB = sB[sgi];
      const float pA = __shfl_xor(oA, 32), pB = __shfl_xor(oB, 32);
      const float fA = ownFirst ? oA : pA, fB = ownFirst ? oB : pB, sA2 = ownFirst ? pA : oA, sB2 = ownFirst ? pB : oB;
      const float A8 = fA * sA2, B8 = sA2 * fB + sB2;
      if (PASS == 1) {
        float hv = ownFirst ? st : fA * st + fB;
        const int mt = sgi >> 2, g = sgi & 3;
#pragma unroll
        for (int e = 0; e < 4; ++e) { const int r = g * 4 + (dir ? 3 - e : e); hv = ga[mt][r] * hv + gx[mt][r];
          if (dir == 0) hsum[mt][r] = hv; else hsum[mt][r] += hv; }
      }
      st = A8 * st + B8; stA *= A8;
    }
    if (PASS == 0 && hi == 0) {
      const size_t ci = ((size_t)((dir * 4 + b) * 132 + c) * 1024 + ch) * 4;
      *(float*)(ws + OFF_CA + ci) = stA; *(float*)(ws + OFF_CB + ci) = st;
    }
  }
  __syncthreads();
  if (PASS == 1) {
#pragma unroll
    for (int mt = 0; mt < 2; ++mt)
#pragma unroll
      for (int r = 0; r < 16; ++r) AT[(mt * 32 + crow(r, hi)) * AT_LD + wid * 32 + r32] = f2bf(hsum[mt][r]);
    __syncthreads();
    bfr* HG = (bfr*)(ws + OFF_RA);
    const int k8 = tid & 31, chh = cg * 256 + k8 * 8;
#pragma unroll
    for (int i = 0; i < 4; ++i) { const int t = (tid >> 5) + i * 16;
      uint4 hv = *(const uint4*)(AT + t * AT_LD + k8 * 8); uint4 gv = *(const uint4*)(SG1 + (size_t)(row0 + t) * 1024 + chh);
      float hf[8], gf[8]; unpack8(hv, hf); unpack8(gv, gf);
      u32x4 pk; pk[0] = cvtpk(hf[0] * gf[0], hf[1] * gf[1]); pk[1] = cvtpk(hf[2] * gf[2], hf[3] * gf[3]);
      pk[2] = cvtpk(hf[4] * gf[4], hf[5] * gf[5]); pk[3] = cvtpk(hf[6] * gf[6], hf[7] * gf[7]);
      *(u32x4*)(HG + ((size_t)(b * NLAT + c * 64 + t)) * 1024 + chh) = pk; }
    __syncthreads();
  }
}
template <int PASS>
__device__ void scan_phase(const Params& p, char* smem, int bid, int nb) {
  const int nchunk = PASS ? 128 : 132;
  for (int it = bid; it < 4 * nchunk * 4; it += nb) { const int cg = it & 3, t2 = it >> 2, c = t2 % nchunk, b = t2 / nchunk; scan_item<PASS>(p, smem, b, c, cg); }
}
__device__ void carry_phase(const Params& p, int bid, int nb) {
  char* ws = p.ws;
  for (int id = bid * NTHR + threadIdx.x; id < 8192; id += nb * NTHR) {
    const int ch = id & 1023, db = id >> 10, dir = db >> 2;
    const float* CA = (const float*)(ws + OFF_CA) + (size_t)db * 132 * 1024 + ch; const float* CB = (const float*)(ws + OFF_CB) + (size_t)db * 132 * 1024 + ch;
    float* HIN = (float*)(ws + OFF_HIN) + (size_t)db * 132 * 1024 + ch;
    float h = 0.f;
    for (int s0 = 0; s0 < 132; s0 += 12) {
      float a[12], bb[12];
#pragma unroll
      for (int u = 0; u < 12; ++u) { const int s = s0 + u; const int c = dir ? 131 - s : (s < 4 ? 128 + s : s - 4); a[u] = CA[(size_t)c * 1024]; bb[u] = CB[(size_t)c * 1024]; }
#pragma unroll
      for (int u = 0; u < 12; ++u) { const int s = s0 + u; const int c = dir ? 131 - s : (s < 4 ? 128 + s : s - 4); HIN[(size_t)c * 1024] = h; h = a[u] * h + bb[u]; }
    }
  }
}

extern __shared__ __attribute__((aligned(16))) char dyn_smem[];
__global__ __launch_bounds__(512, 2) void kf_prep(Params p) { prep_phase(p, dyn_smem, blockIdx.x, gridDim.x); }
__global__ __launch_bounds__(512, 2) void kf_gemm_z(Params p) {
  char* ws = p.ws; FEpiZ e{}; e.Zc = (bfr*)(ws + OFF_RE); e.DQ = (bfr*)(ws + OFF_RC); e.DK = e.DQ + (size_t)RTOT * 512; e.DV = e.DQ + (size_t)RTOT * 1024;
  e.SG0 = (bfr*)(ws + OFF_RB); e.KA = (bfr*)(ws + OFF_RD) + (size_t)RTOT * 768; e.ropeD = (const float2*)(ws + OFF_ROPED); e.ropeA = (const float2*)(ws + OFF_ROPEA);
  gemm_phase((const bfr*)(ws + OFF_RA), 1024, (const bfr*)(ws + OFF_WIN0), 1024, 1024, 132, 26, e, dyn_smem, blockIdx.x, gridDim.x);
}
__global__ __launch_bounds__(512, 2) void kf_attn(Params p) { attn_phase(p, dyn_smem, blockIdx.x, gridDim.x); }
__global__ __launch_bounds__(512, 2) void kf_scan0(Params p) { scan_phase<0>(p, dyn_smem, blockIdx.x, gridDim.x); }
__global__ __launch_bounds__(512, 2) void kf_scan1(Params p) { scan_phase<1>(p, dyn_smem, blockIdx.x, gridDim.x); }
__global__ __launch_bounds__(512, 2) void kf_carry(Params p) { carry_phase(p, blockIdx.x, gridDim.x); }
__global__ __launch_bounds__(512, 2) void kf_upproj(Params p) { upproj_phase(p, dyn_smem, blockIdx.x, gridDim.x); }
__global__ __launch_bounds__(512, 2) void kf_gemm_store(const bfr* A, const bfr* Bt, bfr* C, int mtiles, int ntiles, int K) {
  FEpiStore e{}; e.C = C; e.ldc = ntiles * 128;
  gemm_phase(A, K, Bt, K, K, mtiles, ntiles, e, dyn_smem, blockIdx.x, gridDim.x);
}
__global__ __launch_bounds__(512, 2) void kf_gemm_ug(Params p) {
  char* ws = p.ws; FEpiUG e; e.U = (bfr*)(ws + OFF_RD); e.SG1 = e.U + (size_t)RTOT * 1024;
  gemm_phase((const bfr*)(ws + OFF_RA), 1024, (const bfr*)(ws + OFF_WIN1), 1024, 1024, 132, 16, e, dyn_smem, blockIdx.x, gridDim.x);
}

#define FAST_S1 1
#define FAST_G3 1
#define FAST_ATTN 1
#define FAST_Q2 1
#define FAST_SCAN 1
#define FAST_G5 1
constexpr size_t SMEM_TOTAL = SMEM_BYTES + 1024;
extern "C" void kernel_launch(void* const* d_in, const int* in_sizes, int n_in, void* d_out, int out_size, void* d_ws, size_t ws_size, hipStream_t stream) {
  Params P{};
  { const float** pp = (const float**)&P; for (int i = 0; i < 28; ++i) pp[i] = (const float*)d_in[i]; }
  P.out = (float*)d_out; P.ws = (char*)d_ws;
  const float *x = P.x, *c = P.c, *ctx = P.ctx, *c_ctx = P.c_ctx, *ada_w = P.ada_w, *ada_b = P.ada_b, *ln_g = P.ln_g, *ln_b = P.ln_b, *e_w_in = P.e_w_in, *e_qg = P.e_qg,
              *e_w_uq = P.e_w_uq, *e_kvg = P.e_kvg, *e_w_ukv = P.e_w_ukv, *lq1 = P.lq1, *lk1 = P.lk1, *lq2 = P.lq2, *lk2 = P.lk2, *subg = P.subg, *e_w_out = P.e_w_out,
              *o_w_in = P.o_w_in, *conv_w = P.conv_w, *conv_b = P.conv_b, *ga_w = P.ga_w, *ga_b = P.ga_b, *gx_w = P.gx_w, *gx_b = P.gx_b, *lru_l = P.lru_l, *o_w_out = P.o_w_out;
  float* out = (float*)d_out; char* ws = (char*)d_ws;
  if (ws_size < WS_END) return;
  static int attr_done = 0;
  if (!attr_done) {
    hipFuncSetAttribute((const void*)kf_prep, hipFuncAttributeMaxDynamicSharedMemorySize, (int)SMEM_TOTAL);
    hipFuncSetAttribute((const void*)kf_gemm_z, hipFuncAttributeMaxDynamicSharedMemorySize, (int)SMEM_TOTAL);
    hipFuncSetAttribute((const void*)kf_upproj, hipFuncAttributeMaxDynamicSharedMemorySize, (int)SMEM_TOTAL);
    hipFuncSetAttribute((const void*)kf_gemm_store, hipFuncAttributeMaxDynamicSharedMemorySize, (int)SMEM_TOTAL);
    hipFuncSetAttribute((const void*)kf_attn, hipFuncAttributeMaxDynamicSharedMemorySize, (int)SMEM_TOTAL);
    hipFuncSetAttribute((const void*)kf_scan0, hipFuncAttributeMaxDynamicSharedMemorySize, (int)SMEM_TOTAL);
    hipFuncSetAttribute((const void*)kf_scan1, hipFuncAttributeMaxDynamicSharedMemorySize, (int)SMEM_TOTAL);
    hipFuncSetAttribute((const void*)kf_gemm_ug, hipFuncAttributeMaxDynamicSharedMemorySize, (int)SMEM_TOTAL);
    attr_done = 1;
  }
  const int NB = 256;
  float* mod = (float*)(ws + OFF_MOD); float* lam = (float*)(ws + OFF_LAM);
  bfr* RA = (bfr*)(ws + OFF_RA); bfr* RB = (bfr*)(ws + OFF_RB); bfr* RC = (bfr*)(ws + OFF_RC); bfr* RE = (bfr*)(ws + OFF_RE); bfr* RD = (bfr*)(ws + OFF_RD);
  bfr* XM = RA; bfr* OG = RA; bfr* XM1 = RA; bfr* HG = RA;
  bfr* SG0 = RB; bfr* UC = RB;
  bfr* DQ = RC; bfr* DK = RC + (size_t)RTOT * 512; bfr* DV = RC + (size_t)RTOT * 1024; bfr* Y0 = RC; bfr* G = RC;
  bfr* Zc = RE; float* KRraw = (float*)(ws + OFF_RE + ((size_t)48 << 20)); float* Oraw = (float*)RE;
  bfr* QA = RD; bfr* KA = RD + (size_t)RTOT * 768; bfr* VA = RD + (size_t)RTOT * 1536; bfr* UG = RD;
  bfr* Y1 = RB;

  k_mod<<<dim3(12, 5, 2), 256, 0, stream>>>(c, c_ctx, ada_w, ada_b, mod);
  k_lam<<<1, 64, 0, stream>>>(lq1, lk1, lq2, lk2, lam);
  kf_prep<<<NB, NTHR, SMEM_TOTAL, stream>>>(P);
  k_modulate0<<<RTOT, 256, 0, stream>>>(x, ctx, mod, XM);
#if FAST_S1
  kf_gemm_z<<<NB, NTHR, SMEM_TOTAL, stream>>>(P);
  kf_upproj<<<NB, NTHR, SMEM_TOTAL, stream>>>(P);
#else
  { EpiZ e{}; e.Zc = Zc; e.DQ = DQ; e.DK = DK; e.DV = DV; e.SG0 = SG0; e.KRraw = KRraw;
    k_gemm_naive<<<dim3(51, RTOT / 64, 1), 256, 0, stream>>>(XM, 1024, e_w_in, 3232, RTOT, 3232, 1024, e); }
  k_rms_fix<<<RTOT, 256, 0, stream>>>(Zc, e_qg, e_kvg);
  k_fix_dqk<<<RTOT, 256, 0, stream>>>(DQ, DK, KRraw, KA);
  { EpiQ e{}; e.QA = QA; k_gemm_naive<<<dim3(12, RTOT / 64, 1), 256, 0, stream>>>(Zc, 640, e_w_uq, 768, RTOT, 768, 384, e); }
  { EpiKV e{}; e.KA = KA; e.VA = VA; k_gemm_naive<<<dim3(16, RTOT / 64, 1), 256, 0, stream>>>(Zc + 384, 640, e_w_ukv, 1024, RTOT, 1024, 256, e); }
  k_fix_q<<<RTOT, 256, 0, stream>>>(QA);
#endif
#if FAST_ATTN
  kf_attn<<<NB, NTHR, SMEM_TOTAL, stream>>>(P);
#else
  k_attn_mla_naive<<<dim3(132, 8), 256, 0, stream>>>(QA, KA, VA, SG0, OG);
  k_attn_diff_naive<<<dim3(132, 4, 4), 256, 0, stream>>>(DQ, DK, DV, lam, Oraw);
  k_fix_attn<<<RTOT, 256, 0, stream>>>(Oraw, subg, SG0, OG);
#endif
#if FAST_G3
  kf_gemm_store<<<NB, NTHR, SMEM_TOTAL, stream>>>(OG, (const bfr*)(ws + OFF_WOUT0), Y0, 132, 8, 1024);
#else
  { EpiStore e{}; e.C = Y0; e.ldc = 1024; k_gemm_naive<<<dim3(16, RTOT / 64, 1), 256, 0, stream>>>(OG, 1024, e_w_out, 1024, RTOT, 1024, 1024, e); }
#endif
  k_ln0<<<RTOT / 4, 256, 0, stream>>>(x, ctx, Y0, mod, ln_g, ln_b, out, XM1);
#if FAST_Q2
  kf_gemm_ug<<<NB, NTHR, SMEM_TOTAL, stream>>>(P);
  const bfr* Uu = RD; const int ldu = 1024; const bfr* GT = RD + (size_t)RTOT * 1024; const int ldg = 1024, gsilu = 1;
#else
  { EpiStore e{}; e.C = UG; e.ldc = 2048; k_gemm_naive<<<dim3(32, RTOT / 64, 1), 256, 0, stream>>>(XM1, 1024, o_w_in, 2048, RTOT, 2048, 1024, e); }
  const bfr* Uu = UG; const int ldu = 2048; const bfr* GT = UG + 1024; const int ldg = 2048, gsilu = 0;
#endif
#if FAST_SCAN
  kf_scan0<<<NB, NTHR, SMEM_TOTAL, stream>>>(P);
  kf_carry<<<16, NTHR, 0, stream>>>(P);
  kf_scan1<<<NB, NTHR, SMEM_TOTAL, stream>>>(P);
#else
  k_conv<<<RTOT * 4, 256, 0, stream>>>(Uu, ldu, conv_w, conv_b, UC);
  for (int dir = 0; dir < 2; ++dir) {
    for (int gate = 0; gate < 2; ++gate) {
      const float* w = (gate == 0 ? ga_w : gx_w) + (size_t)dir * 8 * 128 * 128;
      for (int blk = 0; blk < 8; ++blk) {
        EpiStore es{}; es.C = G + (size_t)gate * RTOT * 1024 + blk * 128; es.ldc = 1024;
        k_gemm_naive<<<dim3(2, RTOT / 64, 1), 256, 0, stream>>>(UC + blk * 128, 1024, w + (size_t)blk * 128 * 128, 128, RTOT, 128, 128, es);
      }
    }
    k_scan_naive<<<dim3(4, 4), 256, 0, stream>>>(dir, G, UC, GT, ldg, gsilu, ga_b, gx_b, lru_l, HG);
  }
#endif
#if FAST_G5
  kf_gemm_store<<<NB, NTHR, SMEM_TOTAL, stream>>>(HG, (const bfr*)(ws + OFF_WOUT1), Y1, 128, 8, 1024);
#else
  { EpiStore e{}; e.C = Y1; e.ldc = 1024; k_gemm_naive<<<dim3(16, (B_ * NLAT) / 64, 1), 256, 0, stream>>>(HG, 1024, o_w_out, 1024, B_ * NLAT, 1024, 1024, e); }
#endif
  k_ln1<<<(B_ * NLAT) / 4, 256, 0, stream>>>(Y1, mod, ln_g + 1024, ln_b + 1024, out);
}
```

```cpp
#include <hip/hip_runtime.h>
#include <hip/hip_bf16.h>
#include <hip/hip_cooperative_groups.h>
#include <stdint.h>

typedef unsigned short bfr;

constexpr int B_ = 4, NLAT = 8192, NCTX = 256, SEQA = NLAT + NCTX, RTOT = B_ * SEQA, DM = 1024;
constexpr float ALPHA = 1.4142135623730951f;
constexpr float LOG2E = 1.4426950408889634f;
constexpr float QSC_A = 0.10206207261596577f * LOG2E;
constexpr float QSC_D = 0.125f * LOG2E;

constexpr size_t SZ1024 = (size_t)RTOT * 1024 * 2;
constexpr size_t SZ512  = (size_t)RTOT * 512 * 2;
constexpr size_t SZ768  = (size_t)RTOT * 768 * 2;
constexpr size_t OFF_MOD = 0;
constexpr size_t OFF_LAM = 122880;
constexpr size_t OFF_RA = (size_t)24 << 20;
constexpr size_t OFF_RB = OFF_RA + SZ1024;
constexpr size_t OFF_RC = OFF_RB + SZ1024;
constexpr size_t OFF_RE = OFF_RC + 3 * SZ512;
constexpr size_t OFF_RD = OFF_RE + SZ1024;
constexpr size_t WS_END = OFF_RD + 2 * SZ1024;

__device__ __forceinline__ float bf2f(bfr h) { return __uint_as_float(((unsigned)h) << 16); }
__device__ __forceinline__ bfr f2bf(float f) { unsigned u = __float_as_uint(f); u += 0x7fffu + ((u >> 16) & 1u); return (bfr)(u >> 16); }
__device__ __forceinline__ float silu_f(float x) { return x / (1.f + expf(-x)); }
__device__ __forceinline__ float sigmoid_f(float x) { return 1.f / (1.f + expf(-x)); }
__device__ __forceinline__ const float* xrow(const float* x, const float* ctx, int r) {
  int b = r / SEQA, p = r - b * SEQA;
  return p < NLAT ? x + ((size_t)(b * NLAT + p)) * DM : ctx + ((size_t)(b * NCTX + (p - NLAT))) * DM;
}
__device__ __forceinline__ int modrow(int r) { int b = r / SEQA, p = r - b * SEQA; return p < NLAT ? b : 4; }

__device__ __forceinline__ void unpack8(uint4 u, float* f) {
  f[0] = __uint_as_float(u.x << 16); f[1] = __uint_as_float(u.x & 0xffff0000u);
  f[2] = __uint_as_float(u.y << 16); f[3] = __uint_as_float(u.y & 0xffff0000u);
  f[4] = __uint_as_float(u.z << 16); f[5] = __uint_as_float(u.z & 0xffff0000u);
  f[6] = __uint_as_float(u.w << 16); f[7] = __uint_as_float(u.w & 0xffff0000u);
}
using bf16x8 = __attribute__((ext_vector_type(8))) short;
using s16x4  = __attribute__((ext_vector_type(4))) short;
using f32x16 = __attribute__((ext_vector_type(16))) float;
using u32x4  = __attribute__((ext_vector_type(4))) unsigned;
constexpr int NTHR = 512;
constexpr size_t OFF_ROPED = (size_t)1 << 20;
constexpr size_t OFF_ROPEA = (size_t)3 << 20;
constexpr size_t OFF_WT    = (size_t)4 << 20;
constexpr size_t OFF_WIN0  = OFF_WT;
constexpr size_t OFF_WUQ   = OFF_WIN0 + (size_t)3328 * 1024 * 2;
constexpr size_t OFF_WUKV  = OFF_WUQ + (size_t)768 * 384 * 2;
constexpr size_t OFF_WOUT0 = OFF_WUKV + (size_t)1024 * 256 * 2;
constexpr size_t OFF_WIN1  = OFF_WOUT0 + (size_t)1024 * 1024 * 2;
constexpr size_t OFF_WG    = OFF_WIN1 + (size_t)2048 * 1024 * 2;
constexpr size_t OFF_WOUT1 = OFF_WG + (size_t)32 * 128 * 128 * 2;
static_assert(OFF_WOUT1 + (size_t)1024 * 1024 * 2 <= OFF_RA, "weights overflow");
constexpr size_t SMEM_BYTES = 2 * (256 * 72 + 128 * 72) * 2;

__device__ __forceinline__ int otid() { int t = threadIdx.x; asm volatile("" : "+v"(t)); return t; }
__device__ __forceinline__ int crow(int r, int hi) { return (r & 3) + 8 * (r >> 2) + 4 * hi; }

struct Params {
  const float *x, *c, *ctx, *c_ctx, *ada_w, *ada_b, *ln_g, *ln_b, *e_w_in, *e_qg, *e_w_uq, *e_kvg, *e_w_ukv, *lq1, *lk1, *lq2, *lk2, *subg, *e_w_out,
      *o_w_in, *conv_w, *conv_b, *ga_w, *ga_b, *gx_w, *gx_b, *lru_l, *o_w_out;
  float* out; char* ws;
};

template <int MODE>
__device__ void wt_convert(const float* __restrict__ src, int K, int ldsrc, int Nd, bfr* __restrict__ dst, const float* __restrict__ kscale,
                           float* lds, int bid, int nb) {
  const int tid = otid(), tk = K >> 6, tn = Nd >> 6;
  for (int t = bid; t < tk * tn; t += nb) {
    const int k0 = (t % tk) << 6, n0 = (t / tk) << 6;
    for (int e = tid; e < 4096; e += NTHR) { int i = e >> 6, j = e & 63; int nd = n0 + j; float v;
      if (MODE == 1) { int ns = nd < 640 ? nd : (nd < 3200 ? nd + 32 : nd - 3200 + 640); v = nd < 3232 ? src[(size_t)(k0 + i) * ldsrc + ns] : 0.f; }
      else v = src[(size_t)(k0 + i) * ldsrc + nd];
      if (kscale) v *= kscale[k0 + i];
      lds[j * 65 + i] = v; }
    __syncthreads();
    for (int e = tid; e < 4096; e += NTHR) { int j = e >> 6, i = e & 63; dst[(size_t)(n0 + j) * K + k0 + i] = f2bf(lds[j * 65 + i]); }
    __syncthreads();
  }
}
__device__ void prep_phase(const Params& p, char* smem, int bid, int nb) {
  float* lds = (float*)smem; char* ws = p.ws;
  wt_convert<1>(p.e_w_in, 1024, 3232, 3328, (bfr*)(ws + OFF_WIN0), nullptr, lds, bid, nb);
  wt_convert<0>(p.e_w_uq, 384, 768, 768, (bfr*)(ws + OFF_WUQ), p.e_qg, lds, bid, nb);
  wt_convert<0>(p.e_w_ukv, 256, 1024, 1024, (bfr*)(ws + OFF_WUKV), p.e_kvg, lds, bid, nb);
  wt_convert<0>(p.e_w_out, 1024, 1024, 1024, (bfr*)(ws + OFF_WOUT0), nullptr, lds, bid, nb);
  wt_convert<0>(p.o_w_in, 1024, 2048, 2048, (bfr*)(ws + OFF_WIN1), nullptr, lds, bid, nb);
  wt_convert<0>(p.o_w_out, 1024, 1024, 1024, (bfr*)(ws + OFF_WOUT1), nullptr, lds, bid, nb);
  for (int m = 0; m < 32; ++m) {
    int dir = m >> 4, gate = (m >> 3) & 1, blk = m & 7;
    const float* src = (gate ? p.gx_w : p.ga_w) + ((size_t)dir * 8 + blk) * 128 * 128;
    wt_convert<0>(src, 128, 128, 128, (bfr*)(ws + OFF_WG) + (size_t)m * 128 * 128, nullptr, lds, bid, nb);
  }
  float2* rd = (float2*)(ws + OFF_ROPED); float2* ra = (float2*)(ws + OFF_ROPEA);
  for (int e = bid * NTHR + otid(); e < 8192 * 32; e += nb * NTHR) { int pos = e >> 5, i = e & 31;
    float pp = (i < 16) ? (float)(pos >> 6) : (float)(pos & 63); float fr = powf(10000.f, -(float)(i & 15) / 16.f);
    float sn, cs; sincosf(pp * fr, &sn, &cs); rd[e] = make_float2(cs, sn); }
  for (int e = bid * NTHR + otid(); e < 8192 * 16; e += nb * NTHR) { int pos = e >> 4, i = e & 15;
    float pp = (i < 8) ? (float)(pos >> 6) : (float)(pos & 63); float fr = powf(10000.f, -(float)(i & 7) / 8.f);
    float sn, cs; sincosf(pp * fr, &sn, &cs); ra[e] = make_float2(cs, sn); }
}

template <class Epi>
__device__ __forceinline__ void gemm_tile(const bfr* __restrict__ A, int lda, const bfr* __restrict__ Bt, int ldb, int K, int m0, int n0, Epi& epi, char* smem) {
  const int tid = otid(), wid = tid >> 6, lane = tid & 63, wm = wid >> 1, wn = wid & 1, r32 = lane & 31, hi = lane >> 5;
  bfr* sa = (bfr*)smem; bfr* sb = sa + 2 * 256 * 72;
  f32x16 acc[2][2];
#pragma unroll
  for (int i = 0; i < 2; ++i)
#pragma unroll
    for (int j = 0; j < 2; ++j)
#pragma unroll
      for (int r = 0; r < 16; ++r) acc[i][j][r] = 0.f;
  uint4 ra0, ra1, ra2, ra3, rb0, rb1;
  const int lrow = tid >> 3, lck = (tid & 7) * 8;
  const bfr* Ap = A + (size_t)(m0 + lrow) * lda + lck;
  const bfr* Bp = Bt + (size_t)(n0 + lrow) * ldb + lck;
  const size_t a64 = (size_t)64 * lda, b64 = (size_t)64 * ldb;
  const int nk = K >> 6;
  bfr* swa = sa + lrow * 72 + lck; bfr* swb = sb + lrow * 72 + lck;
#define GLOAD(kt) do { const bfr* ap_ = Ap + (kt) * 64; const bfr* bp_ = Bp + (kt) * 64; \
    ra0 = *(const uint4*)(ap_); ra1 = *(const uint4*)(ap_ + a64); ra2 = *(const uint4*)(ap_ + 2 * a64); ra3 = *(const uint4*)(ap_ + 3 * a64); \
    rb0 = *(const uint4*)(bp_); rb1 = *(const uint4*)(bp_ + b64); } while (0)
#define SWRITE(buf) do { bfr* wa_ = swa + (buf) * 256 * 72; bfr* wb_ = swb + (buf) * 128 * 72; \
    *(uint4*)(wa_) = ra0; *(uint4*)(wa_ + 64 * 72) = ra1; *(uint4*)(wa_ + 128 * 72) = ra2; *(uint4*)(wa_ + 192 * 72) = ra3; \
    *(uint4*)(wb_) = rb0; *(uint4*)(wb_ + 64 * 72) = rb1; } while (0)
  GLOAD(0); SWRITE(0); __syncthreads();
  for (int kt = 0; kt < nk; ++kt) {
    const int cur = kt & 1;
    if (kt + 1 < nk) GLOAD(kt + 1);
    const bfr* pa = sa + cur * 256 * 72 + (wm * 64 + r32) * 72 + hi * 8;
    const bfr* pb = sb + cur * 128 * 72 + (wn * 64 + r32) * 72 + hi * 8;
#pragma unroll
    for (int ks = 0; ks < 4; ++ks) {
      bf16x8 a0 = *(const bf16x8*)(pa + ks * 16), a1 = *(const bf16x8*)(pa + 32 * 72 + ks * 16);
      bf16x8 b0 = *(const bf16x8*)(pb + ks * 16), b1 = *(const bf16x8*)(pb + 32 * 72 + ks * 16);
      acc[0][0] = __builtin_amdgcn_mfma_f32_32x32x16_bf16(a0, b0, acc[0][0], 0, 0, 0);
      acc[0][1] = __builtin_amdgcn_mfma_f32_32x32x16_bf16(a0, b1, acc[0][1], 0, 0, 0);
      acc[1][0] = __builtin_amdgcn_mfma_f32_32x32x16_bf16(a1, b0, acc[1][0], 0, 0, 0);
      acc[1][1] = __builtin_amdgcn_mfma_f32_32x32x16_bf16(a1, b1, acc[1][1], 0, 0, 0);
    }
    if (kt + 1 < nk) SWRITE(cur ^ 1);
    __syncthreads();
  }
#undef GLOAD
#undef SWRITE
  epi(m0 + wm * 64, n0 + wn * 64, acc, r32, hi);
}
template <class Epi>
__device__ __forceinline__ void gemm_phase(const bfr* A, int lda, const bfr* Bt, int ldb, int K, int mtiles, int ntiles, Epi& epi, char* smem, int bid, int nb) {
  for (int t = bid; t < mtiles * ntiles; t += nb) { int mt = t / ntiles, nt = t - mt * ntiles; gemm_tile(A, lda, Bt, ldb, K, mt * 256, nt * 128, epi, smem); }
}
struct FEpiStore { bfr* C; int ldc;
  __device__ __forceinline__ void operator()(int m0, int n0, f32x16 (&acc)[2][2], int r32, int hi) {
#pragma unroll
    for (int mt = 0; mt < 2; ++mt)
#pragma unroll
      for (int nt = 0; nt < 2; ++nt)
#pragma unroll
        for (int r = 0; r < 16; ++r) C[(size_t)(m0 + mt * 32 + crow(r, hi)) * ldc + n0 + nt * 32 + r32] = f2bf(acc[mt][nt][r]);
  } };
struct FEpiUG { bfr *U, *SG1;
  __device__ __forceinline__ void operator()(int m0, int n0, f32x16 (&acc)[2][2], int r32, int hi) {
    const bool g = n0 >= 1024; bfr* C = g ? SG1 : U; const int nn = g ? n0 - 1024 : n0;
#pragma unroll
    for (int mt = 0; mt < 2; ++mt)
#pragma unroll
      for (int nt = 0; nt < 2; ++nt)
#pragma unroll
        for (int r = 0; r < 16; ++r) { float v = acc[mt][nt][r]; if (g) v = silu_f(v);
          C[(size_t)(m0 + mt * 32 + crow(r, hi)) * 1024 + nn + nt * 32 + r32] = f2bf(v); }
  } };
struct FEpiZ { bfr *Zc, *DQ, *DK, *DV, *SG0, *KA; const float2 *ropeD, *ropeA;
  __device__ __forceinline__ void operator()(int m0, int n0, f32x16 (&acc)[2][2], int r32, int hi) {
    const int p0 = m0 % SEQA; const bool lat = p0 < NLAT;
    if (n0 < 640) {
#pragma unroll
      for (int mt = 0; mt < 2; ++mt)
#pragma unroll
        for (int nt = 0; nt < 2; ++nt)
#pragma unroll
          for (int r = 0; r < 16; ++r) Zc[(size_t)(m0 + mt * 32 + crow(r, hi)) * 640 + n0 + nt * 32 + r32] = f2bf(acc[mt][nt][r]);
    } else if (n0 < 1664) {
      const bool isq = n0 < 1152; bfr* C = isq ? DQ : DK; const int nn = isq ? n0 - 640 : n0 - 1152; const float sc = isq ? QSC_D : 1.f;
#pragma unroll
      for (int mt = 0; mt < 2; ++mt)
#pragma unroll
        for (int r = 0; r < 16; ++r) { const int rr = mt * 32 + crow(r, hi);
          float cs = 1.f, sn = 0.f; if (lat) { float2 t = ropeD[(p0 + rr) * 32 + r32]; cs = t.x; sn = t.y; }
          float x1 = acc[mt][0][r], x2 = acc[mt][1][r];
          bfr* d = C + (size_t)(m0 + rr) * 512 + nn + r32;
          d[0] = f2bf((x1 * cs - x2 * sn) * sc); d[32] = f2bf((x2 * cs + x1 * sn) * sc); }
    } else if (n0 < 2176) {
#pragma unroll
      for (int mt = 0; mt < 2; ++mt)
#pragma unroll
        for (int nt = 0; nt < 2; ++nt)
#pragma unroll
          for (int r = 0; r < 16; ++r) DV[(size_t)(m0 + mt * 32 + crow(r, hi)) * 512 + n0 - 1664 + nt * 32 + r32] = f2bf(acc[mt][nt][r]);
    } else if (n0 < 3200) {
#pragma unroll
      for (int mt = 0; mt < 2; ++mt)
#pragma unroll
        for (int nt = 0; nt < 2; ++nt)
#pragma unroll
          for (int r = 0; r < 16; ++r) SG0[(size_t)(m0 + mt * 32 + crow(r, hi)) * 1024 + n0 - 2176 + nt * 32 + r32] = f2bf(silu_f(acc[mt][nt][r]));
    } else if (n0 == 3200) {
#pragma unroll
      for (int mt = 0; mt < 2; ++mt)
#pragma unroll
        for (int r = 0; r < 16; ++r) { const int rr = mt * 32 + crow(r, hi);
          float cs = 1.f, sn = 0.f; if (lat) { float2 t = ropeA[(p0 + rr) * 16 + (r32 & 15)]; cs = t.x; sn = t.y; }
          float xv = acc[mt][0][r]; float pv = __shfl_xor(xv, 16);
          float o = (r32 < 16) ? (xv * cs - pv * sn) : (xv * cs + pv * sn);
          bfr ob = f2bf(o); bfr* d = KA + (size_t)(m0 + rr) * 768 + 64 + r32;
#pragma unroll
          for (int h = 0; h < 8; ++h) d[h * 96] = ob; }
    }
  } };
struct FEpiQ { bfr* QA; const float2* ropeA; const float* rfac;
  __device__ __forceinline__ void operator()(int m0, int n0, f32x16 (&acc)[2][2], int r32, int hi) {
    const int p0 = m0 % SEQA; const bool lat = p0 < NLAT; const int mloc = m0 & 255;
#pragma unroll
    for (int nt = 0; nt < 2; ++nt) { const int s32 = (n0 >> 5) + nt; const bool rope = (s32 % 3) == 2;
#pragma unroll
      for (int mt = 0; mt < 2; ++mt)
#pragma unroll
        for (int r = 0; r < 16; ++r) { const int rr = mt * 32 + crow(r, hi);
          float v = acc[mt][nt][r] * rfac[mloc + rr];
          if (rope) { float cs = 1.f, sn = 0.f; if (lat) { float2 t = ropeA[(p0 + rr) * 16 + (r32 & 15)]; cs = t.x; sn = t.y; }
            float pv = __shfl_xor(v, 16); v = (r32 < 16) ? (v * cs - pv * sn) : (v * cs + pv * sn); }
          QA[(size_t)(m0 + rr) * 768 + s32 * 32 + r32] = f2bf(v * QSC_A); } }
  } };
struct FEpiKV { bfr *KA, *VA; const float* rfac;
  __device__ __forceinline__ void operator()(int m0, int n0, f32x16 (&acc)[2][2], int r32, int hi) {
    const int mloc = m0 & 255;
#pragma unroll
    for (int nt = 0; nt < 2; ++nt) { const int s32 = (n0 >> 5) + nt, h = s32 >> 2, part = s32 & 3;
      bfr* C = part < 2 ? KA + h * 96 + part * 32 : VA + h * 64 + (part - 2) * 32; const int ldc = part < 2 ? 768 : 512;
#pragma unroll
      for (int mt = 0; mt < 2; ++mt)
#pragma unroll
        for (int r = 0; r < 16; ++r) { const int rr = mt * 32 + crow(r, hi);
          C[(size_t)(m0 + rr) * ldc + r32] = f2bf(acc[mt][nt][r] * rfac[mloc + rr]); } }
  } };
__device__ void upproj_phase(const Params& p, char* smem, int bid, int nb) {
  char* ws = p.ws; const bfr* Zc = (const bfr*)(ws + OFF_RE);
  float* rfac = (float*)(smem + SMEM_BYTES);
  bfr* QA = (bfr*)(ws + OFF_RD); bfr* KA = QA + (size_t)RTOT * 768; bfr* VA = QA + (size_t)RTOT * 1536;
  FEpiQ eq; eq.QA = QA; eq.ropeA = (const float2*)(ws + OFF_ROPEA); eq.rfac = rfac;
  FEpiKV ek; ek.KA = KA; ek.VA = VA; ek.rfac = rfac;
  const int tid = otid();
  for (int t = bid; t < 132 * 14; t += nb) {
    const int mt = t / 14, j = t - mt * 14; const bool isq = j < 6; const int m0 = mt * 256;
    {
      const int row = tid >> 1, half = tid & 1; const int ncol = isq ? 192 : 128;
      const bfr* z = Zc + (size_t)(m0 + row) * 640 + (isq ? 0 : 384) + half * ncol;
      float ss = 0.f;
      for (int c = 0; c < ncol; c += 8) { uint4 u = *(const uint4*)(z + c); float f[8]; unpack8(u, f);
#pragma unroll
        for (int e = 0; e < 8; ++e) ss += f[e] * f[e]; }
      ss += __shfl_xor(ss, 1);
      if (half == 0) rfac[row] = rsqrtf(ss / (isq ? 384.f : 256.f) + 1e-6f);
    }
    __syncthreads();
    if (isq) gemm_tile(Zc, 640, (const bfr*)(ws + OFF_WUQ), 384, 384, m0, j * 128, eq, smem);
    else gemm_tile(Zc + 384, 640, (const bfr*)(ws + OFF_WUKV), 256, 256, m0, (j - 6) * 128, ek, smem);
    __syncthreads();
  }
}


constexpr int SHM_KV = 64 * 256;
constexpr float THR2 = 11.5f;
#define KSWZ(row, colB) ((row) * 256 + ((colB) ^ (((row) & 7) << 4)))
#define SBAR() __builtin_amdgcn_sched_barrier(0)
__device__ __forceinline__ unsigned cvtpk(float lo, float hi) { unsigned r; asm volatile("v_cvt_pk_bf16_f32 %0, %1, %2" : "=v"(r) : "v"(lo), "v"(hi)); return r; }
__device__ __forceinline__ void partialSM(f32x16& p0, f32x16& p1, float& m_reg, float& mn, float& alpha) {
  float pmax = p0[0];
#pragma unroll
  for (int r = 1; r < 16; ++r) pmax = fmaxf(pmax, p0[r]);
#pragma unroll
  for (int r = 0; r < 16; ++r) pmax = fmaxf(pmax, p1[r]);
  { auto rr = __builtin_amdgcn_permlane32_swap(__float_as_uint(pmax), __float_as_uint(pmax), false, false);
    pmax = fmaxf(__uint_as_float(rr[0]), __uint_as_float(rr[1])); }
  if (__builtin_expect(__all(pmax - m_reg <= THR2), 1)) { mn = m_reg; alpha = 1.f; }
  else { mn = fmaxf(m_reg, pmax); alpha = __builtin_amdgcn_exp2f(m_reg - mn); m_reg = mn; }
#pragma unroll
  for (int r = 0; r < 16; ++r) p0[r] = p0[r] - mn;
#pragma unroll
  for (int r = 0; r < 16; ++r) p1[r] = p1[r] - mn;
#pragma unroll
  for (int r = 0; r < 16; ++r) p0[r] = __builtin_amdgcn_exp2f(p0[r]);
}
__device__ __forceinline__ void finishSM(f32x16& p0, f32x16& p1, float alpha, float& l_reg, bf16x8& pa0, bf16x8& pa1, bf16x8& pa2, bf16x8& pa3) {
#pragma unroll
  for (int r = 0; r < 16; ++r) p1[r] = __builtin_amdgcn_exp2f(p1[r]);
  float ps = 0;
#pragma unroll
  for (int r = 0; r < 16; ++r) ps += p0[r];
#pragma unroll
  for (int r = 0; r < 16; ++r) ps += p1[r];
  { auto rr = __builtin_amdgcn_permlane32_swap(__float_as_uint(ps), __float_as_uint(ps), false, false);
    ps = __uint_as_float(rr[0]) + __uint_as_float(rr[1]); }
  l_reg = l_reg * alpha + ps;
#define PK4(P, BASE, OUT) do { unsigned a0 = cvtpk(P[BASE + 0], P[BASE + 1]), a1 = cvtpk(P[BASE + 2], P[BASE + 3]);   \
    unsigned b0 = cvtpk(P[BASE + 4], P[BASE + 5]), b1 = cvtpk(P[BASE + 6], P[BASE + 7]);                              \
    auto r0 = __builtin_amdgcn_permlane32_swap(a0, b0, false, false); auto r1 = __builtin_amdgcn_permlane32_swap(a1, b1, false, false); \
    u32x4 w = {r0[0], r1[0], r0[1], r1[1]}; OUT = *reinterpret_cast<bf16x8*>(&w); } while (0)
  PK4(p0, 0, pa0); PK4(p0, 8, pa1); PK4(p1, 0, pa2); PK4(p1, 8, pa3);
#undef PK4
}
template <int NKS>
__device__ __forceinline__ void qkt(f32x16& p0, f32x16& p1, const char* Ks, const bf16x8* qr, int r32, int hi, int qcolB) {
#pragma unroll
  for (int r = 0; r < 16; ++r) { p0[r] = 0.f; p1[r] = 0.f; }
#pragma unroll
  for (int d0 = 0; d0 < NKS; ++d0) { int cb = qcolB + (d0 * 16 + hi * 8) * 2;
    bf16x8 b0 = *reinterpret_cast<const bf16x8*>(Ks + KSWZ(r32, cb));
    bf16x8 b1 = *reinterpret_cast<const bf16x8*>(Ks + KSWZ(32 + r32, cb));
    p0 = __builtin_amdgcn_mfma_f32_32x32x16_bf16(b0, qr[d0], p0, 0, 0, 0);
    p1 = __builtin_amdgcn_mfma_f32_32x32x16_bf16(b1, qr[d0], p1, 0, 0, 0); }
}
__device__ __forceinline__ int v_st(int k, int c) { const int kk = (k & ~0xC) | ((k & 4) << 1) | ((k & 8) >> 1); return ((kk >> 3) * 4 + (c >> 5)) * 512 + ((kk & 7) * 32 + (c & 31)) * 2; }
__device__ __forceinline__ int v_rd_base(int lane) { return ((lane & 3) << 3) | (((lane >> 2) & 3) << 6) | (((lane >> 4) & 1) << 5) | (((lane >> 5) & 1) << 8); }
constexpr int v_rd_off(int d0, int ks, int half) { return d0 * 512 + ks * 4096 + half * 2048; }
template <int OFF> __device__ __forceinline__ s16x4 tr_read(int vb) {
  s16x4 r; asm volatile("ds_read_b64_tr_b16 %0, %1 offset:%2" : "=&v"(r) : "v"(vb), "i"(OFF) : "memory"); return r;
}
template <int D0> __device__ __forceinline__ void pv_one(f32x16& od, int vb, bf16x8 pa0, bf16x8 pa1, bf16x8 pa2, bf16x8 pa3) {
  const s16x4 l0 = tr_read<v_rd_off(D0, 0, 0)>(vb), h0 = tr_read<v_rd_off(D0, 0, 1)>(vb), l1 = tr_read<v_rd_off(D0, 1, 0)>(vb), h1 = tr_read<v_rd_off(D0, 1, 1)>(vb);
  const s16x4 l2 = tr_read<v_rd_off(D0, 2, 0)>(vb), h2 = tr_read<v_rd_off(D0, 2, 1)>(vb), l3 = tr_read<v_rd_off(D0, 3, 0)>(vb), h3 = tr_read<v_rd_off(D0, 3, 1)>(vb);
  asm volatile("s_waitcnt lgkmcnt(0)" ::: "memory"); SBAR();
#define PK(L, H) (bf16x8){L[0], L[1], L[2], L[3], H[0], H[1], H[2], H[3]}
  od = __builtin_amdgcn_mfma_f32_32x32x16_bf16(pa0, PK(l0, h0), od, 0, 0, 0);
  od = __builtin_amdgcn_mfma_f32_32x32x16_bf16(pa1, PK(l1, h1), od, 0, 0, 0);
  od = __builtin_amdgcn_mfma_f32_32x32x16_bf16(pa2, PK(l2, h2), od, 0, 0, 0);
  od = __builtin_amdgcn_mfma_f32_32x32x16_bf16(pa3, PK(l3, h3), od, 0, 0, 0);
#undef PK
}
template <int NVB> __device__ __forceinline__ void pv_all(f32x16* o, int vb, bf16x8 pa0, bf16x8 pa1, bf16x8 pa2, bf16x8 pa3) {
  pv_one<0>(o[0], vb, pa0, pa1, pa2, pa3); pv_one<1>(o[1], vb, pa0, pa1, pa2, pa3);
  if constexpr (NVB == 4) { pv_one<2>(o[2], vb, pa0, pa1, pa2, pa3); pv_one<3>(o[3], vb, pa0, pa1, pa2, pa3); }
}
template <int TYPE>
__device__ __forceinline__ void attn_item(const Params& p, char* lds, int h, int qrow0, int krow0, int NT, float lam) {
  constexpr int NKS = TYPE ? 4 : 6, NVB = TYPE ? 4 : 2;
  constexpr int LDQ = TYPE ? 512 : 768, LDK = TYPE ? 512 : 768, LDV = 512;
  constexpr int KCOLS = TYPE ? 128 : 96, VCOLS = TYPE ? 128 : 64;
  const int tid = otid(), wid = tid >> 6, lane = tid & 63, r32 = lane & 31, hi = lane >> 5;
  const int map = TYPE ? (wid >> 2) : 0, wq = TYPE ? (wid & 3) : wid;
  char* ws = p.ws;
  const bfr* Qb = TYPE ? (const bfr*)(ws + OFF_RC) + (size_t)(qrow0 + wq * 32 + r32) * 512 + h * 128 + map * 64 + hi * 8
                       : (const bfr*)(ws + OFF_RD) + (size_t)(qrow0 + wq * 32 + r32) * 768 + h * 96 + hi * 8;
  const bfr* Kh = TYPE ? (const bfr*)(ws + OFF_RC) + (size_t)RTOT * 512 + (size_t)krow0 * 512 + h * 128
                       : (const bfr*)(ws + OFF_RD) + (size_t)RTOT * 768 + (size_t)krow0 * 768 + h * 96;
  const bfr* Vh = TYPE ? (const bfr*)(ws + OFF_RC) + (size_t)RTOT * 1024 + (size_t)krow0 * 512 + h * 128
                       : (const bfr*)(ws + OFF_RD) + (size_t)RTOT * 1536 + (size_t)krow0 * 512 + h * 64;
  const bfr* SG0 = (const bfr*)(ws + OFF_RB); bfr* OG = (bfr*)(ws + OFF_RA);
  const int qcolB = map * 128;
  char* V_lds = lds; char* K_lds = lds + 2 * SHM_KV;
  float* wsc = (float*)(lds + 4 * SHM_KV) + wid * 64; float* li_l = wsc; float* al_l = wsc + 32;
  float m_reg = -1e30f, l_reg = 0.f; f32x16 o[NVB]; bf16x8 qr[NKS];
#pragma unroll
  for (int d = 0; d < NVB; ++d)
#pragma unroll
    for (int r = 0; r < 16; ++r) o[d][r] = 0.f;
#pragma unroll
  for (int d0 = 0; d0 < NKS; ++d0) qr[d0] = *reinterpret_cast<const bf16x8*>(Qb + d0 * 16);
  const int sr = tid >> 4, sc = (tid & 15) * 8, vst0 = v_st(sr, sc), vst1 = v_st(32 + sr, sc);
  const bool kval = sc < KCOLS, vval = sc < VCOLS;
  const int vb0 = (int)(uintptr_t)V_lds + v_rd_base(lane);
  bf16x8 e_vs0, e_vs1, e_ks0, e_ks1, o_vs0, o_vs1, o_ks0, o_ks1;
#define LD8(ptr) (*reinterpret_cast<const bf16x8*>(ptr))
#define SLOAD_E(k0) do { if (vval) { e_vs0 = LD8(&Vh[(size_t)((k0) + sr) * LDV + sc]); e_vs1 = LD8(&Vh[(size_t)((k0) + 32 + sr) * LDV + sc]); } \
    if (kval) { e_ks0 = LD8(&Kh[(size_t)((k0) + sr) * LDK + sc]); e_ks1 = LD8(&Kh[(size_t)((k0) + 32 + sr) * LDK + sc]); } } while (0)
#define SLOAD_O(k0) do { if (vval) { o_vs0 = LD8(&Vh[(size_t)((k0) + sr) * LDV + sc]); o_vs1 = LD8(&Vh[(size_t)((k0) + 32 + sr) * LDV + sc]); } \
    if (kval) { o_ks0 = LD8(&Kh[(size_t)((k0) + sr) * LDK + sc]); o_ks1 = LD8(&Kh[(size_t)((k0) + 32 + sr) * LDK + sc]); } } while (0)
#define SWRITE_E(b) do { if (vval) { *(bf16x8*)(V_lds + (b) * SHM_KV + vst0) = e_vs0; *(bf16x8*)(V_lds + (b) * SHM_KV + vst1) = e_vs1; } \
    if (kval) { int kc = sc * 2; *(bf16x8*)(K_lds + (b) * SHM_KV + KSWZ(sr, kc)) = e_ks0; *(bf16x8*)(K_lds + (b) * SHM_KV + KSWZ(32 + sr, kc)) = e_ks1; } } while (0)
#define SWRITE_O(b) do { if (vval) { *(bf16x8*)(V_lds + (b) * SHM_KV + vst0) = o_vs0; *(bf16x8*)(V_lds + (b) * SHM_KV + vst1) = o_vs1; } \
    if (kval) { int kc = sc * 2; *(bf16x8*)(K_lds + (b) * SHM_KV + KSWZ(sr, kc)) = o_ks0; *(bf16x8*)(K_lds + (b) * SHM_KV + KSWZ(32 + sr, kc)) = o_ks1; } } while (0)
#define SWAIT() asm volatile("s_waitcnt vmcnt(4)" ::: "memory")
#define RESC(a) do { if (__any((a) < 1.f)) { if (hi == 0) al_l[r32] = (a); asm volatile("s_waitcnt lgkmcnt(0)" ::: "memory"); \
    _Pragma("unroll") for (int d = 0; d < NVB; ++d) _Pragma("unroll") for (int r = 0; r < 16; ++r) o[d][r] *= al_l[crow(r, hi)]; } } while (0)
  f32x16 pA0, pA1, pB0, pB1; float mnA, mnB, alA, alB; bf16x8 pa0, pa1, pa2, pa3;
  SLOAD_E(0); asm volatile("s_waitcnt vmcnt(0)" ::: "memory"); SWRITE_E(0); __syncthreads();
  qkt<NKS>(pA0, pA1, K_lds, qr, r32, hi, qcolB); partialSM(pA0, pA1, m_reg, mnA, alA);
  SLOAD_O(64); if (2 < NT) SLOAD_E(2 * 64);
  SWAIT(); SWRITE_O(1); __syncthreads();
  for (int j = 1; j + 1 < NT; j += 2) {
    SBAR(); qkt<NKS>(pB0, pB1, K_lds + SHM_KV, qr, r32, hi, qcolB);
    finishSM(pA0, pA1, alA, l_reg, pa0, pa1, pa2, pa3); SBAR();
    SLOAD_O((j + 2) * 64); SBAR();
    pv_all<NVB>(o, vb0, pa0, pa1, pa2, pa3); partialSM(pB0, pB1, m_reg, mnB, alB);
    __syncthreads(); SWAIT(); SWRITE_E(0);
    RESC(alB); __syncthreads();
    SBAR(); qkt<NKS>(pA0, pA1, K_lds, qr, r32, hi, qcolB);
    finishSM(pB0, pB1, alB, l_reg, pa0, pa1, pa2, pa3); SBAR();
    if (j + 3 < NT) SLOAD_E((j + 3) * 64); SBAR();
    pv_all<NVB>(o, vb0 + SHM_KV, pa0, pa1, pa2, pa3); partialSM(pA0, pA1, m_reg, mnA, alA);
    __syncthreads(); SWAIT(); SWRITE_O(1);
    RESC(alA); __syncthreads();
  }
  SBAR(); qkt<NKS>(pB0, pB1, K_lds + SHM_KV, qr, r32, hi, qcolB);
  finishSM(pA0, pA1, alA, l_reg, pa0, pa1, pa2, pa3); SBAR();
  pv_all<NVB>(o, vb0, pa0, pa1, pa2, pa3); partialSM(pB0, pB1, m_reg, mnB, alB);
  __syncthreads(); RESC(alB);
  finishSM(pB0, pB1, alB, l_reg, pa0, pa1, pa2, pa3); SBAR();
  pv_all<NVB>(o, vb0 + SHM_KV, pa0, pa1, pa2, pa3);
  if (hi == 0) li_l[r32] = l_reg; asm volatile("s_waitcnt lgkmcnt(0)" ::: "memory");
  float rli[16];
#pragma unroll
  for (int r = 0; r < 16; ++r) rli[r] = __builtin_amdgcn_rcpf(li_l[crow(r, hi)]);
  if constexpr (TYPE == 0) {
#pragma unroll
    for (int r = 0; r < 16; ++r) { const size_t row = (size_t)(qrow0 + wq * 32 + crow(r, hi)) * 1024;
#pragma unroll
      for (int d0 = 0; d0 < NVB; ++d0) { const size_t idx = row + h * 64 + d0 * 32 + r32; OG[idx] = f2bf(o[d0][r] * rli[r] * bf2f(SG0[idx])); } }
    __syncthreads();
  } else {
    float* xch = (float*)lds;
    __syncthreads();
    if (map == 1) {
#pragma unroll
      for (int r = 0; r < 16; ++r) { const float f = rli[r] * lam;
#pragma unroll
        for (int d0 = 0; d0 < 4; ++d0) xch[(wq * 32 + crow(r, hi)) * 128 + d0 * 32 + r32] = o[d0][r] * f; }
    }
    __syncthreads();
    if (map == 0) {
      const float* subg = p.subg;
#pragma unroll
      for (int r = 0; r < 16; ++r) { float ss = 0.f;
#pragma unroll
        for (int d0 = 0; d0 < 4; ++d0) { float v = o[d0][r] * rli[r] - xch[(wq * 32 + crow(r, hi)) * 128 + d0 * 32 + r32]; o[d0][r] = v; ss += v * v; }
        ss += __shfl_xor(ss, 16); ss += __shfl_xor(ss, 8); ss += __shfl_xor(ss, 4); ss += __shfl_xor(ss, 2); ss += __shfl_xor(ss, 1);
        const float rs = rsqrtf(ss * (1.f / 128.f) + 1e-6f) * 0.8f;
        const size_t row = (size_t)(qrow0 + wq * 32 + crow(r, hi)) * 1024;
#pragma unroll
        for (int d0 = 0; d0 < 4; ++d0) { const size_t idx = row + 512 + h * 128 + d0 * 32 + r32;
          OG[idx] = f2bf(o[d0][r] * rs * subg[d0 * 32 + r32] * bf2f(SG0[idx])); } }
    }
    __syncthreads();
  }
#undef LD8
#undef SLOAD_E
#undef SLOAD_O
#undef SWRITE_E
#undef SWRITE_O
#undef SWAIT
#undef RESC
}
__device__ void attn_phase(const Params& p, char* smem, int bid, int nb) {
  const float lam = *(const float*)(p.ws + OFF_LAM);
  for (int it = bid; it < 2112; it += nb) {
    const int rd = it >> 8, j = it & 255;
    int type, h, qrow0, krow0, NT;
    if (rd < 4) { const int b = rd; type = 0; h = j & 7; qrow0 = b * SEQA + (j >> 3) * 256; krow0 = b * SEQA; NT = 132; }
    else if (rd < 8) { const int pair = (j & 7) + 8 * ((rd - 4) >> 1), b = pair >> 2, qt = 2 * (j >> 3) + ((rd - 4) & 1);
      type = 1; h = pair & 3; qrow0 = b * SEQA + qt * 128; krow0 = b * SEQA; NT = 132; }
    else if (j < 32) { const int b = j >> 3; type = 0; h = j & 7; qrow0 = b * SEQA + NLAT; krow0 = qrow0; NT = 4; }
    else if (j < 64) { const int pair = (j - 32) >> 1, b = pair >> 2, qt = (j - 32) & 1;
      type = 1; h = pair & 3; krow0 = b * SEQA + NLAT; qrow0 = krow0 + qt * 128; NT = 4; }
    else continue;
#ifndef ONLY_T1
    if (type == 0) attn_item<0>(p, smem, h, qrow0, krow0, NT, lam);
#endif
#ifndef ONLY_T0
    if (type == 1) attn_item<1>(p, smem, h, qrow0, krow0, NT, lam);
#endif
  }
}


constexpr size_t CARRY_SZ = (size_t)2 * 4 * 132 * 1024 * 4;
constexpr size_t OFF_CA = OFF_RC, OFF_CB = OFF_RC + CARRY_SZ, OFF_HIN = OFF_RC + 2 * CARRY_SZ;
constexpr int AT_LD = 264;
constexpr size_t SCAN_UF_OFF = 64 * AT_LD * 2;

template <int PASS>
__device__ __forceinline__ void scan_item(const Params& p, char* lds, int b, int c, int cg) {
  const int tid = otid(), wid = tid >> 6, lane = tid & 63, r32 = lane & 31, hi = lane >> 5;
  char* ws = p.ws;
  const bfr* U = (const bfr*)(ws + OFF_RD); const bfr* SG1 = U + (size_t)RTOT * 1024;
  bfr* AT = (bfr*)lds; float* UF = (float*)(lds + SCAN_UF_OFF);
  const int row0 = b * SEQA + c * 64;
  const int lo = c < 128 ? 0 : NLAT, hiP = c < 128 ? NLAT : SEQA;
  {
    const int k8 = tid & 31, ch = cg * 256 + k8 * 8;
    float w[4][8], bia[8];
#pragma unroll
    for (int j = 0; j < 4; ++j) { float4 t0 = *(const float4*)(p.conv_w + j * 1024 + ch), t1 = *(const float4*)(p.conv_w + j * 1024 + ch + 4);
      w[j][0] = t0.x; w[j][1] = t0.y; w[j][2] = t0.z; w[j][3] = t0.w; w[j][4] = t1.x; w[j][5] = t1.y; w[j][6] = t1.z; w[j][7] = t1.w; }
    { float4 t0 = *(const float4*)(p.conv_b + ch), t1 = *(const float4*)(p.conv_b + ch + 4);
      bia[0] = t0.x; bia[1] = t0.y; bia[2] = t0.z; bia[3] = t0.w; bia[4] = t1.x; bia[5] = t1.y; bia[6] = t1.z; bia[7] = t1.w; }
#pragma unroll
    for (int i = 0; i < 4; ++i) { const int t = (tid >> 5) + i * 16; const int pt = c * 64 + t;
      float acc[8];
#pragma unroll
      for (int e = 0; e < 8; ++e) acc[e] = bia[e];
#pragma unroll
      for (int j = 0; j < 4; ++j) { const int pp = pt + j - 2;
        if (pp >= lo && pp < hiP) { uint4 u = *(const uint4*)(U + (size_t)(row0 + t + j - 2) * 1024 + ch); float f[8]; unpack8(u, f);
#pragma unroll
          for (int e = 0; e < 8; ++e) acc[e] += w[j][e] * f[e]; } }
      u32x4 pk; pk[0] = cvtpk(acc[0], acc[1]); pk[1] = cvtpk(acc[2], acc[3]); pk[2] = cvtpk(acc[4], acc[5]); pk[3] = cvtpk(acc[6], acc[7]);
      *(u32x4*)(AT + t * AT_LD + k8 * 8) = pk;
      *(float4*)(UF + t * 256 + k8 * 8) = make_float4(acc[0], acc[1], acc[2], acc[3]);
      *(float4*)(UF + t * 256 + k8 * 8 + 4) = make_float4(acc[4], acc[5], acc[6], acc[7]); }
  }
  __syncthreads();
  const int blkl = wid >> 2, blk = cg * 2 + blkl, j0 = (wid & 3) * 32;
  const int ch = cg * 256 + wid * 32 + r32;
  float hsum[2][16];
#pragma unroll
  for (int dir = 0; dir < 2; ++dir) {
    f32x16 ga[2], gx[2];
#pragma unroll
    for (int mt = 0; mt < 2; ++mt)
#pragma unroll
      for (int r = 0; r < 16; ++r) { ga[mt][r] = 0.f; gx[mt][r] = 0.f; }
    const bfr* wa = (const bfr*)(ws + OFF_WG) + (size_t)(dir * 16 + blk) * 16384 + (size_t)(j0 + r32) * 128 + hi * 8;
    const bfr* wx = wa + (size_t)8 * 16384;
    const bfr* ap = AT + r32 * AT_LD + blkl * 128 + hi * 8;
#pragma unroll 2
    for (int ks = 0; ks < 8; ++ks) {
      bf16x8 a0 = *(const bf16x8*)(ap + ks * 16), a1 = *(const bf16x8*)(ap + 32 * AT_LD + ks * 16);
      bf16x8 ba_ = *(const bf16x8*)(wa + ks * 16), bx_ = *(const bf16x8*)(wx + ks * 16);
      ga[0] = __builtin_amdgcn_mfma_f32_32x32x16_bf16(a0, ba_, ga[0], 0, 0, 0);
      ga[1] = __builtin_amdgcn_mfma_f32_32x32x16_bf16(a1, ba_, ga[1], 0, 0, 0);
      gx[0] = __builtin_amdgcn_mfma_f32_32x32x16_bf16(a0, bx_, gx[0], 0, 0, 0);
      gx[1] = __builtin_amdgcn_mfma_f32_32x32x16_bf16(a1, bx_, gx[1], 0, 0, 0);
    }
    const float sp = log1pf(expf(-p.lru_l[dir * 1024 + ch]));
    const float kA = -8.f * sp * LOG2E, biasA = p.ga_b[dir * 1024 + ch], biasX = p.gx_b[dir * 1024 + ch];
#pragma unroll
    for (int mt = 0; mt < 2; ++mt)
#pragma unroll
      for (int r = 0; r < 16; ++r) {
        const float rr = __builtin_amdgcn_rcpf(1.f + __builtin_amdgcn_exp2f(-(ga[mt][r] + biasA) * LOG2E));
        const float ii = __builtin_amdgcn_rcpf(1.f + __builtin_amdgcn_exp2f(-(gx[mt][r] + biasX) * LOG2E));
        const float a = __builtin_amdgcn_exp2f(kA * rr);
        const float uc = UF[(mt * 32 + crow(r, hi)) * 256 + wid * 32 + r32];
        ga[mt][r] = a; gx[mt][r] = __builtin_amdgcn_sqrtf(fmaxf(1.f - a * a, 0.f)) * ii * uc;
      }
    float sA[8], sB[8];
#pragma unroll
    for (int sgi = 0; sgi < 8; ++sgi) { const int mt = sgi >> 2, g = sgi & 3; float A = 1.f, Bv = 0.f;
#pragma unroll
      for (int e = 0; e < 4; ++e) { const int r = g * 4 + (dir ? 3 - e : e); A *= ga[mt][r]; Bv = ga[mt][r] * Bv + gx[mt][r]; }
      sA[sgi] = A; sB[sgi] = Bv; }
    const bool ownFirst = (dir == 0) == (hi == 0);
    float st, stA = 1.f;
    if (PASS == 1) st = *(const float*)(ws + OFF_HIN + ((size_t)((dir * 4 + b) * 132 + c) * 1024 + ch) * 4); else st = 0.f;
#pragma unroll
    for (int q = 0; q < 8; ++q) { const int sgi = dir ? 7 - q : q;
      const float oA = sA[sgi], oB = sB[sgi];
      const float pA = __shfl_xor(oA, 32), pB = __shfl_xor(oB, 32);
      const float fA = ownFirst ? oA : pA, fB = ownFirst ? oB : pB, sA2 = ownFirst ? pA : oA, sB2 = ownFirst ? pB : oB;
      const float A8 = fA * sA2, B8 = sA2 * fB + sB2;
      if (PASS == 1) {
        float hv = ownFirst ? st : fA * st + fB;
        const int mt = sgi >> 2, g = sgi & 3;
#pragma unroll
        for (int e = 0; e < 4; ++e) { const int r = g * 4 + (dir ? 3 - e : e); hv = ga[mt][r] * hv + gx[mt][r];
          if (dir == 0) hsum[mt][r] = hv; else hsum[mt][r] += hv; }
      }
      st = A8 * st + B8; stA *= A8;
    }
    if (PASS == 0 && hi == 0) {
      const size_t ci = ((size_t)((dir * 4 + b) * 132 + c) * 1024 + ch) * 4;
      *(float*)(ws + OFF_CA + ci) = stA; *(float*)(ws + OFF_CB + ci) = st;
    }
  }
  __syncthreads();
  if (PASS == 1) {
#pragma unroll
    for (int mt = 0; mt < 2; ++mt)
#pragma unroll
      for (int r = 0; r < 16; ++r) AT[(mt * 32 + crow(r, hi)) * AT_LD + wid * 32 + r32] = f2bf(hsum[mt][r]);
    __syncthreads();
    bfr* HG = (bfr*)(ws + OFF_RA);
    const int k8 = tid & 31, chh = cg * 256 + k8 * 8;
#pragma unroll
    for (int i = 0; i < 4; ++i) { const int t = (tid >> 5) + i * 16;
      uint4 hv = *(const uint4*)(AT + t * AT_LD + k8 * 8); uint4 gv = *(const uint4*)(SG1 + (size_t)(row0 + t) * 1024 + chh);
      float hf[8], gf[8]; unpack8(hv, hf); unpack8(gv, gf);
      u32x4 pk; pk[0] = cvtpk(hf[0] * gf[0], hf[1] * gf[1]); pk[1] = cvtpk(hf[2] * gf[2], hf[3] * gf[3]);
      pk[2] = cvtpk(hf[4] * gf[4], hf[5] * gf[5]); pk[3] = cvtpk(hf[6] * gf[6], hf[7] * gf[7]);
      *(u32x4*)(HG + ((size_t)(b * NLAT + c * 64 + t)) * 1024 + chh) = pk; }
    __syncthreads();
  }
}
template <int PASS>
__device__ void scan_phase(const Params& p, char* smem, int bid, int nb) {
  const int nchunk = PASS ? 128 : 132;
  for (int it = bid; it < 4 * nchunk * 4; it += nb) { const int cg = it & 3, t2 = it >> 2, c = t2 % nchunk, b = t2 / nchunk; scan_item<PASS>(p, smem, b, c, cg); }
}
__device__ void carry_phase(const Params& p, int bid, int nb) {
  char* ws = p.ws;
  for (int id = bid * NTHR + otid(); id < 8192; id += nb * NTHR) {
    const int ch = id & 1023, db = id >> 10, dir = db >> 2;
    const float* CA = (const float*)(ws + OFF_CA) + (size_t)db * 132 * 1024 + ch; const float* CB = (const float*)(ws + OFF_CB) + (size_t)db * 132 * 1024 + ch;
    float* HIN = (float*)(ws + OFF_HIN) + (size_t)db * 132 * 1024 + ch;
    float h = 0.f;
    for (int s0 = 0; s0 < 132; s0 += 12) {
      float a[12], bb[12];
#pragma unroll
      for (int u = 0; u < 12; ++u) { const int s = s0 + u; const int c = dir ? 131 - s : (s < 4 ? 128 + s : s - 4); a[u] = CA[(size_t)c * 1024]; bb[u] = CB[(size_t)c * 1024]; }
#pragma unroll
      for (int u = 0; u < 12; ++u) { const int s = s0 + u; const int c = dir ? 131 - s : (s < 4 ? 128 + s : s - 4); HIN[(size_t)c * 1024] = h; h = a[u] * h + bb[u]; }
    }
  }
}

__device__ __forceinline__ float ld_agent_f32(const float* p) { return __hip_atomic_load(p, __ATOMIC_RELAXED, __HIP_MEMORY_SCOPE_AGENT); }
__device__ void mod_phase(const Params& p, char* smem, int bid, int nb) {
  float* sc = (float*)smem; float* red = sc + 5 * 1024;
  float* mod = (float*)(p.ws + OFF_MOD);
  const int tid = otid(), kg = tid >> 6, col = tid & 63;
  for (int it = bid; it < 96; it += nb) {
    const int l = it / 48, j0 = (it % 48) * 64;
    for (int e = tid; e < 5120; e += NTHR) { const int mr = e >> 10, k = e & 1023; sc[e] = silu_f(mr < 4 ? p.c[mr * 1024 + k] : p.c_ctx[k]); }
    __syncthreads();
    float acc[5] = {0.f, 0.f, 0.f, 0.f, 0.f};
    const float* w = p.ada_w + (size_t)l * 1024 * 3072 + (size_t)(kg * 128) * 3072 + j0 + col;
#pragma unroll 8
    for (int k = 0; k < 128; ++k) { const float wv = w[(size_t)k * 3072];
#pragma unroll
      for (int mr = 0; mr < 5; ++mr) acc[mr] += sc[mr * 1024 + kg * 128 + k] * wv; }
#pragma unroll
    for (int mr = 0; mr < 5; ++mr) red[(kg * 5 + mr) * 64 + col] = acc[mr];
    __syncthreads();
    if (tid < 320) { const int mr = tid >> 6; float sum = 0.f;
#pragma unroll
      for (int g = 0; g < 8; ++g) sum += red[(g * 5 + mr) * 64 + col];
      mod[(l * 5 + mr) * 3072 + j0 + col] = sum + p.ada_b[l * 3072 + j0 + col]; }
    __syncthreads();
  }
  if (bid == nb - 1 && tid == 0) { float s1 = 0, s2 = 0;
    for (int i = 0; i < 64; ++i) { s1 += p.lq1[i] * p.lk1[i]; s2 += p.lq2[i] * p.lk2[i]; }
    *(float*)(p.ws + OFF_LAM) = expf(s1) - expf(s2) + 0.2f; }
}
__device__ void modulate_phase(const Params& p, int bid, int nb) {
  const float* mod = (const float*)(p.ws + OFF_MOD); bfr* XM = (bfr*)(p.ws + OFF_RA);
  for (size_t idx = (size_t)bid * NTHR + otid(); idx < (size_t)RTOT * 256; idx += (size_t)nb * NTHR) {
    const int r = (int)(idx >> 8), c4 = (int)(idx & 255) * 4;
    const float* src = xrow(p.x, p.ctx, r) + c4; const int mr = modrow(r);
    const float* sh = mod + mr * 3072 + c4; const float* scp = sh + 1024;
    const float4 v = *(const float4*)src, s4 = *(const float4*)sh, c4v = *(const float4*)scp;
    uint2 o; o.x = cvtpk(v.x * (1.f + c4v.x) + s4.x, v.y * (1.f + c4v.y) + s4.y); o.y = cvtpk(v.z * (1.f + c4v.z) + s4.z, v.w * (1.f + c4v.w) + s4.w);
    *(uint2*)(XM + (size_t)r * 1024 + c4) = o;
  }
}
template <int LAYER>
__device__ void ln_phase(const Params& p, int bid, int nb) {
  const float* mod = (const float*)(p.ws + OFF_MOD);
  const int lane = otid() & 63, wv = otid() >> 6;
  const int nrows = LAYER ? B_ * NLAT : RTOT;
  const float* lng = p.ln_g + LAYER * 1024; const float* lnb = p.ln_b + LAYER * 1024;
  for (int r = bid * 8 + wv; r < nrows; r += nb * 8) {
    int b, pp, mr; const float* xin; const bfr* Y; float* orow;
    if (LAYER == 0) { b = r / SEQA; pp = r - b * SEQA; mr = pp < NLAT ? b : 4; xin = xrow(p.x, p.ctx, r); Y = (const bfr*)(p.ws + OFF_RC) + (size_t)r * 1024;
      orow = p.out + ((size_t)(b * NLAT + pp)) * 1024; }
    else { b = r / NLAT; pp = 0; mr = b; orow = p.out + (size_t)r * 1024; xin = orow; Y = (const bfr*)(p.ws + OFF_RB) + (size_t)r * 1024; }
    const float* g = mod + (LAYER * 5 + mr) * 3072 + 2048;
    float v[16]; float s = 0.f;
#pragma unroll
    for (int i = 0; i < 4; ++i) { const int c = i * 256 + lane * 4;
      const float4 xv = *(const float4*)(xin + c), gv = *(const float4*)(g + c); const uint2 yv = *(const uint2*)(Y + c);
      v[i * 4 + 0] = ALPHA * xv.x + gv.x * __uint_as_float(yv.x << 16); v[i * 4 + 1] = ALPHA * xv.y + gv.y * __uint_as_float(yv.x & 0xffff0000u);
      v[i * 4 + 2] = ALPHA * xv.z + gv.z * __uint_as_float(yv.y << 16); v[i * 4 + 3] = ALPHA * xv.w + gv.w * __uint_as_float(yv.y & 0xffff0000u);
      s += v[i * 4] + v[i * 4 + 1] + v[i * 4 + 2] + v[i * 4 + 3]; }
    for (int o = 32; o; o >>= 1) s += __shfl_xor(s, o);
    const float mu = s * (1.f / 1024.f); float q = 0.f;
#pragma unroll
    for (int i = 0; i < 16; ++i) { const float d = v[i] - mu; q += d * d; }
    for (int o = 32; o; o >>= 1) q += __shfl_xor(q, o);
    const float rs = rsqrtf(q * (1.f / 1024.f) + 1e-6f);
    const float* sh1 = mod + (5 + mr) * 3072; const float* sc1 = sh1 + 1024;
#pragma unroll
    for (int i = 0; i < 4; ++i) { const int c = i * 256 + lane * 4;
      const float4 gg = *(const float4*)(lng + c), bb = *(const float4*)(lnb + c);
      float4 y; y.x = (v[i * 4] - mu) * rs * gg.x + bb.x; y.y = (v[i * 4 + 1] - mu) * rs * gg.y + bb.y;
      y.z = (v[i * 4 + 2] - mu) * rs * gg.z + bb.z; y.w = (v[i * 4 + 3] - mu) * rs * gg.w + bb.w;
      if (LAYER == 1 || pp < NLAT) *(float4*)(orow + c) = y;
      if (LAYER == 0) { const float4 s1 = *(const float4*)(sh1 + c), c1 = *(const float4*)(sc1 + c);
        uint2 o; o.x = cvtpk(y.x * (1.f + c1.x) + s1.x, y.y * (1.f + c1.y) + s1.y); o.y = cvtpk(y.z * (1.f + c1.z) + s1.z, y.w * (1.f + c1.w) + s1.w);
        *(uint2*)((bfr*)(p.ws + OFF_RA) + (size_t)r * 1024 + c) = o; } }
  }
}

namespace cg = cooperative_groups;
extern __shared__ __attribute__((aligned(16))) char dyn_smem[];
constexpr size_t SMEM_TOTAL = SMEM_BYTES + 1024;
__global__ __launch_bounds__(512, 2) void fwd_megakernel(Params p) {
  cg::grid_group grid = cg::this_grid();
  const int bid = blockIdx.x, nb = gridDim.x;
  char* smem = dyn_smem; char* ws = p.ws;
  mod_phase(p, smem, bid, nb);
  prep_phase(p, smem, (bid + nb - 96) % nb, nb);
  grid.sync();
  modulate_phase(p, bid, nb);
  grid.sync();
  { FEpiZ e{}; e.Zc = (bfr*)(ws + OFF_RE); e.DQ = (bfr*)(ws + OFF_RC); e.DK = e.DQ + (size_t)RTOT * 512; e.DV = e.DQ + (size_t)RTOT * 1024;
    e.SG0 = (bfr*)(ws + OFF_RB); e.KA = (bfr*)(ws + OFF_RD) + (size_t)RTOT * 768; e.ropeD = (const float2*)(ws + OFF_ROPED); e.ropeA = (const float2*)(ws + OFF_ROPEA);
    gemm_phase((const bfr*)(ws + OFF_RA), 1024, (const bfr*)(ws + OFF_WIN0), 1024, 1024, 132, 26, e, smem, bid, nb); }
  grid.sync();
  upproj_phase(p, smem, bid, nb);
  grid.sync();
  attn_phase(p, smem, bid, nb);
  grid.sync();
  { FEpiStore e{}; e.C = (bfr*)(ws + OFF_RC); e.ldc = 1024;
    gemm_phase((const bfr*)(ws + OFF_RA), 1024, (const bfr*)(ws + OFF_WOUT0), 1024, 1024, 132, 8, e, smem, bid, nb); }
  grid.sync();
  ln_phase<0>(p, bid, nb);
  grid.sync();
  { FEpiUG e{}; e.U = (bfr*)(ws + OFF_RD); e.SG1 = e.U + (size_t)RTOT * 1024;
    gemm_phase((const bfr*)(ws + OFF_RA), 1024, (const bfr*)(ws + OFF_WIN1), 1024, 1024, 132, 16, e, smem, bid, nb); }
  grid.sync();
  scan_phase<0>(p, smem, bid, nb);
  grid.sync();
  carry_phase(p, bid, nb);
  grid.sync();
  scan_phase<1>(p, smem, bid, nb);
  grid.sync();
  { FEpiStore e{}; e.C = (bfr*)(ws + OFF_RB); e.ldc = 1024;
    gemm_phase((const bfr*)(ws + OFF_RA), 1024, (const bfr*)(ws + OFF_WOUT1), 1024, 1024, 128, 8, e, smem, bid, nb); }
  grid.sync();
  ln_phase<1>(p, bid, nb);
}

extern "C" void kernel_launch(void* const* d_in, const int* in_sizes, int n_in, void* d_out, int out_size, void* d_ws, size_t ws_size, hipStream_t stream) {
  Params P{};
  { const float** pp = (const float**)&P; for (int i = 0; i < 28; ++i) pp[i] = (const float*)d_in[i]; }
  P.out = (float*)d_out; P.ws = (char*)d_ws;
  if (ws_size < WS_END || n_in < 28) return;
  static int grid_blocks = 0;
  if (!grid_blocks) {
    (void)hipFuncSetAttribute((const void*)fwd_megakernel, hipFuncAttributeMaxDynamicSharedMemorySize, (int)SMEM_TOTAL);
    int dev = 0, cus = 0, per_cu = 0;
    (void)hipGetDevice(&dev);
    (void)hipDeviceGetAttribute(&cus, hipDeviceAttributeMultiprocessorCount, dev);
    (void)hipOccupancyMaxActiveBlocksPerMultiprocessor(&per_cu, (const void*)fwd_megakernel, NTHR, SMEM_TOTAL);
    if (per_cu > 1) per_cu = 1;
    grid_blocks = cus * per_cu;
    if (grid_blocks <= 0) grid_blocks = 256;
  }
  void* args[] = {&P};
  (void)hipLaunchCooperativeKernel((const void*)fwd_megakernel, dim3(grid_blocks), dim3(NTHR), args, SMEM_TOTAL, stream);
}
```

```cpp
#include <hip/hip_runtime.h>
#include <hip/hip_bf16.h>
#include <hip/hip_cooperative_groups.h>
#include <stdint.h>

typedef unsigned short bfr;

constexpr int B_ = 4, NLAT = 8192, NCTX = 256, SEQA = NLAT + NCTX, RTOT = B_ * SEQA, DM = 1024;
constexpr float ALPHA = 1.4142135623730951f;
constexpr float LOG2E = 1.4426950408889634f;
constexpr float QSC_A = 0.10206207261596577f * LOG2E;
constexpr float QSC_D = 0.125f * LOG2E;

constexpr size_t SZ1024 = (size_t)RTOT * 1024 * 2;
constexpr size_t SZ512  = (size_t)RTOT * 512 * 2;
constexpr size_t SZ768  = (size_t)RTOT * 768 * 2;
constexpr size_t OFF_MOD = 0;
constexpr size_t OFF_LAM = 122880;
constexpr size_t OFF_RA = (size_t)24 << 20;
constexpr size_t OFF_RB = OFF_RA + SZ1024;
constexpr size_t OFF_RC = OFF_RB + SZ1024;
constexpr size_t OFF_RE = OFF_RC + 3 * SZ512;
constexpr size_t OFF_RD = OFF_RE + SZ1024;
constexpr size_t WS_END = OFF_RD + 2 * SZ1024;

__device__ __forceinline__ float bf2f(bfr h) { return __uint_as_float(((unsigned)h) << 16); }
__device__ __forceinline__ bfr f2bf(float f) { unsigned u = __float_as_uint(f); u += 0x7fffu + ((u >> 16) & 1u); return (bfr)(u >> 16); }
__device__ __forceinline__ float silu_f(float x) { return x / (1.f + expf(-x)); }
__device__ __forceinline__ float sigmoid_f(float x) { return 1.f / (1.f + expf(-x)); }
__device__ __forceinline__ const float* xrow(const float* x, const float* ctx, int r) {
  int b = r / SEQA, p = r - b * SEQA;
  return p < NLAT ? x + ((size_t)(b * NLAT + p)) * DM : ctx + ((size_t)(b * NCTX + (p - NLAT))) * DM;
}
__device__ __forceinline__ int modrow(int r) { int b = r / SEQA, p = r - b * SEQA; return p < NLAT ? b : 4; }

__device__ __forceinline__ void unpack8(uint4 u, float* f) {
  f[0] = __uint_as_float(u.x << 16); f[1] = __uint_as_float(u.x & 0xffff0000u);
  f[2] = __uint_as_float(u.y << 16); f[3] = __uint_as_float(u.y & 0xffff0000u);
  f[4] = __uint_as_float(u.z << 16); f[5] = __uint_as_float(u.z & 0xffff0000u);
  f[6] = __uint_as_float(u.w << 16); f[7] = __uint_as_float(u.w & 0xffff0000u);
}
using bf16x8 = __attribute__((ext_vector_type(8))) short;
using s16x4  = __attribute__((ext_vector_type(4))) short;
using f32x16 = __attribute__((ext_vector_type(16))) float;
using u32x4  = __attribute__((ext_vector_type(4))) unsigned;
constexpr int NTHR = 512;
constexpr size_t OFF_ROPED = (size_t)1 << 20;
constexpr size_t OFF_ROPEA = (size_t)3 << 20;
constexpr size_t OFF_WT    = (size_t)4 << 20;
constexpr size_t OFF_WIN0  = OFF_WT;
constexpr size_t OFF_WUQ   = OFF_WIN0 + (size_t)3328 * 1024 * 2;
constexpr size_t OFF_WUKV  = OFF_WUQ + (size_t)768 * 384 * 2;
constexpr size_t OFF_WOUT0 = OFF_WUKV + (size_t)1024 * 256 * 2;
constexpr size_t OFF_WIN1  = OFF_WOUT0 + (size_t)1024 * 1024 * 2;
constexpr size_t OFF_WG    = OFF_WIN1 + (size_t)2048 * 1024 * 2;
constexpr size_t OFF_WOUT1 = OFF_WG + (size_t)32 * 128 * 128 * 2;
static_assert(OFF_WOUT1 + (size_t)1024 * 1024 * 2 <= OFF_RA, "weights overflow");
constexpr size_t SMEM_BYTES = 2 * (256 * 72 + 128 * 72) * 2;

__device__ __forceinline__ int otid() { int t = threadIdx.x; asm volatile("" : "+v"(t)); return t; }
__device__ __forceinline__ int crow(int r, int hi) { return (r & 3) + 8 * (r >> 2) + 4 * hi; }

struct Params {
  const float *x, *c, *ctx, *c_ctx, *ada_w, *ada_b, *ln_g, *ln_b, *e_w_in, *e_qg, *e_w_uq, *e_kvg, *e_w_ukv, *lq1, *lk1, *lq2, *lk2, *subg, *e_w_out,
      *o_w_in, *conv_w, *conv_b, *ga_w, *ga_b, *gx_w, *gx_b, *lru_l, *o_w_out;
  float* out; char* ws;
};

template <int MODE>
__device__ __forceinline__ void wt_convert(const float* __restrict__ src, int K, int ldsrc, int Nd, bfr* __restrict__ dst, const float* __restrict__ kscale,
                           float* lds, int bid, int nb) {
  const int tid = otid(), tk = K >> 6, tn = Nd >> 6;
  for (int t = bid; t < tk * tn; t += nb) {
    const int k0 = (t % tk) << 6, n0 = (t / tk) << 6;
    for (int e = tid; e < 4096; e += NTHR) { int i = e >> 6, j = e & 63; int nd = n0 + j; float v;
      if (MODE == 1) { int ns = nd < 640 ? nd : (nd < 3200 ? nd + 32 : nd - 3200 + 640); v = nd < 3232 ? src[(size_t)(k0 + i) * ldsrc + ns] : 0.f; }
      else v = src[(size_t)(k0 + i) * ldsrc + nd];
      if (kscale) v *= kscale[k0 + i];
      lds[j * 65 + i] = v; }
    __syncthreads();
    for (int e = tid; e < 4096; e += NTHR) { int j = e >> 6, i = e & 63; dst[(size_t)(n0 + j) * K + k0 + i] = f2bf(lds[j * 65 + i]); }
    __syncthreads();
  }
}
__device__ __forceinline__ void prep_phase(const Params& p, char* smem, int bid, int nb) {
  float* lds = (float*)smem; char* ws = p.ws;
  wt_convert<1>(p.e_w_in, 1024, 3232, 3328, (bfr*)(ws + OFF_WIN0), nullptr, lds, bid, nb);
  wt_convert<0>(p.e_w_uq, 384, 768, 768, (bfr*)(ws + OFF_WUQ), p.e_qg, lds, bid, nb);
  wt_convert<0>(p.e_w_ukv, 256, 1024, 1024, (bfr*)(ws + OFF_WUKV), p.e_kvg, lds, bid, nb);
  wt_convert<0>(p.e_w_out, 1024, 1024, 1024, (bfr*)(ws + OFF_WOUT0), nullptr, lds, bid, nb);
  wt_convert<0>(p.o_w_in, 1024, 2048, 2048, (bfr*)(ws + OFF_WIN1), nullptr, lds, bid, nb);
  wt_convert<0>(p.o_w_out, 1024, 1024, 1024, (bfr*)(ws + OFF_WOUT1), nullptr, lds, bid, nb);
  for (int m = 0; m < 32; ++m) {
    int dir = m >> 4, gate = (m >> 3) & 1, blk = m & 7;
    const float* src = (gate ? p.gx_w : p.ga_w) + ((size_t)dir * 8 + blk) * 128 * 128;
    wt_convert<0>(src, 128, 128, 128, (bfr*)(ws + OFF_WG) + (size_t)m * 128 * 128, nullptr, lds, bid, nb);
  }
  float2* rd = (float2*)(ws + OFF_ROPED); float2* ra = (float2*)(ws + OFF_ROPEA);
  for (int e = bid * NTHR + otid(); e < 8192 * 32; e += nb * NTHR) { int pos = e >> 5, i = e & 31;
    float pp = (i < 16) ? (float)(pos >> 6) : (float)(pos & 63); float fr = powf(10000.f, -(float)(i & 15) / 16.f);
    float sn, cs; sincosf(pp * fr, &sn, &cs); rd[e] = make_float2(cs, sn); }
  for (int e = bid * NTHR + otid(); e < 8192 * 16; e += nb * NTHR) { int pos = e >> 4, i = e & 15;
    float pp = (i < 8) ? (float)(pos >> 6) : (float)(pos & 63); float fr = powf(10000.f, -(float)(i & 7) / 8.f);
    float sn, cs; sincosf(pp * fr, &sn, &cs); ra[e] = make_float2(cs, sn); }
}

template <class Epi>
__device__ __forceinline__ void gemm_tile(const bfr* __restrict__ A, int lda, const bfr* __restrict__ Bt, int ldb, int K, int m0, int n0, Epi& epi, char* smem) {
  const int tid = otid(), wid = tid >> 6, lane = tid & 63, wm = wid >> 1, wn = wid & 1, r32 = lane & 31, hi = lane >> 5;
  bfr* sa = (bfr*)smem; bfr* sb = sa + 2 * 256 * 72;
  f32x16 acc[2][2];
#pragma unroll
  for (int i = 0; i < 2; ++i)
#pragma unroll
    for (int j = 0; j < 2; ++j)
#pragma unroll
      for (int r = 0; r < 16; ++r) acc[i][j][r] = 0.f;
  uint4 ra0, ra1, ra2, ra3, rb0, rb1;
  const int lrow = tid >> 3, lck = (tid & 7) * 8;
  const bfr* Ap = A + (size_t)(m0 + lrow) * lda + lck;
  const bfr* Bp = Bt + (size_t)(n0 + lrow) * ldb + lck;
  const size_t a64 = (size_t)64 * lda, b64 = (size_t)64 * ldb;
  const int nk = K >> 6;
  bfr* swa = sa + lrow * 72 + lck; bfr* swb = sb + lrow * 72 + lck;
#define GLOAD(kt) do { const bfr* ap_ = Ap + (kt) * 64; const bfr* bp_ = Bp + (kt) * 64; \
    ra0 = *(const uint4*)(ap_); ra1 = *(const uint4*)(ap_ + a64); ra2 = *(const uint4*)(ap_ + 2 * a64); ra3 = *(const uint4*)(ap_ + 3 * a64); \
    rb0 = *(const uint4*)(bp_); rb1 = *(const uint4*)(bp_ + b64); } while (0)
#define SWRITE(buf) do { bfr* wa_ = swa + (buf) * 256 * 72; bfr* wb_ = swb + (buf) * 128 * 72; \
    *(uint4*)(wa_) = ra0; *(uint4*)(wa_ + 64 * 72) = ra1; *(uint4*)(wa_ + 128 * 72) = ra2; *(uint4*)(wa_ + 192 * 72) = ra3; \
    *(uint4*)(wb_) = rb0; *(uint4*)(wb_ + 64 * 72) = rb1; } while (0)
  GLOAD(0); SWRITE(0); __syncthreads();
  for (int kt = 0; kt < nk; ++kt) {
    const int cur = kt & 1;
    if (kt + 1 < nk) GLOAD(kt + 1);
    const bfr* pa = sa + cur * 256 * 72 + (wm * 64 + r32) * 72 + hi * 8;
    const bfr* pb = sb + cur * 128 * 72 + (wn * 64 + r32) * 72 + hi * 8;
#pragma unroll
    for (int ks = 0; ks < 4; ++ks) {
      bf16x8 a0 = *(const bf16x8*)(pa + ks * 16), a1 = *(const bf16x8*)(pa + 32 * 72 + ks * 16);
      bf16x8 b0 = *(const bf16x8*)(pb + ks * 16), b1 = *(const bf16x8*)(pb + 32 * 72 + ks * 16);
      acc[0][0] = __builtin_amdgcn_mfma_f32_32x32x16_bf16(a0, b0, acc[0][0], 0, 0, 0);
      acc[0][1] = __builtin_amdgcn_mfma_f32_32x32x16_bf16(a0, b1, acc[0][1], 0, 0, 0);
      acc[1][0] = __builtin_amdgcn_mfma_f32_32x32x16_bf16(a1, b0, acc[1][0], 0, 0, 0);
      acc[1][1] = __builtin_amdgcn_mfma_f32_32x32x16_bf16(a1, b1, acc[1][1], 0, 0, 0);
    }
    if (kt + 1 < nk) SWRITE(cur ^ 1);
    __syncthreads();
  }
#undef GLOAD
#undef SWRITE
  epi(m0 + wm * 64, n0 + wn * 64, acc, r32, hi);
}
template <class Epi>
__device__ __forceinline__ void gemm_phase(const bfr* A, int lda, const bfr* Bt, int ldb, int K, int mtiles, int ntiles, Epi& epi, char* smem, int bid, int nb) {
  for (int t = bid; t < mtiles * ntiles; t += nb) { int mt = t / ntiles, nt = t - mt * ntiles; gemm_tile(A, lda, Bt, ldb, K, mt * 256, nt * 128, epi, smem); }
}
struct FEpiStore { bfr* C; int ldc;
  __device__ __forceinline__ void operator()(int m0, int n0, f32x16 (&acc)[2][2], int r32, int hi) {
#pragma unroll
    for (int mt = 0; mt < 2; ++mt)
#pragma unroll
      for (int nt = 0; nt < 2; ++nt)
#pragma unroll
        for (int r = 0; r < 16; ++r) C[(size_t)(m0 + mt * 32 + crow(r, hi)) * ldc + n0 + nt * 32 + r32] = f2bf(acc[mt][nt][r]);
  } };
struct FEpiUG { bfr *U, *SG1;
  __device__ __forceinline__ void operator()(int m0, int n0, f32x16 (&acc)[2][2], int r32, int hi) {
    const bool g = n0 >= 1024; bfr* C = g ? SG1 : U; const int nn = g ? n0 - 1024 : n0;
#pragma unroll
    for (int mt = 0; mt < 2; ++mt)
#pragma unroll
      for (int nt = 0; nt < 2; ++nt)
#pragma unroll
        for (int r = 0; r < 16; ++r) { float v = acc[mt][nt][r]; if (g) v = silu_f(v);
          C[(size_t)(m0 + mt * 32 + crow(r, hi)) * 1024 + nn + nt * 32 + r32] = f2bf(v); }
  } };
struct FEpiZ { bfr *Zc, *DQ, *DK, *DV, *SG0, *KA; const float2 *ropeD, *ropeA;
  __device__ __forceinline__ void operator()(int m0, int n0, f32x16 (&acc)[2][2], int r32, int hi) {
    const int p0 = m0 % SEQA; const bool lat = p0 < NLAT;
    if (n0 < 640) {
#pragma unroll
      for (int mt = 0; mt < 2; ++mt)
#pragma unroll
        for (int nt = 0; nt < 2; ++nt)
#pragma unroll
          for (int r = 0; r < 16; ++r) Zc[(size_t)(m0 + mt * 32 + crow(r, hi)) * 640 + n0 + nt * 32 + r32] = f2bf(acc[mt][nt][r]);
    } else if (n0 < 1664) {
      const bool isq = n0 < 1152; bfr* C = isq ? DQ : DK; const int nn = isq ? n0 - 640 : n0 - 1152; const float sc = isq ? QSC_D : 1.f;
#pragma unroll
      for (int mt = 0; mt < 2; ++mt)
#pragma unroll
        for (int r = 0; r < 16; ++r) { const int rr = mt * 32 + crow(r, hi);
          float cs = 1.f, sn = 0.f; if (lat) { float2 t = ropeD[(p0 + rr) * 32 + r32]; cs = t.x; sn = t.y; }
          float x1 = acc[mt][0][r], x2 = acc[mt][1][r];
          bfr* d = C + (size_t)(m0 + rr) * 512 + nn + r32;
          d[0] = f2bf((x1 * cs - x2 * sn) * sc); d[32] = f2bf((x2 * cs + x1 * sn) * sc); }
    } else if (n0 < 2176) {
#pragma unroll
      for (int mt = 0; mt < 2; ++mt)
#pragma unroll
        for (int nt = 0; nt < 2; ++nt)
#pragma unroll
          for (int r = 0; r < 16; ++r) DV[(size_t)(m0 + mt * 32 + crow(r, hi)) * 512 + n0 - 1664 + nt * 32 + r32] = f2bf(acc[mt][nt][r]);
    } else if (n0 < 3200) {
#pragma unroll
      for (int mt = 0; mt < 2; ++mt)
#pragma unroll
        for (int nt = 0; nt < 2; ++nt)
#pragma unroll
          for (int r = 0; r < 16; ++r) SG0[(size_t)(m0 + mt * 32 + crow(r, hi)) * 1024 + n0 - 2176 + nt * 32 + r32] = f2bf(silu_f(acc[mt][nt][r]));
    } else if (n0 == 3200) {
#pragma unroll
      for (int mt = 0; mt < 2; ++mt)
#pragma unroll
        for (int r = 0; r < 16; ++r) { const int rr = mt * 32 + crow(r, hi);
          float cs = 1.f, sn = 0.f; if (lat) { float2 t = ropeA[(p0 + rr) * 16 + (r32 & 15)]; cs = t.x; sn = t.y; }
          float xv = acc[mt][0][r]; float pv = __shfl_xor(xv, 16);
          float o = (r32 < 16) ? (xv * cs - pv * sn) : (xv * cs + pv * sn);
          bfr ob = f2bf(o); bfr* d = KA + (size_t)(m0 + rr) * 768 + 64 + r32;
#pragma unroll
          for (int h = 0; h < 8; ++h) d[h * 96] = ob; }
    }
  } };
struct FEpiQ { bfr* QA; const float2* ropeA; const float* rfac;
  __device__ __forceinline__ void operator()(int m0, int n0, f32x16 (&acc)[2][2], int r32, int hi) {
    const int p0 = m0 % SEQA; const bool lat = p0 < NLAT; const int mloc = m0 & 255;
#pragma unroll
    for (int nt = 0; nt < 2; ++nt) { const int s32 = (n0 >> 5) + nt; const bool rope = (s32 % 3) == 2;
#pragma unroll
      for (int mt = 0; mt < 2; ++mt)
#pragma unroll
        for (int r = 0; r < 16; ++r) { const int rr = mt * 32 + crow(r, hi);
          float v = acc[mt][nt][r] * rfac[mloc + rr];
          if (rope) { float cs = 1.f, sn = 0.f; if (lat) { float2 t = ropeA[(p0 + rr) * 16 + (r32 & 15)]; cs = t.x; sn = t.y; }
            float pv = __shfl_xor(v, 16); v = (r32 < 16) ? (v * cs - pv * sn) : (v * cs + pv * sn); }
          QA[(size_t)(m0 + rr) * 768 + s32 * 32 + r32] = f2bf(v * QSC_A); } }
  } };
struct FEpiKV { bfr *KA, *VA; const float* rfac;
  __device__ __forceinline__ void operator()(int m0, int n0, f32x16 (&acc)[2][2], int r32, int hi) {
    const int mloc = m0 & 255;
#pragma unroll
    for (int nt = 0; nt < 2; ++nt) { const int s32 = (n0 >> 5) + nt, h = s32 >> 2, part = s32 & 3;
      bfr* C = part < 2 ? KA + h * 96 + part * 32 : VA + h * 64 + (part - 2) * 32; const int ldc = part < 2 ? 768 : 512;
#pragma unroll
      for (int mt = 0; mt < 2; ++mt)
#pragma unroll
        for (int r = 0; r < 16; ++r) { const int rr = mt * 32 + crow(r, hi);
          C[(size_t)(m0 + rr) * ldc + r32] = f2bf(acc[mt][nt][r] * rfac[mloc + rr]); } }
  } };
__device__ __forceinline__ void upproj_phase(const Params& p, char* smem, int bid, int nb) {
  char* ws = p.ws; const bfr* Zc = (const bfr*)(ws + OFF_RE);
  float* rfac = (float*)(smem + SMEM_BYTES);
  bfr* QA = (bfr*)(ws + OFF_RD); bfr* KA = QA + (size_t)RTOT * 768; bfr* VA = QA + (size_t)RTOT * 1536;
  FEpiQ eq; eq.QA = QA; eq.ropeA = (const float2*)(ws + OFF_ROPEA); eq.rfac = rfac;
  FEpiKV ek; ek.KA = KA; ek.VA = VA; ek.rfac = rfac;
  const int tid = otid();
  for (int t = bid; t < 132 * 14; t += nb) {
    const int mt = t / 14, j = t - mt * 14; const bool isq = j < 6; const int m0 = mt * 256;
    {
      const int row = tid >> 1, half = tid & 1; const int ncol = isq ? 192 : 128;
      const bfr* z = Zc + (size_t)(m0 + row) * 640 + (isq ? 0 : 384) + half * ncol;
      float ss = 0.f;
      for (int c = 0; c < ncol; c += 8) { uint4 u = *(const uint4*)(z + c); float f[8]; unpack8(u, f);
#pragma unroll
        for (int e = 0; e < 8; ++e) ss += f[e] * f[e]; }
      ss += __shfl_xor(ss, 1);
      if (half == 0) rfac[row] = rsqrtf(ss / (isq ? 384.f : 256.f) + 1e-6f);
    }
    __syncthreads();
    if (isq) gemm_tile(Zc, 640, (const bfr*)(ws + OFF_WUQ), 384, 384, m0, j * 128, eq, smem);
    else gemm_tile(Zc + 384, 640, (const bfr*)(ws + OFF_WUKV), 256, 256, m0, (j - 6) * 128, ek, smem);
    __syncthreads();
  }
}


constexpr int SHM_KV = 64 * 256;
constexpr float THR2 = 11.5f;
#define KSWZ(row, colB) ((row) * 256 + ((colB) ^ (((row) & 7) << 4)))
#define SBAR() __builtin_amdgcn_sched_barrier(0)
__device__ __forceinline__ unsigned cvtpk(float lo, float hi) { unsigned r; asm volatile("v_cvt_pk_bf16_f32 %0, %1, %2" : "=v"(r) : "v"(lo), "v"(hi)); return r; }
__device__ __forceinline__ void partialSM(f32x16& p0, f32x16& p1, float& m_reg, float& mn, float& alpha) {
  float pmax = p0[0];
#pragma unroll
  for (int r = 1; r < 16; ++r) pmax = fmaxf(pmax, p0[r]);
#pragma unroll
  for (int r = 0; r < 16; ++r) pmax = fmaxf(pmax, p1[r]);
  { auto rr = __builtin_amdgcn_permlane32_swap(__float_as_uint(pmax), __float_as_uint(pmax), false, false);
    pmax = fmaxf(__uint_as_float(rr[0]), __uint_as_float(rr[1])); }
  if (__builtin_expect(__all(pmax - m_reg <= THR2), 1)) { mn = m_reg; alpha = 1.f; }
  else { mn = fmaxf(m_reg, pmax); alpha = __builtin_amdgcn_exp2f(m_reg - mn); m_reg = mn; }
#pragma unroll
  for (int r = 0; r < 16; ++r) p0[r] = p0[r] - mn;
#pragma unroll
  for (int r = 0; r < 16; ++r) p1[r] = p1[r] - mn;
#pragma unroll
  for (int r = 0; r < 16; ++r) p0[r] = __builtin_amdgcn_exp2f(p0[r]);
}
__device__ __forceinline__ void finishSM(f32x16& p0, f32x16& p1, float alpha, float& l_reg, bf16x8& pa0, bf16x8& pa1, bf16x8& pa2, bf16x8& pa3) {
#pragma unroll
  for (int r = 0; r < 16; ++r) p1[r] = __builtin_amdgcn_exp2f(p1[r]);
  float ps = 0;
#pragma unroll
  for (int r = 0; r < 16; ++r) ps += p0[r];
#pragma unroll
  for (int r = 0; r < 16; ++r) ps += p1[r];
  { auto rr = __builtin_amdgcn_permlane32_swap(__float_as_uint(ps), __float_as_uint(ps), false, false);
    ps = __uint_as_float(rr[0]) + __uint_as_float(rr[1]); }
  l_reg = l_reg * alpha + ps;
#define PK4(P, BASE, OUT) do { unsigned a0 = cvtpk(P[BASE + 0], P[BASE + 1]), a1 = cvtpk(P[BASE + 2], P[BASE + 3]);   \
    unsigned b0 = cvtpk(P[BASE + 4], P[BASE + 5]), b1 = cvtpk(P[BASE + 6], P[BASE + 7]);                              \
    auto r0 = __builtin_amdgcn_permlane32_swap(a0, b0, false, false); auto r1 = __builtin_amdgcn_permlane32_swap(a1, b1, false, false); \
    u32x4 w = {r0[0], r1[0], r0[1], r1[1]}; OUT = *reinterpret_cast<bf16x8*>(&w); } while (0)
  PK4(p0, 0, pa0); PK4(p0, 8, pa1); PK4(p1, 0, pa2); PK4(p1, 8, pa3);
#undef PK4
}
template <int NKS>
__device__ __forceinline__ void qkt(f32x16& p0, f32x16& p1, const char* Ks, const bf16x8* qr, int r32, int hi, int qcolB) {
#pragma unroll
  for (int r = 0; r < 16; ++r) { p0[r] = 0.f; p1[r] = 0.f; }
#pragma unroll
  for (int d0 = 0; d0 < NKS; ++d0) { int cb = qcolB + (d0 * 16 + hi * 8) * 2;
    bf16x8 b0 = *reinterpret_cast<const bf16x8*>(Ks + KSWZ(r32, cb));
    bf16x8 b1 = *reinterpret_cast<const bf16x8*>(Ks + KSWZ(32 + r32, cb));
    p0 = __builtin_amdgcn_mfma_f32_32x32x16_bf16(b0, qr[d0], p0, 0, 0, 0);
    p1 = __builtin_amdgcn_mfma_f32_32x32x16_bf16(b1, qr[d0], p1, 0, 0, 0); }
}
__device__ __forceinline__ int v_st(int k, int c) { const int kk = (k & ~0xC) | ((k & 4) << 1) | ((k & 8) >> 1); return ((kk >> 3) * 4 + (c >> 5)) * 512 + ((kk & 7) * 32 + (c & 31)) * 2; }
__device__ __forceinline__ int v_rd_base(int lane) { return ((lane & 3) << 3) | (((lane >> 2) & 3) << 6) | (((lane >> 4) & 1) << 5) | (((lane >> 5) & 1) << 8); }
constexpr int v_rd_off(int d0, int ks, int half) { return d0 * 512 + ks * 4096 + half * 2048; }
template <int OFF> __device__ __forceinline__ s16x4 tr_read(int vb) {
  s16x4 r; asm volatile("ds_read_b64_tr_b16 %0, %1 offset:%2" : "=&v"(r) : "v"(vb), "i"(OFF) : "memory"); return r;
}
template <int D0> __device__ __forceinline__ void pv_one(f32x16& od, int vb, bf16x8 pa0, bf16x8 pa1, bf16x8 pa2, bf16x8 pa3) {
  const s16x4 l0 = tr_read<v_rd_off(D0, 0, 0)>(vb), h0 = tr_read<v_rd_off(D0, 0, 1)>(vb), l1 = tr_read<v_rd_off(D0, 1, 0)>(vb), h1 = tr_read<v_rd_off(D0, 1, 1)>(vb);
  const s16x4 l2 = tr_read<v_rd_off(D0, 2, 0)>(vb), h2 = tr_read<v_rd_off(D0, 2, 1)>(vb), l3 = tr_read<v_rd_off(D0, 3, 0)>(vb), h3 = tr_read<v_rd_off(D0, 3, 1)>(vb);
  asm volatile("s_waitcnt lgkmcnt(0)" ::: "memory"); SBAR();
#define PK(L, H) (bf16x8){L[0], L[1], L[2], L[3], H[0], H[1], H[2], H[3]}
  od = __builtin_amdgcn_mfma_f32_32x32x16_bf16(pa0, PK(l0, h0), od, 0, 0, 0);
  od = __builtin_amdgcn_mfma_f32_32x32x16_bf16(pa1, PK(l1, h1), od, 0, 0, 0);
  od = __builtin_amdgcn_mfma_f32_32x32x16_bf16(pa2, PK(l2, h2), od, 0, 0, 0);
  od = __builtin_amdgcn_mfma_f32_32x32x16_bf16(pa3, PK(l3, h3), od, 0, 0, 0);
#undef PK
}
template <int NVB> __device__ __forceinline__ void pv_all(f32x16* o, int vb, bf16x8 pa0, bf16x8 pa1, bf16x8 pa2, bf16x8 pa3) {
  pv_one<0>(o[0], vb, pa0, pa1, pa2, pa3); pv_one<1>(o[1], vb, pa0, pa1, pa2, pa3);
  if constexpr (NVB == 4) { pv_one<2>(o[2], vb, pa0, pa1, pa2, pa3); pv_one<3>(o[3], vb, pa0, pa1, pa2, pa3); }
}
template <int TYPE>
__device__ __forceinline__ void attn_item(const Params& p, char* lds, int h, int qrow0, int krow0, int NT, float lam) {
  constexpr int NKS = TYPE ? 4 : 6, NVB = TYPE ? 4 : 2;
  constexpr int LDQ = TYPE ? 512 : 768, LDK = TYPE ? 512 : 768, LDV = 512;
  constexpr int KCOLS = TYPE ? 128 : 96, VCOLS = TYPE ? 128 : 64;
  const int tid = otid(), wid = tid >> 6, lane = tid & 63, r32 = lane & 31, hi = lane >> 5;
  const int map = TYPE ? (wid >> 2) : 0, wq = TYPE ? (wid & 3) : wid;
  char* ws = p.ws;
  const bfr* Qb = TYPE ? (const bfr*)(ws + OFF_RC) + (size_t)(qrow0 + wq * 32 + r32) * 512 + h * 128 + map * 64 + hi * 8
                       : (const bfr*)(ws + OFF_RD) + (size_t)(qrow0 + wq * 32 + r32) * 768 + h * 96 + hi * 8;
  const bfr* Kh = TYPE ? (const bfr*)(ws + OFF_RC) + (size_t)RTOT * 512 + (size_t)krow0 * 512 + h * 128
                       : (const bfr*)(ws + OFF_RD) + (size_t)RTOT * 768 + (size_t)krow0 * 768 + h * 96;
  const bfr* Vh = TYPE ? (const bfr*)(ws + OFF_RC) + (size_t)RTOT * 1024 + (size_t)krow0 * 512 + h * 128
                       : (const bfr*)(ws + OFF_RD) + (size_t)RTOT * 1536 + (size_t)krow0 * 512 + h * 64;
  const bfr* SG0 = (const bfr*)(ws + OFF_RB); bfr* OG = (bfr*)(ws + OFF_RA);
  const int qcolB = map * 128;
  char* V_lds = lds; char* K_lds = lds + 2 * SHM_KV;
  float* wsc = (float*)(lds + 4 * SHM_KV) + wid * 64; float* li_l = wsc; float* al_l = wsc + 32;
  float m_reg = -1e30f, l_reg = 0.f; f32x16 o[NVB]; bf16x8 qr[NKS];
#pragma unroll
  for (int d = 0; d < NVB; ++d)
#pragma unroll
    for (int r = 0; r < 16; ++r) o[d][r] = 0.f;
#pragma unroll
  for (int d0 = 0; d0 < NKS; ++d0) qr[d0] = *reinterpret_cast<const bf16x8*>(Qb + d0 * 16);
  const int sr = tid >> 4, sc = (tid & 15) * 8, vst0 = v_st(sr, sc), vst1 = v_st(32 + sr, sc);
  const bool kval = sc < KCOLS, vval = sc < VCOLS;
  const int vb0 = (int)(uintptr_t)V_lds + v_rd_base(lane);
  bf16x8 e_vs0, e_vs1, e_ks0, e_ks1, o_vs0, o_vs1, o_ks0, o_ks1;
#define LD8(ptr) (*reinterpret_cast<const bf16x8*>(ptr))
#define SLOAD_E(k0) do { if (vval) { e_vs0 = LD8(&Vh[(size_t)((k0) + sr) * LDV + sc]); e_vs1 = LD8(&Vh[(size_t)((k0) + 32 + sr) * LDV + sc]); } \
    if (kval) { e_ks0 = LD8(&Kh[(size_t)((k0) + sr) * LDK + sc]); e_ks1 = LD8(&Kh[(size_t)((k0) + 32 + sr) * LDK + sc]); } } while (0)
#define SLOAD_O(k0) do { if (vval) { o_vs0 = LD8(&Vh[(size_t)((k0) + sr) * LDV + sc]); o_vs1 = LD8(&Vh[(size_t)((k0) + 32 + sr) * LDV + sc]); } \
    if (kval) { o_ks0 = LD8(&Kh[(size_t)((k0) + sr) * LDK + sc]); o_ks1 = LD8(&Kh[(size_t)((k0) + 32 + sr) * LDK + sc]); } } while (0)
#define SWRITE_E(b) do { if (vval) { *(bf16x8*)(V_lds + (b) * SHM_KV + vst0) = e_vs0; *(bf16x8*)(V_lds + (b) * SHM_KV + vst1) = e_vs1; } \
    if (kval) { int kc = sc * 2; *(bf16x8*)(K_lds + (b) * SHM_KV + KSWZ(sr, kc)) = e_ks0; *(bf16x8*)(K_lds + (b) * SHM_KV + KSWZ(32 + sr, kc)) = e_ks1; } } while (0)
#define SWRITE_O(b) do { if (vval) { *(bf16x8*)(V_lds + (b) * SHM_KV + vst0) = o_vs0; *(bf16x8*)(V_lds + (b) * SHM_KV + vst1) = o_vs1; } \
    if (kval) { int kc = sc * 2; *(bf16x8*)(K_lds + (b) * SHM_KV + KSWZ(sr, kc)) = o_ks0; *(bf16x8*)(K_lds + (b) * SHM_KV + KSWZ(32 + sr, kc)) = o_ks1; } } while (0)
#define SWAIT() asm volatile("s_waitcnt vmcnt(4)" ::: "memory")
#define RESC(a) do { if (__any((a) < 1.f)) { if (hi == 0) al_l[r32] = (a); asm volatile("s_waitcnt lgkmcnt(0)" ::: "memory"); \
    _Pragma("unroll") for (int d = 0; d < NVB; ++d) _Pragma("unroll") for (int r = 0; r < 16; ++r) o[d][r] *= al_l[crow(r, hi)]; } } while (0)
  f32x16 pA0, pA1, pB0, pB1; float mnA, mnB, alA, alB; bf16x8 pa0, pa1, pa2, pa3;
  SLOAD_E(0); asm volatile("s_waitcnt vmcnt(0)" ::: "memory"); SWRITE_E(0); __syncthreads();
  qkt<NKS>(pA0, pA1, K_lds, qr, r32, hi, qcolB); partialSM(pA0, pA1, m_reg, mnA, alA);
  SLOAD_O(64); if (2 < NT) SLOAD_E(2 * 64);
  SWAIT(); SWRITE_O(1); __syncthreads();
  for (int j = 1; j + 1 < NT; j += 2) {
    SBAR(); qkt<NKS>(pB0, pB1, K_lds + SHM_KV, qr, r32, hi, qcolB);
    finishSM(pA0, pA1, alA, l_reg, pa0, pa1, pa2, pa3); SBAR();
    SLOAD_O((j + 2) * 64); SBAR();
    pv_all<NVB>(o, vb0, pa0, pa1, pa2, pa3); partialSM(pB0, pB1, m_reg, mnB, alB);
    __syncthreads(); SWAIT(); SWRITE_E(0);
    RESC(alB); __syncthreads();
    SBAR(); qkt<NKS>(pA0, pA1, K_lds, qr, r32, hi, qcolB);
    finishSM(pB0, pB1, alB, l_reg, pa0, pa1, pa2, pa3); SBAR();
    if (j + 3 < NT) SLOAD_E((j + 3) * 64); SBAR();
    pv_all<NVB>(o, vb0 + SHM_KV, pa0, pa1, pa2, pa3); partialSM(pA0, pA1, m_reg, mnA, alA);
    __syncthreads(); SWAIT(); SWRITE_O(1);
    RESC(alA); __syncthreads();
  }
  SBAR(); qkt<NKS>(pB0, pB1, K_lds + SHM_KV, qr, r32, hi, qcolB);
  finishSM(pA0, pA1, alA, l_reg, pa0, pa1, pa2, pa3); SBAR();
  pv_all<NVB>(o, vb0, pa0, pa1, pa2, pa3); partialSM(pB0, pB1, m_reg, mnB, alB);
  __syncthreads(); RESC(alB);
  finishSM(pB0, pB1, alB, l_reg, pa0, pa1, pa2, pa3); SBAR();
  pv_all<NVB>(o, vb0 + SHM_KV, pa0, pa1, pa2, pa3);
  if (hi == 0) li_l[r32] = l_reg; asm volatile("s_waitcnt lgkmcnt(0)" ::: "memory");
  float rli[16];
#pragma unroll
  for (int r = 0; r < 16; ++r) rli[r] = __builtin_amdgcn_rcpf(li_l[crow(r, hi)]);
  if constexpr (TYPE == 0) {
#pragma unroll
    for (int r = 0; r < 16; ++r) { const size_t row = (size_t)(qrow0 + wq * 32 + crow(r, hi)) * 1024;
#pragma unroll
      for (int d0 = 0; d0 < NVB; ++d0) { const size_t idx = row + h * 64 + d0 * 32 + r32; OG[idx] = f2bf(o[d0][r] * rli[r] * bf2f(SG0[idx])); } }
    __syncthreads();
  } else {
    float* xch = (float*)lds;
    __syncthreads();
    if (map == 1) {
#pragma unroll
      for (int r = 0; r < 16; ++r) { const float f = rli[r] * lam;
#pragma unroll
        for (int d0 = 0; d0 < 4; ++d0) xch[(wq * 32 + crow(r, hi)) * 128 + d0 * 32 + r32] = o[d0][r] * f; }
    }
    __syncthreads();
    if (map == 0) {
      const float* subg = p.subg;
#pragma unroll
      for (int r = 0; r < 16; ++r) { float ss = 0.f;
#pragma unroll
        for (int d0 = 0; d0 < 4; ++d0) { float v = o[d0][r] * rli[r] - xch[(wq * 32 + crow(r, hi)) * 128 + d0 * 32 + r32]; o[d0][r] = v; ss += v * v; }
        ss += __shfl_xor(ss, 16); ss += __shfl_xor(ss, 8); ss += __shfl_xor(ss, 4); ss += __shfl_xor(ss, 2); ss += __shfl_xor(ss, 1);
        const float rs = rsqrtf(ss * (1.f / 128.f) + 1e-6f) * 0.8f;
        const size_t row = (size_t)(qrow0 + wq * 32 + crow(r, hi)) * 1024;
#pragma unroll
        for (int d0 = 0; d0 < 4; ++d0) { const size_t idx = row + 512 + h * 128 + d0 * 32 + r32;
          OG[idx] = f2bf(o[d0][r] * rs * subg[d0 * 32 + r32] * bf2f(SG0[idx])); } }
    }
    __syncthreads();
  }
#undef LD8
#undef SLOAD_E
#undef SLOAD_O
#undef SWRITE_E
#undef SWRITE_O
#undef SWAIT
#undef RESC
}
__device__ __forceinline__ void attn_phase(const Params& p, char* smem, int bid, int nb) {
  const float lam = *(const float*)(p.ws + OFF_LAM);
  for (int it = bid; it < 2112; it += nb) {
    const int rd = it >> 8, j = it & 255;
    int type, h, qrow0, krow0, NT;
    if (rd < 4) { const int b = rd; type = 0; h = j & 7; qrow0 = b * SEQA + (j >> 3) * 256; krow0 = b * SEQA; NT = 132; }
    else if (rd < 8) { const int pair = (j & 7) + 8 * ((rd - 4) >> 1), b = pair >> 2, qt = 2 * (j >> 3) + ((rd - 4) & 1);
      type = 1; h = pair & 3; qrow0 = b * SEQA + qt * 128; krow0 = b * SEQA; NT = 132; }
    else if (j < 32) { const int b = j >> 3; type = 0; h = j & 7; qrow0 = b * SEQA + NLAT; krow0 = qrow0; NT = 4; }
    else if (j < 64) { const int pair = (j - 32) >> 1, b = pair >> 2, qt = (j - 32) & 1;
      type = 1; h = pair & 3; krow0 = b * SEQA + NLAT; qrow0 = krow0 + qt * 128; NT = 4; }
    else continue;
#ifndef ONLY_T1
    if (type == 0) attn_item<0>(p, smem, h, qrow0, krow0, NT, lam);
#endif
#ifndef ONLY_T0
    if (type == 1) attn_item<1>(p, smem, h, qrow0, krow0, NT, lam);
#endif
  }
}


constexpr size_t CARRY_SZ = (size_t)2 * 4 * 132 * 1024 * 4;
constexpr size_t OFF_CA = OFF_RC, OFF_CB = OFF_RC + CARRY_SZ, OFF_HIN = OFF_RC + 2 * CARRY_SZ;
constexpr int AT_LD = 264;
constexpr size_t SCAN_UF_OFF = 64 * AT_LD * 2;

template <int PASS>
__device__ __forceinline__ void scan_item(const Params& p, char* lds, int b, int c, int cg) {
  const int tid = otid(), wid = tid >> 6, lane = tid & 63, r32 = lane & 31, hi = lane >> 5;
  char* ws = p.ws;
  const bfr* U = (const bfr*)(ws + OFF_RD); const bfr* SG1 = U + (size_t)RTOT * 1024;
  bfr* AT = (bfr*)lds; float* UF = (float*)(lds + SCAN_UF_OFF);
  const int row0 = b * SEQA + c * 64;
  const int lo = c < 128 ? 0 : NLAT, hiP = c < 128 ? NLAT : SEQA;
  {
    const int k8 = tid & 31, ch = cg * 256 + k8 * 8;
    float w[4][8], bia[8];
#pragma unroll
    for (int j = 0; j < 4; ++j) { float4 t0 = *(const float4*)(p.conv_w + j * 1024 + ch), t1 = *(const float4*)(p.conv_w + j * 1024 + ch + 4);
      w[j][0] = t0.x; w[j][1] = t0.y; w[j][2] = t0.z; w[j][3] = t0.w; w[j][4] = t1.x; w[j][5] = t1.y; w[j][6] = t1.z; w[j][7] = t1.w; }
    { float4 t0 = *(const float4*)(p.conv_b + ch), t1 = *(const float4*)(p.conv_b + ch + 4);
      bia[0] = t0.x; bia[1] = t0.y; bia[2] = t0.z; bia[3] = t0.w; bia[4] = t1.x; bia[5] = t1.y; bia[6] = t1.z; bia[7] = t1.w; }
#pragma unroll
    for (int i = 0; i < 4; ++i) { const int t = (tid >> 5) + i * 16; const int pt = c * 64 + t;
      float acc[8];
#pragma unroll
      for (int e = 0; e < 8; ++e) acc[e] = bia[e];
#pragma unroll
      for (int j = 0; j < 4; ++j) { const int pp = pt + j - 2;
        if (pp >= lo && pp < hiP) { uint4 u = *(const uint4*)(U + (size_t)(row0 + t + j - 2) * 1024 + ch); float f[8]; unpack8(u, f);
#pragma unroll
          for (int e = 0; e < 8; ++e) acc[e] += w[j][e] * f[e]; } }
      u32x4 pk; pk[0] = cvtpk(acc[0], acc[1]); pk[1] = cvtpk(acc[2], acc[3]); pk[2] = cvtpk(acc[4], acc[5]); pk[3] = cvtpk(acc[6], acc[7]);
      *(u32x4*)(AT + t * AT_LD + k8 * 8) = pk;
      *(float4*)(UF + t * 256 + k8 * 8) = make_float4(acc[0], acc[1], acc[2], acc[3]);
      *(float4*)(UF + t * 256 + k8 * 8 + 4) = make_float4(acc[4], acc[5], acc[6], acc[7]); }
  }
  __syncthreads();
  const int blkl = wid >> 2, blk = cg * 2 + blkl, j0 = (wid & 3) * 32;
  const int ch = cg * 256 + wid * 32 + r32;
  float hsum[2][16];
#pragma unroll
  for (int dir = 0; dir < 2; ++dir) {
    f32x16 ga[2], gx[2];
#pragma unroll
    for (int mt = 0; mt < 2; ++mt)
#pragma unroll
      for (int r = 0; r < 16; ++r) { ga[mt][r] = 0.f; gx[mt][r] = 0.f; }
    const bfr* wa = (const bfr*)(ws + OFF_WG) + (size_t)(dir * 16 + blk) * 16384 + (size_t)(j0 + r32) * 128 + hi * 8;
    const bfr* wx = wa + (size_t)8 * 16384;
    const bfr* ap = AT + r32 * AT_LD + blkl * 128 + hi * 8;
#pragma unroll 2
    for (int ks = 0; ks < 8; ++ks) {
      bf16x8 a0 = *(const bf16x8*)(ap + ks * 16), a1 = *(const bf16x8*)(ap + 32 * AT_LD + ks * 16);
      bf16x8 ba_ = *(const bf16x8*)(wa + ks * 16), bx_ = *(const bf16x8*)(wx + ks * 16);
      ga[0] = __builtin_amdgcn_mfma_f32_32x32x16_bf16(a0, ba_, ga[0], 0, 0, 0);
      ga[1] = __builtin_amdgcn_mfma_f32_32x32x16_bf16(a1, ba_, ga[1], 0, 0, 0);
      gx[0] = __builtin_amdgcn_mfma_f32_32x32x16_bf16(a0, bx_, gx[0], 0, 0, 0);
      gx[1] = __builtin_amdgcn_mfma_f32_32x32x16_bf16(a1, bx_, gx[1], 0, 0, 0);
    }
    const float sp = log1pf(expf(-p.lru_l[dir * 1024 + ch]));
    const float kA = -8.f * sp * LOG2E, biasA = p.ga_b[dir * 1024 + ch], biasX = p.gx_b[dir * 1024 + ch];
#pragma unroll
    for (int mt = 0; mt < 2; ++mt)
#pragma unroll
      for (int r = 0; r < 16; ++r) {
        const float rr = __builtin_amdgcn_rcpf(1.f + __builtin_amdgcn_exp2f(-(ga[mt][r] + biasA) * LOG2E));
        const float ii = __builtin_amdgcn_rcpf(1.f + __builtin_amdgcn_exp2f(-(gx[mt][r] + biasX) * LOG2E));
        const float a = __builtin_amdgcn_exp2f(kA * rr);
        const float uc = UF[(mt * 32 + crow(r, hi)) * 256 + wid * 32 + r32];
        ga[mt][r] = a; gx[mt][r] = __builtin_amdgcn_sqrtf(fmaxf(1.f - a * a, 0.f)) * ii * uc;
      }
    float sA[8], sB[8];
#pragma unroll
    for (int sgi = 0; sgi < 8; ++sgi) { const int mt = sgi >> 2, g = sgi & 3; float A = 1.f, Bv = 0.f;
#pragma unroll
      for (int e = 0; e < 4; ++e) { const int r = g * 4 + (dir ? 3 - e : e); A *= ga[mt][r]; Bv = ga[mt][r] * Bv + gx[mt][r]; }
      sA[sgi] = A; sB[sgi] = Bv; }
    const bool ownFirst = (dir == 0) == (hi == 0);
    float st, stA = 1.f;
    if (PASS == 1) st = *(const float*)(ws + OFF_HIN + ((size_t)((dir * 4 + b) * 132 + c) * 1024 + ch) * 4); else st = 0.f;
#pragma unroll
    for (int q = 0; q < 8; ++q) { const int sgi = dir ? 7 - q : q;
      const float oA = sA[sgi], oB = sB[sgi];
      const float pA = __shfl_xor(oA, 32), pB = __shfl_xor(oB, 32);
      const float fA = ownFirst ? oA : pA, fB = ownFirst ? oB : pB, sA2 = ownFirst ? pA : oA, sB2 = ownFirst ? pB : oB;
      const float A8 = fA * sA2, B8 = sA2 * fB + sB2;
      if (PASS == 1) {
        float hv = ownFirst ? st : fA * st + fB;
        const int mt = sgi >> 2, g = sgi & 3;
#pragma unroll
        for (int e = 0; e < 4; ++e) { const int r = g * 4 + (dir ? 3 - e : e); hv = ga[mt][r] * hv + gx[mt][r];
          if (dir == 0) hsum[mt][r] = hv; else hsum[mt][r] += hv; }
      }
      st = A8 * st + B8; stA *= A8;
    }
    if (PASS == 0 && hi == 0) {
      const size_t ci = ((size_t)((dir * 4 + b) * 132 + c) * 1024 + ch) * 4;
      *(float*)(ws + OFF_CA + ci) = stA; *(float*)(ws + OFF_CB + ci) = st;
    }
  }
  __syncthreads();
  if (PASS == 1) {
#pragma unroll
    for (int mt = 0; mt < 2; ++mt)
#pragma unroll
      for (int r = 0; r < 16; ++r) AT[(mt * 32 + crow(r, hi)) * AT_LD + wid * 32 + r32] = f2bf(hsum[mt][r]);
    __syncthreads();
    bfr* HG = (bfr*)(ws + OFF_RA);
    const int k8 = tid & 31, chh = cg * 256 + k8 * 8;
#pragma unroll
    for (int i = 0; i < 4; ++i) { const int t = (tid >> 5) + i * 16;
      uint4 hv = *(const uint4*)(AT + t * AT_LD + k8 * 8); uint4 gv = *(const uint4*)(SG1 + (size_t)(row0 + t) * 1024 + chh);
      float hf[8], gf[8]; unpack8(hv, hf); unpack8(gv, gf);
      u32x4 pk; pk[0] = cvtpk(hf[0] * gf[0], hf[1] * gf[1]); pk[1] = cvtpk(hf[2] * gf[2], hf[3] * gf[3]);
      pk[2] = cvtpk(hf[4] * gf[4], hf[5] * gf[5]); pk[3] = cvtpk(hf[6] * gf[6], hf[7] * gf[7]);
      *(u32x4*)(HG + ((size_t)(b * NLAT + c * 64 + t)) * 1024 + chh) = pk; }
    __syncthreads();
  }
}
template <int PASS>
__device__ __forceinline__ void scan_phase(const Params& p, char* smem, int bid, int nb) {
  const int nchunk = PASS ? 128 : 132;
  for (int it = bid; it < 4 * nchunk * 4; it += nb) { const int cg = it & 3, t2 = it >> 2, c = t2 % nchunk, b = t2 / nchunk; scan_item<PASS>(p, smem, b, c, cg); }
}
__device__ __forceinline__ void carry_phase(const Params& p, int bid, int nb) {
  char* ws = p.ws;
  for (int id = bid * NTHR + otid(); id < 8192; id += nb * NTHR) {
    const int ch = id & 1023, db = id >> 10, dir = db >> 2;
    const float* CA = (const float*)(ws + OFF_CA) + (size_t)db * 132 * 1024 + ch; const float* CB = (const float*)(ws + OFF_CB) + (size_t)db * 132 * 1024 + ch;
    float* HIN = (float*)(ws + OFF_HIN) + (size_t)db * 132 * 1024 + ch;
    float h = 0.f;
    for (int s0 = 0; s0 < 132; s0 += 12) {
      float a[12], bb[12];
#pragma unroll
      for (int u = 0; u < 12; ++u) { const int s = s0 + u; const int c = dir ? 131 - s : (s < 4 ? 128 + s : s - 4); a[u] = CA[(size_t)c * 1024]; bb[u] = CB[(size_t)c * 1024]; }
#pragma unroll
      for (int u = 0; u < 12; ++u) { const int s = s0 + u; const int c = dir ? 131 - s : (s < 4 ? 128 + s : s - 4); HIN[(size_t)c * 1024] = h; h = a[u] * h + bb[u]; }
    }
  }
}

__device__ __forceinline__ float ld_agent_f32(const float* p) { return __hip_atomic_load(p, __ATOMIC_RELAXED, __HIP_MEMORY_SCOPE_AGENT); }
__device__ __forceinline__ void mod_phase(const Params& p, char* smem, int bid, int nb) {
  float* sc = (float*)smem; float* red = sc + 5 * 1024;
  float* mod = (float*)(p.ws + OFF_MOD);
  const int tid = otid(), kg = tid >> 6, col = tid & 63;
  for (int it = bid; it < 96; it += nb) {
    const int l = it / 48, j0 = (it % 48) * 64;
    for (int e = tid; e < 5120; e += NTHR) { const int mr = e >> 10, k = e & 1023; sc[e] = silu_f(mr < 4 ? p.c[mr * 1024 + k] : p.c_ctx[k]); }
    __syncthreads();
    float acc[5] = {0.f, 0.f, 0.f, 0.f, 0.f};
    const float* w = p.ada_w + (size_t)l * 1024 * 3072 + (size_t)(kg * 128) * 3072 + j0 + col;
#pragma unroll 8
    for (int k = 0; k < 128; ++k) { const float wv = w[(size_t)k * 3072];
#pragma unroll
      for (int mr = 0; mr < 5; ++mr) acc[mr] += sc[mr * 1024 + kg * 128 + k] * wv; }
#pragma unroll
    for (int mr = 0; mr < 5; ++mr) red[(kg * 5 + mr) * 64 + col] = acc[mr];
    __syncthreads();
    if (tid < 320) { const int mr = tid >> 6; float sum = 0.f;
#pragma unroll
      for (int g = 0; g < 8; ++g) sum += red[(g * 5 + mr) * 64 + col];
      mod[(l * 5 + mr) * 3072 + j0 + col] = sum + p.ada_b[l * 3072 + j0 + col]; }
    __syncthreads();
  }
  if (bid == nb - 1 && tid == 0) { float s1 = 0, s2 = 0;
    for (int i = 0; i < 64; ++i) { s1 += p.lq1[i] * p.lk1[i]; s2 += p.lq2[i] * p.lk2[i]; }
    *(float*)(p.ws + OFF_LAM) = expf(s1) - expf(s2) + 0.2f; }
}
__device__ __forceinline__ void modulate_phase(const Params& p, int bid, int nb) {
  const float* mod = (const float*)(p.ws + OFF_MOD); bfr* XM = (bfr*)(p.ws + OFF_RA);
  for (size_t idx = (size_t)bid * NTHR + otid(); idx < (size_t)RTOT * 256; idx += (size_t)nb * NTHR) {
    const int r = (int)(idx >> 8), c4 = (int)(idx & 255) * 4;
    const float* src = xrow(p.x, p.ctx, r) + c4; const int mr = modrow(r);
    const float* sh = mod + mr * 3072 + c4; const float* scp = sh + 1024;
    const float4 v = *(const float4*)src, s4 = *(const float4*)sh, c4v = *(const float4*)scp;
    uint2 o; o.x = cvtpk(v.x * (1.f + c4v.x) + s4.x, v.y * (1.f + c4v.y) + s4.y); o.y = cvtpk(v.z * (1.f + c4v.z) + s4.z, v.w * (1.f + c4v.w) + s4.w);
    *(uint2*)(XM + (size_t)r * 1024 + c4) = o;
  }
}
template <int LAYER>
__device__ __forceinline__ void ln_phase(const Params& p, int bid, int nb) {
  const float* mod = (const float*)(p.ws + OFF_MOD);
  const int lane = otid() & 63, wv = otid() >> 6;
  const int nrows = LAYER ? B_ * NLAT : RTOT;
  const float* lng = p.ln_g + LAYER * 1024; const float* lnb = p.ln_b + LAYER * 1024;
  for (int r = bid * 8 + wv; r < nrows; r += nb * 8) {
    int b, pp, mr; const float* xin; const bfr* Y; float* orow;
    if (LAYER == 0) { b = r / SEQA; pp = r - b * SEQA; mr = pp < NLAT ? b : 4; xin = xrow(p.x, p.ctx, r); Y = (const bfr*)(p.ws + OFF_RC) + (size_t)r * 1024;
      orow = p.out + ((size_t)(b * NLAT + pp)) * 1024; }
    else { b = r / NLAT; pp = 0; mr = b; orow = p.out + (size_t)r * 1024; xin = orow; Y = (const bfr*)(p.ws + OFF_RB) + (size_t)r * 1024; }
    const float* g = mod + (LAYER * 5 + mr) * 3072 + 2048;
    float v[16]; float s = 0.f;
#pragma unroll
    for (int i = 0; i < 4; ++i) { const int c = i * 256 + lane * 4;
      const float4 xv = *(const float4*)(xin + c), gv = *(const float4*)(g + c); const uint2 yv = *(const uint2*)(Y + c);
      v[i * 4 + 0] = ALPHA * xv.x + gv.x * __uint_as_float(yv.x << 16); v[i * 4 + 1] = ALPHA * xv.y + gv.y * __uint_as_float(yv.x & 0xffff0000u);
      v[i * 4 + 2] = ALPHA * xv.z + gv.z * __uint_as_float(yv.y << 16); v[i * 4 + 3] = ALPHA * xv.w + gv.w * __uint_as_float(yv.y & 0xffff0000u);
      s += v[i * 4] + v[i * 4 + 1] + v[i * 4 + 2] + v[i * 4 + 3]; }
    for (int o = 32; o; o >>= 1) s += __shfl_xor(s, o);
    const float mu = s * (1.f / 1024.f); float q = 0.f;
#pragma unroll
    for (int i = 0; i < 16; ++i) { const float d = v[i] - mu; q += d * d; }
    for (int o = 32; o; o >>= 1) q += __shfl_xor(q, o);
    const float rs = rsqrtf(q * (1.f / 1024.f) + 1e-6f);
    const float* sh1 = mod + (5 + mr) * 3072; const float* sc1 = sh1 + 1024;
#pragma unroll
    for (int i = 0; i < 4; ++i) { const int c = i * 256 + lane * 4;
      const float4 gg = *(const float4*)(lng + c), bb = *(const float4*)(lnb + c);
      float4 y; y.x = (v[i * 4] - mu) * rs * gg.x + bb.x; y.y = (v[i * 4 + 1] - mu) * rs * gg.y + bb.y;
      y.z = (v[i * 4 + 2] - mu) * rs * gg.z + bb.z; y.w = (v[i * 4 + 3] - mu) * rs * gg.w + bb.w;
      if (LAYER == 1 || pp < NLAT) *(float4*)(orow + c) = y;
      if (LAYER == 0) { const float4 s1 = *(const float4*)(sh1 + c), c1 = *(const float4*)(sc1 + c);
        uint2 o; o.x = cvtpk(y.x * (1.f + c1.x) + s1.x, y.y * (1.f + c1.y) + s1.y); o.y = cvtpk(y.z * (1.f + c1.z) + s1.z, y.w * (1.f + c1.w) + s1.w);
        *(uint2*)((bfr*)(p.ws + OFF_RA) + (size_t)r * 1024 + c) = o; } }
  }
}


constexpr size_t OFF_BAR = 131072;
#define XB_TMO      128
#define XB_XCNT(j)  (256  + 64 * (j))
#define XB_XSUB(j)  (1280 + 64 * (j))
#define XB_XGEN(j)  (2304 + 64 * (j))
#define XB_TOP      3328
#define XB_TOPGEN   3392
#define XCD_BAR_WORDS 3456
#define XB_SPIN_CAP (1u << 22)
#define LAS __attribute__((address_space(3)))
__device__ __forceinline__ unsigned xb_ld(unsigned* p)              { return __hip_atomic_load(p, __ATOMIC_RELAXED, __HIP_MEMORY_SCOPE_AGENT); }
__device__ __forceinline__ unsigned xb_add(unsigned* p, unsigned v) { return __hip_atomic_fetch_add(p, v, __ATOMIC_RELAXED, __HIP_MEMORY_SCOPE_AGENT); }
__device__ __forceinline__ unsigned xb_xcc_id() { return (unsigned)__builtin_amdgcn_s_getreg((3 << 11) | 20) & 0xFu; }
#define XB_SPIN(cond, bar) do { unsigned _sp = 0; while (cond) { __builtin_amdgcn_s_sleep(1); \
    if ((++_sp & 255u) == 0u) { if (xb_ld(&(bar)[XB_TMO])) break; if (_sp > XB_SPIN_CAP) { atomicAdd(&(bar)[XB_TMO], 1u); break; } } } } while (0)
struct XcdBarrier { unsigned* bar; unsigned x; volatile LAS unsigned* st; };
__device__ __forceinline__ XcdBarrier xcd_barrier_post(unsigned* bar, volatile LAS unsigned* st) {
  XcdBarrier b; b.bar = bar; b.x = xb_xcc_id(); b.st = st;
  if (threadIdx.x == 0) (void)xb_add(&bar[XB_XCNT(b.x)], 1u);
  return b;
}
__device__ __forceinline__ void xcd_barrier_complete(unsigned* bar, unsigned x, unsigned& nloc, unsigned& nx) {
  const unsigned G = gridDim.x * gridDim.y * gridDim.z;
  unsigned sum, cnt, mine, sp = 0u;
  for (;;) {
    sum = 0u; cnt = 0u; mine = 0u;
#pragma unroll
    for (unsigned j = 0; j < 16; ++j) { const unsigned c = xb_ld(&bar[XB_XCNT(j)]); sum += c; cnt += (c > 0u) ? 1u : 0u; mine = (j == x) ? c : mine; }
    if (sum == G) break;
    __builtin_amdgcn_s_sleep(1);
    if ((++sp & 255u) == 0u) { if (xb_ld(&bar[XB_TMO])) break; if (sp > XB_SPIN_CAP) { atomicAdd(&bar[XB_TMO], 1u); break; } }
  }
  nloc = mine > 0u ? mine : 1u; nx = cnt > 0u ? cnt : 1u;
}
__device__ __forceinline__ void xcd_barrier(const XcdBarrier& b) {
  asm volatile("s_waitcnt vmcnt(0)" ::: "memory");
  __syncthreads();
  if (threadIdx.x == 0) {
    unsigned* bar = b.bar;
    __builtin_amdgcn_s_waitcnt(0);
    unsigned nloc = b.st[0], nx = b.st[1];
    if (nloc == 0u) { xcd_barrier_complete(bar, b.x, nloc, nx); b.st[0] = nloc; b.st[1] = nx; }
    const unsigned old = xb_add(&bar[XB_XSUB(b.x)], 1u);
    const unsigned gen = old / nloc;
    if (old + 1u == (gen + 1u) * nloc) {
      __builtin_amdgcn_fence(__ATOMIC_RELEASE, "agent");
      asm volatile("s_waitcnt vmcnt(0)" ::: "memory");
      const unsigned og = xb_add(&bar[XB_TOP], 1u);
      const unsigned tg = og / nx;
      if (og + 1u == (tg + 1u) * nx) xb_add(&bar[XB_TOPGEN], 1u);
      else XB_SPIN(xb_ld(&bar[XB_TOPGEN]) == tg, bar);
      __builtin_amdgcn_fence(__ATOMIC_ACQUIRE, "agent");
      xb_add(&bar[XB_XGEN(b.x)], 1u);
      asm volatile("s_waitcnt vmcnt(0)" ::: "memory");
    } else {
      XB_SPIN(xb_ld(&bar[XB_XGEN(b.x)]) == gen, bar);
      __builtin_amdgcn_fence(__ATOMIC_ACQUIRE, "agent");
      asm volatile("s_waitcnt vmcnt(0)" ::: "memory");
    }
  }
  __syncthreads();
}

namespace cg = cooperative_groups;
extern __shared__ __attribute__((aligned(16))) char dyn_smem[];
constexpr size_t SMEM_TOTAL = SMEM_BYTES + 1024 + 16;
__global__ __launch_bounds__(512, 2) void fwd_megakernel(Params p) {
  cg::grid_group grid = cg::this_grid();
  const int bid = blockIdx.x, nb = gridDim.x;
  char* smem = dyn_smem; char* ws = p.ws;
  volatile LAS unsigned* xst = (volatile LAS unsigned*)(smem + SMEM_BYTES + 1024);
  if (threadIdx.x == 0) { xst[0] = 0u; xst[1] = 0u; }
  __syncthreads();
  const XcdBarrier xb = xcd_barrier_post((unsigned*)(ws + OFF_BAR), xst);
  mod_phase(p, smem, bid, nb);
  prep_phase(p, smem, (bid + nb - 96) % nb, nb);
  grid.sync();
  modulate_phase(p, bid, nb);
  xcd_barrier(xb);
  { FEpiZ e{}; e.Zc = (bfr*)(ws + OFF_RE); e.DQ = (bfr*)(ws + OFF_RC); e.DK = e.DQ + (size_t)RTOT * 512; e.DV = e.DQ + (size_t)RTOT * 1024;
    e.SG0 = (bfr*)(ws + OFF_RB); e.KA = (bfr*)(ws + OFF_RD) + (size_t)RTOT * 768; e.ropeD = (const float2*)(ws + OFF_ROPED); e.ropeA = (const float2*)(ws + OFF_ROPEA);
    gemm_phase((const bfr*)(ws + OFF_RA), 1024, (const bfr*)(ws + OFF_WIN0), 1024, 1024, 132, 26, e, smem, bid, nb); }
  xcd_barrier(xb);
  upproj_phase(p, smem, bid, nb);
  xcd_barrier(xb);
  attn_phase(p, smem, bid, nb);
  xcd_barrier(xb);
  { FEpiStore e{}; e.C = (bfr*)(ws + OFF_RC); e.ldc = 1024;
    gemm_phase((const bfr*)(ws + OFF_RA), 1024, (const bfr*)(ws + OFF_WOUT0), 1024, 1024, 132, 8, e, smem, bid, nb); }
  xcd_barrier(xb);
  ln_phase<0>(p, bid, nb);
  xcd_barrier(xb);
  { FEpiUG e{}; e.U = (bfr*)(ws + OFF_RD); e.SG1 = e.U + (size_t)RTOT * 1024;
    gemm_phase((const bfr*)(ws + OFF_RA), 1024, (const bfr*)(ws + OFF_WIN1), 1024, 1024, 132, 16, e, smem, bid, nb); }
  xcd_barrier(xb);
  scan_phase<0>(p, smem, bid, nb);
  xcd_barrier(xb);
  carry_phase(p, bid, nb);
  xcd_barrier(xb);
  scan_phase<1>(p, smem, bid, nb);
  xcd_barrier(xb);
  { FEpiStore e{}; e.C = (bfr*)(ws + OFF_RB); e.ldc = 1024;
    gemm_phase((const bfr*)(ws + OFF_RA), 1024, (const bfr*)(ws + OFF_WOUT1), 1024, 1024, 128, 8, e, smem, bid, nb); }
  xcd_barrier(xb);
  ln_phase<1>(p, bid, nb);
}

extern "C" void kernel_launch(void* const* d_in, const int* in_sizes, int n_in, void* d_out, int out_size, void* d_ws, size_t ws_size, hipStream_t stream) {
  Params P{};
  { const float** pp = (const float**)&P; for (int i = 0; i < 28; ++i) pp[i] = (const float*)d_in[i]; }
  P.out = (float*)d_out; P.ws = (char*)d_ws;
  if (ws_size < WS_END || n_in < 28) return;
  static int grid_blocks = 0;
  if (!grid_blocks) {
    (void)hipFuncSetAttribute((const void*)fwd_megakernel, hipFuncAttributeMaxDynamicSharedMemorySize, (int)SMEM_TOTAL);
    int dev = 0, cus = 0, per_cu = 0;
    (void)hipGetDevice(&dev);
    (void)hipDeviceGetAttribute(&cus, hipDeviceAttributeMultiprocessorCount, dev);
    (void)hipOccupancyMaxActiveBlocksPerMultiprocessor(&per_cu, (const void*)fwd_megakernel, NTHR, SMEM_TOTAL);
    if (per_cu > 1) per_cu = 1;
    grid_blocks = cus * per_cu;
    if (grid_blocks <= 0) grid_blocks = 256;
  }
  (void)hipMemsetAsync((char*)d_ws + OFF_BAR, 0, XCD_BAR_WORDS * 4, stream);
  void* args[] = {&P};
  (void)hipLaunchCooperativeKernel((const void*)fwd_megakernel, dim3(grid_blocks), dim3(NTHR), args, SMEM_TOTAL, stream);
}
```

```cpp
#include <hip/hip_runtime.h>
#include <hip/hip_bf16.h>
#include <hip/hip_cooperative_groups.h>
#include <stdint.h>

typedef unsigned short bfr;

constexpr int B_ = 4, NLAT = 8192, NCTX = 256, SEQA = NLAT + NCTX, RTOT = B_ * SEQA, DM = 1024;
constexpr float ALPHA = 1.4142135623730951f;
constexpr float LOG2E = 1.4426950408889634f;
constexpr float QSC_A = 0.10206207261596577f * LOG2E;
constexpr float QSC_D = 0.125f * LOG2E;

constexpr size_t SZ1024 = (size_t)RTOT * 1024 * 2;
constexpr size_t SZ512  = (size_t)RTOT * 512 * 2;
constexpr size_t SZ768  = (size_t)RTOT * 768 * 2;
constexpr size_t OFF_MOD = 0;
constexpr size_t OFF_LAM = 122880;
constexpr size_t OFF_RA = (size_t)24 << 20;
constexpr size_t OFF_RB = OFF_RA + SZ1024;
constexpr size_t OFF_RC = OFF_RB + SZ1024;
constexpr size_t OFF_RE = OFF_RC + 3 * SZ512;
constexpr size_t OFF_RD = OFF_RE + SZ1024;
constexpr size_t WS_END = OFF_RD + 2 * SZ1024;

__device__ __forceinline__ float bf2f(bfr h) { return __uint_as_float(((unsigned)h) << 16); }
__device__ __forceinline__ bfr f2bf(float f) { unsigned u = __float_as_uint(f); u += 0x7fffu + ((u >> 16) & 1u); return (bfr)(u >> 16); }
__device__ __forceinline__ float silu_f(float x) { return x / (1.f + expf(-x)); }
__device__ __forceinline__ float sigmoid_f(float x) { return 1.f / (1.f + expf(-x)); }
__device__ __forceinline__ const float* xrow(const float* x, const float* ctx, int r) {
  int b = r / SEQA, p = r - b * SEQA;
  return p < NLAT ? x + ((size_t)(b * NLAT + p)) * DM : ctx + ((size_t)(b * NCTX + (p - NLAT))) * DM;
}
__device__ __forceinline__ int modrow(int r) { int b = r / SEQA, p = r - b * SEQA; return p < NLAT ? b : 4; }

__device__ __forceinline__ void unpack8(uint4 u, float* f) {
  f[0] = __uint_as_float(u.x << 16); f[1] = __uint_as_float(u.x & 0xffff0000u);
  f[2] = __uint_as_float(u.y << 16); f[3] = __uint_as_float(u.y & 0xffff0000u);
  f[4] = __uint_as_float(u.z << 16); f[5] = __uint_as_float(u.z & 0xffff0000u);
  f[6] = __uint_as_float(u.w << 16); f[7] = __uint_as_float(u.w & 0xffff0000u);
}
using bf16x8 = __attribute__((ext_vector_type(8))) short;
using s16x4  = __attribute__((ext_vector_type(4))) short;
using f32x16 = __attribute__((ext_vector_type(16))) float;
using u32x4  = __attribute__((ext_vector_type(4))) unsigned;
constexpr int NTHR = 512;
constexpr size_t OFF_ROPED = (size_t)1 << 20;
constexpr size_t OFF_ROPEA = (size_t)3 << 20;
constexpr size_t OFF_WT    = (size_t)4 << 20;
constexpr size_t OFF_WIN0  = OFF_WT;
constexpr size_t OFF_WUQ   = OFF_WIN0 + (size_t)3328 * 1024 * 2;
constexpr size_t OFF_WUKV  = OFF_WUQ + (size_t)768 * 384 * 2;
constexpr size_t OFF_WOUT0 = OFF_WUKV + (size_t)1024 * 256 * 2;
constexpr size_t OFF_WIN1  = OFF_WOUT0 + (size_t)1024 * 1024 * 2;
constexpr size_t OFF_WG    = OFF_WIN1 + (size_t)2048 * 1024 * 2;
constexpr size_t OFF_WOUT1 = OFF_WG + (size_t)32 * 128 * 128 * 2;
static_assert(OFF_WOUT1 + (size_t)1024 * 1024 * 2 <= OFF_RA, "weights overflow");
constexpr size_t SMEM_BYTES = 2 * (256 * 72 + 128 * 72) * 2;

__device__ __forceinline__ int otid() { int t = threadIdx.x; asm volatile("" : "+v"(t)); return t; }
__device__ __forceinline__ int crow(int r, int hi) { return (r & 3) + 8 * (r >> 2) + 4 * hi; }

struct Params {
  const float *x, *c, *ctx, *c_ctx, *ada_w, *ada_b, *ln_g, *ln_b, *e_w_in, *e_qg, *e_w_uq, *e_kvg, *e_w_ukv, *lq1, *lk1, *lq2, *lk2, *subg, *e_w_out,
      *o_w_in, *conv_w, *conv_b, *ga_w, *ga_b, *gx_w, *gx_b, *lru_l, *o_w_out;
  float* out; char* ws;
};

template <int MODE>
__device__ __forceinline__ void wt_convert(const float* __restrict__ src, int K, int ldsrc, int Nd, bfr* __restrict__ dst, const float* __restrict__ kscale,
                           float* lds, int bid, int nb) {
  const int tid = otid(), tk = K >> 6, tn = Nd >> 6;
  for (int t = bid; t < tk * tn; t += nb) {
    const int k0 = (t % tk) << 6, n0 = (t / tk) << 6;
    for (int e = tid; e < 4096; e += NTHR) { int i = e >> 6, j = e & 63; int nd = n0 + j; float v;
      if (MODE == 1) { int ns = nd < 640 ? nd : (nd < 3200 ? nd + 32 : nd - 3200 + 640); v = nd < 3232 ? src[(size_t)(k0 + i) * ldsrc + ns] : 0.f; }
      else v = src[(size_t)(k0 + i) * ldsrc + nd];
      if (kscale) v *= kscale[k0 + i];
      lds[j * 65 + i] = v; }
    __syncthreads();
    for (int e = tid; e < 4096; e += NTHR) { int j = e >> 6, i = e & 63; dst[(size_t)(n0 + j) * K + k0 + i] = f2bf(lds[j * 65 + i]); }
    __syncthreads();
  }
}
__device__ __forceinline__ void prep_phase(const Params& p, char* smem, int bid, int nb) {
  float* lds = (float*)smem; char* ws = p.ws;
  wt_convert<1>(p.e_w_in, 1024, 3232, 3328, (bfr*)(ws + OFF_WIN0), nullptr, lds, bid, nb);
  wt_convert<0>(p.e_w_uq, 384, 768, 768, (bfr*)(ws + OFF_WUQ), p.e_qg, lds, bid, nb);
  wt_convert<0>(p.e_w_ukv, 256, 1024, 1024, (bfr*)(ws + OFF_WUKV), p.e_kvg, lds, bid, nb);
  wt_convert<0>(p.e_w_out, 1024, 1024, 1024, (bfr*)(ws + OFF_WOUT0), nullptr, lds, bid, nb);
  wt_convert<0>(p.o_w_in, 1024, 2048, 2048, (bfr*)(ws + OFF_WIN1), nullptr, lds, bid, nb);
  wt_convert<0>(p.o_w_out, 1024, 1024, 1024, (bfr*)(ws + OFF_WOUT1), nullptr, lds, bid, nb);
  for (int m = 0; m < 32; ++m) {
    int dir = m >> 4, gate = (m >> 3) & 1, blk = m & 7;
    const float* src = (gate ? p.gx_w : p.ga_w) + ((size_t)dir * 8 + blk) * 128 * 128;
    wt_convert<0>(src, 128, 128, 128, (bfr*)(ws + OFF_WG) + (size_t)m * 128 * 128, nullptr, lds, bid, nb);
  }
  float2* rd = (float2*)(ws + OFF_ROPED); float2* ra = (float2*)(ws + OFF_ROPEA);
  for (int e = bid * NTHR + otid(); e < 8192 * 32; e += nb * NTHR) { int pos = e >> 5, i = e & 31;
    float pp = (i < 16) ? (float)(pos >> 6) : (float)(pos & 63); float fr = powf(10000.f, -(float)(i & 15) / 16.f);
    float sn, cs; sincosf(pp * fr, &sn, &cs); rd[e] = make_float2(cs, sn); }
  for (int e = bid * NTHR + otid(); e < 8192 * 16; e += nb * NTHR) { int pos = e >> 4, i = e & 15;
    float pp = (i < 8) ? (float)(pos >> 6) : (float)(pos & 63); float fr = powf(10000.f, -(float)(i & 7) / 8.f);
    float sn, cs; sincosf(pp * fr, &sn, &cs); ra[e] = make_float2(cs, sn); }
}

template <class Epi>
__device__ __forceinline__ void gemm_tile(const bfr* __restrict__ A, int lda, const bfr* __restrict__ Bt, int ldb, int K, int m0, int n0, Epi& epi, char* smem) {
  const int tid = otid(), wid = tid >> 6, lane = tid & 63, wm = wid >> 1, wn = wid & 1, r32 = lane & 31, hi = lane >> 5;
  bfr* sa = (bfr*)smem; bfr* sb = sa + 2 * 256 * 72;
  f32x16 acc[2][2];
#pragma unroll
  for (int i = 0; i < 2; ++i)
#pragma unroll
    for (int j = 0; j < 2; ++j)
#pragma unroll
      for (int r = 0; r < 16; ++r) acc[i][j][r] = 0.f;
  uint4 ra0, ra1, ra2, ra3, rb0, rb1;
  const int lrow = tid >> 3, lck = (tid & 7) * 8;
  const bfr* Ap = A + (size_t)(m0 + lrow) * lda + lck;
  const bfr* Bp = Bt + (size_t)(n0 + lrow) * ldb + lck;
  const size_t a64 = (size_t)64 * lda, b64 = (size_t)64 * ldb;
  const int nk = K >> 6;
  bfr* swa = sa + lrow * 72 + lck; bfr* swb = sb + lrow * 72 + lck;
#define GLOAD(kt) do { const bfr* ap_ = Ap + (kt) * 64; const bfr* bp_ = Bp + (kt) * 64; \
    ra0 = *(const uint4*)(ap_); ra1 = *(const uint4*)(ap_ + a64); ra2 = *(const uint4*)(ap_ + 2 * a64); ra3 = *(const uint4*)(ap_ + 3 * a64); \
    rb0 = *(const uint4*)(bp_); rb1 = *(const uint4*)(bp_ + b64); } while (0)
#define SWRITE(buf) do { bfr* wa_ = swa + (buf) * 256 * 72; bfr* wb_ = swb + (buf) * 128 * 72; \
    *(uint4*)(wa_) = ra0; *(uint4*)(wa_ + 64 * 72) = ra1; *(uint4*)(wa_ + 128 * 72) = ra2; *(uint4*)(wa_ + 192 * 72) = ra3; \
    *(uint4*)(wb_) = rb0; *(uint4*)(wb_ + 64 * 72) = rb1; } while (0)
  GLOAD(0); SWRITE(0); __syncthreads();
  for (int kt = 0; kt < nk; ++kt) {
    const int cur = kt & 1;
    if (kt + 1 < nk) GLOAD(kt + 1);
    const bfr* pa = sa + cur * 256 * 72 + (wm * 64 + r32) * 72 + hi * 8;
    const bfr* pb = sb + cur * 128 * 72 + (wn * 64 + r32) * 72 + hi * 8;
#pragma unroll
    for (int ks = 0; ks < 4; ++ks) {
      bf16x8 a0 = *(const bf16x8*)(pa + ks * 16), a1 = *(const bf16x8*)(pa + 32 * 72 + ks * 16);
      bf16x8 b0 = *(const bf16x8*)(pb + ks * 16), b1 = *(const bf16x8*)(pb + 32 * 72 + ks * 16);
      acc[0][0] = __builtin_amdgcn_mfma_f32_32x32x16_bf16(a0, b0, acc[0][0], 0, 0, 0);
      acc[0][1] = __builtin_amdgcn_mfma_f32_32x32x16_bf16(a0, b1, acc[0][1], 0, 0, 0);
      acc[1][0] = __builtin_amdgcn_mfma_f32_32x32x16_bf16(a1, b0, acc[1][0], 0, 0, 0);
      acc[1][1] = __builtin_amdgcn_mfma_f32_32x32x16_bf16(a1, b1, acc[1][1], 0, 0, 0);
    }
    if (kt + 1 < nk) SWRITE(cur ^ 1);
    __syncthreads();
  }
#undef GLOAD
#undef SWRITE
  epi(m0 + wm * 64, n0 + wn * 64, acc, r32, hi);
}
template <class Epi>
__device__ __forceinline__ void gemm_phase(const bfr* A, int lda, const bfr* Bt, int ldb, int K, int mtiles, int ntiles, Epi& epi, char* smem, int bid, int nb) {
  for (int t = bid; t < mtiles * ntiles; t += nb) { int mt = t / ntiles, nt = t - mt * ntiles; gemm_tile(A, lda, Bt, ldb, K, mt * 256, nt * 128, epi, smem); }
}
struct FEpiStore { bfr* C; int ldc;
  __device__ __forceinline__ void operator()(int m0, int n0, f32x16 (&acc)[2][2], int r32, int hi) {
#pragma unroll
    for (int mt = 0; mt < 2; ++mt)
#pragma unroll
      for (int nt = 0; nt < 2; ++nt)
#pragma unroll
        for (int r = 0; r < 16; ++r) C[(size_t)(m0 + mt * 32 + crow(r, hi)) * ldc + n0 + nt * 32 + r32] = f2bf(acc[mt][nt][r]);
  } };
struct FEpiUG { bfr *U, *SG1;
  __device__ __forceinline__ void operator()(int m0, int n0, f32x16 (&acc)[2][2], int r32, int hi) {
    const bool g = n0 >= 1024; bfr* C = g ? SG1 : U; const int nn = g ? n0 - 1024 : n0;
#pragma unroll
    for (int mt = 0; mt < 2; ++mt)
#pragma unroll
      for (int nt = 0; nt < 2; ++nt)
#pragma unroll
        for (int r = 0; r < 16; ++r) { float v = acc[mt][nt][r]; if (g) v = silu_f(v);
          C[(size_t)(m0 + mt * 32 + crow(r, hi)) * 1024 + nn + nt * 32 + r32] = f2bf(v); }
  } };
struct FEpiZ { bfr *Zc, *DQ, *DK, *DV, *SG0, *KA; const float2 *ropeD, *ropeA;
  __device__ __forceinline__ void operator()(int m0, int n0, f32x16 (&acc)[2][2], int r32, int hi) {
    const int p0 = m0 % SEQA; const bool lat = p0 < NLAT;
    if (n0 < 640) {
#pragma unroll
      for (int mt = 0; mt < 2; ++mt)
#pragma unroll
        for (int nt = 0; nt < 2; ++nt)
#pragma unroll
          for (int r = 0; r < 16; ++r) Zc[(size_t)(m0 + mt * 32 + crow(r, hi)) * 640 + n0 + nt * 32 + r32] = f2bf(acc[mt][nt][r]);
    } else if (n0 < 1664) {
      const bool isq = n0 < 1152; bfr* C = isq ? DQ : DK; const int nn = isq ? n0 - 640 : n0 - 1152; const float sc = isq ? QSC_D : 1.f;
#pragma unroll
      for (int mt = 0; mt < 2; ++mt)
#pragma unroll
        for (int r = 0; r < 16; ++r) { const int rr = mt * 32 + crow(r, hi);
          float cs = 1.f, sn = 0.f; if (lat) { float2 t = ropeD[(p0 + rr) * 32 + r32]; cs = t.x; sn = t.y; }
          float x1 = acc[mt][0][r], x2 = acc[mt][1][r];
          bfr* d = C + (size_t)(m0 + rr) * 512 + nn + r32;
          d[0] = f2bf((x1 * cs - x2 * sn) * sc); d[32] = f2bf((x2 * cs + x1 * sn) * sc); }
    } else if (n0 < 2176) {
#pragma unroll
      for (int mt = 0; mt < 2; ++mt)
#pragma unroll
        for (int nt = 0; nt < 2; ++nt)
#pragma unroll
          for (int r = 0; r < 16; ++r) DV[(size_t)(m0 + mt * 32 + crow(r, hi)) * 512 + n0 - 1664 + nt * 32 + r32] = f2bf(acc[mt][nt][r]);
    } else if (n0 < 3200) {
#pragma unroll
      for (int mt = 0; mt < 2; ++mt)
#pragma unroll
        for (int nt = 0; nt < 2; ++nt)
#pragma unroll
          for (int r = 0; r < 16; ++r) SG0[(size_t)(m0 + mt * 32 + crow(r, hi)) * 1024 + n0 - 2176 + nt * 32 + r32] = f2bf(silu_f(acc[mt][nt][r]));
    } else if (n0 == 3200) {
#pragma unroll
      for (int mt = 0; mt < 2; ++mt)
#pragma unroll
        for (int r = 0; r < 16; ++r) { const int rr = mt * 32 + crow(r, hi);
          float cs = 1.f, sn = 0.f; if (lat) { float2 t = ropeA[(p0 + rr) * 16 + (r32 & 15)]; cs = t.x; sn = t.y; }
          float xv = acc[mt][0][r]; float pv = __shfl_xor(xv, 16);
          float o = (r32 < 16) ? (xv * cs - pv * sn) : (xv * cs + pv * sn);
          bfr ob = f2bf(o); bfr* d = KA + (size_t)(m0 + rr) * 768 + 64 + r32;
#pragma unroll
          for (int h = 0; h < 8; ++h) d[h * 96] = ob; }
    }
  } };
struct FEpiQ { bfr* QA; const float2* ropeA; const float* rfac;
  __device__ __forceinline__ void operator()(int m0, int n0, f32x16 (&acc)[2][2], int r32, int hi) {
    const int p0 = m0 % SEQA; const bool lat = p0 < NLAT; const int mloc = m0 & 255;
#pragma unroll
    for (int nt = 0; nt < 2; ++nt) { const int s32 = (n0 >> 5) + nt; const bool rope = (s32 % 3) == 2;
#pragma unroll
      for (int mt = 0; mt < 2; ++mt)
#pragma unroll
        for (int r = 0; r < 16; ++r) { const int rr = mt * 32 + crow(r, hi);
          float v = acc[mt][nt][r] * rfac[mloc + rr];
          if (rope) { float cs = 1.f, sn = 0.f; if (lat) { float2 t = ropeA[(p0 + rr) * 16 + (r32 & 15)]; cs = t.x; sn = t.y; }
            float pv = __shfl_xor(v, 16); v = (r32 < 16) ? (v * cs - pv * sn) : (v * cs + pv * sn); }
          QA[(size_t)(m0 + rr) * 768 + s32 * 32 + r32] = f2bf(v * QSC_A); } }
  } };
struct FEpiKV { bfr *KA, *VA; const float* rfac;
  __device__ __forceinline__ void operator()(int m0, int n0, f32x16 (&acc)[2][2], int r32, int hi) {
    const int mloc = m0 & 255;
#pragma unroll
    for (int nt = 0; nt < 2; ++nt) { const int s32 = (n0 >> 5) + nt, h = s32 >> 2, part = s32 & 3;
      bfr* C = part < 2 ? KA + h * 96 + part * 32 : VA + h * 64 + (part - 2) * 32; const int ldc = part < 2 ? 768 : 512;
#pragma unroll
      for (int mt = 0; mt < 2; ++mt)
#pragma unroll
        for (int r = 0; r < 16; ++r) { const int rr = mt * 32 + crow(r, hi);
          C[(size_t)(m0 + rr) * ldc + r32] = f2bf(acc[mt][nt][r] * rfac[mloc + rr]); } }
  } };
__device__ __forceinline__ void upproj_phase(const Params& p, char* smem, int bid, int nb) {
  char* ws = p.ws; const bfr* Zc = (const bfr*)(ws + OFF_RE);
  float* rfac = (float*)(smem + SMEM_BYTES);
  bfr* QA = (bfr*)(ws + OFF_RD); bfr* KA = QA + (size_t)RTOT * 768; bfr* VA = QA + (size_t)RTOT * 1536;
  FEpiQ eq; eq.QA = QA; eq.ropeA = (const float2*)(ws + OFF_ROPEA); eq.rfac = rfac;
  FEpiKV ek; ek.KA = KA; ek.VA = VA; ek.rfac = rfac;
  const int tid = otid();
  for (int t = bid; t < 132 * 14; t += nb) {
    const int mt = t / 14, j = t - mt * 14; const bool isq = j < 6; const int m0 = mt * 256;
    {
      const int row = tid >> 1, half = tid & 1; const int ncol = isq ? 192 : 128;
      const bfr* z = Zc + (size_t)(m0 + row) * 640 + (isq ? 0 : 384) + half * ncol;
      float ss = 0.f;
      for (int c = 0; c < ncol; c += 8) { uint4 u = *(const uint4*)(z + c); float f[8]; unpack8(u, f);
#pragma unroll
        for (int e = 0; e < 8; ++e) ss += f[e] * f[e]; }
      ss += __shfl_xor(ss, 1);
      if (half == 0) rfac[row] = rsqrtf(ss / (isq ? 384.f : 256.f) + 1e-6f);
    }
    __syncthreads();
    if (isq) gemm_tile(Zc, 640, (const bfr*)(ws + OFF_WUQ), 384, 384, m0, j * 128, eq, smem);
    else gemm_tile(Zc + 384, 640, (const bfr*)(ws + OFF_WUKV), 256, 256, m0, (j - 6) * 128, ek, smem);
    __syncthreads();
  }
}


constexpr int SHM_KV = 64 * 256;
constexpr float THR2 = 11.5f;
#define KSWZ(row, colB) ((row) * 256 + ((colB) ^ (((row) & 7) << 4)))
#define SBAR() __builtin_amdgcn_sched_barrier(0)
__device__ __forceinline__ unsigned cvtpk(float lo, float hi) { unsigned r; asm volatile("v_cvt_pk_bf16_f32 %0, %1, %2" : "=v"(r) : "v"(lo), "v"(hi)); return r; }
template <bool FIRST>
__device__ __forceinline__ void partialSM(f32x16& p0, f32x16& p1, float& m_ref, float& alpha) {
  float pmax = p0[0];
#pragma unroll
  for (int r = 1; r < 16; ++r) pmax = fmaxf(pmax, p0[r]);
#pragma unroll
  for (int r = 0; r < 16; ++r) pmax = fmaxf(pmax, p1[r]);
  { auto rr = __builtin_amdgcn_permlane32_swap(__float_as_uint(pmax), __float_as_uint(pmax), false, false);
    pmax = fmaxf(__uint_as_float(rr[0]), __uint_as_float(rr[1])); }
  if (!FIRST && __builtin_expect(__all(pmax <= THR2), 1)) { alpha = 1.f; }
  else {
    const float mn = bf2f(f2bf(m_ref + (FIRST ? pmax : fmaxf(pmax, 0.f))));
    const float delta = mn - m_ref;
    alpha = FIRST ? 0.f : __builtin_amdgcn_exp2f(-delta);
    m_ref = mn;
#pragma unroll
    for (int r = 0; r < 16; ++r) p0[r] = p0[r] - delta;
#pragma unroll
    for (int r = 0; r < 16; ++r) p1[r] = p1[r] - delta;
  }
#pragma unroll
  for (int r = 0; r < 16; ++r) p0[r] = __builtin_amdgcn_exp2f(p0[r]);
}
__device__ __forceinline__ void finishSM(f32x16& p0, f32x16& p1, float alpha, float& l_reg, bf16x8& pa0, bf16x8& pa1, bf16x8& pa2, bf16x8& pa3) {
#pragma unroll
  for (int r = 0; r < 16; ++r) p1[r] = __builtin_amdgcn_exp2f(p1[r]);
  float ps = 0;
#pragma unroll
  for (int r = 0; r < 16; ++r) ps += p0[r];
#pragma unroll
  for (int r = 0; r < 16; ++r) ps += p1[r];
  { auto rr = __builtin_amdgcn_permlane32_swap(__float_as_uint(ps), __float_as_uint(ps), false, false);
    ps = __uint_as_float(rr[0]) + __uint_as_float(rr[1]); }
  l_reg = l_reg * alpha + ps;
#define PK8(P, BASE, OUT) do { u32x4 w = {cvtpk(P[BASE + 0], P[BASE + 1]), cvtpk(P[BASE + 2], P[BASE + 3]), cvtpk(P[BASE + 4], P[BASE + 5]), cvtpk(P[BASE + 6], P[BASE + 7])}; \
    OUT = *reinterpret_cast<bf16x8*>(&w); } while (0)
  PK8(p0, 0, pa0); PK8(p0, 8, pa1); PK8(p1, 0, pa2); PK8(p1, 8, pa3);
#undef PK8
}
template <int NKS>
__device__ __forceinline__ void qkt(f32x16& p0, f32x16& p1, const char* Ks, const bf16x8* qr, int r32, int hi, int qcolB, float m_ref) {
  { const unsigned one = hi ? 0u : 0x3F80u, nm = hi ? 0u : (unsigned)f2bf(-m_ref);
    u32x4 ka = {one, 0u, 0u, 0u}, qa = {nm, 0u, 0u, 0u};
    f32x16 z;
#pragma unroll
    for (int r = 0; r < 16; ++r) z[r] = 0.f;
    p0 = __builtin_amdgcn_mfma_f32_32x32x16_bf16(*reinterpret_cast<bf16x8*>(&ka), *reinterpret_cast<bf16x8*>(&qa), z, 0, 0, 0);
    p1 = __builtin_amdgcn_mfma_f32_32x32x16_bf16(*reinterpret_cast<bf16x8*>(&ka), *reinterpret_cast<bf16x8*>(&qa), z, 0, 0, 0); }
#pragma unroll
  for (int d0 = 0; d0 < NKS; ++d0) { int cb = qcolB + (d0 * 16 + hi * 8) * 2;
    bf16x8 b0 = *reinterpret_cast<const bf16x8*>(Ks + KSWZ(r32, cb));
    bf16x8 b1 = *reinterpret_cast<const bf16x8*>(Ks + KSWZ(32 + r32, cb));
    p0 = __builtin_amdgcn_mfma_f32_32x32x16_bf16(b0, qr[d0], p0, 0, 0, 0);
    p1 = __builtin_amdgcn_mfma_f32_32x32x16_bf16(b1, qr[d0], p1, 0, 0, 0); }
}
__device__ __forceinline__ int v_st(int k, int c) { const int kk = (k & ~0xC) | ((k & 4) << 1) | ((k & 8) >> 1); return ((kk >> 3) * 4 + (c >> 5)) * 512 + ((kk & 7) * 32 + (c & 31)) * 2; }
__device__ __forceinline__ int v_rd_base(int lane) { return ((lane & 3) << 3) | (((lane >> 2) & 3) << 6) | (((lane >> 4) & 1) << 5) | (((lane >> 5) & 1) << 11); }
constexpr int v_rd_off(int d0, int ks, int half) { return d0 * 512 + ks * 4096 + half * 256; }
template <int OFF> __device__ __forceinline__ s16x4 tr_read(int vb) {
  s16x4 r; asm volatile("ds_read_b64_tr_b16 %0, %1 offset:%2" : "=&v"(r) : "v"(vb), "i"(OFF) : "memory"); return r;
}
template <int D0> __device__ __forceinline__ void pv_one(f32x16& od, int vb, bf16x8 pa0, bf16x8 pa1, bf16x8 pa2, bf16x8 pa3) {
  const s16x4 l0 = tr_read<v_rd_off(D0, 0, 0)>(vb), h0 = tr_read<v_rd_off(D0, 0, 1)>(vb), l1 = tr_read<v_rd_off(D0, 1, 0)>(vb), h1 = tr_read<v_rd_off(D0, 1, 1)>(vb);
  const s16x4 l2 = tr_read<v_rd_off(D0, 2, 0)>(vb), h2 = tr_read<v_rd_off(D0, 2, 1)>(vb), l3 = tr_read<v_rd_off(D0, 3, 0)>(vb), h3 = tr_read<v_rd_off(D0, 3, 1)>(vb);
  asm volatile("s_waitcnt lgkmcnt(0)" ::: "memory"); SBAR();
#define PK(L, H) (bf16x8){L[0], L[1], L[2], L[3], H[0], H[1], H[2], H[3]}
  od = __builtin_amdgcn_mfma_f32_32x32x16_bf16(pa0, PK(l0, h0), od, 0, 0, 0);
  od = __builtin_amdgcn_mfma_f32_32x32x16_bf16(pa1, PK(l1, h1), od, 0, 0, 0);
  od = __builtin_amdgcn_mfma_f32_32x32x16_bf16(pa2, PK(l2, h2), od, 0, 0, 0);
  od = __builtin_amdgcn_mfma_f32_32x32x16_bf16(pa3, PK(l3, h3), od, 0, 0, 0);
#undef PK
}
template <int NVB> __device__ __forceinline__ void pv_all(f32x16* o, int vb, bf16x8 pa0, bf16x8 pa1, bf16x8 pa2, bf16x8 pa3) {
  pv_one<0>(o[0], vb, pa0, pa1, pa2, pa3); pv_one<1>(o[1], vb, pa0, pa1, pa2, pa3);
  if constexpr (NVB == 4) { pv_one<2>(o[2], vb, pa0, pa1, pa2, pa3); pv_one<3>(o[3], vb, pa0, pa1, pa2, pa3); }
}
template <int TYPE>
__device__ __forceinline__ void attn_item(const Params& p, char* lds, int h, int qrow0, int krow0, int NT, float lam) {
  constexpr int NKS = TYPE ? 4 : 6, NVB = TYPE ? 4 : 2;
  constexpr int LDQ = TYPE ? 512 : 768, LDK = TYPE ? 512 : 768, LDV = 512;
  constexpr int KCOLS = TYPE ? 128 : 96, VCOLS = TYPE ? 128 : 64;
  const int tid = otid(), wid = tid >> 6, lane = tid & 63, r32 = lane & 31, hi = lane >> 5;
  const int map = TYPE ? (wid >> 2) : 0, wq = TYPE ? (wid & 3) : wid;
  char* ws = p.ws;
  const bfr* Qb = TYPE ? (const bfr*)(ws + OFF_RC) + (size_t)(qrow0 + wq * 32 + r32) * 512 + h * 128 + map * 64 + hi * 8
                       : (const bfr*)(ws + OFF_RD) + (size_t)(qrow0 + wq * 32 + r32) * 768 + h * 96 + hi * 8;
  const bfr* Kh = TYPE ? (const bfr*)(ws + OFF_RC) + (size_t)RTOT * 512 + (size_t)krow0 * 512 + h * 128
                       : (const bfr*)(ws + OFF_RD) + (size_t)RTOT * 768 + (size_t)krow0 * 768 + h * 96;
  const bfr* Vh = TYPE ? (const bfr*)(ws + OFF_RC) + (size_t)RTOT * 1024 + (size_t)krow0 * 512 + h * 128
                       : (const bfr*)(ws + OFF_RD) + (size_t)RTOT * 1536 + (size_t)krow0 * 512 + h * 64;
  const bfr* SG0 = (const bfr*)(ws + OFF_RB); bfr* OG = (bfr*)(ws + OFF_RA);
  const int qcolB = map * 128;
  char* V_lds = lds; char* K_lds = lds + 2 * SHM_KV;
  float* wsc = (float*)(lds + 4 * SHM_KV) + wid * 64; float* li_l = wsc; float* al_l = wsc + 32;
  float m_ref = 0.f, l_reg = 0.f; f32x16 o[NVB]; bf16x8 qr[NKS];
#pragma unroll
  for (int d = 0; d < NVB; ++d)
#pragma unroll
    for (int r = 0; r < 16; ++r) o[d][r] = 0.f;
#pragma unroll
  for (int d0 = 0; d0 < NKS; ++d0) qr[d0] = *reinterpret_cast<const bf16x8*>(Qb + d0 * 16);
  const int sr = tid >> 4, sc = (tid & 15) * 8, vst0 = v_st(sr, sc), vst1 = v_st(32 + sr, sc);
  const bool kval = sc < KCOLS, vval = sc < VCOLS;
  const int vb0 = (int)(uintptr_t)V_lds + v_rd_base(lane);
  bf16x8 e_vs0, e_vs1, e_ks0, e_ks1, o_vs0, o_vs1, o_ks0, o_ks1;
#define LD8(ptr) (*reinterpret_cast<const bf16x8*>(ptr))
#define SLOAD_E(k0) do { if (vval) { e_vs0 = LD8(&Vh[(size_t)((k0) + sr) * LDV + sc]); e_vs1 = LD8(&Vh[(size_t)((k0) + 32 + sr) * LDV + sc]); } \
    if (kval) { e_ks0 = LD8(&Kh[(size_t)((k0) + sr) * LDK + sc]); e_ks1 = LD8(&Kh[(size_t)((k0) + 32 + sr) * LDK + sc]); } } while (0)
#define SLOAD_O(k0) do { if (vval) { o_vs0 = LD8(&Vh[(size_t)((k0) + sr) * LDV + sc]); o_vs1 = LD8(&Vh[(size_t)((k0) + 32 + sr) * LDV + sc]); } \
    if (kval) { o_ks0 = LD8(&Kh[(size_t)((k0) + sr) * LDK + sc]); o_ks1 = LD8(&Kh[(size_t)((k0) + 32 + sr) * LDK + sc]); } } while (0)
#define SWRITE_E(b) do { if (vval) { *(bf16x8*)(V_lds + (b) * SHM_KV + vst0) = e_vs0; *(bf16x8*)(V_lds + (b) * SHM_KV + vst1) = e_vs1; } \
    if (kval) { int kc = sc * 2; *(bf16x8*)(K_lds + (b) * SHM_KV + KSWZ(sr, kc)) = e_ks0; *(bf16x8*)(K_lds + (b) * SHM_KV + KSWZ(32 + sr, kc)) = e_ks1; } } while (0)
#define SWRITE_O(b) do { if (vval) { *(bf16x8*)(V_lds + (b) * SHM_KV + vst0) = o_vs0; *(bf16x8*)(V_lds + (b) * SHM_KV + vst1) = o_vs1; } \
    if (kval) { int kc = sc * 2; *(bf16x8*)(K_lds + (b) * SHM_KV + KSWZ(sr, kc)) = o_ks0; *(bf16x8*)(K_lds + (b) * SHM_KV + KSWZ(32 + sr, kc)) = o_ks1; } } while (0)
#define SWAIT() asm volatile("s_waitcnt vmcnt(4)" ::: "memory")
#define RESC(a) do { if (__any((a) < 1.f)) { if (hi == 0) al_l[r32] = (a); asm volatile("s_waitcnt lgkmcnt(0)" ::: "memory"); \
    _Pragma("unroll") for (int d = 0; d < NVB; ++d) _Pragma("unroll") for (int r = 0; r < 16; ++r) o[d][r] *= al_l[crow(r, hi)]; } } while (0)
  f32x16 pA0, pA1, pB0, pB1; float alA, alB; bf16x8 pa0, pa1, pa2, pa3;
  SLOAD_E(0); asm volatile("s_waitcnt vmcnt(0)" ::: "memory"); SWRITE_E(0); __syncthreads();
  qkt<NKS>(pA0, pA1, K_lds, qr, r32, hi, qcolB, m_ref); partialSM<true>(pA0, pA1, m_ref, alA);
  SLOAD_O(64); if (2 < NT) SLOAD_E(2 * 64);
  SWAIT(); SWRITE_O(1); __syncthreads();
  for (int j = 1; j + 1 < NT; j += 2) {
    SBAR(); qkt<NKS>(pB0, pB1, K_lds + SHM_KV, qr, r32, hi, qcolB, m_ref);
    finishSM(pA0, pA1, alA, l_reg, pa0, pa1, pa2, pa3); SBAR();
    SLOAD_O((j + 2) * 64); SBAR();
    pv_all<NVB>(o, vb0, pa0, pa1, pa2, pa3); partialSM<false>(pB0, pB1, m_ref, alB);
    __syncthreads(); SWAIT(); SWRITE_E(0);
    RESC(alB); __syncthreads();
    SBAR(); qkt<NKS>(pA0, pA1, K_lds, qr, r32, hi, qcolB, m_ref);
    finishSM(pB0, pB1, alB, l_reg, pa0, pa1, pa2, pa3); SBAR();
    if (j + 3 < NT) SLOAD_E((j + 3) * 64); SBAR();
    pv_all<NVB>(o, vb0 + SHM_KV, pa0, pa1, pa2, pa3); partialSM<false>(pA0, pA1, m_ref, alA);
    __syncthreads(); SWAIT(); SWRITE_O(1);
    RESC(alA); __syncthreads();
  }
  SBAR(); qkt<NKS>(pB0, pB1, K_lds + SHM_KV, qr, r32, hi, qcolB, m_ref);
  finishSM(pA0, pA1, alA, l_reg, pa0, pa1, pa2, pa3); SBAR();
  pv_all<NVB>(o, vb0, pa0, pa1, pa2, pa3); partialSM<false>(pB0, pB1, m_ref, alB);
  __syncthreads(); RESC(alB);
  finishSM(pB0, pB1, alB, l_reg, pa0, pa1, pa2, pa3); SBAR();
  pv_all<NVB>(o, vb0 + SHM_KV, pa0, pa1, pa2, pa3);
  if (hi == 0) li_l[r32] = l_reg; asm volatile("s_waitcnt lgkmcnt(0)" ::: "memory");
  float rli[16];
#pragma unroll
  for (int r = 0; r < 16; ++r) rli[r] = __builtin_amdgcn_rcpf(li_l[crow(r, hi)]);
  if constexpr (TYPE == 0) {
#pragma unroll
    for (int r = 0; r < 16; ++r) { const size_t row = (size_t)(qrow0 + wq * 32 + crow(r, hi)) * 1024;
#pragma unroll
      for (int d0 = 0; d0 < NVB; ++d0) { const size_t idx = row + h * 64 + d0 * 32 + r32; OG[idx] = f2bf(o[d0][r] * rli[r] * bf2f(SG0[idx])); } }
    __syncthreads();
  } else {
    float* xch = (float*)lds;
    __syncthreads();
    if (map == 1) {
#pragma unroll
      for (int r = 0; r < 16; ++r) { const float f = rli[r] * lam;
#pragma unroll
        for (int d0 = 0; d0 < 4; ++d0) xch[(wq * 32 + crow(r, hi)) * 128 + d0 * 32 + r32] = o[d0][r] * f; }
    }
    __syncthreads();
    if (map == 0) {
      const float* subg = p.subg;
#pragma unroll
      for (int r = 0; r < 16; ++r) { float ss = 0.f;
#pragma unroll
        for (int d0 = 0; d0 < 4; ++d0) { float v = o[d0][r] * rli[r] - xch[(wq * 32 + crow(r, hi)) * 128 + d0 * 32 + r32]; o[d0][r] = v; ss += v * v; }
        ss += __shfl_xor(ss, 16); ss += __shfl_xor(ss, 8); ss += __shfl_xor(ss, 4); ss += __shfl_xor(ss, 2); ss += __shfl_xor(ss, 1);
        const float rs = rsqrtf(ss * (1.f / 128.f) + 1e-6f) * 0.8f;
        const size_t row = (size_t)(qrow0 + wq * 32 + crow(r, hi)) * 1024;
#pragma unroll
        for (int d0 = 0; d0 < 4; ++d0) { const size_t idx = row + 512 + h * 128 + d0 * 32 + r32;
          OG[idx] = f2bf(o[d0][r] * rs * subg[d0 * 32 + r32] * bf2f(SG0[idx])); } }
    }
    __syncthreads();
  }
#undef LD8
#undef SLOAD_E
#undef SLOAD_O
#undef SWRITE_E
#undef SWRITE_O
#undef SWAIT
#undef RESC
}
__device__ __forceinline__ void attn_phase(const Params& p, char* smem, int bid, int nb) {
  const float lam = *(const float*)(p.ws + OFF_LAM);
  for (int it = bid; it < 2112; it += nb) {
    const int rd = it >> 8, j = it & 255;
    int type, h, qrow0, krow0, NT;
    if (rd < 4) { const int b = rd; type = 0; h = j & 7; qrow0 = b * SEQA + (j >> 3) * 256; krow0 = b * SEQA; NT = 132; }
    else if (rd < 8) { const int pair = (j & 7) + 8 * ((rd - 4) >> 1), b = pair >> 2, qt = 2 * (j >> 3) + ((rd - 4) & 1);
      type = 1; h = pair & 3; qrow0 = b * SEQA + qt * 128; krow0 = b * SEQA; NT = 132; }
    else if (j < 32) { const int b = j >> 3; type = 0; h = j & 7; qrow0 = b * SEQA + NLAT; krow0 = qrow0; NT = 4; }
    else if (j < 64) { const int pair = (j - 32) >> 1, b = pair >> 2, qt = (j - 32) & 1;
      type = 1; h = pair & 3; krow0 = b * SEQA + NLAT; qrow0 = krow0 + qt * 128; NT = 4; }
    else continue;
#ifndef ONLY_T1
    if (type == 0) attn_item<0>(p, smem, h, qrow0, krow0, NT, lam);
#endif
#ifndef ONLY_T0
    if (type == 1) attn_item<1>(p, smem, h, qrow0, krow0, NT, lam);
#endif
  }
}


constexpr size_t CARRY_SZ = (size_t)2 * 4 * 132 * 1024 * 4;
constexpr size_t OFF_CA = OFF_RC, OFF_CB = OFF_RC + CARRY_SZ, OFF_HIN = OFF_RC + 2 * CARRY_SZ;
constexpr int AT_LD = 264;
constexpr size_t SCAN_UF_OFF = 64 * AT_LD * 2;

template <int PASS>
__device__ __forceinline__ void scan_item(const Params& p, char* lds, int b, int c, int cg) {
  const int tid = otid(), wid = tid >> 6, lane = tid & 63, r32 = lane & 31, hi = lane >> 5;
  char* ws = p.ws;
  const bfr* U = (const bfr*)(ws + OFF_RD); const bfr* SG1 = U + (size_t)RTOT * 1024;
  bfr* AT = (bfr*)lds; float* UF = (float*)(lds + SCAN_UF_OFF);
  const int row0 = b * SEQA + c * 64;
  const int lo = c < 128 ? 0 : NLAT, hiP = c < 128 ? NLAT : SEQA;
  {
    const int k8 = tid & 31, ch = cg * 256 + k8 * 8;
    float w[4][8], bia[8];
#pragma unroll
    for (int j = 0; j < 4; ++j) { float4 t0 = *(const float4*)(p.conv_w + j * 1024 + ch), t1 = *(const float4*)(p.conv_w + j * 1024 + ch + 4);
      w[j][0] = t0.x; w[j][1] = t0.y; w[j][2] = t0.z; w[j][3] = t0.w; w[j][4] = t1.x; w[j][5] = t1.y; w[j][6] = t1.z; w[j][7] = t1.w; }
    { float4 t0 = *(const float4*)(p.conv_b + ch), t1 = *(const float4*)(p.conv_b + ch + 4);
      bia[0] = t0.x; bia[1] = t0.y; bia[2] = t0.z; bia[3] = t0.w; bia[4] = t1.x; bia[5] = t1.y; bia[6] = t1.z; bia[7] = t1.w; }
#pragma unroll
    for (int i = 0; i < 4; ++i) { const int t = (tid >> 5) + i * 16; const int pt = c * 64 + t;
      float acc[8];
#pragma unroll
      for (int e = 0; e < 8; ++e) acc[e] = bia[e];
#pragma unroll
      for (int j = 0; j < 4; ++j) { const int pp = pt + j - 2;
        if (pp >= lo && pp < hiP) { uint4 u = *(const uint4*)(U + (size_t)(row0 + t + j - 2) * 1024 + ch); float f[8]; unpack8(u, f);
#pragma unroll
          for (int e = 0; e < 8; ++e) acc[e] += w[j][e] * f[e]; } }
      u32x4 pk; pk[0] = cvtpk(acc[0], acc[1]); pk[1] = cvtpk(acc[2], acc[3]); pk[2] = cvtpk(acc[4], acc[5]); pk[3] = cvtpk(acc[6], acc[7]);
      *(u32x4*)(AT + t * AT_LD + k8 * 8) = pk;
      *(float4*)(UF + t * 256 + k8 * 8) = make_float4(acc[0], acc[1], acc[2], acc[3]);
      *(float4*)(UF + t * 256 + k8 * 8 + 4) = make_float4(acc[4], acc[5], acc[6], acc[7]); }
  }
  __syncthreads();
  const int blkl = wid >> 2, blk = cg * 2 + blkl, j0 = (wid & 3) * 32;
  const int ch = cg * 256 + wid * 32 + r32;
  float hsum[2][16];
#pragma unroll
  for (int dir = 0; dir < 2; ++dir) {
    f32x16 ga[2], gx[2];
#pragma unroll
    for (int mt = 0; mt < 2; ++mt)
#pragma unroll
      for (int r = 0; r < 16; ++r) { ga[mt][r] = 0.f; gx[mt][r] = 0.f; }
    const bfr* wa = (const bfr*)(ws + OFF_WG) + (size_t)(dir * 16 + blk) * 16384 + (size_t)(j0 + r32) * 128 + hi * 8;
    const bfr* wx = wa + (size_t)8 * 16384;
    const bfr* ap = AT + r32 * AT_LD + blkl * 128 + hi * 8;
#pragma unroll 2
    for (int ks = 0; ks < 8; ++ks) {
      bf16x8 a0 = *(const bf16x8*)(ap + ks * 16), a1 = *(const bf16x8*)(ap + 32 * AT_LD + ks * 16);
      bf16x8 ba_ = *(const bf16x8*)(wa + ks * 16), bx_ = *(const bf16x8*)(wx + ks * 16);
      ga[0] = __builtin_amdgcn_mfma_f32_32x32x16_bf16(a0, ba_, ga[0], 0, 0, 0);
      ga[1] = __builtin_amdgcn_mfma_f32_32x32x16_bf16(a1, ba_, ga[1], 0, 0, 0);
      gx[0] = __builtin_amdgcn_mfma_f32_32x32x16_bf16(a0, bx_, gx[0], 0, 0, 0);
      gx[1] = __builtin_amdgcn_mfma_f32_32x32x16_bf16(a1, bx_, gx[1], 0, 0, 0);
    }
    const float sp = log1pf(expf(-p.lru_l[dir * 1024 + ch]));
    const float kA = -8.f * sp * LOG2E, biasA = p.ga_b[dir * 1024 + ch], biasX = p.gx_b[dir * 1024 + ch];
#pragma unroll
    for (int mt = 0; mt < 2; ++mt)
#pragma unroll
      for (int r = 0; r < 16; ++r) {
        const float rr = __builtin_amdgcn_rcpf(1.f + __builtin_amdgcn_exp2f(-(ga[mt][r] + biasA) * LOG2E));
        const float ii = __builtin_amdgcn_rcpf(1.f + __builtin_amdgcn_exp2f(-(gx[mt][r] + biasX) * LOG2E));
        const float a = __builtin_amdgcn_exp2f(kA * rr);
        const float uc = UF[(mt * 32 + crow(r, hi)) * 256 + wid * 32 + r32];
        ga[mt][r] = a; gx[mt][r] = __builtin_amdgcn_sqrtf(fmaxf(1.f - a * a, 0.f)) * ii * uc;
      }
    float sA[8], sB[8];
#pragma unroll
    for (int sgi = 0; sgi < 8; ++sgi) { const int mt = sgi >> 2, g = sgi & 3; float A = 1.f, Bv = 0.f;
#pragma unroll
      for (int e = 0; e < 4; ++e) { const int r = g * 4 + (dir ? 3 - e : e); A *= ga[mt][r]; Bv = ga[mt][r] * Bv + gx[mt][r]; }
      sA[sgi] = A; sB[sgi] = Bv; }
    const bool ownFirst = (dir == 0) == (hi == 0);
    float st, stA = 1.f;
    if (PASS == 1) st = *(const float*)(ws + OFF_HIN + ((size_t)((dir * 4 + b) * 132 + c) * 1024 + ch) * 4); else st = 0.f;
#pragma unroll
    for (int q = 0; q < 8; ++q) { const int sgi = dir ? 7 - q : q;
      const float oA = sA[sgi], oB = sB[sgi];
      const float pA = __shfl_xor(oA, 32), pB = __shfl_xor(oB, 32);
      const float fA = ownFirst ? oA : pA, fB = ownFirst ? oB : pB, sA2 = ownFirst ? pA : oA, sB2 = ownFirst ? pB : oB;
      const float A8 = fA * sA2, B8 = sA2 * fB + sB2;
      if (PASS == 1) {
        float hv = ownFirst ? st : fA * st + fB;
        const int mt = sgi >> 2, g = sgi & 3;
#pragma unroll
        for (int e = 0; e < 4; ++e) { const int r = g * 4 + (dir ? 3 - e : e); hv = ga[mt][r] * hv + gx[mt][r];
          if (dir == 0) hsum[mt][r] = hv; else hsum[mt][r] += hv; }
      }
      st = A8 * st + B8; stA *= A8;
    }
    if (PASS == 0 && hi == 0) {
      const size_t ci = ((size_t)((dir * 4 + b) * 132 + c) * 1024 + ch) * 4;
      *(float*)(ws + OFF_CA + ci) = stA; *(float*)(ws + OFF_CB + ci) = st;
    }
  }
  __syncthreads();
  if (PASS == 1) {
#pragma unroll
    for (int mt = 0; mt < 2; ++mt)
#pragma unroll
      for (int r = 0; r < 16; ++r) AT[(mt * 32 + crow(r, hi)) * AT_LD + wid * 32 + r32] = f2bf(hsum[mt][r]);
    __syncthreads();
    bfr* HG = (bfr*)(ws + OFF_RA);
    const int k8 = tid & 31, chh = cg * 256 + k8 * 8;
#pragma unroll
    for (int i = 0; i < 4; ++i) { const int t = (tid >> 5) + i * 16;
      uint4 hv = *(const uint4*)(AT + t * AT_LD + k8 * 8); uint4 gv = *(const uint4*)(SG1 + (size_t)(row0 + t) * 1024 + chh);
      float hf[8], gf[8]; unpack8(hv, hf); unpack8(gv, gf);
      u32x4 pk; pk[0] = cvtpk(hf[0] * gf[0], hf[1] * gf[1]); pk[1] = cvtpk(hf[2] * gf[2], hf[3] * gf[3]);
      pk[2] = cvtpk(hf[4] * gf[4], hf[5] * gf[5]); pk[3] = cvtpk(hf[6] * gf[6], hf[7] * gf[7]);
      *(u32x4*)(HG + ((size_t)(b * NLAT + c * 64 + t)) * 1024 + chh) = pk; }
    __syncthreads();
  }
}
template <int PASS>
__device__ __forceinline__ void scan_phase(const Params& p, char* smem, int bid, int nb) {
  const int nchunk = PASS ? 128 : 132;
  for (int it = bid; it < 4 * nchunk * 4; it += nb) { const int cg = it & 3, t2 = it >> 2, c = t2 % nchunk, b = t2 / nchunk; scan_item<PASS>(p, smem, b, c, cg); }
}
__device__ __forceinline__ void carry_phase(const Params& p, int bid, int nb) {
  char* ws = p.ws;
  for (int id = bid * NTHR + otid(); id < 8192; id += nb * NTHR) {
    const int ch = id & 1023, db = id >> 10, dir = db >> 2;
    const float* CA = (const float*)(ws + OFF_CA) + (size_t)db * 132 * 1024 + ch; const float* CB = (const float*)(ws + OFF_CB) + (size_t)db * 132 * 1024 + ch;
    float* HIN = (float*)(ws + OFF_HIN) + (size_t)db * 132 * 1024 + ch;
    float h = 0.f;
    for (int s0 = 0; s0 < 132; s0 += 12) {
      float a[12], bb[12];
#pragma unroll
      for (int u = 0; u < 12; ++u) { const int s = s0 + u; const int c = dir ? 131 - s : (s < 4 ? 128 + s : s - 4); a[u] = CA[(size_t)c * 1024]; bb[u] = CB[(size_t)c * 1024]; }
#pragma unroll
      for (int u = 0; u < 12; ++u) { const int s = s0 + u; const int c = dir ? 131 - s : (s < 4 ? 128 + s : s - 4); HIN[(size_t)c * 1024] = h; h = a[u] * h + bb[u]; }
    }
  }
}

__device__ __forceinline__ float ld_agent_f32(const float* p) { return __hip_atomic_load(p, __ATOMIC_RELAXED, __HIP_MEMORY_SCOPE_AGENT); }
__device__ __forceinline__ void mod_phase(const Params& p, char* smem, int bid, int nb) {
  float* sc = (float*)smem; float* red = sc + 5 * 1024;
  float* mod = (float*)(p.ws + OFF_MOD);
  const int tid = otid(), kg = tid >> 6, col = tid & 63;
  for (int it = bid; it < 96; it += nb) {
    const int l = it / 48, j0 = (it % 48) * 64;
    for (int e = tid; e < 5120; e += NTHR) { const int mr = e >> 10, k = e & 1023; sc[e] = silu_f(mr < 4 ? p.c[mr * 1024 + k] : p.c_ctx[k]); }
    __syncthreads();
    float acc[5] = {0.f, 0.f, 0.f, 0.f, 0.f};
    const float* w = p.ada_w + (size_t)l * 1024 * 3072 + (size_t)(kg * 128) * 3072 + j0 + col;
#pragma unroll 8
    for (int k = 0; k < 128; ++k) { const float wv = w[(size_t)k * 3072];
#pragma unroll
      for (int mr = 0; mr < 5; ++mr) acc[mr] += sc[mr * 1024 + kg * 128 + k] * wv; }
#pragma unroll
    for (int mr = 0; mr < 5; ++mr) red[(kg * 5 + mr) * 64 + col] = acc[mr];
    __syncthreads();
    if (tid < 320) { const int mr = tid >> 6; float sum = 0.f;
#pragma unroll
      for (int g = 0; g < 8; ++g) sum += red[(g * 5 + mr) * 64 + col];
      mod[(l * 5 + mr) * 3072 + j0 + col] = sum + p.ada_b[l * 3072 + j0 + col]; }
    __syncthreads();
  }
  if (bid == nb - 1 && tid == 0) { float s1 = 0, s2 = 0;
    for (int i = 0; i < 64; ++i) { s1 += p.lq1[i] * p.lk1[i]; s2 += p.lq2[i] * p.lk2[i]; }
    *(float*)(p.ws + OFF_LAM) = expf(s1) - expf(s2) + 0.2f; }
}
__device__ __forceinline__ void modulate_phase(const Params& p, int bid, int nb) {
  const float* mod = (const float*)(p.ws + OFF_MOD); bfr* XM = (bfr*)(p.ws + OFF_RA);
  for (size_t idx = (size_t)bid * NTHR + otid(); idx < (size_t)RTOT * 256; idx += (size_t)nb * NTHR) {
    const int r = (int)(idx >> 8), c4 = (int)(idx & 255) * 4;
    const float* src = xrow(p.x, p.ctx, r) + c4; const int mr = modrow(r);
    const float* sh = mod + mr * 3072 + c4; const float* scp = sh + 1024;
    const float4 v = *(const float4*)src, s4 = *(const float4*)sh, c4v = *(const float4*)scp;
    uint2 o; o.x = cvtpk(v.x * (1.f + c4v.x) + s4.x, v.y * (1.f + c4v.y) + s4.y); o.y = cvtpk(v.z * (1.f + c4v.z) + s4.z, v.w * (1.f + c4v.w) + s4.w);
    *(uint2*)(XM + (size_t)r * 1024 + c4) = o;
  }
}
template <int LAYER>
__device__ __forceinline__ void ln_phase(const Params& p, int bid, int nb) {
  const float* mod = (const float*)(p.ws + OFF_MOD);
  const int lane = otid() & 63, wv = otid() >> 6;
  const int nrows = LAYER ? B_ * NLAT : RTOT;
  const float* lng = p.ln_g + LAYER * 1024; const float* lnb = p.ln_b + LAYER * 1024;
  for (int r = bid * 8 + wv; r < nrows; r += nb * 8) {
    int b, pp, mr; const float* xin; const bfr* Y; float* orow;
    if (LAYER == 0) { b = r / SEQA; pp = r - b * SEQA; mr = pp < NLAT ? b : 4; xin = xrow(p.x, p.ctx, r); Y = (const bfr*)(p.ws + OFF_RC) + (size_t)r * 1024;
      orow = p.out + ((size_t)(b * NLAT + pp)) * 1024; }
    else { b = r / NLAT; pp = 0; mr = b; orow = p.out + (size_t)r * 1024; xin = orow; Y = (const bfr*)(p.ws + OFF_RB) + (size_t)r * 1024; }
    const float* g = mod + (LAYER * 5 + mr) * 3072 + 2048;
    float v[16]; float s = 0.f;
#pragma unroll
    for (int i = 0; i < 4; ++i) { const int c = i * 256 + lane * 4;
      const float4 xv = *(const float4*)(xin + c), gv = *(const float4*)(g + c); const uint2 yv = *(const uint2*)(Y + c);
      v[i * 4 + 0] = ALPHA * xv.x + gv.x * __uint_as_float(yv.x << 16); v[i * 4 + 1] = ALPHA * xv.y + gv.y * __uint_as_float(yv.x & 0xffff0000u);
      v[i * 4 + 2] = ALPHA * xv.z + gv.z * __uint_as_float(yv.y << 16); v[i * 4 + 3] = ALPHA * xv.w + gv.w * __uint_as_float(yv.y & 0xffff0000u);
      s += v[i * 4] + v[i * 4 + 1] + v[i * 4 + 2] + v[i * 4 + 3]; }
    for (int o = 32; o; o >>= 1) s += __shfl_xor(s, o);
    const float mu = s * (1.f / 1024.f); float q = 0.f;
#pragma unroll
    for (int i = 0; i < 16; ++i) { const float d = v[i] - mu; q += d * d; }
    for (int o = 32; o; o >>= 1) q += __shfl_xor(q, o);
    const float rs = rsqrtf(q * (1.f / 1024.f) + 1e-6f);
    const float* sh1 = mod + (5 + mr) * 3072; const float* sc1 = sh1 + 1024;
#pragma unroll
    for (int i = 0; i < 4; ++i) { const int c = i * 256 + lane * 4;
      const float4 gg = *(const float4*)(lng + c), bb = *(const float4*)(lnb + c);
      float4 y; y.x = (v[i * 4] - mu) * rs * gg.x + bb.x; y.y = (v[i * 4 + 1] - mu) * rs * gg.y + bb.y;
      y.z = (v[i * 4 + 2] - mu) * rs * gg.z + bb.z; y.w = (v[i * 4 + 3] - mu) * rs * gg.w + bb.w;
      if (LAYER == 1 || pp < NLAT) *(float4*)(orow + c) = y;
      if (LAYER == 0) { const float4 s1 = *(const float4*)(sh1 + c), c1 = *(const float4*)(sc1 + c);
        uint2 o; o.x = cvtpk(y.x * (1.f + c1.x) + s1.x, y.y * (1.f + c1.y) + s1.y); o.y = cvtpk(y.z * (1.f + c1.z) + s1.z, y.w * (1.f + c1.w) + s1.w);
        *(uint2*)((bfr*)(p.ws + OFF_RA) + (size_t)r * 1024 + c) = o; } }
  }
}


constexpr size_t OFF_BAR = 131072;
#define XB_TMO      128
#define XB_XCNT(j)  (256  + 64 * (j))
#define XB_XSUB(j)  (1280 + 64 * (j))
#define XB_XGEN(j)  (2304 + 64 * (j))
#define XB_TOP      3328
#define XB_TOPGEN   3392
#define XCD_BAR_WORDS 3456
#define XB_SPIN_CAP (1u << 22)
#define LAS __attribute__((address_space(3)))
__device__ __forceinline__ unsigned xb_ld(unsigned* p)              { return __hip_atomic_load(p, __ATOMIC_RELAXED, __HIP_MEMORY_SCOPE_AGENT); }
__device__ __forceinline__ unsigned xb_add(unsigned* p, unsigned v) { return __hip_atomic_fetch_add(p, v, __ATOMIC_RELAXED, __HIP_MEMORY_SCOPE_AGENT); }
__device__ __forceinline__ unsigned xb_xcc_id() { return (unsigned)__builtin_amdgcn_s_getreg((3 << 11) | 20) & 0xFu; }
#define XB_SPIN(cond, bar) do { unsigned _sp = 0; while (cond) { __builtin_amdgcn_s_sleep(1); \
    if ((++_sp & 255u) == 0u) { if (xb_ld(&(bar)[XB_TMO])) break; if (_sp > XB_SPIN_CAP) { atomicAdd(&(bar)[XB_TMO], 1u); break; } } } } while (0)
struct XcdBarrier { unsigned* bar; unsigned x; volatile LAS unsigned* st; };
__device__ __forceinline__ XcdBarrier xcd_barrier_post(unsigned* bar, volatile LAS unsigned* st) {
  XcdBarrier b; b.bar = bar; b.x = xb_xcc_id(); b.st = st;
  if (threadIdx.x == 0) (void)xb_add(&bar[XB_XCNT(b.x)], 1u);
  return b;
}
__device__ __forceinline__ void xcd_barrier_complete(unsigned* bar, unsigned x, unsigned& nloc, unsigned& nx) {
  const unsigned G = gridDim.x * gridDim.y * gridDim.z;
  unsigned sum, cnt, mine, sp = 0u;
  for (;;) {
    sum = 0u; cnt = 0u; mine = 0u;
#pragma unroll
    for (unsigned j = 0; j < 16; ++j) { const unsigned c = xb_ld(&bar[XB_XCNT(j)]); sum += c; cnt += (c > 0u) ? 1u : 0u; mine = (j == x) ? c : mine; }
    if (sum == G) break;
    __builtin_amdgcn_s_sleep(1);
    if ((++sp & 255u) == 0u) { if (xb_ld(&bar[XB_TMO])) break; if (sp > XB_SPIN_CAP) { atomicAdd(&bar[XB_TMO], 1u); break; } }
  }
  nloc = mine > 0u ? mine : 1u; nx = cnt > 0u ? cnt : 1u;
}
__device__ __forceinline__ void xcd_barrier(const XcdBarrier& b) {
  asm volatile("s_waitcnt vmcnt(0)" ::: "memory");
  __syncthreads();
  if (threadIdx.x == 0) {
    unsigned* bar = b.bar;
    __builtin_amdgcn_s_waitcnt(0);
    unsigned nloc = b.st[0], nx = b.st[1];
    if (nloc == 0u) { xcd_barrier_complete(bar, b.x, nloc, nx); b.st[0] = nloc; b.st[1] = nx; }
    const unsigned old = xb_add(&bar[XB_XSUB(b.x)], 1u);
    const unsigned gen = old / nloc;
    if (old + 1u == (gen + 1u) * nloc) {
      __builtin_amdgcn_fence(__ATOMIC_RELEASE, "agent");
      asm volatile("s_waitcnt vmcnt(0)" ::: "memory");
      const unsigned og = xb_add(&bar[XB_TOP], 1u);
      const unsigned tg = og / nx;
      if (og + 1u == (tg + 1u) * nx) xb_add(&bar[XB_TOPGEN], 1u);
      else XB_SPIN(xb_ld(&bar[XB_TOPGEN]) == tg, bar);
      __builtin_amdgcn_fence(__ATOMIC_ACQUIRE, "agent");
      xb_add(&bar[XB_XGEN(b.x)], 1u);
      asm volatile("s_waitcnt vmcnt(0)" ::: "memory");
    } else {
      XB_SPIN(xb_ld(&bar[XB_XGEN(b.x)]) == gen, bar);
      __builtin_amdgcn_fence(__ATOMIC_ACQUIRE, "agent");
      asm volatile("s_waitcnt vmcnt(0)" ::: "memory");
    }
  }
  __syncthreads();
}

namespace cg = cooperative_groups;
extern __shared__ __attribute__((aligned(16))) char dyn_smem[];
constexpr size_t SMEM_TOTAL = SMEM_BYTES + 1024 + 16;
__global__ __launch_bounds__(512, 2) void fwd_megakernel(Params p) {
  cg::grid_group grid = cg::this_grid();
  const int bid = blockIdx.x, nb = gridDim.x;
  char* smem = dyn_smem; char* ws = p.ws;
  volatile LAS unsigned* xst = (volatile LAS unsigned*)(smem + SMEM_BYTES + 1024);
  if (threadIdx.x == 0) { xst[0] = 0u; xst[1] = 0u; }
  __syncthreads();
  const XcdBarrier xb = xcd_barrier_post((unsigned*)(ws + OFF_BAR), xst);
#ifndef PROBE_DOUBLE
#define PROBE_DOUBLE -1
#endif
#define REP(n) for (int rep_ = 0; rep_ < ((PROBE_DOUBLE == (n)) ? 2 : 1); ++rep_)
  REP(0) { mod_phase(p, smem, bid, nb);
  prep_phase(p, smem, (bid + nb - 96) % nb, nb); }
  grid.sync();
  REP(1) modulate_phase(p, bid, nb);
  xcd_barrier(xb);
  REP(2) { FEpiZ e{}; e.Zc = (bfr*)(ws + OFF_RE); e.DQ = (bfr*)(ws + OFF_RC); e.DK = e.DQ + (size_t)RTOT * 512; e.DV = e.DQ + (size_t)RTOT * 1024;
    e.SG0 = (bfr*)(ws + OFF_RB); e.KA = (bfr*)(ws + OFF_RD) + (size_t)RTOT * 768; e.ropeD = (const float2*)(ws + OFF_ROPED); e.ropeA = (const float2*)(ws + OFF_ROPEA);
    gemm_phase((const bfr*)(ws + OFF_RA), 1024, (const bfr*)(ws + OFF_WIN0), 1024, 1024, 132, 26, e, smem, bid, nb); }
  xcd_barrier(xb);
  REP(3) upproj_phase(p, smem, bid, nb);
  xcd_barrier(xb);
  REP(4) attn_phase(p, smem, bid, nb);
  xcd_barrier(xb);
  REP(5) { FEpiStore e{}; e.C = (bfr*)(ws + OFF_RC); e.ldc = 1024;
    gemm_phase((const bfr*)(ws + OFF_RA), 1024, (const bfr*)(ws + OFF_WOUT0), 1024, 1024, 132, 8, e, smem, bid, nb); }
  xcd_barrier(xb);
  REP(6) ln_phase<0>(p, bid, nb);
  xcd_barrier(xb);
  REP(7) { FEpiUG e{}; e.U = (bfr*)(ws + OFF_RD); e.SG1 = e.U + (size_t)RTOT * 1024;
    gemm_phase((const bfr*)(ws + OFF_RA), 1024, (const bfr*)(ws + OFF_WIN1), 1024, 1024, 132, 16, e, smem, bid, nb); }
  xcd_barrier(xb);
  REP(8) scan_phase<0>(p, smem, bid, nb);
  xcd_barrier(xb);
  REP(9) carry_phase(p, bid, nb);
  xcd_barrier(xb);
  REP(10) scan_phase<1>(p, smem, bid, nb);
  xcd_barrier(xb);
  REP(11) { FEpiStore e{}; e.C = (bfr*)(ws + OFF_RB); e.ldc = 1024;
    gemm_phase((const bfr*)(ws + OFF_RA), 1024, (const bfr*)(ws + OFF_WOUT1), 1024, 1024, 128, 8, e, smem, bid, nb); }
  xcd_barrier(xb);
  ln_phase<1>(p, bid, nb);
}

extern "C" void kernel_launch(void* const* d_in, const int* in_sizes, int n_in, void* d_out, int out_size, void* d_ws, size_t ws_size, hipStream_t stream) {
  Params P{};
  { const float** pp = (const float**)&P; for (int i = 0; i < 28; ++i) pp[i] = (const float*)d_in[i]; }
  P.out = (float*)d_out; P.ws = (char*)d_ws;
  if (ws_size < WS_END || n_in < 28) return;
  static int grid_blocks = 0;
  if (!grid_blocks) {
    (void)hipFuncSetAttribute((const void*)fwd_megakernel, hipFuncAttributeMaxDynamicSharedMemorySize, (int)SMEM_TOTAL);
    int dev = 0, cus = 0, per_cu = 0;
    (void)hipGetDevice(&dev);
    (void)hipDeviceGetAttribute(&cus, hipDeviceAttributeMultiprocessorCount, dev);
    (void)hipOccupancyMaxActiveBlocksPerMultiprocessor(&per_cu, (const void*)fwd_megakernel, NTHR, SMEM_TOTAL);
    if (per_cu > 1) per_cu = 1;
    grid_blocks = cus * per_cu;
    if (grid_blocks <= 0) grid_blocks = 256;
  }
  (void)hipMemsetAsync((char*)d_ws + OFF_BAR, 0, XCD_BAR_WORDS * 4, stream);
  void* args[] = {&P};
  (void)hipLaunchCooperativeKernel((const void*)fwd_megakernel, dim3(grid_blocks), dim3(NTHR), args, SMEM_TOTAL, stream);
}
```

```cpp
#include <hip/hip_runtime.h>
#include <hip/hip_bf16.h>
#include <hip/hip_cooperative_groups.h>
#include <stdint.h>

typedef unsigned short bfr;

constexpr int B_ = 4, NLAT = 8192, NCTX = 256, SEQA = NLAT + NCTX, RTOT = B_ * SEQA, DM = 1024;
constexpr float ALPHA = 1.4142135623730951f;
constexpr float LOG2E = 1.4426950408889634f;
constexpr float QSC_A = 0.10206207261596577f * LOG2E;
constexpr float QSC_D = 0.125f * LOG2E;

constexpr size_t SZ1024 = (size_t)RTOT * 1024 * 2;
constexpr size_t SZ512  = (size_t)RTOT * 512 * 2;
constexpr size_t SZ768  = (size_t)RTOT * 768 * 2;
constexpr size_t OFF_MOD = 0;
constexpr size_t OFF_LAM = 122880;
constexpr size_t OFF_RA = (size_t)24 << 20;
constexpr size_t OFF_RB = OFF_RA + SZ1024;
constexpr size_t OFF_RC = OFF_RB + SZ1024;
constexpr size_t OFF_RE = OFF_RC + 3 * SZ512;
constexpr size_t OFF_RD = OFF_RE + SZ1024;
constexpr size_t CARRY_SZ = (size_t)2 * 4 * 132 * 1024 * 4;
constexpr size_t OFF_CA = OFF_RD + 2 * SZ1024, OFF_CB = OFF_CA + CARRY_SZ, OFF_HIN = OFF_CB + CARRY_SZ;
constexpr size_t WS_END = OFF_HIN + CARRY_SZ;
constexpr size_t OFF_SAB = OFF_RA;
static_assert(OFF_SAB + (size_t)(2048 + 64) * 131072 <= OFF_RD, "SAB overflows into U/SG1");

__device__ __forceinline__ float bf2f(bfr h) { return __uint_as_float(((unsigned)h) << 16); }
__device__ __forceinline__ bfr f2bf(float f) { unsigned u = __float_as_uint(f); u += 0x7fffu + ((u >> 16) & 1u); return (bfr)(u >> 16); }
__device__ __forceinline__ float silu_f(float x) { return x / (1.f + expf(-x)); }
__device__ __forceinline__ float sigmoid_f(float x) { return 1.f / (1.f + expf(-x)); }
__device__ __forceinline__ const float* xrow(const float* x, const float* ctx, int r) {
  int b = r / SEQA, p = r - b * SEQA;
  return p < NLAT ? x + ((size_t)(b * NLAT + p)) * DM : ctx + ((size_t)(b * NCTX + (p - NLAT))) * DM;
}
__device__ __forceinline__ int modrow(int r) { int b = r / SEQA, p = r - b * SEQA; return p < NLAT ? b : 4; }

__device__ __forceinline__ void unpack8(uint4 u, float* f) {
  f[0] = __uint_as_float(u.x << 16); f[1] = __uint_as_float(u.x & 0xffff0000u);
  f[2] = __uint_as_float(u.y << 16); f[3] = __uint_as_float(u.y & 0xffff0000u);
  f[4] = __uint_as_float(u.z << 16); f[5] = __uint_as_float(u.z & 0xffff0000u);
  f[6] = __uint_as_float(u.w << 16); f[7] = __uint_as_float(u.w & 0xffff0000u);
}
using bf16x8 = __attribute__((ext_vector_type(8))) short;
using s16x4  = __attribute__((ext_vector_type(4))) short;
using f32x16 = __attribute__((ext_vector_type(16))) float;
using u32x4  = __attribute__((ext_vector_type(4))) unsigned;
constexpr int NTHR = 512;
constexpr size_t OFF_ROPED = (size_t)1 << 20;
constexpr size_t OFF_ROPEA = (size_t)3 << 20;
constexpr size_t OFF_WT    = (size_t)4 << 20;
constexpr size_t OFF_WIN0  = OFF_WT;
constexpr size_t OFF_WUQ   = OFF_WIN0 + (size_t)3328 * 1024 * 2;
constexpr size_t OFF_WUKV  = OFF_WUQ + (size_t)768 * 384 * 2;
constexpr size_t OFF_WOUT0 = OFF_WUKV + (size_t)1024 * 256 * 2;
constexpr size_t OFF_WIN1  = OFF_WOUT0 + (size_t)1024 * 1024 * 2;
constexpr size_t OFF_WG    = OFF_WIN1 + (size_t)2048 * 1024 * 2;
constexpr size_t OFF_WOUT1 = OFF_WG + (size_t)32 * 128 * 128 * 2;
static_assert(OFF_WOUT1 + (size_t)1024 * 1024 * 2 <= OFF_RA, "weights overflow");
constexpr size_t SMEM_BYTES = 131072;
constexpr size_t OFF_PSQ = OFF_RE + ((size_t)48 << 20);
constexpr size_t OFF_V8A = OFF_RE;
constexpr size_t OFF_V8D = OFF_RE + ((size_t)20 << 20);

__device__ __forceinline__ int otid() { int t = threadIdx.x; asm volatile("" : "+v"(t)); return t; }
__device__ __forceinline__ int crow(int r, int hi) { return (r & 3) + 8 * (r >> 2) + 4 * hi; }

struct Params {
  const float *x, *c, *ctx, *c_ctx, *ada_w, *ada_b, *ln_g, *ln_b, *e_w_in, *e_qg, *e_w_uq, *e_kvg, *e_w_ukv, *lq1, *lk1, *lq2, *lk2, *subg, *e_w_out,
      *o_w_in, *conv_w, *conv_b, *ga_w, *ga_b, *gx_w, *gx_b, *lru_l, *o_w_out;
  float* out; char* ws;
};

__device__ __forceinline__ int colmap(int MODE, int nd) {
  if (MODE == 0) return nd;
  if (MODE == 1) {
    if (nd < 1024) { const int base = nd < 512 ? 672 : 1184; const int x = nd & 511, tl = x >> 8, y = x & 255, bj = y >> 7, g = (y >> 5) & 3, i = y & 31;
      return base + (tl * 4 + g) * 64 + bj * 32 + i; }
    if (nd < 1536) return 1696 + (nd - 1024);
    if (nd < 2560) return 2208 + (nd - 1536);
    if (nd < 2816) return nd - 2560;
    if (nd < 2944) return 256 + (nd - 2816);
    if (nd < 3072) return 384 + (nd - 2944);
    const int x = nd - 3072;
    if (x < 64) return 512 + x;
    if (x < 80) return 640 + (x - 64);
    if (x < 128) return -1;
    if (x < 192) return 576 + (x - 128);
    if (x < 208) return 656 + (x - 192);
    return -1;
  }
  if (nd < 512) return (nd >> 6) * 96 + (nd & 63);
  if (nd < 640) return ((nd - 512) >> 4) * 96 + 64 + ((nd - 512) & 15);
  return ((nd - 640) >> 4) * 96 + 80 + ((nd - 640) & 15);
}
template <int MODE>
__device__ __forceinline__ void wt_convert(const float* __restrict__ src, int K, int ldsrc, int Nd, bfr* __restrict__ dst, const float* __restrict__ kscale,
                           float* lds, int bid, int nb) {
  const int tid = otid(), tk = K >> 6, tn = Nd >> 6;
  const int j = tid & 63, i0 = tid >> 6;
  for (int t = bid; t < tk * tn; t += nb) {
    const int k0 = (t % tk) << 6, n0 = (t / tk) << 6;
    const int ns = colmap(MODE, n0 + j);
    float v[8];
#pragma unroll
    for (int u = 0; u < 8; ++u) v[u] = ns >= 0 ? src[(size_t)(k0 + i0 + 8 * u) * ldsrc + ns] : 0.f;
    if (kscale) {
#pragma unroll
      for (int u = 0; u < 8; ++u) v[u] *= kscale[k0 + i0 + 8 * u]; }
#pragma unroll
    for (int u = 0; u < 8; ++u) lds[j * 65 + i0 + 8 * u] = v[u];
    __syncthreads();
#pragma unroll
    for (int u = 0; u < 8; ++u) dst[(size_t)(n0 + i0 + 8 * u) * K + k0 + j] = f2bf(lds[(i0 + 8 * u) * 65 + j]);
    __syncthreads();
  }
}
__device__ __forceinline__ void prep_phase(const Params& p, char* smem, int bid, int nb) {
  float* lds = (float*)smem; char* ws = p.ws;
  wt_convert<1>(p.e_w_in, 1024, 3232, 3328, (bfr*)(ws + OFF_WIN0), nullptr, lds, bid, nb);
  wt_convert<2>(p.e_w_uq, 384, 768, 768, (bfr*)(ws + OFF_WUQ), p.e_qg, lds, bid, nb);
  wt_convert<0>(p.e_w_ukv, 256, 1024, 1024, (bfr*)(ws + OFF_WUKV), p.e_kvg, lds, bid, nb);
  wt_convert<0>(p.e_w_out, 1024, 1024, 1024, (bfr*)(ws + OFF_WOUT0), nullptr, lds, bid, nb);
  wt_convert<0>(p.o_w_in, 1024, 2048, 2048, (bfr*)(ws + OFF_WIN1), nullptr, lds, bid, nb);
  wt_convert<0>(p.o_w_out, 1024, 1024, 1024, (bfr*)(ws + OFF_WOUT1), nullptr, lds, bid, nb);
  for (int m = 0; m < 32; ++m) {
    int dir = m >> 4, gate = (m >> 3) & 1, blk = m & 7;
    const float* src = (gate ? p.gx_w : p.ga_w) + ((size_t)dir * 8 + blk) * 128 * 128;
    wt_convert<0>(src, 128, 128, 128, (bfr*)(ws + OFF_WG) + (size_t)m * 128 * 128, nullptr, lds, bid, nb);
  }
  float2* rd = (float2*)(ws + OFF_ROPED); float2* ra = (float2*)(ws + OFF_ROPEA);
  for (int e = bid * NTHR + otid(); e < 8192 * 32; e += nb * NTHR) { int pos = e >> 5, i = e & 31;
    float pp = (i < 16) ? (float)(pos >> 6) : (float)(pos & 63); float fr = powf(10000.f, -(float)(i & 15) / 16.f);
    float sn, cs; sincosf(pp * fr, &sn, &cs); rd[e] = make_float2(cs, sn); }
  for (int e = bid * NTHR + otid(); e < 8192 * 16; e += nb * NTHR) { int pos = e >> 4, i = e & 15;
    float pp = (i < 8) ? (float)(pos >> 6) : (float)(pos & 63); float fr = powf(10000.f, -(float)(i & 7) / 8.f);
    float sn, cs; sincosf(pp * fr, &sn, &cs); ra[e] = make_float2(cs, sn); }
}

namespace pg8 {
#define PG8_LAS __attribute__((address_space(3)))
typedef unsigned short bf16_t;
typedef short bf16x8 __attribute__((ext_vector_type(8)));
typedef float f32x4 __attribute__((ext_vector_type(4)));
typedef unsigned u32x4 __attribute__((ext_vector_type(4)));
constexpr int BM = 256, BK = 64, HALF = 128, HTB = HALF * BK * 2  , STAGE_BYTES = 8 * HTB, NXCD = 8, WGM = 8;

__host__ __device__ __forceinline__ int lds_byte(int r, int c) { const int st = (r >> 4) * 2 + (c >> 5), rr = r & 15, cc = c & 31, ob = rr * 64 + cc * 2; return st * 1024 + (ob ^ (((ob >> 9) & 1) << 5)); }
__host__ __device__ __forceinline__ void stage_rc(int b, int& R, int& C) { const int st = b / 1024, sb = b % 1024, swz = sb ^ (((sb >> 9) & 1) << 5); R = (st >> 1) * 16 + swz / 64; C = (st & 1) * 32 + (swz % 64) / 2; }
__host__ __device__ __forceinline__ int perm32(int rho) { const int n = rho >> 4, i = rho & 15; return 8 * (i >> 2) + 4 * n + (i & 3); }

struct Unit { int pm, pn; };
struct Gemm { const bf16_t* A; const bf16_t* Bt; int M, N, K; };

struct StaticOrder {
    int nM, nN, nwg, G, c;
    __host__ __device__ void init(int M, int N, int G_, int c_) { nM = M / BM; nN = N / BM; nwg = nM * nN; G = G_; c = c_; }
    __host__ __device__ bool next(int i, Unit& u) const {
        const long L = (long)i * G + c; if (L >= nwg) return false;
        int wgid = (int)L; { const int q = nwg / NXCD, r = nwg % NXCD, xcd = wgid % NXCD, off = wgid / NXCD; wgid = (xcd < r ? xcd * (q + 1) : r * (q + 1) + (xcd - r) * q) + off; }
        const int nig = WGM * nN, gid = wgid / nig, fm = gid * WGM, gsz = (nM - fm) < WGM ? (nM - fm) : WGM;
        u.pm = fm + ((wgid % nig) % gsz); u.pn = (wgid % nig) / gsz; return true;
    }
    __device__ __forceinline__ void a_ready(const Unit&) const {}
    __device__ __forceinline__ void done(const Unit&) const {}
};

__device__ __forceinline__ unsigned cvt_pk_bf16(float lo, float hi) { unsigned r; asm volatile("v_cvt_pk_bf16_f32 %0, %1, %2" : "=v"(r) : "v"(lo), "v"(hi)); return r; }
__device__ __forceinline__ u32x4 pack8(const float* v) { u32x4 w; w.x = cvt_pk_bf16(v[0], v[1]); w.y = cvt_pk_bf16(v[2], v[3]); w.z = cvt_pk_bf16(v[4], v[5]); w.w = cvt_pk_bf16(v[6], v[7]); return w; }
__device__ __forceinline__ uint2 pack8_fp8(const float* v, float sc) {
  int a = 0, b = 0;
  a = __builtin_amdgcn_cvt_pk_fp8_f32(v[0] * sc, v[1] * sc, a, false); a = __builtin_amdgcn_cvt_pk_fp8_f32(v[2] * sc, v[3] * sc, a, true);
  b = __builtin_amdgcn_cvt_pk_fp8_f32(v[4] * sc, v[5] * sc, b, false); b = __builtin_amdgcn_cvt_pk_fp8_f32(v[6] * sc, v[7] * sc, b, true);
  return make_uint2((unsigned)a, (unsigned)b); }
constexpr float Q8S = 16.f, K8S = 4.f;
__device__ __forceinline__ void get8(const f32x4 (&a)[2], float* v) { v[0] = a[0][0]; v[1] = a[0][1]; v[2] = a[0][2]; v[3] = a[0][3]; v[4] = a[1][0]; v[5] = a[1][1]; v[6] = a[1][2]; v[7] = a[1][3]; }
__device__ __forceinline__ void rope8(float* x1, float* x2, const float2* tab, bool lat, float sc) {
  float cs[8], sn[8];
  if (lat) { const float4* t4 = (const float4*)tab;
#pragma unroll
    for (int i = 0; i < 4; ++i) { const float4 t = t4[i]; cs[2 * i] = t.x; sn[2 * i] = t.y; cs[2 * i + 1] = t.z; sn[2 * i + 1] = t.w; } }
  else {
#pragma unroll
    for (int i = 0; i < 8; ++i) { cs[i] = 1.f; sn[i] = 0.f; } }
#pragma unroll
  for (int i = 0; i < 8; ++i) { const float a = x1[i], b = x2[i]; x1[i] = (a * cs[i] - b * sn[i]) * sc; x2[i] = (b * cs[i] + a * sn[i]) * sc; }
}
struct EStore { static constexpr bool PERM = true, AFTER_DRAIN = false; bf16_t* C; int ldc;
  __device__ __forceinline__ void operator()(const f32x4 (&acc)[2][2][4][2], const Unit& u, int wr, int wc, int fr_, int fq_) const {
    int fr = fr_, fq = fq_; asm volatile("" : "+v"(fr), "+v"(fq));
    const int row0 = u.pm * BM + wr * 64 + fr, col0 = u.pn * BM + wc * 32 + 8 * fq;
#pragma unroll
    for (int ai = 0; ai < 2; ++ai)
#pragma unroll
      for (int m = 0; m < 4; ++m) { bf16_t* rowp = C + (size_t)(row0 + ai * HALF + m * 16) * ldc + col0;
#pragma unroll
        for (int bj = 0; bj < 2; ++bj) { float v[8]; get8(acc[ai][bj][m], v); *(u32x4*)(rowp + bj * HALF) = pack8(v); } }
  } };
struct EUG { static constexpr bool PERM = true, AFTER_DRAIN = false; bf16_t *U, *SG1;
  __device__ __forceinline__ void operator()(const f32x4 (&acc)[2][2][4][2], const Unit& u, int wr, int wc, int fr_, int fq_) const {
    int fr = fr_, fq = fq_; asm volatile("" : "+v"(fr), "+v"(fq));
    const bool g = u.pn >= 4; bf16_t* C = g ? SG1 : U;
    const int row0 = u.pm * BM + wr * 64 + fr, col0 = (u.pn & 3) * BM + wc * 32 + 8 * fq;
#pragma unroll
    for (int ai = 0; ai < 2; ++ai)
#pragma unroll
      for (int m = 0; m < 4; ++m) { bf16_t* rowp = C + (size_t)(row0 + ai * HALF + m * 16) * 1024 + col0;
#pragma unroll
        for (int bj = 0; bj < 2; ++bj) { float v[8]; get8(acc[ai][bj][m], v);
          if (g) {
#pragma unroll
            for (int i = 0; i < 8; ++i) v[i] = silu_f(v[i]); }
          *(u32x4*)(rowp + bj * HALF) = pack8(v); } }
  } };
struct EZ { static constexpr bool PERM = true, AFTER_DRAIN = false; char* ws;
  __device__ __forceinline__ void operator()(const f32x4 (&acc)[2][2][4][2], const Unit& u, int wr, int wc, int fr_, int fq_) const {
    int fr = fr_, fq = fq_; asm volatile("" : "+v"(fr), "+v"(fq));
    const int pn = u.pn, row0 = u.pm * BM + wr * 64 + fr, p00 = (u.pm * BM) % SEQA + wr * 64 + fr; const bool lat = ((u.pm * BM) % SEQA) < NLAT;
    const int c8 = wc * 32 + 8 * fq;
    if (pn < 4) {
      unsigned char* C = (unsigned char*)(ws + OFF_RC) + (pn >= 2 ? SZ512 : 0); const float sc = pn < 2 ? QSC_D * Q8S : K8S;
      const int tcol = ((pn & 1) * 4 + wc) * 64 + 8 * fq; const float2* rd = (const float2*)(ws + OFF_ROPED) + 8 * fq;
#pragma unroll
      for (int ai = 0; ai < 2; ++ai)
#pragma unroll
        for (int m = 0; m < 4; ++m) { const int ro = ai * HALF + m * 16; float x1[8], x2[8]; get8(acc[ai][0][m], x1); get8(acc[ai][1][m], x2);
          rope8(x1, x2, rd + (size_t)(p00 + ro) * 32, lat, sc);
          unsigned char* d = C + (size_t)(row0 + ro) * 512 + tcol; *(uint2*)d = pack8_fp8(x1, 1.f); *(uint2*)(d + 32) = pack8_fp8(x2, 1.f); }
    } else if (pn < 6) {
      bf16_t* C = (bf16_t*)(ws + OFF_RC) + (size_t)RTOT * 1024 + (pn - 4) * BM + c8;
#pragma unroll
      for (int ai = 0; ai < 2; ++ai)
#pragma unroll
        for (int m = 0; m < 4; ++m)
#pragma unroll
          for (int bj = 0; bj < 2; ++bj) { float v[8]; get8(acc[ai][bj][m], v); *(u32x4*)(C + (size_t)(row0 + ai * HALF + m * 16) * 512 + bj * HALF) = pack8(v); }
    } else if (pn < 10) {
      bf16_t* C = (bf16_t*)(ws + OFF_RB) + (pn - 6) * BM + c8;
#pragma unroll
      for (int ai = 0; ai < 2; ++ai)
#pragma unroll
        for (int m = 0; m < 4; ++m)
#pragma unroll
          for (int bj = 0; bj < 2; ++bj) { float v[8]; get8(acc[ai][bj][m], v);
#pragma unroll
            for (int i = 0; i < 8; ++i) v[i] = silu_f(v[i]);
            *(u32x4*)(C + (size_t)(row0 + ai * HALF + m * 16) * 1024 + bj * HALF) = pack8(v); }
    } else {
      bf16_t* Zq = (bf16_t*)(ws + OFF_RE); bf16_t* Zkv = Zq + (size_t)RTOT * 384; float* PSQ = (float*)(ws + OFF_PSQ);
#pragma unroll
      for (int ai = 0; ai < 2; ++ai)
#pragma unroll
        for (int m = 0; m < 4; ++m) { const int ro = ai * HALF + m * 16; const size_t row = (size_t)(row0 + ro);
#pragma unroll
          for (int bj = 0; bj < 2; ++bj) { float v[8]; get8(acc[ai][bj][m], v);
            bf16_t* d = nullptr;
            if (pn == 10) d = Zq + row * 384 + bj * HALF + c8;
            else if (pn == 11) d = bj ? Zkv + row * 256 + c8 : Zq + row * 384 + 256 + c8;
            else if (wc < 2) d = Zkv + row * 256 + (bj ? 192 : 128) + c8;
            if (d) { *(u32x4*)d = pack8(v);
              float ss = 0.f;
#pragma unroll
              for (int i = 0; i < 8; ++i) ss += v[i] * v[i];
              ss += __shfl_xor(ss, 16); ss += __shfl_xor(ss, 32);
              if (fq == 0) PSQ[row * 24 + (pn - 10) * 8 + bj * 4 + wc] = ss; } }
          if (pn == 12 && wc == 2 && fq < 2) { float x1[8], x2[8]; get8(acc[ai][0][m], x1); get8(acc[ai][1][m], x2);
            rope8(x1, x2, (const float2*)(ws + OFF_ROPEA) + (size_t)(p00 + ro) * 16 + 8 * fq, lat, K8S);
            const uint2 o1 = pack8_fp8(x1, 1.f), o2 = pack8_fp8(x2, 1.f); unsigned char* ka = (unsigned char*)(ws + OFF_RD) + SZ768 + row * 1024 + 64 + 8 * fq;
#pragma unroll
            for (int h = 0; h < 8; ++h) { *(uint2*)(ka + h * 128) = o1; *(uint2*)(ka + h * 128 + 16) = o2;
              *(uint4*)(ka + h * 128 + 32 - 8 * fq + 16 * fq) = make_uint4(0u, 0u, 0u, 0u); } } }
    }
  } };
struct EQ { static constexpr bool PERM = true, AFTER_DRAIN = false; char* ws;
  __device__ __forceinline__ void operator()(const f32x4 (&acc)[2][2][4][2], const Unit& u, int wr, int wc, int fr_, int fq_) const {
    int fr = fr_, fq = fq_; asm volatile("" : "+v"(fr), "+v"(fq));
    const int pn = u.pn, row0 = u.pm * BM + wr * 64 + fr, p00 = (u.pm * BM) % SEQA + wr * 64 + fr; const bool lat = ((u.pm * BM) % SEQA) < NLAT;
    unsigned char* Q8 = (unsigned char*)(ws + OFF_RD); const float* PSQ = (const float*)(ws + OFF_PSQ);
#pragma unroll
    for (int ai = 0; ai < 2; ++ai)
#pragma unroll
      for (int m = 0; m < 4; ++m) { const int ro = ai * HALF + m * 16; const size_t row = (size_t)(row0 + ro);
        const float4* ps = (const float4*)(PSQ + row * 24); const float4 s0 = ps[0], s1 = ps[1], s2 = ps[2];
        const float rq = rsqrtf((s0.x + s0.y + s0.z + s0.w + s1.x + s1.y + s1.z + s1.w + s2.x + s2.y + s2.z + s2.w) * (1.f / 384.f) + 1e-6f) * QSC_A;
        if (pn < 2) {
#pragma unroll
          for (int bj = 0; bj < 2; ++bj) { float v[8]; get8(acc[ai][bj][m], v);
#pragma unroll
            for (int i = 0; i < 8; ++i) v[i] *= rq;
            const int col = pn * BM + bj * HALF + wc * 32 + 8 * fq; *(uint2*)(Q8 + row * 1024 + (col >> 6) * 128 + (col & 63)) = pack8_fp8(v, Q8S); }
        } else { float x1[8], x2[8]; get8(acc[ai][0][m], x1); get8(acc[ai][1][m], x2);
          const int idx = wc * 32 + 8 * fq, h = idx >> 4, i0 = idx & 15;
          rope8(x1, x2, (const float2*)(ws + OFF_ROPEA) + (size_t)(p00 + ro) * 16 + i0, lat, rq);
          unsigned char* d = Q8 + row * 1024 + h * 128 + 64 + i0; *(uint2*)d = pack8_fp8(x1, Q8S); *(uint2*)(d + 16) = pack8_fp8(x2, Q8S);
          *(uint4*)(Q8 + row * 1024 + h * 128 + 96 + 2 * i0) = make_uint4(0u, 0u, 0u, 0u); } }
  } };
struct EKV { static constexpr bool PERM = true, AFTER_DRAIN = false; char* ws;
  __device__ __forceinline__ void operator()(const f32x4 (&acc)[2][2][4][2], const Unit& u, int wr, int wc, int fr_, int fq_) const {
    int fr = fr_, fq = fq_; asm volatile("" : "+v"(fr), "+v"(fq));
    const int pn = u.pn, row0 = u.pm * BM + wr * 64 + fr, c8 = wc * 32 + 8 * fq;
    unsigned char* K8 = (unsigned char*)(ws + OFF_RD) + SZ768; bf16_t* VA = (bf16_t*)(ws + OFF_RD) + (size_t)RTOT * 1536; const float* PSQ = (const float*)(ws + OFF_PSQ);
#pragma unroll
    for (int ai = 0; ai < 2; ++ai)
#pragma unroll
      for (int m = 0; m < 4; ++m) { const size_t row = (size_t)(row0 + ai * HALF + m * 16);
        const float4 s0 = *(const float4*)(PSQ + row * 24 + 12); const float2 s1 = *(const float2*)(PSQ + row * 24 + 16), s2 = *(const float2*)(PSQ + row * 24 + 20);
        const float rk = rsqrtf((s0.x + s0.y + s0.z + s0.w + s1.x + s1.y + s2.x + s2.y) * (1.f / 256.f) + 1e-6f);
#pragma unroll
        for (int bj = 0; bj < 2; ++bj) { float v[8]; get8(acc[ai][bj][m], v);
#pragma unroll
          for (int i = 0; i < 8; ++i) v[i] *= rk;
          const int h = pn * 2 + bj;
          if (c8 < 64) *(uint2*)(K8 + row * 1024 + h * 128 + c8) = pack8_fp8(v, K8S);
          else *(u32x4*)(VA + row * 512 + h * 64 + (c8 - 64)) = pack8(v); } }
  } };

template <class Epi, class Sched, bool STAMP = false>
__device__ __forceinline__ void gemm_phase(PG8_LAS unsigned char* lds, const Gemm g, const Sched& S, const Epi& E, unsigned long long* stamps) {
    const int tid = otid(), wid = __builtin_amdgcn_readfirstlane(tid >> 6), lane = tid & 63, wr = wid >> 2, wc = wid & 3, fr = lane & 15, fq = lane >> 4;
    int K_ = g.K; asm volatile("" : "+s"(K_));
    const int K = K_, nt = K / BK;
    int ts_lo = 0, ts_hi = 0, nts = 0; const unsigned long long rt_entry = STAMP ? (unsigned long long)wall_clock64() : 0ull;
#define PG8_STAMP() do { if (STAMP && wid == 0 && nts < 64) { const unsigned long long _c = (unsigned long long)clock64(); \
        ts_lo = (lane == nts) ? (int)(unsigned)_c : ts_lo; ts_hi = (lane == nts) ? (int)(unsigned)(_c >> 32) : ts_hi; ++nts; } } while (0)
    PG8_STAMP();
    unsigned voffA[2], voffB[2];
#pragma unroll
    for (int i = 0; i < 2; ++i) { int R, C; stage_rc(tid * 16 + i * 8192, R, C); const int Rb = Epi::PERM ? ((R & ~31) + perm32(R & 31)) : R;
        voffA[i] = (unsigned)(R * K + C) * 2u; voffB[i] = (unsigned)(Rb * K + C) * 2u; }
    const size_t kstep = (size_t)(BK * 2);
    const size_t hstep = (size_t)HALF * K * 2;
    const size_t tstep = 2 * hstep;
    const unsigned ldsw = (unsigned)wid * 1024u;
    const int aoff = lds_byte(wr * 64 + fr, fq * 8), boff = lds_byte(wc * 32 + fr, fq * 8);
#define PG8_SA(b, h) (((b) * 2 + (h)) * HTB)
#define PG8_SB(b, h) ((4 + (b) * 2 + (h)) * HTB)
#define PG8_STAGE(bufoff, gbase, voff) do { _Pragma("unroll") for (int _i = 0; _i < 2; ++_i) \
        __builtin_amdgcn_global_load_lds((const unsigned*)((const char*)(gbase) + (voff)[_i]), (PG8_LAS unsigned*)(lds + (bufoff) + ldsw + _i * 8192), 16, 0, 0); } while (0)
#define PG8_LDA(dst, b, h) do { _Pragma("unroll") for (int m = 0; m < 4; ++m) _Pragma("unroll") for (int k = 0; k < 2; ++k) dst[m][k] = *(const PG8_LAS bf16x8*)(lds + PG8_SA(b, h) + aoff + m * 2048 + k * 1024); } while (0)
#define PG8_LDB(dst, b, h) do { _Pragma("unroll") for (int n = 0; n < 2; ++n) _Pragma("unroll") for (int k = 0; k < 2; ++k) dst[n][k] = *(const PG8_LAS bf16x8*)(lds + PG8_SB(b, h) + boff + n * 2048 + k * 1024); } while (0)
#define PG8_MMA(ai, bj, At, Bt) do { __builtin_amdgcn_s_setprio(1); _Pragma("unroll") for (int m = 0; m < 4; ++m) _Pragma("unroll") for (int n = 0; n < 2; ++n) _Pragma("unroll") for (int k = 0; k < 2; ++k) \
        acc[ai][bj][m][n] = __builtin_amdgcn_mfma_f32_16x16x32_bf16(Bt[n][k], At[m][k], acc[ai][bj][m][n], 0, 0, 0); __builtin_amdgcn_s_setprio(0); } while (0)
#define PG8_WAIT_V(n) asm volatile("s_waitcnt vmcnt(" #n ")" ::: "memory")
#define PG8_WAIT_L(n) asm volatile("s_waitcnt lgkmcnt(" #n ")" ::: "memory")
#define PG8_BAR __builtin_amdgcn_s_barrier()
#define PG8_SCHED __builtin_amdgcn_sched_barrier(0)
    Unit cur, nxt; int ui = 0;
    if (!S.next(0, cur)) return;
    f32x4 acc[2][2][4][2];
#pragma unroll
    for (int a = 0; a < 2; ++a)
#pragma unroll
        for (int b = 0; b < 2; ++b)
#pragma unroll
            for (int m = 0; m < 4; ++m)
#pragma unroll
                for (int n = 0; n < 2; ++n) acc[a][b][m][n] = (f32x4){0.f, 0.f, 0.f, 0.f};
    bf16x8 At[4][2], B0[2][2], B1[2][2];
    const char* cA = (const char*)g.A + (size_t)cur.pm * tstep; const char* cB = (const char*)g.Bt + (size_t)cur.pn * tstep;
    S.a_ready(cur);
    PG8_STAGE(PG8_SB(0, 0), cB, voffB); PG8_STAGE(PG8_SA(0, 0), cA, voffA); PG8_STAGE(PG8_SB(0, 1), cB + hstep, voffB); PG8_STAGE(PG8_SA(0, 1), cA + hstep, voffA);
    if (wr == 1) PG8_BAR;
    PG8_WAIT_V(4); PG8_BAR;
    PG8_STAGE(PG8_SB(1, 0), cB + kstep, voffB); PG8_STAGE(PG8_SA(1, 0), cA + kstep, voffA); PG8_STAGE(PG8_SB(1, 1), cB + hstep + kstep, voffB);
    PG8_WAIT_V(6); PG8_BAR;
    PG8_STAMP();
    for (;;) {
        const bool has_next = S.next(ui + 1, nxt);
        const char* nA = has_next ? (const char*)g.A + (size_t)nxt.pm * tstep : cA; const char* nB = has_next ? (const char*)g.Bt + (size_t)nxt.pn * tstep : cB;
        for (int t = 0; t < nt; t += 2) {
            const bool last = (t == nt - 2);
            const char* a1 = cA + (size_t)(t + 1) * kstep;
            const char* a2 = last ? nA : cA + (size_t)(t + 2) * kstep; const char* b2 = last ? nB : cB + (size_t)(t + 2) * kstep;
            const char* a3 = a2 + kstep; const char* b3 = b2 + kstep;
            if (last && has_next) S.a_ready(nxt);
            PG8_LDB(B0, 0, 0); PG8_SCHED; PG8_LDA(At, 0, 0); PG8_STAGE(PG8_SA(1, 1), a1 + hstep, voffA);
            PG8_WAIT_L(8); PG8_BAR; PG8_WAIT_L(0); PG8_MMA(0, 0, At, B0); PG8_BAR; PG8_SCHED;
            PG8_LDB(B1, 0, 1); PG8_STAGE(PG8_SB(0, 0), b2, voffB);
            PG8_BAR; PG8_WAIT_L(0); PG8_MMA(0, 1, At, B1); PG8_BAR;
            PG8_LDA(At, 0, 1); PG8_STAGE(PG8_SA(0, 0), a2, voffA);
            PG8_BAR; PG8_WAIT_L(0); PG8_MMA(1, 0, At, B0); PG8_BAR; PG8_SCHED;
            PG8_STAGE(PG8_SB(0, 1), b2 + hstep, voffB);
            PG8_WAIT_V(6); PG8_BAR; PG8_MMA(1, 1, At, B1); PG8_BAR;
            PG8_LDB(B0, 1, 0); PG8_SCHED; PG8_LDA(At, 1, 0); PG8_STAGE(PG8_SA(0, 1), a2 + hstep, voffA);
            PG8_WAIT_L(8); PG8_BAR; PG8_WAIT_L(0); PG8_MMA(0, 0, At, B0); PG8_BAR; PG8_SCHED;
            PG8_LDB(B1, 1, 1); PG8_STAGE(PG8_SB(1, 0), b3, voffB);
            PG8_BAR; PG8_WAIT_L(0); PG8_MMA(0, 1, At, B1); PG8_BAR;
            PG8_LDA(At, 1, 1); PG8_STAGE(PG8_SA(1, 0), a3, voffA);
            PG8_BAR; PG8_WAIT_L(0); PG8_MMA(1, 0, At, B0); PG8_BAR; PG8_SCHED;
            PG8_STAGE(PG8_SB(1, 1), b3 + hstep, voffB);
            PG8_WAIT_V(6); PG8_BAR; PG8_MMA(1, 1, At, B1); PG8_BAR;
        }
        PG8_STAMP();
        if constexpr (!Epi::AFTER_DRAIN) { E(acc, cur, wr, wc, fr, fq); S.done(cur); }
        PG8_STAMP();
        if (!has_next) break;
#pragma unroll
        for (int a = 0; a < 2; ++a)
#pragma unroll
            for (int b = 0; b < 2; ++b)
#pragma unroll
                for (int m = 0; m < 4; ++m)
#pragma unroll
                    for (int n = 0; n < 2; ++n) acc[a][b][m][n] = (f32x4){0.f, 0.f, 0.f, 0.f};
        cur = nxt; cA = nA; cB = nB; ++ui;
    }
    PG8_WAIT_V(0);
    if (wr == 0) PG8_BAR;
    PG8_BAR;
    if constexpr (Epi::AFTER_DRAIN) { E.fused(acc, cur, wr, wc, fr, fq, lds, wid, lane); S.done(cur); }
    PG8_STAMP();
    if (STAMP && wid == 0) { stamps[lane] = lane < nts ? (((unsigned long long)(unsigned)ts_hi << 32) | (unsigned)ts_lo) : 0ull;
        if (lane == 62) stamps[62] = rt_entry; if (lane == 63) stamps[63] = (unsigned long long)wall_clock64(); }
#undef PG8_STAMP
#undef PG8_SA
#undef PG8_SB
#undef PG8_STAGE
#undef PG8_LDA
#undef PG8_LDB
#undef PG8_MMA
#undef PG8_WAIT_V
#undef PG8_WAIT_L
#undef PG8_BAR
#undef PG8_SCHED
}
}

constexpr int SHM_KV = 64 * 256;
#ifndef ATT_AUG
#define ATT_AUG 1
#endif
constexpr float THR2 = 11.5f;
#define KSWZ(row, colB) ((row) * 256 + ((colB) ^ (((row) & 15) << 4)))
#define SBAR() __builtin_amdgcn_sched_barrier(0)
__device__ __forceinline__ unsigned cvtpk(float lo, float hi) { unsigned r; asm volatile("v_cvt_pk_bf16_f32 %0, %1, %2" : "=v"(r) : "v"(lo), "v"(hi)); return r; }
constexpr float P_TOP = 8.f, P_REF = 2.f;
typedef int v8i_t __attribute__((ext_vector_type(8)));
template <bool FIRST, int VAR, bool ALLEXP = false>
__device__ __forceinline__ void partialSM(f32x16& p0, f32x16& p1, float& m_ref, float& alpha) {
  if (VAR == 3) { alpha = 1.f; return; }
  float pmax = p0[0];
#pragma unroll
  for (int r = 1; r < 16; ++r) pmax = fmaxf(pmax, p0[r]);
#pragma unroll
  for (int r = 0; r < 16; ++r) pmax = fmaxf(pmax, p1[r]);
  { auto rr = __builtin_amdgcn_permlane32_swap(__float_as_uint(pmax), __float_as_uint(pmax), false, false);
    pmax = fmaxf(__uint_as_float(rr[0]), __uint_as_float(rr[1])); }
  if (!FIRST && __builtin_expect(__all(pmax <= P_TOP), 1)) { alpha = 1.f; }
  else {
    const float mn = bf2f(f2bf(m_ref + (FIRST ? pmax - P_REF : fmaxf(pmax - P_REF, 0.f))));
    const float delta = mn - m_ref;
    alpha = FIRST ? 0.f : __builtin_amdgcn_exp2f(-delta);
    m_ref = mn;
#pragma unroll
    for (int r = 0; r < 16; ++r) p0[r] = p0[r] - delta;
#pragma unroll
    for (int r = 0; r < 16; ++r) p1[r] = p1[r] - delta;
  }
#pragma unroll
  for (int r = 0; r < 16; ++r) p0[r] = __builtin_amdgcn_exp2f(p0[r]);
  if (ALLEXP) {
#pragma unroll
    for (int r = 0; r < 16; ++r) p1[r] = __builtin_amdgcn_exp2f(p1[r]);
  }
}
template <int VAR, bool ALLEXP = false>
__device__ __forceinline__ void finishSM(f32x16& p0, f32x16& p1, v8i_t& pa) {
  if (VAR != 3 && !ALLEXP) {
#pragma unroll
  for (int r = 0; r < 16; ++r) p1[r] = __builtin_amdgcn_exp2f(p1[r]);
  }
#pragma unroll
  for (int g = 0; g < 4; ++g) { int w = 0; w = __builtin_amdgcn_cvt_pk_fp8_f32(p0[4 * g], p0[4 * g + 1], w, false); w = __builtin_amdgcn_cvt_pk_fp8_f32(p0[4 * g + 2], p0[4 * g + 3], w, true); pa[g] = w; }
#pragma unroll
  for (int g = 0; g < 4; ++g) { int w = 0; w = __builtin_amdgcn_cvt_pk_fp8_f32(p1[4 * g], p1[4 * g + 1], w, false); w = __builtin_amdgcn_cvt_pk_fp8_f32(p1[4 * g + 2], p1[4 * g + 3], w, true); pa[4 + g] = w; }
}
template <int NP>
__device__ __forceinline__ void qkt8(f32x16& p0, f32x16& p1, const char* Ks, const v8i_t* q8, int r32, int hi, int kbyte0, float m_ref) {
  { const unsigned one = hi ? 0u : 0x3F80u, nm = hi ? 0u : (unsigned)f2bf(-m_ref);
    u32x4 ka = {one, 0u, 0u, 0u}, qa = {nm, 0u, 0u, 0u};
    f32x16 z;
#pragma unroll
    for (int r = 0; r < 16; ++r) z[r] = 0.f;
    p0 = __builtin_amdgcn_mfma_f32_32x32x16_bf16(*reinterpret_cast<bf16x8*>(&ka), *reinterpret_cast<bf16x8*>(&qa), z, 0, 0, 0);
    p1 = __builtin_amdgcn_mfma_f32_32x32x16_bf16(*reinterpret_cast<bf16x8*>(&ka), *reinterpret_cast<bf16x8*>(&qa), z, 0, 0, 0); }
  const int sw = (r32 >> 1) & 7;
#pragma unroll
  for (int part = 0; part < NP; ++part) { const int c0 = (kbyte0 + part * 64 + 32 * hi) >> 4;
    const char* r0 = Ks + r32 * 128; const char* r1 = r0 + 32 * 128;
    const uint4 a0 = *reinterpret_cast<const uint4*>(r0 + ((c0 ^ sw) << 4)), a1 = *reinterpret_cast<const uint4*>(r0 + (((c0 + 1) ^ sw) << 4));
    const uint4 b0 = *reinterpret_cast<const uint4*>(r1 + ((c0 ^ sw) << 4)), b1 = *reinterpret_cast<const uint4*>(r1 + (((c0 + 1) ^ sw) << 4));
    v8i_t A0, A1; A0[0] = a0.x; A0[1] = a0.y; A0[2] = a0.z; A0[3] = a0.w; A0[4] = a1.x; A0[5] = a1.y; A0[6] = a1.z; A0[7] = a1.w;
    A1[0] = b0.x; A1[1] = b0.y; A1[2] = b0.z; A1[3] = b0.w; A1[4] = b1.x; A1[5] = b1.y; A1[6] = b1.z; A1[7] = b1.w;
    p0 = __builtin_amdgcn_mfma_scale_f32_32x32x64_f8f6f4(A0, q8[part], p0, 0, 0, 0, 0x7D7D7D7D, 0, 0x7B7B7B7B);
    p1 = __builtin_amdgcn_mfma_scale_f32_32x32x64_f8f6f4(A1, q8[part], p1, 0, 0, 0, 0x7D7D7D7D, 0, 0x7B7B7B7B); }
}
template <int NVB> __device__ __forceinline__ void pv8_all(f32x16* o, f32x16& osum, const char* v8, int r32, int hi, v8i_t pa) {
  { v8i_t ones;
#pragma unroll
    for (int g = 0; g < 8; ++g) ones[g] = 0x38383838;
    osum = __builtin_amdgcn_mfma_scale_f32_32x32x64_f8f6f4(pa, ones, osum, 0, 0, 0, 0x7F7F7F7F, 0, 0x7F7F7F7F); }
#pragma unroll
  for (int blk = 0; blk < NVB; ++blk) { const int d = blk * 32 + r32, sw = (d >> 2) & 3;
    const uint4 lo = *reinterpret_cast<const uint4*>(v8 + d * 64 + (((2 * hi) ^ sw) << 4)), hi4 = *reinterpret_cast<const uint4*>(v8 + d * 64 + (((2 * hi + 1) ^ sw) << 4));
    v8i_t bq; bq[0] = lo.x; bq[1] = lo.y; bq[2] = lo.z; bq[3] = lo.w; bq[4] = hi4.x; bq[5] = hi4.y; bq[6] = hi4.z; bq[7] = hi4.w;
    o[blk] = __builtin_amdgcn_mfma_scale_f32_32x32x64_f8f6f4(pa, bq, o[blk], 0, 0, 0, 0x7F7F7F7F, 0, 0x7C7C7C7C); }
}
template <int NP> __device__ __forceinline__ void k8_load(v8i_t (&kf)[NP][2], const char* Ks, int r32, int hi, int kbyte0) {
  const int sw = (r32 >> 1) & 7;
#pragma unroll
  for (int part = 0; part < NP; ++part) { const int c0 = (kbyte0 + part * 64 + 32 * hi) >> 4;
    const char* r0 = Ks + r32 * 128; const char* r1 = r0 + 32 * 128;
    const uint4 a0 = *reinterpret_cast<const uint4*>(r0 + ((c0 ^ sw) << 4)), a1 = *reinterpret_cast<const uint4*>(r0 + (((c0 + 1) ^ sw) << 4));
    const uint4 b0 = *reinterpret_cast<const uint4*>(r1 + ((c0 ^ sw) << 4)), b1 = *reinterpret_cast<const uint4*>(r1 + (((c0 + 1) ^ sw) << 4));
    kf[part][0][0] = a0.x; kf[part][0][1] = a0.y; kf[part][0][2] = a0.z; kf[part][0][3] = a0.w; kf[part][0][4] = a1.x; kf[part][0][5] = a1.y; kf[part][0][6] = a1.z; kf[part][0][7] = a1.w;
    kf[part][1][0] = b0.x; kf[part][1][1] = b0.y; kf[part][1][2] = b0.z; kf[part][1][3] = b0.w; kf[part][1][4] = b1.x; kf[part][1][5] = b1.y; kf[part][1][6] = b1.z; kf[part][1][7] = b1.w; }
}
template <int NP> __device__ __forceinline__ void qk8_mma(f32x16& p0, f32x16& p1, const v8i_t (&kf)[NP][2], const v8i_t* q8, int hi, float m_ref) {
  { const unsigned one = hi ? 0u : 0x3F80u, nm = hi ? 0u : (unsigned)f2bf(-m_ref);
    u32x4 ka = {one, 0u, 0u, 0u}, qa = {nm, 0u, 0u, 0u};
    f32x16 z;
#pragma unroll
    for (int r = 0; r < 16; ++r) z[r] = 0.f;
    p0 = __builtin_amdgcn_mfma_f32_32x32x16_bf16(*reinterpret_cast<bf16x8*>(&ka), *reinterpret_cast<bf16x8*>(&qa), z, 0, 0, 0);
    p1 = __builtin_amdgcn_mfma_f32_32x32x16_bf16(*reinterpret_cast<bf16x8*>(&ka), *reinterpret_cast<bf16x8*>(&qa), z, 0, 0, 0); }
#pragma unroll
  for (int part = 0; part < NP; ++part) {
    p0 = __builtin_amdgcn_mfma_scale_f32_32x32x64_f8f6f4(kf[part][0], q8[part], p0, 0, 0, 0, 0x7D7D7D7D, 0, 0x7B7B7B7B);
    p1 = __builtin_amdgcn_mfma_scale_f32_32x32x64_f8f6f4(kf[part][1], q8[part], p1, 0, 0, 0, 0x7D7D7D7D, 0, 0x7B7B7B7B); }
}
template <int NVB> __device__ __forceinline__ void v8_load(v8i_t (&vf)[NVB], const char* v8, int r32, int hi) {
#pragma unroll
  for (int blk = 0; blk < NVB; ++blk) { const int d = blk * 32 + r32, sw = (d >> 2) & 3;
    const uint4 lo = *reinterpret_cast<const uint4*>(v8 + d * 64 + (((2 * hi) ^ sw) << 4)), hi4 = *reinterpret_cast<const uint4*>(v8 + d * 64 + (((2 * hi + 1) ^ sw) << 4));
    vf[blk][0] = lo.x; vf[blk][1] = lo.y; vf[blk][2] = lo.z; vf[blk][3] = lo.w; vf[blk][4] = hi4.x; vf[blk][5] = hi4.y; vf[blk][6] = hi4.z; vf[blk][7] = hi4.w; }
}
template <int B0, int B1, int NVB> __device__ __forceinline__ void v8_load_range(v8i_t (&vf)[NVB], const char* v8, int r32, int hi) {
#pragma unroll
  for (int blk = B0; blk < B1; ++blk) { const int d = blk * 32 + r32, sw = (d >> 2) & 3;
    const uint4 lo = *reinterpret_cast<const uint4*>(v8 + d * 64 + (((2 * hi) ^ sw) << 4)), hi4 = *reinterpret_cast<const uint4*>(v8 + d * 64 + (((2 * hi + 1) ^ sw) << 4));
    vf[blk][0] = lo.x; vf[blk][1] = lo.y; vf[blk][2] = lo.z; vf[blk][3] = lo.w; vf[blk][4] = hi4.x; vf[blk][5] = hi4.y; vf[blk][6] = hi4.z; vf[blk][7] = hi4.w; }
}
template <int NVB> __device__ __forceinline__ void pv8_mma(f32x16* o, f32x16& osum, const v8i_t (&vf)[NVB], v8i_t pa) {
  { v8i_t ones;
#pragma unroll
    for (int g = 0; g < 8; ++g) ones[g] = 0x38383838;
    osum = __builtin_amdgcn_mfma_scale_f32_32x32x64_f8f6f4(pa, ones, osum, 0, 0, 0, 0x7F7F7F7F, 0, 0x7F7F7F7F); }
#pragma unroll
  for (int blk = 0; blk < NVB; ++blk) o[blk] = __builtin_amdgcn_mfma_scale_f32_32x32x64_f8f6f4(pa, vf[blk], o[blk], 0, 0, 0, 0x7F7F7F7F, 0, 0x7C7C7C7C);
}
__device__ __forceinline__ void v8_phase(const Params& p, char* smem, int bid, int nb) {
  char* ws = p.ws; bfr* T = (bfr*)smem; constexpr int LP = 520;
  const int tid = otid();
  for (int it = bid; it < 4 * 132 * 2; it += nb) {
    const int type = it & 1, t = (it >> 1) % 132, b = (it >> 1) / 132;
    const size_t r0 = (size_t)b * SEQA + (size_t)t * 64;
    const bfr* src = (type ? (const bfr*)(ws + OFF_RC) + (size_t)RTOT * 1024 : (const bfr*)(ws + OFF_RD) + (size_t)RTOT * 1536) + r0 * 512;
#pragma unroll
    for (int u = 0; u < 8; ++u) { const int e = tid + u * NTHR, row = e >> 6, ck = e & 63;
      *(uint4*)(T + row * LP + ck * 8) = *(const uint4*)(src + (size_t)row * 512 + ck * 8); }
    __syncthreads();
#pragma unroll
    for (int u = 0; u < 4; ++u) { const int task = tid + u * NTHR, c = task & 511, q4 = task >> 9, hh = q4 >> 1, kb = (q4 & 1) * 32;
      int w[4];
#pragma unroll
      for (int g = 0; g < 4; ++g) { float f[4];
#pragma unroll
        for (int e = 0; e < 4; ++e) f[e] = 8.f * bf2f(T[(kb + crow(4 * g + e, hh)) * LP + c]);
        int x = 0; x = __builtin_amdgcn_cvt_pk_fp8_f32(f[0], f[1], x, false); x = __builtin_amdgcn_cvt_pk_fp8_f32(f[2], f[3], x, true); w[g] = x; }
      char* dst = type ? ws + OFF_V8D + ((((size_t)(b * 4 + (c >> 7)) * 132 + t) * 128 + (c & 127)) << 6)
                       : ws + OFF_V8A + ((((size_t)(b * 8 + (c >> 6)) * 132 + t) * 64 + (c & 63)) << 6);
      *(int4*)(dst + q4 * 16) = make_int4(w[0], w[1], w[2], w[3]); }
    __syncthreads();
  }
}
extern __shared__ __attribute__((aligned(16))) char dyn_smem[];
__device__ __forceinline__ char* dyn_smem_base() { return dyn_smem; }
#ifndef PROBE_VAR
#define PROBE_VAR 0
#endif
#define PSYNC() do { if (VAR != 1) __syncthreads(); } while (0)
template <int TYPE, int VAR>
__device__ __forceinline__ void attn_item(const Params& p, char* lds, int h, int qrow0, int krow0, int NT, float lam) {
  const int bq_ = krow0 / SEQA, t0_ = (krow0 - bq_ * SEQA) >> 6;
  constexpr int NP = TYPE ? 1 : 2, NVB = TYPE ? 4 : 2;
  constexpr int STG = 16384, KOFF = 8192;
  const int tid = otid(), wid = __builtin_amdgcn_readfirstlane(tid >> 6), lane = tid & 63, r32 = lane & 31, hi = lane >> 5;
  const int map = TYPE ? (wid >> 2) : 0, wq = TYPE ? (wid & 3) : wid, grp = wid >> 2;
  char* ws = p.ws;
  const unsigned char* Q8 = TYPE ? (const unsigned char*)(ws + OFF_RC) + (size_t)(qrow0 + wq * 32 + r32) * 512 + h * 128 + map * 64 + hi * 32
                                 : (const unsigned char*)(ws + OFF_RD) + (size_t)(qrow0 + wq * 32 + r32) * 1024 + h * 128 + hi * 32;
  const unsigned char* Kh = TYPE ? (const unsigned char*)(ws + OFF_RC) + SZ512 + (size_t)krow0 * 512 + h * 128
                                 : (const unsigned char*)(ws + OFF_RD) + SZ768 + (size_t)krow0 * 1024 + h * 128;
  constexpr int LDKB = TYPE ? 512 : 1024;
  const char* v8g = TYPE ? (const char*)(ws + OFF_V8D) + (((size_t)(bq_ * 4 + h) * 132 + t0_) << 13)
                         : (const char*)(ws + OFF_V8A) + (((size_t)(bq_ * 8 + h) * 132 + t0_) << 12);
  const bfr* SG0 = (const bfr*)(ws + OFF_RB); bfr* OG = (bfr*)(ws + OFF_RA);
  const int kbyte0 = map * 64;
  PG8_LAS unsigned char* ldsA = (PG8_LAS unsigned char*)dyn_smem_base();
  float* al_l = (float*)(lds + 4 * STG) + wid * 32;
  float m_ref = 0.f; f32x16 o[NVB], osum, p0, p1; v8i_t q8[NP], pa, kf[NP][2], vf[NVB];
#pragma unroll
  for (int d = 0; d < NVB; ++d)
#pragma unroll
    for (int r = 0; r < 16; ++r) o[d][r] = 0.f;
#pragma unroll
  for (int r = 0; r < 16; ++r) osum[r] = 0.f;
#pragma unroll
  for (int g = 0; g < 8; ++g) pa[g] = 0;
  const int k8of = (8 * wid + (lane >> 3)) * LDKB + (((lane & 7) ^ (((8 * wid + (lane >> 3)) >> 1) & 7)) << 4);
  const int v8of = (16 * wid + (lane >> 2)) * 64 + (((lane & 3) ^ (((16 * wid + (lane >> 2)) >> 2) & 3)) << 4);
#define GLDS(gp, loff) __builtin_amdgcn_global_load_lds((const unsigned*)(gp), (PG8_LAS unsigned*)(ldsA + (loff)), 16, 0, 0)
#define STAGE_TILE(t, sg) do { \
    if (wid < NVB * 2) GLDS(v8g + (size_t)(t) * (NVB * 2048) + v8of, (unsigned)(sg) * STG + (unsigned)wid * 1024u); \
    GLDS(Kh + (size_t)(t) * 64 * LDKB + k8of, (unsigned)(sg) * STG + KOFF + (unsigned)wid * 1024u); } while (0)
#define BAR_L()  asm volatile("s_waitcnt lgkmcnt(0)\n\ts_barrier" ::: "memory")
#define BAR_VL() asm volatile("s_waitcnt vmcnt(0) lgkmcnt(0)\n\ts_barrier" ::: "memory")
  STAGE_TILE(0, 0); STAGE_TILE(1, 1);
#pragma unroll
  for (int part = 0; part < NP; ++part) { const uint4 x0 = *reinterpret_cast<const uint4*>(Q8 + part * 64), x1 = *reinterpret_cast<const uint4*>(Q8 + part * 64 + 16);
    q8[part][0] = x0.x; q8[part][1] = x0.y; q8[part][2] = x0.z; q8[part][3] = x0.w; q8[part][4] = x1.x; q8[part][5] = x1.y; q8[part][6] = x1.z; q8[part][7] = x1.w; }
  BAR_VL();
  k8_load<NP>(kf, lds + KOFF, r32, hi, kbyte0);
#pragma unroll
  for (int blk = 0; blk < NVB; ++blk)
#pragma unroll
    for (int g = 0; g < 8; ++g) vf[blk][g] = 0;
  if (grp == 1) BAR_L();
  for (int j = 0; j < NT; ++j) {
    if (j + 2 < NT) STAGE_TILE(j + 2, (j + 2) & 3);
    qk8_mma<NP>(p0, p1, kf, q8, hi, m_ref);
    if (j > 0) { if (VAR != 4) pv8_mma<NVB>(o, osum, vf, pa); }
    BAR_L();
    if (j + 1 < NT) k8_load<NP>(kf, lds + ((j + 1) & 3) * STG + KOFF, r32, hi, kbyte0);
    if constexpr (TYPE == 0) v8_load<NVB>(vf, lds + (j & 3) * STG, r32, hi); else v8_load_range<0, 2, NVB>(vf, lds + (j & 3) * STG, r32, hi);
    float alpha;
    { float pmax = p0[0];
#pragma unroll
      for (int r = 1; r < 16; ++r) pmax = fmaxf(pmax, p0[r]);
#pragma unroll
      for (int r = 0; r < 16; ++r) pmax = fmaxf(pmax, p1[r]);
      { auto rr = __builtin_amdgcn_permlane32_swap(__float_as_uint(pmax), __float_as_uint(pmax), false, false);
        pmax = fmaxf(__uint_as_float(rr[0]), __uint_as_float(rr[1])); }
      const bool first = (j == 0);
      if (!first && __builtin_expect(__all(pmax <= P_TOP), 1)) { alpha = 1.f; }
      else {
        const float mn = bf2f(f2bf(m_ref + (first ? pmax - P_REF : fmaxf(pmax - P_REF, 0.f))));
        const float delta = mn - m_ref;
        alpha = first ? 0.f : __builtin_amdgcn_exp2f(-delta);
        m_ref = mn;
#pragma unroll
        for (int r = 0; r < 16; ++r) { p0[r] = p0[r] - delta; p1[r] = p1[r] - delta; }
      }
      if (VAR != 3) {
#pragma unroll
      for (int r = 0; r < 16; ++r) p0[r] = __builtin_amdgcn_exp2f(p0[r]);
#pragma unroll
      for (int r = 0; r < 16; ++r) p1[r] = __builtin_amdgcn_exp2f(p1[r]);
      }
#pragma unroll
      for (int g = 0; g < 4; ++g) { int w = 0; w = __builtin_amdgcn_cvt_pk_fp8_f32(p0[4 * g], p0[4 * g + 1], w, false); w = __builtin_amdgcn_cvt_pk_fp8_f32(p0[4 * g + 2], p0[4 * g + 3], w, true); pa[g] = w; }
#pragma unroll
      for (int g = 0; g < 4; ++g) { int w = 0; w = __builtin_amdgcn_cvt_pk_fp8_f32(p1[4 * g], p1[4 * g + 1], w, false); w = __builtin_amdgcn_cvt_pk_fp8_f32(p1[4 * g + 2], p1[4 * g + 3], w, true); pa[4 + g] = w; }
    }
    if (__any(alpha < 1.f)) { if (hi == 0) al_l[r32] = alpha; asm volatile("s_waitcnt lgkmcnt(0)" ::: "memory");
#pragma unroll
      for (int r = 0; r < 16; ++r) { const float f_ = al_l[crow(r, hi)]; osum[r] *= f_;
#pragma unroll
        for (int d = 0; d < NVB; ++d) o[d][r] *= f_; } }
    if constexpr (TYPE == 1) v8_load_range<2, 4, NVB>(vf, lds + (j & 3) * STG, r32, hi);
    BAR_VL();
  }
  pv8_mma<NVB>(o, osum, vf, pa);
  if (grp == 0) BAR_L();
  float rli[16];
#pragma unroll
  for (int r = 0; r < 16; ++r) rli[r] = __builtin_amdgcn_rcpf(osum[r]);
  if constexpr (TYPE == 0) {
#pragma unroll
    for (int r = 0; r < 16; ++r) { const size_t row = (size_t)(qrow0 + wq * 32 + crow(r, hi)) * 1024;
#pragma unroll
      for (int d0 = 0; d0 < NVB; ++d0) { const size_t idx = row + h * 64 + d0 * 32 + r32; const bfr ov = f2bf(o[d0][r] * rli[r] * bf2f(SG0[idx]));
        if (VAR == 0) OG[idx] = ov; else asm volatile("" :: "v"((unsigned)ov)); } }
    __syncthreads();
  } else {
    float* xch = (float*)lds;
    __syncthreads();
    if (map == 1) {
#pragma unroll
      for (int r = 0; r < 16; ++r) { const float f = rli[r] * lam;
#pragma unroll
        for (int d0 = 0; d0 < 4; ++d0) xch[(wq * 32 + crow(r, hi)) * 128 + d0 * 32 + r32] = o[d0][r] * f; }
    }
    __syncthreads();
    if (map == 0) {
      const float* subg = p.subg;
#pragma unroll
      for (int r = 0; r < 16; ++r) { float ss = 0.f;
#pragma unroll
        for (int d0 = 0; d0 < 4; ++d0) { float v = o[d0][r] * rli[r] - xch[(wq * 32 + crow(r, hi)) * 128 + d0 * 32 + r32]; o[d0][r] = v; ss += v * v; }
        ss += __shfl_xor(ss, 16); ss += __shfl_xor(ss, 8); ss += __shfl_xor(ss, 4); ss += __shfl_xor(ss, 2); ss += __shfl_xor(ss, 1);
        const float rs = rsqrtf(ss * (1.f / 128.f) + 1e-6f) * 0.8f;
        const size_t row = (size_t)(qrow0 + wq * 32 + crow(r, hi)) * 1024;
#pragma unroll
        for (int d0 = 0; d0 < 4; ++d0) { const size_t idx = row + 512 + h * 128 + d0 * 32 + r32;
          const bfr ov = f2bf(o[d0][r] * rs * subg[d0 * 32 + r32] * bf2f(SG0[idx]));
          if (VAR == 0) OG[idx] = ov; else asm volatile("" :: "v"((unsigned)ov)); } }
    }
    __syncthreads();
  }
#undef GLDS
#undef STAGE_TILE
#undef BAR_L
#undef BAR_VL
}
template <int VAR>
__device__ __forceinline__ void attn_phase(const Params& p, char* smem, int bid, int nb) {
  const float lam = *(const float*)(p.ws + OFF_LAM);
  for (int it = bid; it < 2112; it += nb) {
    const int rd = it >> 8, j = it & 255;
    int type, h, qrow0, krow0, NT;
    if (rd < 4) { const int b = rd; type = 0; h = j & 7; qrow0 = b * SEQA + (j >> 3) * 256; krow0 = b * SEQA; NT = 132; }
    else if (rd < 8) { const int pair = (j & 7) + 8 * ((rd - 4) >> 1), b = pair >> 2, qt = 2 * (j >> 3) + ((rd - 4) & 1);
      type = 1; h = pair & 3; qrow0 = b * SEQA + qt * 128; krow0 = b * SEQA; NT = 132; }
    else if (j < 32) { const int b = j >> 3; type = 0; h = j & 7; qrow0 = b * SEQA + NLAT; krow0 = qrow0; NT = 4; }
    else if (j < 64) { const int pair = (j - 32) >> 1, b = pair >> 2, qt = (j - 32) & 1;
      type = 1; h = pair & 3; krow0 = b * SEQA + NLAT; qrow0 = krow0 + qt * 128; NT = 4; }
    else continue;
#ifndef ONLY_T1
    if (type == 0) attn_item<0, VAR>(p, smem, h, qrow0, krow0, NT, lam);
#endif
#ifndef ONLY_T0
    if (type == 1) attn_item<1, VAR>(p, smem, h, qrow0, krow0, NT, lam);
#endif
  }
}


constexpr int AT_LD = 264;
constexpr size_t SCAN_UF_OFF = 64 * AT_LD * 2;

template <int PASS>
__device__ __forceinline__ void scan_item(const Params& p, char* lds, int b, int c, int cg) {
  const int tid = otid(), wid = tid >> 6, lane = tid & 63, r32 = lane & 31, hi = lane >> 5;
  char* ws = p.ws;
  const bfr* U = (const bfr*)(ws + OFF_RD); const bfr* SG1 = U + (size_t)RTOT * 1024;
  bfr* AT = (bfr*)lds; float* UF = (float*)(lds + SCAN_UF_OFF);
  const int row0 = b * SEQA + c * 64;
  const int lo = c < 128 ? 0 : NLAT, hiP = c < 128 ? NLAT : SEQA;
  const int blkl = wid >> 2, blk = cg * 2 + blkl, j0 = (wid & 3) * 32;
  const int ch = cg * 256 + wid * 32 + r32;
  bf16x8 wA[8], wX[8];
#define LOADW(dir) do { const bfr* wa_ = (const bfr*)(ws + OFF_WG) + (size_t)((dir) * 16 + blk) * 16384 + (size_t)(j0 + r32) * 128 + hi * 8; \
    _Pragma("unroll") for (int ks = 0; ks < 8; ++ks) { wA[ks] = *(const bf16x8*)(wa_ + ks * 16); wX[ks] = *(const bf16x8*)(wa_ + (size_t)8 * 16384 + ks * 16); } } while (0)
  LOADW(0);
  {
    const int k8 = tid & 31, chc = cg * 256 + k8 * 8;
    float w[4][8], bia[8];
#pragma unroll
    for (int j = 0; j < 4; ++j) { float4 t0 = *(const float4*)(p.conv_w + j * 1024 + chc), t1 = *(const float4*)(p.conv_w + j * 1024 + chc + 4);
      w[j][0] = t0.x; w[j][1] = t0.y; w[j][2] = t0.z; w[j][3] = t0.w; w[j][4] = t1.x; w[j][5] = t1.y; w[j][6] = t1.z; w[j][7] = t1.w; }
    { float4 t0 = *(const float4*)(p.conv_b + chc), t1 = *(const float4*)(p.conv_b + chc + 4);
      bia[0] = t0.x; bia[1] = t0.y; bia[2] = t0.z; bia[3] = t0.w; bia[4] = t1.x; bia[5] = t1.y; bia[6] = t1.z; bia[7] = t1.w; }
#pragma unroll
    for (int ih = 0; ih < 2; ++ih) {
      uint4 uu[2][4];
#pragma unroll
      for (int i2 = 0; i2 < 2; ++i2) { const int t = (tid >> 5) + (ih * 2 + i2) * 16;
#pragma unroll
        for (int j = 0; j < 4; ++j) { int pp = c * 64 + t + j - 2; pp = pp < lo ? lo : (pp >= hiP ? hiP - 1 : pp);
          uu[i2][j] = *(const uint4*)(U + (size_t)(b * SEQA + pp) * 1024 + chc); } }
#pragma unroll
      for (int i2 = 0; i2 < 2; ++i2) { const int t = (tid >> 5) + (ih * 2 + i2) * 16; const int pt = c * 64 + t;
        float acc[8];
#pragma unroll
        for (int e = 0; e < 8; ++e) acc[e] = bia[e];
#pragma unroll
        for (int j = 0; j < 4; ++j) { const int pp = pt + j - 2; const float vm = (pp >= lo && pp < hiP) ? 1.f : 0.f; float f[8]; unpack8(uu[i2][j], f);
#pragma unroll
          for (int e = 0; e < 8; ++e) acc[e] += (w[j][e] * vm) * f[e]; }
        u32x4 pk; pk[0] = cvtpk(acc[0], acc[1]); pk[1] = cvtpk(acc[2], acc[3]); pk[2] = cvtpk(acc[4], acc[5]); pk[3] = cvtpk(acc[6], acc[7]);
        *(u32x4*)(AT + t * AT_LD + k8 * 8) = pk;
        *(float4*)(UF + t * 256 + k8 * 8) = make_float4(acc[0], acc[1], acc[2], acc[3]);
        *(float4*)(UF + t * 256 + k8 * 8 + 4) = make_float4(acc[4], acc[5], acc[6], acc[7]); }
    }
  }
  __syncthreads();
  float hsum[2][16];
#pragma unroll
  for (int dir = 0; dir < 2; ++dir) {
    f32x16 ga[2], gx[2];
#pragma unroll
    for (int mt = 0; mt < 2; ++mt)
#pragma unroll
      for (int r = 0; r < 16; ++r) { ga[mt][r] = 0.f; gx[mt][r] = 0.f; }
    const bfr* ap = AT + r32 * AT_LD + blkl * 128 + hi * 8;
    if (dir == 0 || PASS == 0) {
#pragma unroll
      for (int ks = 0; ks < 8; ++ks) {
        bf16x8 a0 = *(const bf16x8*)(ap + ks * 16), a1 = *(const bf16x8*)(ap + 32 * AT_LD + ks * 16);
        ga[0] = __builtin_amdgcn_mfma_f32_32x32x16_bf16(a0, wA[ks], ga[0], 0, 0, 0);
        ga[1] = __builtin_amdgcn_mfma_f32_32x32x16_bf16(a1, wA[ks], ga[1], 0, 0, 0);
        gx[0] = __builtin_amdgcn_mfma_f32_32x32x16_bf16(a0, wX[ks], gx[0], 0, 0, 0);
        gx[1] = __builtin_amdgcn_mfma_f32_32x32x16_bf16(a1, wX[ks], gx[1], 0, 0, 0);
      }
    } else {
      const bfr* wa_ = (const bfr*)(ws + OFF_WG) + (size_t)(16 + blk) * 16384 + (size_t)(j0 + r32) * 128 + hi * 8;
#pragma unroll 2
      for (int ks = 0; ks < 8; ++ks) {
        bf16x8 a0 = *(const bf16x8*)(ap + ks * 16), a1 = *(const bf16x8*)(ap + 32 * AT_LD + ks * 16);
        bf16x8 ba_ = *(const bf16x8*)(wa_ + ks * 16), bx_ = *(const bf16x8*)(wa_ + (size_t)8 * 16384 + ks * 16);
        ga[0] = __builtin_amdgcn_mfma_f32_32x32x16_bf16(a0, ba_, ga[0], 0, 0, 0);
        ga[1] = __builtin_amdgcn_mfma_f32_32x32x16_bf16(a1, ba_, ga[1], 0, 0, 0);
        gx[0] = __builtin_amdgcn_mfma_f32_32x32x16_bf16(a0, bx_, gx[0], 0, 0, 0);
        gx[1] = __builtin_amdgcn_mfma_f32_32x32x16_bf16(a1, bx_, gx[1], 0, 0, 0);
      }
    }
    if (dir == 0 && PASS == 0) LOADW(1);
    const float sp = log1pf(expf(-p.lru_l[dir * 1024 + ch]));
    const float kA = -8.f * sp * LOG2E, biasA = p.ga_b[dir * 1024 + ch] * -LOG2E, biasX = p.gx_b[dir * 1024 + ch] * -LOG2E;
#pragma unroll
    for (int mt = 0; mt < 2; ++mt) {
      unsigned lap[8], bpk[8];
#pragma unroll
      for (int r2 = 0; r2 < 8; ++r2) {
        float la2[2], bv2[2];
#pragma unroll
        for (int e = 0; e < 2; ++e) { const int r = r2 * 2 + e;
          const float e1 = 1.f + __builtin_amdgcn_exp2f(fmaf(ga[mt][r], -LOG2E, biasA)), e2 = 1.f + __builtin_amdgcn_exp2f(fmaf(gx[mt][r], -LOG2E, biasX));
          const float inv = __builtin_amdgcn_rcpf(e1 * e2);
          const float rr = e2 * inv, ii = e1 * inv;
          const float la = kA * rr;
          const float a = __builtin_amdgcn_exp2f(la);
          const float uc = UF[(mt * 32 + crow(r, hi)) * 256 + wid * 32 + r32];
          const float bv = __builtin_amdgcn_sqrtf(fmaxf(1.f - a * a, 0.f)) * ii * uc;
          ga[mt][r] = a; gx[mt][r] = bv; la2[e] = la; bv2[e] = bv; }
        lap[r2] = cvtpk(la2[0], la2[1]); bpk[r2] = cvtpk(bv2[0], bv2[1]);
      }
      if (c < 128) {
        char* sab = ws + OFF_SAB + ((size_t)(((b * 128 + c) * 4 + cg) * 2 + dir) * 8) * 8192 + (size_t)tid * 16;
        *(u32x4*)(sab + (mt * 2 + 0) * 8192) = u32x4{lap[0], lap[1], lap[2], lap[3]};
        *(u32x4*)(sab + (mt * 2 + 1) * 8192) = u32x4{lap[4], lap[5], lap[6], lap[7]};
        *(u32x4*)(sab + (4 + mt * 2 + 0) * 8192) = u32x4{bpk[0], bpk[1], bpk[2], bpk[3]};
        *(u32x4*)(sab + (4 + mt * 2 + 1) * 8192) = u32x4{bpk[4], bpk[5], bpk[6], bpk[7]};
      }
    }
    float sA[8], sB[8];
#pragma unroll
    for (int sgi = 0; sgi < 8; ++sgi) { const int mt = sgi >> 2, g = sgi & 3; float A = 1.f, Bv = 0.f;
#pragma unroll
      for (int e = 0; e < 4; ++e) { const int r = g * 4 + (dir ? 3 - e : e); A *= ga[mt][r]; Bv = ga[mt][r] * Bv + gx[mt][r]; }
      sA[sgi] = A; sB[sgi] = Bv; }
    const bool ownFirst = (dir == 0) == (hi == 0);
    float st, stA = 1.f;
    if (PASS == 1) st = *(const float*)(ws + OFF_HIN + ((size_t)((dir * 4 + b) * 132 + c) * 1024 + ch) * 4); else st = 0.f;
#pragma unroll
    for (int q = 0; q < 8; ++q) { const int sgi = dir ? 7 - q : q;
      const float oA = sA[sgi], oB = sB[sgi];
      const float pA = __shfl_xor(oA, 32), pB = __shfl_xor(oB, 32);
      const float fA = ownFirst ? oA : pA, fB = ownFirst ? oB : pB, sA2 = ownFirst ? pA : oA, sB2 = ownFirst ? pB : oB;
      const float A8 = fA * sA2, B8 = sA2 * fB + sB2;
      if (PASS == 1) {
        float hv = ownFirst ? st : fA * st + fB;
        const int mt = sgi >> 2, g = sgi & 3;
#pragma unroll
        for (int e = 0; e < 4; ++e) { const int r = g * 4 + (dir ? 3 - e : e); hv = ga[mt][r] * hv + gx[mt][r];
          if (dir == 0) hsum[mt][r] = hv; else hsum[mt][r] += hv; }
      }
      st = A8 * st + B8; stA *= A8;
    }
    if (PASS == 0 && hi == 0) {
      const size_t ci = ((size_t)((dir * 4 + b) * 132 + c) * 1024 + ch) * 4;
      *(float*)(ws + OFF_CA + ci) = stA; *(float*)(ws + OFF_CB + ci) = st;
    }
  }
#undef LOADW
  __syncthreads();
  if (PASS == 1) {
#pragma unroll
    for (int mt = 0; mt < 2; ++mt)
#pragma unroll
      for (int r = 0; r < 16; ++r) AT[(mt * 32 + crow(r, hi)) * AT_LD + wid * 32 + r32] = f2bf(hsum[mt][r]);
    __syncthreads();
    bfr* HG = (bfr*)(ws + OFF_RA);
    const int k8 = tid & 31, chh = cg * 256 + k8 * 8;
#pragma unroll
    for (int i = 0; i < 4; ++i) { const int t = (tid >> 5) + i * 16;
      uint4 hv = *(const uint4*)(AT + t * AT_LD + k8 * 8); uint4 gv = *(const uint4*)(SG1 + (size_t)(row0 + t) * 1024 + chh);
      float hf[8], gf[8]; unpack8(hv, hf); unpack8(gv, gf);
      u32x4 pk; pk[0] = cvtpk(hf[0] * gf[0], hf[1] * gf[1]); pk[1] = cvtpk(hf[2] * gf[2], hf[3] * gf[3]);
      pk[2] = cvtpk(hf[4] * gf[4], hf[5] * gf[5]); pk[3] = cvtpk(hf[6] * gf[6], hf[7] * gf[7]);
      *(u32x4*)(HG + ((size_t)(b * NLAT + c * 64 + t)) * 1024 + chh) = pk; }
    __syncthreads();
  }
}
template <int PASS>
__device__ __forceinline__ void scan_phase(const Params& p, char* smem, int bid, int nb) {
  const int nchunk = PASS ? 128 : 132;
  for (int it = bid; it < 4 * nchunk * 4; it += nb) { const int cg = it & 3, t2 = it >> 2, c = t2 % nchunk, b = t2 / nchunk; scan_item<PASS>(p, smem, b, c, cg); }
}
constexpr size_t SCAN_UT_OFF = SCAN_UF_OFF + (size_t)64 * 256 * 4;
constexpr size_t SCAN_CW_OFF = SCAN_UT_OFF + (size_t)80 * 512;
constexpr size_t SCAN_LDS_END = SCAN_CW_OFF + 5 * 256 * 4;
__device__ __forceinline__ void scan0_phase(const Params& p, char* lds, int bid, int nb) {
  const int tid = otid(), wid = tid >> 6, lane = tid & 63, r32 = lane & 31, hi = lane >> 5;
  char* ws = p.ws;
  const bfr* U = (const bfr*)(ws + OFF_RD);
  bfr* AT = (bfr*)lds; float* UF = (float*)(lds + SCAN_UF_OFF); const bfr* UT = (const bfr*)(lds + SCAN_UT_OFF); float* CW = (float*)(lds + SCAN_CW_OFF);
  PG8_LAS unsigned char* ldsA = (PG8_LAS unsigned char*)dyn_smem_base();
  const int nb4 = nb & ~3;
  if (bid < nb4) {
    const int cg = bid & 3, pstep = nb4 >> 2;
    const int blkl = wid >> 2, blk = cg * 2 + blkl, j0 = (wid & 3) * 32;
    const int ch = cg * 256 + wid * 32 + r32;
    float kA[2], biasA[2], biasX[2];
#pragma unroll
    for (int dir = 0; dir < 2; ++dir) { const float sp = log1pf(expf(-p.lru_l[dir * 1024 + ch]));
      kA[dir] = -8.f * sp * LOG2E; biasA[dir] = p.ga_b[dir * 1024 + ch] * -LOG2E; biasX[dir] = p.gx_b[dir * 1024 + ch] * -LOG2E; }
    for (int i = tid; i < 1280; i += NTHR) { const int j = i >> 8, cc = i & 255; CW[i] = j < 4 ? p.conv_w[j * 1024 + cg * 256 + cc] : p.conv_b[cg * 256 + cc]; }
    bf16x8 wA[8], wX[8];
#define LOADW(dir) do { const bfr* wa_ = (const bfr*)(ws + OFF_WG) + (size_t)((dir) * 16 + blk) * 16384 + (size_t)(j0 + r32) * 128 + hi * 8; \
    const bfr* wx_ = wa_ + (size_t)8 * 16384; asm volatile("" : "+v"(wa_), "+v"(wx_));     \
    _Pragma("unroll") for (int ks = 0; ks < 8; ++ks) { wA[ks] = *(const bf16x8*)(wa_ + ks * 16); wX[ks] = *(const bf16x8*)(wx_ + ks * 16); } } while (0)
#define ISSUE_UT(prn_) do { const int bn_ = (prn_) / 132, cn_ = (prn_) - bn_ * 132; const int lo_ = cn_ < 128 ? 0 : NLAT, hp_ = cn_ < 128 ? NLAT : SEQA; \
    _Pragma("unroll") for (int k_ = 0; k_ < 5; ++k_) { const int i_ = wid + 8 * k_; int pp_ = cn_ * 64 + 2 * i_ + hi - 2; pp_ = pp_ < lo_ ? lo_ : (pp_ >= hp_ ? hp_ - 1 : pp_); \
      __builtin_amdgcn_global_load_lds((const unsigned*)(U + (size_t)(bn_ * SEQA + pp_) * 1024 + cg * 256 + r32 * 8), (PG8_LAS unsigned*)(ldsA + SCAN_UT_OFF + i_ * 1024), 16, 0, 0); } } while (0)
    int pr = bid >> 2;
    if (pr < 528) { ISSUE_UT(pr); LOADW(0); }
    asm volatile("s_waitcnt vmcnt(0)" ::: "memory");
    for (; pr < 528; pr += pstep) {
      const int b = pr / 132, c = pr - b * 132;
      const int lo = c < 128 ? 0 : NLAT, hiP = c < 128 ? NLAT : SEQA;
      const int sitem = c < 128 ? (b * 128 + c) * 4 + cg : 2048 + (b * 4 + c - 128) * 4 + cg;
      __syncthreads();
      {
        const int k8 = tid & 31;
        float w[4][8], bia[8];
#pragma unroll
        for (int j = 0; j < 4; ++j) { const float4 t0 = *(const float4*)(CW + j * 256 + k8 * 8), t1 = *(const float4*)(CW + j * 256 + k8 * 8 + 4);
          w[j][0] = t0.x; w[j][1] = t0.y; w[j][2] = t0.z; w[j][3] = t0.w; w[j][4] = t1.x; w[j][5] = t1.y; w[j][6] = t1.z; w[j][7] = t1.w; }
        { const float4 t0 = *(const float4*)(CW + 1024 + k8 * 8), t1 = *(const float4*)(CW + 1024 + k8 * 8 + 4);
          bia[0] = t0.x; bia[1] = t0.y; bia[2] = t0.z; bia[3] = t0.w; bia[4] = t1.x; bia[5] = t1.y; bia[6] = t1.z; bia[7] = t1.w; }
#pragma unroll
        for (int i = 0; i < 4; ++i) { const int t = (tid >> 5) + i * 16; const int pt = c * 64 + t;
          float acc[8];
#pragma unroll
          for (int e = 0; e < 8; ++e) acc[e] = bia[e];
#pragma unroll
          for (int j = 0; j < 4; ++j) { const int pp = pt + j - 2; const float vm = (pp >= lo && pp < hiP) ? 1.f : 0.f;
            const uint4 uu = *(const uint4*)(UT + (t + j) * 256 + k8 * 8); float f[8]; unpack8(uu, f);
#pragma unroll
            for (int e = 0; e < 8; ++e) acc[e] += (w[j][e] * vm) * f[e]; }
          u32x4 pk; pk[0] = cvtpk(acc[0], acc[1]); pk[1] = cvtpk(acc[2], acc[3]); pk[2] = cvtpk(acc[4], acc[5]); pk[3] = cvtpk(acc[6], acc[7]);
          *(u32x4*)(AT + t * AT_LD + k8 * 8) = pk;
          *(float4*)(UF + t * 256 + k8 * 8) = make_float4(acc[0], acc[1], acc[2], acc[3]);
          *(float4*)(UF + t * 256 + k8 * 8 + 4) = make_float4(acc[4], acc[5], acc[6], acc[7]); }
      }
      __syncthreads();
      float comp[2];
      const int prn = pr + pstep < 528 ? pr + pstep : 527;
#pragma unroll
      for (int dir = 0; dir < 2; ++dir) {
        f32x16 ga[2], gx[2];
#pragma unroll
        for (int mt = 0; mt < 2; ++mt)
#pragma unroll
          for (int r = 0; r < 16; ++r) { ga[mt][r] = 0.f; gx[mt][r] = 0.f; }
        if (dir == 1) asm volatile("s_waitcnt vmcnt(0)" ::: "memory");
        const bfr* ap = AT + r32 * AT_LD + blkl * 128 + hi * 8;
#pragma unroll
        for (int ks = 0; ks < 8; ++ks) {
          bf16x8 a0 = *(const bf16x8*)(ap + ks * 16), a1 = *(const bf16x8*)(ap + 32 * AT_LD + ks * 16);
          ga[0] = __builtin_amdgcn_mfma_f32_32x32x16_bf16(a0, wA[ks], ga[0], 0, 0, 0);
          ga[1] = __builtin_amdgcn_mfma_f32_32x32x16_bf16(a1, wA[ks], ga[1], 0, 0, 0);
          gx[0] = __builtin_amdgcn_mfma_f32_32x32x16_bf16(a0, wX[ks], gx[0], 0, 0, 0);
          gx[1] = __builtin_amdgcn_mfma_f32_32x32x16_bf16(a1, wX[ks], gx[1], 0, 0, 0);
        }
        if (dir == 0) { ISSUE_UT(prn); asm volatile("" ::: "memory"); LOADW(1); } else LOADW(0);
        const float kA_ = kA[dir], bA_ = biasA[dir], bX_ = biasX[dir];
#pragma unroll
        for (int mt = 0; mt < 2; ++mt) {
          unsigned lap[8], bpk[8];
#pragma unroll
          for (int r2 = 0; r2 < 8; ++r2) {
            float la2[2], bv2[2];
#pragma unroll
            for (int e = 0; e < 2; ++e) { const int r = r2 * 2 + e;
              const float e1 = 1.f + __builtin_amdgcn_exp2f(fmaf(ga[mt][r], -LOG2E, bA_)), e2 = 1.f + __builtin_amdgcn_exp2f(fmaf(gx[mt][r], -LOG2E, bX_));
              const float inv = __builtin_amdgcn_rcpf(e1 * e2);
              const float rr = e2 * inv, ii = e1 * inv;
              const float la = kA_ * rr;
              const float a = __builtin_amdgcn_exp2f(la);
              const float uc = UF[(mt * 32 + crow(r, hi)) * 256 + wid * 32 + r32];
              const float bv = __builtin_amdgcn_sqrtf(fmaxf(1.f - a * a, 0.f)) * ii * uc;
              ga[mt][r] = a; gx[mt][r] = bv; la2[e] = la; bv2[e] = bv; }
            lap[r2] = cvtpk(la2[0], la2[1]); bpk[r2] = cvtpk(bv2[0], bv2[1]);
          }
          {
            char* sab = ws + OFF_SAB + ((size_t)(sitem * 2 + dir) * 8) * 8192 + (size_t)tid * 16;
            *(u32x4*)(sab + (mt * 2 + 0) * 8192) = u32x4{lap[0], lap[1], lap[2], lap[3]};
            *(u32x4*)(sab + (mt * 2 + 1) * 8192) = u32x4{lap[4], lap[5], lap[6], lap[7]};
            *(u32x4*)(sab + (4 + mt * 2 + 0) * 8192) = u32x4{bpk[0], bpk[1], bpk[2], bpk[3]};
            *(u32x4*)(sab + (4 + mt * 2 + 1) * 8192) = u32x4{bpk[4], bpk[5], bpk[6], bpk[7]};
          }
        }
        float sA[8], sB[8];
#pragma unroll
        for (int sgi = 0; sgi < 8; ++sgi) { const int mt = sgi >> 2, g = sgi & 3; float A = 1.f, Bv = 0.f;
#pragma unroll
          for (int e = 0; e < 4; ++e) { const int r = g * 4 + (dir ? 3 - e : e); A *= ga[mt][r]; Bv = ga[mt][r] * Bv + gx[mt][r]; }
          sA[sgi] = A; sB[sgi] = Bv; }
        const bool ownFirst = (dir == 0) == (hi == 0);
        float st = 0.f, stA = 1.f;
#pragma unroll
        for (int q = 0; q < 8; ++q) { const int sgi = dir ? 7 - q : q;
          const float oA = sA[sgi], oB = sB[sgi];
          const float pA = __shfl_xor(oA, 32), pB = __shfl_xor(oB, 32);
          const float fA = ownFirst ? oA : pA, fB = ownFirst ? oB : pB, sA2 = ownFirst ? pA : oA, sB2 = ownFirst ? pB : oB;
          const float A8 = fA * sA2, B8 = sA2 * fB + sB2;
          st = A8 * st + B8; stA *= A8;
        }
        comp[dir] = hi ? st : stA;
      }
#pragma unroll
      for (int dir = 0; dir < 2; ++dir) *(float*)(ws + (hi ? OFF_CB : OFF_CA) + ((size_t)((dir * 4 + b) * 132 + c) * 1024 + ch) * 4) = comp[dir];
    }
#undef LOADW
#undef ISSUE_UT
  }
  __syncthreads();
}
__device__ __forceinline__ void scan_apply_item(const Params& p, char* lds, int b, int c, int cg, int par) {
  const int tid = otid(), wid = tid >> 6, lane = tid & 63, r32 = lane & 31, hi = lane >> 5;
  char* ws = p.ws;
  const bfr* SG1 = (const bfr*)(ws + OFF_RD) + (size_t)RTOT * 1024;
  bfr* AT = (bfr*)(lds + par * (64 * AT_LD * 2));
  const int row0 = b * SEQA + c * 64;
  const int ch = cg * 256 + wid * 32 + r32;
  const char* sab = ws + OFF_SAB + ((size_t)(((b * 128 + c) * 4 + cg) * 2) * 8) * 8192 + (size_t)tid * 16;
  u32x4 pc[2][8];
#pragma unroll
  for (int dir = 0; dir < 2; ++dir)
#pragma unroll
    for (int k = 0; k < 8; ++k) pc[dir][k] = *(const u32x4*)(sab + (size_t)(dir * 8 + k) * 8192);
  float hin[2];
#pragma unroll
  for (int dir = 0; dir < 2; ++dir) hin[dir] = *(const float*)(ws + OFF_HIN + ((size_t)((dir * 4 + b) * 132 + c) * 1024 + ch) * 4);
  const int k8 = tid & 31, chh = cg * 256 + k8 * 8;
  uint4 gv[4];
#pragma unroll
  for (int i = 0; i < 4; ++i) gv[i] = *(const uint4*)(SG1 + (size_t)(row0 + (tid >> 5) + i * 16) * 1024 + chh);
  float hsum[2][16];
#pragma unroll
  for (int dir = 0; dir < 2; ++dir) {
    float ga[2][16], gx[2][16];
#pragma unroll
    for (int mt = 0; mt < 2; ++mt)
#pragma unroll
      for (int q = 0; q < 8; ++q) { const unsigned wl = pc[dir][mt * 2 + (q >> 2)][q & 3], wb = pc[dir][4 + mt * 2 + (q >> 2)][q & 3];
        ga[mt][2 * q] = __builtin_amdgcn_exp2f(__uint_as_float(wl << 16)); ga[mt][2 * q + 1] = __builtin_amdgcn_exp2f(__uint_as_float(wl & 0xffff0000u));
        gx[mt][2 * q] = __uint_as_float(wb << 16); gx[mt][2 * q + 1] = __uint_as_float(wb & 0xffff0000u); }
    float sA[8], sB[8];
#pragma unroll
    for (int sgi = 0; sgi < 8; ++sgi) { const int mt = sgi >> 2, g = sgi & 3; float A = 1.f, Bv = 0.f;
#pragma unroll
      for (int e = 0; e < 4; ++e) { const int r = g * 4 + (dir ? 3 - e : e); A *= ga[mt][r]; Bv = ga[mt][r] * Bv + gx[mt][r]; }
      sA[sgi] = A; sB[sgi] = Bv; }
    const bool ownFirst = (dir == 0) == (hi == 0);
    float st = hin[dir];
#pragma unroll
    for (int q = 0; q < 8; ++q) { const int sgi = dir ? 7 - q : q;
      const float oA = sA[sgi], oB = sB[sgi];
      const float pA = __shfl_xor(oA, 32), pB = __shfl_xor(oB, 32);
      const float fA = ownFirst ? oA : pA, fB = ownFirst ? oB : pB, sA2 = ownFirst ? pA : oA, sB2 = ownFirst ? pB : oB;
      const float A8 = fA * sA2, B8 = sA2 * fB + sB2;
      float hv = ownFirst ? st : fA * st + fB;
      const int mt = sgi >> 2, g = sgi & 3;
#pragma unroll
      for (int e = 0; e < 4; ++e) { const int r = g * 4 + (dir ? 3 - e : e); hv = ga[mt][r] * hv + gx[mt][r];
        if (dir == 0) hsum[mt][r] = hv; else hsum[mt][r] += hv; }
      st = A8 * st + B8;
    }
  }
#pragma unroll
  for (int mt = 0; mt < 2; ++mt)
#pragma unroll
    for (int r = 0; r < 16; ++r) AT[(mt * 32 + crow(r, hi)) * AT_LD + wid * 32 + r32] = f2bf(hsum[mt][r]);
  __syncthreads();
  bfr* HG = (bfr*)(ws + OFF_RD);
#pragma unroll
  for (int i = 0; i < 4; ++i) { const int t = (tid >> 5) + i * 16;
    uint4 hv = *(const uint4*)(AT + t * AT_LD + k8 * 8);
    float hf[8], gf[8]; unpack8(hv, hf); unpack8(gv[i], gf);
    u32x4 pk; pk[0] = cvtpk(hf[0] * gf[0], hf[1] * gf[1]); pk[1] = cvtpk(hf[2] * gf[2], hf[3] * gf[3]);
    pk[2] = cvtpk(hf[4] * gf[4], hf[5] * gf[5]); pk[3] = cvtpk(hf[6] * gf[6], hf[7] * gf[7]);
    *(u32x4*)(HG + ((size_t)(b * NLAT + c * 64 + t)) * 1024 + chh) = pk; }
}
__device__ __forceinline__ void scan_apply_phase(const Params& p, char* smem, int bid, int nb) {
  int par = 0;
  for (int it = bid; it < 4 * 128 * 4; it += nb, par ^= 1) { const int cg = it & 3, t2 = it >> 2, c = t2 & 127, b = t2 >> 7; scan_apply_item(p, smem, b, c, cg, par); }
  __syncthreads();
}
__device__ __forceinline__ void carry_phase(const Params& p, int bid, int nb) {
  char* ws = p.ws;
  for (int id = bid * NTHR + otid(); id < 8192; id += nb * NTHR) {
    const int ch = id & 1023, db = id >> 10, dir = db >> 2;
    const float* CA = (const float*)(ws + OFF_CA) + (size_t)db * 132 * 1024 + ch; const float* CB = (const float*)(ws + OFF_CB) + (size_t)db * 132 * 1024 + ch;
    float* HIN = (float*)(ws + OFF_HIN) + (size_t)db * 132 * 1024 + ch;
    float h = 0.f;
    for (int s0 = 0; s0 < 132; s0 += 12) {
      float a[12], bb[12];
#pragma unroll
      for (int u = 0; u < 12; ++u) { const int s = s0 + u; const int c = dir ? 131 - s : (s < 4 ? 128 + s : s - 4); a[u] = CA[(size_t)c * 1024]; bb[u] = CB[(size_t)c * 1024]; }
#pragma unroll
      for (int u = 0; u < 12; ++u) { const int s = s0 + u; const int c = dir ? 131 - s : (s < 4 ? 128 + s : s - 4); HIN[(size_t)c * 1024] = h; h = a[u] * h + bb[u]; }
    }
  }
}

__device__ __forceinline__ float ld_agent_f32(const float* p) { return __hip_atomic_load(p, __ATOMIC_RELAXED, __HIP_MEMORY_SCOPE_AGENT); }
__device__ __forceinline__ void mod_phase(const Params& p, char* smem, int bid, int nb) {
  float* sc = (float*)smem; float* red = sc + 5 * 1024;
  float* mod = (float*)(p.ws + OFF_MOD);
  const int tid = otid(), kg = tid >> 5, col = tid & 31;
  for (int it = bid; it < 192; it += nb) {
    const int l = it / 96, j0 = (it % 96) * 32;
    const float* w = p.ada_w + (size_t)l * 1024 * 3072 + (size_t)(kg * 64) * 3072 + j0 + col;
    float wv[64];
#pragma unroll
    for (int k = 0; k < 64; ++k) wv[k] = w[(size_t)k * 3072];
    for (int e = tid; e < 5120; e += NTHR) { const int mr = e >> 10, k = e & 1023; sc[e] = silu_f(mr < 4 ? p.c[mr * 1024 + k] : p.c_ctx[k]); }
    __syncthreads();
    float acc[5] = {0.f, 0.f, 0.f, 0.f, 0.f};
#pragma unroll
    for (int k = 0; k < 64; ++k) {
#pragma unroll
      for (int mr = 0; mr < 5; ++mr) acc[mr] += sc[mr * 1024 + kg * 64 + k] * wv[k]; }
#pragma unroll
    for (int mr = 0; mr < 5; ++mr) red[(kg * 5 + mr) * 32 + col] = acc[mr];
    __syncthreads();
    if (tid < 160) { const int mr = tid >> 5; float sum = 0.f;
#pragma unroll
      for (int g = 0; g < 16; ++g) sum += red[(g * 5 + mr) * 32 + col];
      mod[(l * 5 + mr) * 3072 + j0 + col] = sum + p.ada_b[l * 3072 + j0 + col]; }
    __syncthreads();
  }
  if (bid == nb - 1 && tid == 0) { float s1 = 0, s2 = 0;
    for (int i = 0; i < 64; ++i) { s1 += p.lq1[i] * p.lk1[i]; s2 += p.lq2[i] * p.lk2[i]; }
    *(float*)(p.ws + OFF_LAM) = expf(s1) - expf(s2) + 0.2f; }
}
__device__ __forceinline__ void modulate_phase(const Params& p, int bid, int nb) {
  const float* mod = (const float*)(p.ws + OFF_MOD); bfr* XM = (bfr*)(p.ws + OFF_RA);
  for (size_t idx = (size_t)bid * NTHR + otid(); idx < (size_t)RTOT * 256; idx += (size_t)nb * NTHR) {
    const int r = (int)(idx >> 8), c4 = (int)(idx & 255) * 4;
    const float* src = xrow(p.x, p.ctx, r) + c4; const int mr = modrow(r);
    const float* sh = mod + mr * 3072 + c4; const float* scp = sh + 1024;
    const float4 v = *(const float4*)src, s4 = *(const float4*)sh, c4v = *(const float4*)scp;
    uint2 o; o.x = cvtpk(v.x * (1.f + c4v.x) + s4.x, v.y * (1.f + c4v.y) + s4.y); o.y = cvtpk(v.z * (1.f + c4v.z) + s4.z, v.w * (1.f + c4v.w) + s4.w);
    *(uint2*)(XM + (size_t)r * 1024 + c4) = o;
  }
}
template <int LAYER>
__device__ __forceinline__ void ln_phase(const Params& p, int bid, int nb) {
  const float* mod = (const float*)(p.ws + OFF_MOD);
  const int lane = otid() & 63, wv = otid() >> 6;
  const int nrows = LAYER ? B_ * NLAT : RTOT;
  const float* lng = p.ln_g + LAYER * 1024; const float* lnb = p.ln_b + LAYER * 1024;
  const int stride = nb * 8;
  for (int r0 = bid * 8 + wv; r0 < nrows; r0 += 2 * stride) {
    float v[2][16]; float s[2]; int mrs[2], pps[2]; float* orows[2]; int rr[2]; bool ok[2];
#pragma unroll
    for (int u = 0; u < 2; ++u) {
      int r = r0 + u * stride; ok[u] = r < nrows; if (!ok[u]) r = r0; rr[u] = r;
      int b, pp, mr; const float* xin; const bfr* Y; float* orow;
      if (LAYER == 0) { b = r / SEQA; pp = r - b * SEQA; mr = pp < NLAT ? b : 4; xin = xrow(p.x, p.ctx, r); Y = (const bfr*)(p.ws + OFF_RC) + (size_t)r * 1024;
        orow = p.out + ((size_t)(b * NLAT + (pp < NLAT ? pp : 0))) * 1024; }
      else { b = r / NLAT; pp = 0; mr = b; orow = p.out + (size_t)r * 1024; xin = orow; Y = (const bfr*)(p.ws + OFF_RB) + (size_t)r * 1024; }
      mrs[u] = mr; pps[u] = pp; orows[u] = orow;
      const float* g = mod + (LAYER * 5 + mr) * 3072 + 2048;
      float sacc = 0.f;
#pragma unroll
      for (int i = 0; i < 4; ++i) { const int c = i * 256 + lane * 4;
        const float4 xv = *(const float4*)(xin + c), gv = *(const float4*)(g + c); const uint2 yv = *(const uint2*)(Y + c);
        v[u][i * 4 + 0] = ALPHA * xv.x + gv.x * __uint_as_float(yv.x << 16); v[u][i * 4 + 1] = ALPHA * xv.y + gv.y * __uint_as_float(yv.x & 0xffff0000u);
        v[u][i * 4 + 2] = ALPHA * xv.z + gv.z * __uint_as_float(yv.y << 16); v[u][i * 4 + 3] = ALPHA * xv.w + gv.w * __uint_as_float(yv.y & 0xffff0000u);
        sacc += v[u][i * 4] + v[u][i * 4 + 1] + v[u][i * 4 + 2] + v[u][i * 4 + 3]; }
      s[u] = sacc;
    }
#pragma unroll
    for (int u = 0; u < 2; ++u) {
      float su = s[u];
      for (int o = 32; o; o >>= 1) su += __shfl_xor(su, o);
      const float mu = su * (1.f / 1024.f); float q = 0.f;
#pragma unroll
      for (int i = 0; i < 16; ++i) { const float d = v[u][i] - mu; q += d * d; }
      for (int o = 32; o; o >>= 1) q += __shfl_xor(q, o);
      const float rs = rsqrtf(q * (1.f / 1024.f) + 1e-6f);
      const float* sh1 = mod + (5 + mrs[u]) * 3072; const float* sc1 = sh1 + 1024;
      if (ok[u]) {
#pragma unroll
        for (int i = 0; i < 4; ++i) { const int c = i * 256 + lane * 4;
          const float4 gg = *(const float4*)(lng + c), bb = *(const float4*)(lnb + c);
          float4 y; y.x = (v[u][i * 4] - mu) * rs * gg.x + bb.x; y.y = (v[u][i * 4 + 1] - mu) * rs * gg.y + bb.y;
          y.z = (v[u][i * 4 + 2] - mu) * rs * gg.z + bb.z; y.w = (v[u][i * 4 + 3] - mu) * rs * gg.w + bb.w;
          if (LAYER == 1 || pps[u] < NLAT) *(float4*)(orows[u] + c) = y;
          if (LAYER == 0) { const float4 s1 = *(const float4*)(sh1 + c), c1 = *(const float4*)(sc1 + c);
            uint2 o; o.x = cvtpk(y.x * (1.f + c1.x) + s1.x, y.y * (1.f + c1.y) + s1.y); o.y = cvtpk(y.z * (1.f + c1.z) + s1.z, y.w * (1.f + c1.w) + s1.w);
            *(uint2*)((bfr*)(p.ws + OFF_RA) + (size_t)rr[u] * 1024 + c) = o; } }
      }
    }
  }
}

constexpr size_t OFF_BAR = 131072;
#define XB_TMO      128
#define XB_XCNT(j)  (256  + 64 * (j))
#define XB_XSUB(j)  (1280 + 64 * (j))
#define XB_XGEN(j)  (2304 + 64 * (j))
#define XB_TOP      3328
#define XB_TOPGEN   3392
#define XCD_BAR_WORDS 3456
#define XB_SPIN_CAP (1u << 22)
#define LAS __attribute__((address_space(3)))
__device__ __forceinline__ unsigned xb_ld(unsigned* p)              { return __hip_atomic_load(p, __ATOMIC_RELAXED, __HIP_MEMORY_SCOPE_AGENT); }
__device__ __forceinline__ unsigned xb_add(unsigned* p, unsigned v) { return __hip_atomic_fetch_add(p, v, __ATOMIC_RELAXED, __HIP_MEMORY_SCOPE_AGENT); }
__device__ __forceinline__ unsigned xb_xcc_id() { return (unsigned)__builtin_amdgcn_s_getreg((3 << 11) | 20) & 0xFu; }
#define XB_SPIN(cond, bar) do { unsigned _sp = 0; while (cond) { __builtin_amdgcn_s_sleep(1); \
    if ((++_sp & 255u) == 0u) { if (xb_ld(&(bar)[XB_TMO])) break; if (_sp > XB_SPIN_CAP) { atomicAdd(&(bar)[XB_TMO], 1u); break; } } } } while (0)
struct XcdBarrier { unsigned* bar; unsigned x; volatile LAS unsigned* st; };
__device__ __forceinline__ XcdBarrier xcd_barrier_post(unsigned* bar, volatile LAS unsigned* st) {
  XcdBarrier b; b.bar = bar; b.x = xb_xcc_id(); b.st = st;
  if (threadIdx.x == 0) (void)xb_add(&bar[XB_XCNT(b.x)], 1u);
  return b;
}
__device__ __forceinline__ void xcd_barrier_complete(unsigned* bar, unsigned x, unsigned& nloc, unsigned& nx) {
  const unsigned G = gridDim.x * gridDim.y * gridDim.z;
  unsigned sum, cnt, mine, sp = 0u;
  for (;;) {
    sum = 0u; cnt = 0u; mine = 0u;
#pragma unroll
    for (unsigned j = 0; j < 16; ++j) { const unsigned c = xb_ld(&bar[XB_XCNT(j)]); sum += c; cnt += (c > 0u) ? 1u : 0u; mine = (j == x) ? c : mine; }
    if (sum == G) break;
    __builtin_amdgcn_s_sleep(1);
    if ((++sp & 255u) == 0u) { if (xb_ld(&bar[XB_TMO])) break; if (sp > XB_SPIN_CAP) { atomicAdd(&bar[XB_TMO], 1u); break; } }
  }
  nloc = mine > 0u ? mine : 1u; nx = cnt > 0u ? cnt : 1u;
}
__device__ __forceinline__ void xcd_barrier(const XcdBarrier& b) {
  asm volatile("s_waitcnt vmcnt(0)" ::: "memory");
  __syncthreads();
  if (threadIdx.x == 0) {
    unsigned* bar = b.bar;
    __builtin_amdgcn_s_waitcnt(0);
    unsigned nloc = b.st[0], nx = b.st[1];
    if (nloc == 0u) { xcd_barrier_complete(bar, b.x, nloc, nx); b.st[0] = nloc; b.st[1] = nx; }
    const unsigned old = xb_add(&bar[XB_XSUB(b.x)], 1u);
    const unsigned gen = old / nloc;
    if (old + 1u == (gen + 1u) * nloc) {
      __builtin_amdgcn_fence(__ATOMIC_RELEASE, "agent");
      asm volatile("s_waitcnt vmcnt(0)" ::: "memory");
      const unsigned og = xb_add(&bar[XB_TOP], 1u);
      const unsigned tg = og / nx;
      if (og + 1u == (tg + 1u) * nx) xb_add(&bar[XB_TOPGEN], 1u);
      else XB_SPIN(xb_ld(&bar[XB_TOPGEN]) == tg, bar);
      __builtin_amdgcn_fence(__ATOMIC_ACQUIRE, "agent");
      xb_add(&bar[XB_XGEN(b.x)], 1u);
      asm volatile("s_waitcnt vmcnt(0)" ::: "memory");
    } else {
      XB_SPIN(xb_ld(&bar[XB_XGEN(b.x)]) == gen, bar);
      __builtin_amdgcn_fence(__ATOMIC_ACQUIRE, "agent");
      asm volatile("s_waitcnt vmcnt(0)" ::: "memory");
    }
  }
  __syncthreads();
}

namespace cg = cooperative_groups;
constexpr size_t XST_OFF = SCAN_LDS_END > SMEM_BYTES ? SCAN_LDS_END : SMEM_BYTES;
constexpr size_t SMEM_TOTAL = XST_OFF + 16;
__global__ __launch_bounds__(512, 2) void fwd_megakernel(Params p) {
  cg::grid_group grid = cg::this_grid();
  const int bid = blockIdx.x, nb = gridDim.x;
  char* smem = dyn_smem; char* ws = p.ws;
  PG8_LAS unsigned char* glds = (PG8_LAS unsigned char*)dyn_smem;
  volatile LAS unsigned* xst = (volatile LAS unsigned*)(smem + XST_OFF);
  if (threadIdx.x == 0) { xst[0] = 0u; xst[1] = 0u; }
  __syncthreads();
  const XcdBarrier xb = xcd_barrier_post((unsigned*)(ws + OFF_BAR), xst);
#ifndef PROBE_DOUBLE
#define PROBE_DOUBLE -1
#endif
#define REP(n) for (int rep_ = 0; rep_ < ((PROBE_DOUBLE == (n)) ? 2 : 1); ++rep_)
  REP(0) { mod_phase(p, smem, bid, nb);
  prep_phase(p, smem, (bid + nb - 192) % nb, nb); }
  grid.sync();
  REP(1) modulate_phase(p, bid, nb);
  xcd_barrier(xb);
  REP(2) { pg8::EZ e{}; e.ws = ws; pg8::StaticOrder S; S.init(RTOT, 3328, nb, bid);
    pg8::gemm_phase<pg8::EZ, pg8::StaticOrder, false>(glds, pg8::Gemm{(const bfr*)(ws + OFF_RA), (const bfr*)(ws + OFF_WIN0), RTOT, 3328, 1024}, S, e, nullptr); }
  xcd_barrier(xb);
  REP(3) { { pg8::EQ e{}; e.ws = ws; pg8::StaticOrder S; S.init(RTOT, 768, nb, bid);
      pg8::gemm_phase<pg8::EQ, pg8::StaticOrder, false>(glds, pg8::Gemm{(const bfr*)(ws + OFF_RE), (const bfr*)(ws + OFF_WUQ), RTOT, 768, 384}, S, e, nullptr); }
    { pg8::EKV e{}; e.ws = ws; pg8::StaticOrder S; S.init(RTOT, 1024, nb, (bid + 140) % nb);
      pg8::gemm_phase<pg8::EKV, pg8::StaticOrder, false>(glds, pg8::Gemm{(const bfr*)(ws + OFF_RE) + (size_t)RTOT * 384, (const bfr*)(ws + OFF_WUKV), RTOT, 1024, 256}, S, e, nullptr); } }
  xcd_barrier(xb);
  v8_phase(p, smem, bid, nb);
  xcd_barrier(xb);
  attn_phase<0>(p, smem, bid, nb);
#if PROBE_DOUBLE == 4
  xcd_barrier(xb);
  attn_phase<PROBE_VAR>(p, smem, bid, nb);
#endif
  xcd_barrier(xb);
  REP(5) { pg8::EStore e{}; e.C = (bfr*)(ws + OFF_RC); e.ldc = 1024; pg8::StaticOrder S; S.init(RTOT, 1024, nb, bid);
    pg8::gemm_phase<pg8::EStore, pg8::StaticOrder, false>(glds, pg8::Gemm{(const bfr*)(ws + OFF_RA), (const bfr*)(ws + OFF_WOUT0), RTOT, 1024, 1024}, S, e, nullptr); }
  xcd_barrier(xb);
  REP(6) ln_phase<0>(p, bid, nb);
  xcd_barrier(xb);
  REP(7) { pg8::EUG e{}; e.U = (bfr*)(ws + OFF_RD); e.SG1 = e.U + (size_t)RTOT * 1024; pg8::StaticOrder S; S.init(RTOT, 2048, nb, bid);
    pg8::gemm_phase<pg8::EUG, pg8::StaticOrder, false>(glds, pg8::Gemm{(const bfr*)(ws + OFF_RA), (const bfr*)(ws + OFF_WIN1), RTOT, 2048, 1024}, S, e, nullptr); }
  xcd_barrier(xb);
  REP(8) scan0_phase(p, smem, bid, nb);
  xcd_barrier(xb);
  REP(9) carry_phase(p, bid, nb);
  xcd_barrier(xb);
  REP(10) scan_apply_phase(p, smem, bid, nb);
  xcd_barrier(xb);
  REP(11) { pg8::EStore e{}; e.C = (bfr*)(ws + OFF_RB); e.ldc = 1024; pg8::StaticOrder S; S.init(B_ * NLAT, 1024, nb, bid);
    pg8::gemm_phase<pg8::EStore, pg8::StaticOrder, false>(glds, pg8::Gemm{(const bfr*)(ws + OFF_RD), (const bfr*)(ws + OFF_WOUT1), B_ * NLAT, 1024, 1024}, S, e, nullptr); }
  xcd_barrier(xb);
  ln_phase<1>(p, bid, nb);
}

extern "C" void kernel_launch(void* const* d_in, const int* in_sizes, int n_in, void* d_out, int out_size, void* d_ws, size_t ws_size, hipStream_t stream) {
  Params P{};
  { const float** pp = (const float**)&P; for (int i = 0; i < 28; ++i) pp[i] = (const float*)d_in[i]; }
  P.out = (float*)d_out; P.ws = (char*)d_ws;
  if (ws_size < WS_END || n_in < 28) return;
  static int grid_blocks = 0;
  if (!grid_blocks) {
    (void)hipFuncSetAttribute((const void*)fwd_megakernel, hipFuncAttributeMaxDynamicSharedMemorySize, (int)SMEM_TOTAL);
    int dev = 0, cus = 0, per_cu = 0;
    (void)hipGetDevice(&dev);
    (void)hipDeviceGetAttribute(&cus, hipDeviceAttributeMultiprocessorCount, dev);
    (void)hipOccupancyMaxActiveBlocksPerMultiprocessor(&per_cu, (const void*)fwd_megakernel, NTHR, SMEM_TOTAL);
    if (per_cu > 1) per_cu = 1;
    grid_blocks = cus * per_cu;
    if (grid_blocks <= 0) grid_blocks = 256;
  }
  (void)hipMemsetAsync((char*)d_ws + OFF_BAR, 0, XCD_BAR_WORDS * 4, stream);
  void* args[] = {&P};
  (void)hipLaunchCooperativeKernel((const void*)fwd_megakernel, dim3(grid_blocks), dim3(NTHR), args, SMEM_TOTAL, stream);
}
```

```cpp
#include <hip/hip_runtime.h>
#include <hip/hip_bf16.h>
#include <hip/hip_cooperative_groups.h>
#include <stdint.h>

typedef unsigned short bfr;

constexpr int B_ = 4, NLAT = 8192, NCTX = 256, SEQA = NLAT + NCTX, RTOT = B_ * SEQA, DM = 1024;
constexpr float ALPHA = 1.4142135623730951f;
constexpr float LOG2E = 1.4426950408889634f;
constexpr float QSC_A = 0.10206207261596577f * LOG2E;
constexpr float QSC_D = 0.125f * LOG2E;

constexpr size_t SZ1024 = (size_t)RTOT * 1024 * 2;
constexpr size_t SZ512  = (size_t)RTOT * 512 * 2;
constexpr size_t SZ768  = (size_t)RTOT * 768 * 2;
constexpr size_t OFF_MOD = 0;
constexpr size_t OFF_LAM = 122880;
constexpr size_t OFF_RA = (size_t)24 << 20;
constexpr size_t OFF_RB = OFF_RA + SZ1024;
constexpr size_t OFF_RC = OFF_RB + SZ1024;
constexpr size_t OFF_RE = OFF_RC + 3 * SZ512;
constexpr size_t OFF_RD = OFF_RE + SZ1024;
constexpr size_t CARRY_SZ = (size_t)2 * 4 * 132 * 1024 * 4;
constexpr size_t OFF_CA = OFF_RD + 2 * SZ1024, OFF_CB = OFF_CA + CARRY_SZ, OFF_HIN = OFF_CB + CARRY_SZ;
constexpr size_t WS_END = OFF_HIN + CARRY_SZ;
constexpr size_t OFF_SAB = OFF_RA;
static_assert(OFF_SAB + (size_t)2048 * 131072 <= OFF_RD, "SAB overflows into U/SG1");

__device__ __forceinline__ float bf2f(bfr h) { return __uint_as_float(((unsigned)h) << 16); }
__device__ __forceinline__ bfr f2bf(float f) { unsigned u = __float_as_uint(f); u += 0x7fffu + ((u >> 16) & 1u); return (bfr)(u >> 16); }
__device__ __forceinline__ float silu_f(float x) { return x / (1.f + expf(-x)); }
__device__ __forceinline__ float sigmoid_f(float x) { return 1.f / (1.f + expf(-x)); }
__device__ __forceinline__ const float* xrow(const float* x, const float* ctx, int r) {
  int b = r / SEQA, p = r - b * SEQA;
  return p < NLAT ? x + ((size_t)(b * NLAT + p)) * DM : ctx + ((size_t)(b * NCTX + (p - NLAT))) * DM;
}
__device__ __forceinline__ int modrow(int r) { int b = r / SEQA, p = r - b * SEQA; return p < NLAT ? b : 4; }

__device__ __forceinline__ void unpack8(uint4 u, float* f) {
  f[0] = __uint_as_float(u.x << 16); f[1] = __uint_as_float(u.x & 0xffff0000u);
  f[2] = __uint_as_float(u.y << 16); f[3] = __uint_as_float(u.y & 0xffff0000u);
  f[4] = __uint_as_float(u.z << 16); f[5] = __uint_as_float(u.z & 0xffff0000u);
  f[6] = __uint_as_float(u.w << 16); f[7] = __uint_as_float(u.w & 0xffff0000u);
}
using bf16x8 = __attribute__((ext_vector_type(8))) short;
using s16x4  = __attribute__((ext_vector_type(4))) short;
using f32x16 = __attribute__((ext_vector_type(16))) float;
using u32x4  = __attribute__((ext_vector_type(4))) unsigned;
constexpr int NTHR = 512;
constexpr size_t OFF_ROPED = (size_t)1 << 20;
constexpr size_t OFF_ROPEA = (size_t)3 << 20;
constexpr size_t OFF_WT    = (size_t)4 << 20;
constexpr size_t OFF_WIN0  = OFF_WT;
constexpr size_t OFF_WUQ   = OFF_WIN0 + (size_t)3328 * 1024 * 2;
constexpr size_t OFF_WUKV  = OFF_WUQ + (size_t)768 * 384 * 2;
constexpr size_t OFF_WOUT0 = OFF_WUKV + (size_t)1024 * 256 * 2;
constexpr size_t OFF_WIN1  = OFF_WOUT0 + (size_t)1024 * 1024 * 2;
constexpr size_t OFF_WG    = OFF_WIN1 + (size_t)2048 * 1024 * 2;
constexpr size_t OFF_WOUT1 = OFF_WG + (size_t)32 * 128 * 128 * 2;
static_assert(OFF_WOUT1 + (size_t)1024 * 1024 * 2 <= OFF_RA, "weights overflow");
constexpr size_t SMEM_BYTES = 131072;
constexpr size_t OFF_PSQ = OFF_RE + ((size_t)48 << 20);
constexpr size_t OFF_V8A = OFF_RE;
constexpr size_t OFF_V8D = OFF_RE + ((size_t)20 << 20);

__device__ __forceinline__ int otid() { int t = threadIdx.x; asm volatile("" : "+v"(t)); return t; }
__device__ __forceinline__ int crow(int r, int hi) { return (r & 3) + 8 * (r >> 2) + 4 * hi; }

struct Params {
  const float *x, *c, *ctx, *c_ctx, *ada_w, *ada_b, *ln_g, *ln_b, *e_w_in, *e_qg, *e_w_uq, *e_kvg, *e_w_ukv, *lq1, *lk1, *lq2, *lk2, *subg, *e_w_out,
      *o_w_in, *conv_w, *conv_b, *ga_w, *ga_b, *gx_w, *gx_b, *lru_l, *o_w_out;
  float* out; char* ws;
};

__device__ __forceinline__ int colmap(int MODE, int nd) {
  if (MODE == 0) return nd;
  if (MODE == 1) {
    if (nd < 1024) { const int base = nd < 512 ? 672 : 1184; const int x = nd & 511, tl = x >> 8, y = x & 255, bj = y >> 7, g = (y >> 5) & 3, i = y & 31;
      return base + (tl * 4 + g) * 64 + bj * 32 + i; }
    if (nd < 1536) return 1696 + (nd - 1024);
    if (nd < 2560) return 2208 + (nd - 1536);
    if (nd < 2816) return nd - 2560;
    if (nd < 2944) return 256 + (nd - 2816);
    if (nd < 3072) return 384 + (nd - 2944);
    const int x = nd - 3072;
    if (x < 64) return 512 + x;
    if (x < 80) return 640 + (x - 64);
    if (x < 128) return -1;
    if (x < 192) return 576 + (x - 128);
    if (x < 208) return 656 + (x - 192);
    return -1;
  }
  if (nd < 512) return (nd >> 6) * 96 + (nd & 63);
  if (nd < 640) return ((nd - 512) >> 4) * 96 + 64 + ((nd - 512) & 15);
  return ((nd - 640) >> 4) * 96 + 80 + ((nd - 640) & 15);
}
template <int MODE>
__device__ __forceinline__ void wt_convert(const float* __restrict__ src, int K, int ldsrc, int Nd, bfr* __restrict__ dst, const float* __restrict__ kscale,
                           float* lds, int bid, int nb) {
  const int tid = otid(), tk = K >> 6, tn = Nd >> 6;
  const int j = tid & 63, i0 = tid >> 6;
  for (int t = bid; t < tk * tn; t += nb) {
    const int k0 = (t % tk) << 6, n0 = (t / tk) << 6;
    const int ns = colmap(MODE, n0 + j);
    float v[8];
#pragma unroll
    for (int u = 0; u < 8; ++u) v[u] = ns >= 0 ? src[(size_t)(k0 + i0 + 8 * u) * ldsrc + ns] : 0.f;
    if (kscale) {
#pragma unroll
      for (int u = 0; u < 8; ++u) v[u] *= kscale[k0 + i0 + 8 * u]; }
#pragma unroll
    for (int u = 0; u < 8; ++u) lds[j * 65 + i0 + 8 * u] = v[u];
    __syncthreads();
#pragma unroll
    for (int u = 0; u < 8; ++u) dst[(size_t)(n0 + i0 + 8 * u) * K + k0 + j] = f2bf(lds[(i0 + 8 * u) * 65 + j]);
    __syncthreads();
  }
}
__device__ __forceinline__ void prep_phase(const Params& p, char* smem, int bid, int nb) {
  float* lds = (float*)smem; char* ws = p.ws;
  wt_convert<1>(p.e_w_in, 1024, 3232, 3328, (bfr*)(ws + OFF_WIN0), nullptr, lds, bid, nb);
  wt_convert<2>(p.e_w_uq, 384, 768, 768, (bfr*)(ws + OFF_WUQ), p.e_qg, lds, bid, nb);
  wt_convert<0>(p.e_w_ukv, 256, 1024, 1024, (bfr*)(ws + OFF_WUKV), p.e_kvg, lds, bid, nb);
  wt_convert<0>(p.e_w_out, 1024, 1024, 1024, (bfr*)(ws + OFF_WOUT0), nullptr, lds, bid, nb);
  wt_convert<0>(p.o_w_in, 1024, 2048, 2048, (bfr*)(ws + OFF_WIN1), nullptr, lds, bid, nb);
  wt_convert<0>(p.o_w_out, 1024, 1024, 1024, (bfr*)(ws + OFF_WOUT1), nullptr, lds, bid, nb);
  { bfr* wg = (bfr*)(ws + OFF_WG);
    for (int d = bid * NTHR + otid(); d < 32 * 16384; d += nb * NTHR) {
      const int i = d & 7, lane = (d >> 3) & 63, ks = (d >> 9) & 7, jt = (d >> 12) & 3, blk = (d >> 14) & 7, gate = (d >> 17) & 1, dir = d >> 18;
      const int n = jt * 32 + (lane & 31), k = ks * 16 + (lane >> 5) * 8 + i;
      wg[d] = f2bf(((gate ? p.gx_w : p.ga_w) + ((size_t)dir * 8 + blk) * 128 * 128)[k * 128 + n]); } }
  float2* rd = (float2*)(ws + OFF_ROPED); float2* ra = (float2*)(ws + OFF_ROPEA);
  for (int e = bid * NTHR + otid(); e < 8192 * 32; e += nb * NTHR) { int pos = e >> 5, i = e & 31;
    float pp = (i < 16) ? (float)(pos >> 6) : (float)(pos & 63); float fr = powf(10000.f, -(float)(i & 15) / 16.f);
    float sn, cs; sincosf(pp * fr, &sn, &cs); rd[e] = make_float2(cs, sn); }
  for (int e = bid * NTHR + otid(); e < 8192 * 16; e += nb * NTHR) { int pos = e >> 4, i = e & 15;
    float pp = (i < 8) ? (float)(pos >> 6) : (float)(pos & 63); float fr = powf(10000.f, -(float)(i & 7) / 8.f);
    float sn, cs; sincosf(pp * fr, &sn, &cs); ra[e] = make_float2(cs, sn); }
}

namespace pg8 {
#define PG8_LAS __attribute__((address_space(3)))
typedef unsigned short bf16_t;
typedef short bf16x8 __attribute__((ext_vector_type(8)));
typedef float f32x4 __attribute__((ext_vector_type(4)));
typedef unsigned u32x4 __attribute__((ext_vector_type(4)));
constexpr int BM = 256, BK = 64, HALF = 128, HTB = HALF * BK * 2  , STAGE_BYTES = 8 * HTB, NXCD = 8, WGM = 8;

__host__ __device__ __forceinline__ int lds_byte(int r, int c) { const int st = (r >> 4) * 2 + (c >> 5), rr = r & 15, cc = c & 31, ob = rr * 64 + cc * 2; return st * 1024 + (ob ^ (((ob >> 9) & 1) << 5)); }
__host__ __device__ __forceinline__ void stage_rc(int b, int& R, int& C) { const int st = b / 1024, sb = b % 1024, swz = sb ^ (((sb >> 9) & 1) << 5); R = (st >> 1) * 16 + swz / 64; C = (st & 1) * 32 + (swz % 64) / 2; }
__host__ __device__ __forceinline__ int perm32(int rho) { const int n = rho >> 4, i = rho & 15; return 8 * (i >> 2) + 4 * n + (i & 3); }

struct Unit { int pm, pn; };
struct Gemm { const bf16_t* A; const bf16_t* Bt; int M, N, K; };

struct StaticOrder {
    int nM, nN, nwg, G, c;
    __host__ __device__ void init(int M, int N, int G_, int c_) { nM = M / BM; nN = N / BM; nwg = nM * nN; G = G_; c = c_; }
    __host__ __device__ bool next(int i, Unit& u) const {
        const long L = (long)i * G + c; if (L >= nwg) return false;
        int wgid = (int)L; { const int q = nwg / NXCD, r = nwg % NXCD, xcd = wgid % NXCD, off = wgid / NXCD; wgid = (xcd < r ? xcd * (q + 1) : r * (q + 1) + (xcd - r) * q) + off; }
        const int nig = WGM * nN, gid = wgid / nig, fm = gid * WGM, gsz = (nM - fm) < WGM ? (nM - fm) : WGM;
        u.pm = fm + ((wgid % nig) % gsz); u.pn = (wgid % nig) / gsz; return true;
    }
    __device__ __forceinline__ void a_ready(const Unit&) const {}
    __device__ __forceinline__ void done(const Unit&) const {}
};

__device__ __forceinline__ unsigned cvt_pk_bf16(float lo, float hi) { unsigned r; asm volatile("v_cvt_pk_bf16_f32 %0, %1, %2" : "=v"(r) : "v"(lo), "v"(hi)); return r; }
__device__ __forceinline__ u32x4 pack8(const float* v) { u32x4 w; w.x = cvt_pk_bf16(v[0], v[1]); w.y = cvt_pk_bf16(v[2], v[3]); w.z = cvt_pk_bf16(v[4], v[5]); w.w = cvt_pk_bf16(v[6], v[7]); return w; }
__device__ __forceinline__ uint2 pack8_fp8(const float* v, float sc) {
  int a = 0, b = 0;
  a = __builtin_amdgcn_cvt_pk_fp8_f32(v[0] * sc, v[1] * sc, a, false); a = __builtin_amdgcn_cvt_pk_fp8_f32(v[2] * sc, v[3] * sc, a, true);
  b = __builtin_amdgcn_cvt_pk_fp8_f32(v[4] * sc, v[5] * sc, b, false); b = __builtin_amdgcn_cvt_pk_fp8_f32(v[6] * sc, v[7] * sc, b, true);
  return make_uint2((unsigned)a, (unsigned)b); }
constexpr float Q8S = 16.f, K8S = 4.f;
__device__ __forceinline__ void get8(const f32x4 (&a)[2], float* v) { v[0] = a[0][0]; v[1] = a[0][1]; v[2] = a[0][2]; v[3] = a[0][3]; v[4] = a[1][0]; v[5] = a[1][1]; v[6] = a[1][2]; v[7] = a[1][3]; }
__device__ __forceinline__ void rope8(float* x1, float* x2, const float2* tab, bool lat, float sc) {
  float cs[8], sn[8];
  if (lat) { const float4* t4 = (const float4*)tab;
#pragma unroll
    for (int i = 0; i < 4; ++i) { const float4 t = t4[i]; cs[2 * i] = t.x; sn[2 * i] = t.y; cs[2 * i + 1] = t.z; sn[2 * i + 1] = t.w; } }
  else {
#pragma unroll
    for (int i = 0; i < 8; ++i) { cs[i] = 1.f; sn[i] = 0.f; } }
#pragma unroll
  for (int i = 0; i < 8; ++i) { const float a = x1[i], b = x2[i]; x1[i] = (a * cs[i] - b * sn[i]) * sc; x2[i] = (b * cs[i] + a * sn[i]) * sc; }
}
struct EStore { static constexpr bool PERM = true, AFTER_DRAIN = false; bf16_t* C; int ldc;
  __device__ __forceinline__ void operator()(const f32x4 (&acc)[2][2][4][2], const Unit& u, int wr, int wc, int fr_, int fq_) const {
    int fr = fr_, fq = fq_; asm volatile("" : "+v"(fr), "+v"(fq));
    const int row0 = u.pm * BM + wr * 64 + fr, col0 = u.pn * BM + wc * 32 + 8 * fq;
#pragma unroll
    for (int ai = 0; ai < 2; ++ai)
#pragma unroll
      for (int m = 0; m < 4; ++m) { bf16_t* rowp = C + (size_t)(row0 + ai * HALF + m * 16) * ldc + col0;
#pragma unroll
        for (int bj = 0; bj < 2; ++bj) { float v[8]; get8(acc[ai][bj][m], v); *(u32x4*)(rowp + bj * HALF) = pack8(v); } }
  } };
struct EUG { static constexpr bool PERM = true, AFTER_DRAIN = false; bf16_t *U, *SG1;
  __device__ __forceinline__ void operator()(const f32x4 (&acc)[2][2][4][2], const Unit& u, int wr, int wc, int fr_, int fq_) const {
    int fr = fr_, fq = fq_; asm volatile("" : "+v"(fr), "+v"(fq));
    const bool g = u.pn >= 4; bf16_t* C = g ? SG1 : U;
    const int row0 = u.pm * BM + wr * 64 + fr, col0 = (u.pn & 3) * BM + wc * 32 + 8 * fq;
#pragma unroll
    for (int ai = 0; ai < 2; ++ai)
#pragma unroll
      for (int m = 0; m < 4; ++m) { bf16_t* rowp = C + (size_t)(row0 + ai * HALF + m * 16) * 1024 + col0;
#pragma unroll
        for (int bj = 0; bj < 2; ++bj) { float v[8]; get8(acc[ai][bj][m], v);
          if (g) {
#pragma unroll
            for (int i = 0; i < 8; ++i) v[i] = silu_f(v[i]); }
          *(u32x4*)(rowp + bj * HALF) = pack8(v); } }
  } };
struct EZ { static constexpr bool PERM = true, AFTER_DRAIN = false; char* ws;
  __device__ __forceinline__ void operator()(const f32x4 (&acc)[2][2][4][2], const Unit& u, int wr, int wc, int fr_, int fq_) const {
    int fr = fr_, fq = fq_; asm volatile("" : "+v"(fr), "+v"(fq));
    const int pn = u.pn, row0 = u.pm * BM + wr * 64 + fr, p00 = (u.pm * BM) % SEQA + wr * 64 + fr; const bool lat = ((u.pm * BM) % SEQA) < NLAT;
    const int c8 = wc * 32 + 8 * fq;
    if (pn < 4) {
      unsigned char* C = (unsigned char*)(ws + OFF_RC) + (pn >= 2 ? SZ512 : 0); const float sc = pn < 2 ? QSC_D * Q8S : K8S;
      const int tcol = ((pn & 1) * 4 + wc) * 64 + 8 * fq; const float2* rd = (const float2*)(ws + OFF_ROPED) + 8 * fq;
#pragma unroll
      for (int ai = 0; ai < 2; ++ai)
#pragma unroll
        for (int m = 0; m < 4; ++m) { const int ro = ai * HALF + m * 16; float x1[8], x2[8]; get8(acc[ai][0][m], x1); get8(acc[ai][1][m], x2);
          rope8(x1, x2, rd + (size_t)(p00 + ro) * 32, lat, sc);
          unsigned char* d = C + (size_t)(row0 + ro) * 512 + tcol; *(uint2*)d = pack8_fp8(x1, 1.f); *(uint2*)(d + 32) = pack8_fp8(x2, 1.f); }
    } else if (pn < 6) {
      bf16_t* C = (bf16_t*)(ws + OFF_RC) + (size_t)RTOT * 1024 + (pn - 4) * BM + c8;
#pragma unroll
      for (int ai = 0; ai < 2; ++ai)
#pragma unroll
        for (int m = 0; m < 4; ++m)
#pragma unroll
          for (int bj = 0; bj < 2; ++bj) { float v[8]; get8(acc[ai][bj][m], v); *(u32x4*)(C + (size_t)(row0 + ai * HALF + m * 16) * 512 + bj * HALF) = pack8(v); }
    } else if (pn < 10) {
      bf16_t* C = (bf16_t*)(ws + OFF_RB) + (pn - 6) * BM + c8;
#pragma unroll
      for (int ai = 0; ai < 2; ++ai)
#pragma unroll
        for (int m = 0; m < 4; ++m)
#pragma unroll
          for (int bj = 0; bj < 2; ++bj) { float v[8]; get8(acc[ai][bj][m], v);
#pragma unroll
            for (int i = 0; i < 8; ++i) v[i] = silu_f(v[i]);
            *(u32x4*)(C + (size_t)(row0 + ai * HALF + m * 16) * 1024 + bj * HALF) = pack8(v); }
    } else {
      bf16_t* Zq = (bf16_t*)(ws + OFF_RE); bf16_t* Zkv = Zq + (size_t)RTOT * 384; float* PSQ = (float*)(ws + OFF_PSQ);
#pragma unroll
      for (int ai = 0; ai < 2; ++ai)
#pragma unroll
        for (int m = 0; m < 4; ++m) { const int ro = ai * HALF + m * 16; const size_t row = (size_t)(row0 + ro);
#pragma unroll
          for (int bj = 0; bj < 2; ++bj) { float v[8]; get8(acc[ai][bj][m], v);
            bf16_t* d = nullptr;
            if (pn == 10) d = Zq + row * 384 + bj * HALF + c8;
            else if (pn == 11) d = bj ? Zkv + row * 256 + c8 : Zq + row * 384 + 256 + c8;
            else if (wc < 2) d = Zkv + row * 256 + (bj ? 192 : 128) + c8;
            if (d) { *(u32x4*)d = pack8(v);
              float ss = 0.f;
#pragma unroll
              for (int i = 0; i < 8; ++i) ss += v[i] * v[i];
              ss += __shfl_xor(ss, 16); ss += __shfl_xor(ss, 32);
              if (fq == 0) PSQ[row * 24 + (pn - 10) * 8 + bj * 4 + wc] = ss; } }
          if (pn == 12 && wc == 2 && fq < 2) { float x1[8], x2[8]; get8(acc[ai][0][m], x1); get8(acc[ai][1][m], x2);
            rope8(x1, x2, (const float2*)(ws + OFF_ROPEA) + (size_t)(p00 + ro) * 16 + 8 * fq, lat, K8S);
            const uint2 o1 = pack8_fp8(x1, 1.f), o2 = pack8_fp8(x2, 1.f); unsigned char* ka = (unsigned char*)(ws + OFF_RD) + SZ768 + row * 1024 + 64 + 8 * fq;
#pragma unroll
            for (int h = 0; h < 8; ++h) { *(uint2*)(ka + h * 128) = o1; *(uint2*)(ka + h * 128 + 16) = o2;
              *(uint4*)(ka + h * 128 + 32 - 8 * fq + 16 * fq) = make_uint4(0u, 0u, 0u, 0u); } } }
    }
  } };
struct EQ { static constexpr bool PERM = true, AFTER_DRAIN = false; char* ws;
  __device__ __forceinline__ void operator()(const f32x4 (&acc)[2][2][4][2], const Unit& u, int wr, int wc, int fr_, int fq_) const {
    int fr = fr_, fq = fq_; asm volatile("" : "+v"(fr), "+v"(fq));
    const int pn = u.pn, row0 = u.pm * BM + wr * 64 + fr, p00 = (u.pm * BM) % SEQA + wr * 64 + fr; const bool lat = ((u.pm * BM) % SEQA) < NLAT;
    unsigned char* Q8 = (unsigned char*)(ws + OFF_RD); const float* PSQ = (const float*)(ws + OFF_PSQ);
#pragma unroll
    for (int ai = 0; ai < 2; ++ai)
#pragma unroll
      for (int m = 0; m < 4; ++m) { const int ro = ai * HALF + m * 16; const size_t row = (size_t)(row0 + ro);
        const float4* ps = (const float4*)(PSQ + row * 24); const float4 s0 = ps[0], s1 = ps[1], s2 = ps[2];
        const float rq = rsqrtf((s0.x + s0.y + s0.z + s0.w + s1.x + s1.y + s1.z + s1.w + s2.x + s2.y + s2.z + s2.w) * (1.f / 384.f) + 1e-6f) * QSC_A;
        if (pn < 2) {
#pragma unroll
          for (int bj = 0; bj < 2; ++bj) { float v[8]; get8(acc[ai][bj][m], v);
#pragma unroll
            for (int i = 0; i < 8; ++i) v[i] *= rq;
            const int col = pn * BM + bj * HALF + wc * 32 + 8 * fq; *(uint2*)(Q8 + row * 1024 + (col >> 6) * 128 + (col & 63)) = pack8_fp8(v, Q8S); }
        } else { float x1[8], x2[8]; get8(acc[ai][0][m], x1); get8(acc[ai][1][m], x2);
          const int idx = wc * 32 + 8 * fq, h = idx >> 4, i0 = idx & 15;
          rope8(x1, x2, (const float2*)(ws + OFF_ROPEA) + (size_t)(p00 + ro) * 16 + i0, lat, rq);
          unsigned char* d = Q8 + row * 1024 + h * 128 + 64 + i0; *(uint2*)d = pack8_fp8(x1, Q8S); *(uint2*)(d + 16) = pack8_fp8(x2, Q8S);
          *(uint4*)(Q8 + row * 1024 + h * 128 + 96 + 2 * i0) = make_uint4(0u, 0u, 0u, 0u); } }
  } };
struct EKV { static constexpr bool PERM = true, AFTER_DRAIN = false; char* ws;
  __device__ __forceinline__ void operator()(const f32x4 (&acc)[2][2][4][2], const Unit& u, int wr, int wc, int fr_, int fq_) const {
    int fr = fr_, fq = fq_; asm volatile("" : "+v"(fr), "+v"(fq));
    const int pn = u.pn, row0 = u.pm * BM + wr * 64 + fr, c8 = wc * 32 + 8 * fq;
    unsigned char* K8 = (unsigned char*)(ws + OFF_RD) + SZ768; bf16_t* VA = (bf16_t*)(ws + OFF_RD) + (size_t)RTOT * 1536; const float* PSQ = (const float*)(ws + OFF_PSQ);
#pragma unroll
    for (int ai = 0; ai < 2; ++ai)
#pragma unroll
      for (int m = 0; m < 4; ++m) { const size_t row = (size_t)(row0 + ai * HALF + m * 16);
        const float4 s0 = *(const float4*)(PSQ + row * 24 + 12); const float2 s1 = *(const float2*)(PSQ + row * 24 + 16), s2 = *(const float2*)(PSQ + row * 24 + 20);
        const float rk = rsqrtf((s0.x + s0.y + s0.z + s0.w + s1.x + s1.y + s2.x + s2.y) * (1.f / 256.f) + 1e-6f);
#pragma unroll
        for (int bj = 0; bj < 2; ++bj) { float v[8]; get8(acc[ai][bj][m], v);
#pragma unroll
          for (int i = 0; i < 8; ++i) v[i] *= rk;
          const int h = pn * 2 + bj;
          if (c8 < 64) *(uint2*)(K8 + row * 1024 + h * 128 + c8) = pack8_fp8(v, K8S);
          else *(u32x4*)(VA + row * 512 + h * 64 + (c8 - 64)) = pack8(v); } }
  } };

template <class Epi, class Sched, bool STAMP = false>
__device__ __forceinline__ void gemm_phase(PG8_LAS unsigned char* lds, const Gemm g, const Sched& S, const Epi& E, unsigned long long* stamps) {
    const int tid = otid(), wid = __builtin_amdgcn_readfirstlane(tid >> 6), lane = tid & 63, wr = wid >> 2, wc = wid & 3, fr = lane & 15, fq = lane >> 4;
    int K_ = g.K; asm volatile("" : "+s"(K_));
    const int K = K_, nt = K / BK;
    int ts_lo = 0, ts_hi = 0, nts = 0; const unsigned long long rt_entry = STAMP ? (unsigned long long)wall_clock64() : 0ull;
#define PG8_STAMP() do { if (STAMP && wid == 0 && nts < 64) { const unsigned long long _c = (unsigned long long)clock64(); \
        ts_lo = (lane == nts) ? (int)(unsigned)_c : ts_lo; ts_hi = (lane == nts) ? (int)(unsigned)(_c >> 32) : ts_hi; ++nts; } } while (0)
    PG8_STAMP();
    unsigned voffA[2], voffB[2];
#pragma unroll
    for (int i = 0; i < 2; ++i) { int R, C; stage_rc(tid * 16 + i * 8192, R, C); const int Rb = Epi::PERM ? ((R & ~31) + perm32(R & 31)) : R;
        voffA[i] = (unsigned)(R * K + C) * 2u; voffB[i] = (unsigned)(Rb * K + C) * 2u; }
    const size_t kstep = (size_t)(BK * 2);
    const size_t hstep = (size_t)HALF * K * 2;
    const size_t tstep = 2 * hstep;
    const unsigned ldsw = (unsigned)wid * 1024u;
    const int aoff = lds_byte(wr * 64 + fr, fq * 8), boff = lds_byte(wc * 32 + fr, fq * 8);
#define PG8_SA(b, h) (((b) * 2 + (h)) * HTB)
#define PG8_SB(b, h) ((4 + (b) * 2 + (h)) * HTB)
#define PG8_STAGE(bufoff, gbase, voff) do { _Pragma("unroll") for (int _i = 0; _i < 2; ++_i) \
        __builtin_amdgcn_global_load_lds((const unsigned*)((const char*)(gbase) + (voff)[_i]), (PG8_LAS unsigned*)(lds + (bufoff) + ldsw + _i * 8192), 16, 0, 0); } while (0)
#define PG8_LDA(dst, b, h) do { _Pragma("unroll") for (int m = 0; m < 4; ++m) _Pragma("unroll") for (int k = 0; k < 2; ++k) dst[m][k] = *(const PG8_LAS bf16x8*)(lds + PG8_SA(b, h) + aoff + m * 2048 + k * 1024); } while (0)
#define PG8_LDB(dst, b, h) do { _Pragma("unroll") for (int n = 0; n < 2; ++n) _Pragma("unroll") for (int k = 0; k < 2; ++k) dst[n][k] = *(const PG8_LAS bf16x8*)(lds + PG8_SB(b, h) + boff + n * 2048 + k * 1024); } while (0)
#define PG8_MMA(ai, bj, At, Bt) do { __builtin_amdgcn_s_setprio(1); _Pragma("unroll") for (int m = 0; m < 4; ++m) _Pragma("unroll") for (int n = 0; n < 2; ++n) _Pragma("unroll") for (int k = 0; k < 2; ++k) \
        acc[ai][bj][m][n] = __builtin_amdgcn_mfma_f32_16x16x32_bf16(Bt[n][k], At[m][k], acc[ai][bj][m][n], 0, 0, 0); __builtin_amdgcn_s_setprio(0); } while (0)
#define PG8_WAIT_V(n) asm volatile("s_waitcnt vmcnt(" #n ")" ::: "memory")
#define PG8_WAIT_L(n) asm volatile("s_waitcnt lgkmcnt(" #n ")" ::: "memory")
#define PG8_BAR __builtin_amdgcn_s_barrier()
#define PG8_SCHED __builtin_amdgcn_sched_barrier(0)
    Unit cur, nxt; int ui = 0;
    if (!S.next(0, cur)) return;
    f32x4 acc[2][2][4][2];
#pragma unroll
    for (int a = 0; a < 2; ++a)
#pragma unroll
        for (int b = 0; b < 2; ++b)
#pragma unroll
            for (int m = 0; m < 4; ++m)
#pragma unroll
                for (int n = 0; n < 2; ++n) acc[a][b][m][n] = (f32x4){0.f, 0.f, 0.f, 0.f};
    bf16x8 At[4][2], B0[2][2], B1[2][2];
    const char* cA = (const char*)g.A + (size_t)cur.pm * tstep; const char* cB = (const char*)g.Bt + (size_t)cur.pn * tstep;
    S.a_ready(cur);
    PG8_STAGE(PG8_SB(0, 0), cB, voffB); PG8_STAGE(PG8_SA(0, 0), cA, voffA); PG8_STAGE(PG8_SB(0, 1), cB + hstep, voffB); PG8_STAGE(PG8_SA(0, 1), cA + hstep, voffA);
    if (wr == 1) PG8_BAR;
    PG8_WAIT_V(4); PG8_BAR;
    PG8_STAGE(PG8_SB(1, 0), cB + kstep, voffB); PG8_STAGE(PG8_SA(1, 0), cA + kstep, voffA); PG8_STAGE(PG8_SB(1, 1), cB + hstep + kstep, voffB);
    PG8_WAIT_V(6); PG8_BAR;
    PG8_STAMP();
    for (;;) {
        const bool has_next = S.next(ui + 1, nxt);
        const char* nA = has_next ? (const char*)g.A + (size_t)nxt.pm * tstep : cA; const char* nB = has_next ? (const char*)g.Bt + (size_t)nxt.pn * tstep : cB;
        for (int t = 0; t < nt; t += 2) {
            const bool last = (t == nt - 2);
            const char* a1 = cA + (size_t)(t + 1) * kstep;
            const char* a2 = last ? nA : cA + (size_t)(t + 2) * kstep; const char* b2 = last ? nB : cB + (size_t)(t + 2) * kstep;
            const char* a3 = a2 + kstep; const char* b3 = b2 + kstep;
            if (last && has_next) S.a_ready(nxt);
            PG8_LDB(B0, 0, 0); PG8_SCHED; PG8_LDA(At, 0, 0); PG8_STAGE(PG8_SA(1, 1), a1 + hstep, voffA);
            PG8_WAIT_L(8); PG8_BAR; PG8_WAIT_L(0); PG8_MMA(0, 0, At, B0); PG8_BAR; PG8_SCHED;
            PG8_LDB(B1, 0, 1); PG8_STAGE(PG8_SB(0, 0), b2, voffB);
            PG8_BAR; PG8_WAIT_L(0); PG8_MMA(0, 1, At, B1); PG8_BAR;
            PG8_LDA(At, 0, 1); PG8_STAGE(PG8_SA(0, 0), a2, voffA);
            PG8_BAR; PG8_WAIT_L(0); PG8_MMA(1, 0, At, B0); PG8_BAR; PG8_SCHED;
            PG8_STAGE(PG8_SB(0, 1), b2 + hstep, voffB);
            PG8_WAIT_V(6); PG8_BAR; PG8_MMA(1, 1, At, B1); PG8_BAR;
            PG8_LDB(B0, 1, 0); PG8_SCHED; PG8_LDA(At, 1, 0); PG8_STAGE(PG8_SA(0, 1), a2 + hstep, voffA);
            PG8_WAIT_L(8); PG8_BAR; PG8_WAIT_L(0); PG8_MMA(0, 0, At, B0); PG8_BAR; PG8_SCHED;
            PG8_LDB(B1, 1, 1); PG8_STAGE(PG8_SB(1, 0), b3, voffB);
            PG8_BAR; PG8_WAIT_L(0); PG8_MMA(0, 1, At, B1); PG8_BAR;
            PG8_LDA(At, 1, 1); PG8_STAGE(PG8_SA(1, 0), a3, voffA);
            PG8_BAR; PG8_WAIT_L(0); PG8_MMA(1, 0, At, B0); PG8_BAR; PG8_SCHED;
            PG8_STAGE(PG8_SB(1, 1), b3 + hstep, voffB);
            PG8_WAIT_V(6); PG8_BAR; PG8_MMA(1, 1, At, B1); PG8_BAR;
        }
        PG8_STAMP();
        if constexpr (!Epi::AFTER_DRAIN) { E(acc, cur, wr, wc, fr, fq); S.done(cur); }
        PG8_STAMP();
        if (!has_next) break;
#pragma unroll
        for (int a = 0; a < 2; ++a)
#pragma unroll
            for (int b = 0; b < 2; ++b)
#pragma unroll
                for (int m = 0; m < 4; ++m)
#pragma unroll
                    for (int n = 0; n < 2; ++n) acc[a][b][m][n] = (f32x4){0.f, 0.f, 0.f, 0.f};
        cur = nxt; cA = nA; cB = nB; ++ui;
    }
    PG8_WAIT_V(0);
    if (wr == 0) PG8_BAR;
    PG8_BAR;
    if constexpr (Epi::AFTER_DRAIN) { E.fused(acc, cur, wr, wc, fr, fq, lds, wid, lane); S.done(cur); }
    PG8_STAMP();
    if (STAMP && wid == 0) { stamps[lane] = lane < nts ? (((unsigned long long)(unsigned)ts_hi << 32) | (unsigned)ts_lo) : 0ull;
        if (lane == 62) stamps[62] = rt_entry; if (lane == 63) stamps[63] = (unsigned long long)wall_clock64(); }
#undef PG8_STAMP
#undef PG8_SA
#undef PG8_SB
#undef PG8_STAGE
#undef PG8_LDA
#undef PG8_LDB
#undef PG8_MMA
#undef PG8_WAIT_V
#undef PG8_WAIT_L
#undef PG8_BAR
#undef PG8_SCHED
}
}

constexpr int SHM_KV = 64 * 256;
#ifndef ATT_AUG
#define ATT_AUG 1
#endif
constexpr float THR2 = 11.5f;
#define KSWZ(row, colB) ((row) * 256 + ((colB) ^ (((row) & 15) << 4)))
#define SBAR() __builtin_amdgcn_sched_barrier(0)
__device__ __forceinline__ unsigned cvtpk(float lo, float hi) { unsigned r; asm volatile("v_cvt_pk_bf16_f32 %0, %1, %2" : "=v"(r) : "v"(lo), "v"(hi)); return r; }
constexpr float P_TOP = 8.f, P_REF = 2.f;
typedef int v8i_t __attribute__((ext_vector_type(8)));
template <bool FIRST, int VAR, bool ALLEXP = false>
__device__ __forceinline__ void partialSM(f32x16& p0, f32x16& p1, float& m_ref, float& alpha) {
  if (VAR == 3) { alpha = 1.f; return; }
  float pmax = p0[0];
#pragma unroll
  for (int r = 1; r < 16; ++r) pmax = fmaxf(pmax, p0[r]);
#pragma unroll
  for (int r = 0; r < 16; ++r) pmax = fmaxf(pmax, p1[r]);
  { auto rr = __builtin_amdgcn_permlane32_swap(__float_as_uint(pmax), __float_as_uint(pmax), false, false);
    pmax = fmaxf(__uint_as_float(rr[0]), __uint_as_float(rr[1])); }
  if (!FIRST && __builtin_expect(__all(pmax <= P_TOP), 1)) { alpha = 1.f; }
  else {
    const float mn = bf2f(f2bf(m_ref + (FIRST ? pmax - P_REF : fmaxf(pmax - P_REF, 0.f))));
    const float delta = mn - m_ref;
    alpha = FIRST ? 0.f : __builtin_amdgcn_exp2f(-delta);
    m_ref = mn;
#pragma unroll
    for (int r = 0; r < 16; ++r) p0[r] = p0[r] - delta;
#pragma unroll
    for (int r = 0; r < 16; ++r) p1[r] = p1[r] - delta;
  }
#pragma unroll
  for (int r = 0; r < 16; ++r) p0[r] = __builtin_amdgcn_exp2f(p0[r]);
  if (ALLEXP) {
#pragma unroll
    for (int r = 0; r < 16; ++r) p1[r] = __builtin_amdgcn_exp2f(p1[r]);
  }
}
template <int VAR, bool ALLEXP = false>
__device__ __forceinline__ void finishSM(f32x16& p0, f32x16& p1, v8i_t& pa) {
  if (VAR != 3 && !ALLEXP) {
#pragma unroll
  for (int r = 0; r < 16; ++r) p1[r] = __builtin_amdgcn_exp2f(p1[r]);
  }
#pragma unroll
  for (int g = 0; g < 4; ++g) { int w = 0; w = __builtin_amdgcn_cvt_pk_fp8_f32(p0[4 * g], p0[4 * g + 1], w, false); w = __builtin_amdgcn_cvt_pk_fp8_f32(p0[4 * g + 2], p0[4 * g + 3], w, true); pa[g] = w; }
#pragma unroll
  for (int g = 0; g < 4; ++g) { int w = 0; w = __builtin_amdgcn_cvt_pk_fp8_f32(p1[4 * g], p1[4 * g + 1], w, false); w = __builtin_amdgcn_cvt_pk_fp8_f32(p1[4 * g + 2], p1[4 * g + 3], w, true); pa[4 + g] = w; }
}
template <int NP>
__device__ __forceinline__ void qkt8(f32x16& p0, f32x16& p1, const char* Ks, const v8i_t* q8, int r32, int hi, int kbyte0, float m_ref) {
  { const unsigned one = hi ? 0u : 0x3F80u, nm = hi ? 0u : (unsigned)f2bf(-m_ref);
    u32x4 ka = {one, 0u, 0u, 0u}, qa = {nm, 0u, 0u, 0u};
    f32x16 z;
#pragma unroll
    for (int r = 0; r < 16; ++r) z[r] = 0.f;
    p0 = __builtin_amdgcn_mfma_f32_32x32x16_bf16(*reinterpret_cast<bf16x8*>(&ka), *reinterpret_cast<bf16x8*>(&qa), z, 0, 0, 0);
    p1 = __builtin_amdgcn_mfma_f32_32x32x16_bf16(*reinterpret_cast<bf16x8*>(&ka), *reinterpret_cast<bf16x8*>(&qa), z, 0, 0, 0); }
  const int sw = (r32 >> 1) & 7;
#pragma unroll
  for (int part = 0; part < NP; ++part) { const int c0 = (kbyte0 + part * 64 + 32 * hi) >> 4;
    const char* r0 = Ks + r32 * 128; const char* r1 = r0 + 32 * 128;
    const uint4 a0 = *reinterpret_cast<const uint4*>(r0 + ((c0 ^ sw) << 4)), a1 = *reinterpret_cast<const uint4*>(r0 + (((c0 + 1) ^ sw) << 4));
    const uint4 b0 = *reinterpret_cast<const uint4*>(r1 + ((c0 ^ sw) << 4)), b1 = *reinterpret_cast<const uint4*>(r1 + (((c0 + 1) ^ sw) << 4));
    v8i_t A0, A1; A0[0] = a0.x; A0[1] = a0.y; A0[2] = a0.z; A0[3] = a0.w; A0[4] = a1.x; A0[5] = a1.y; A0[6] = a1.z; A0[7] = a1.w;
    A1[0] = b0.x; A1[1] = b0.y; A1[2] = b0.z; A1[3] = b0.w; A1[4] = b1.x; A1[5] = b1.y; A1[6] = b1.z; A1[7] = b1.w;
    p0 = __builtin_amdgcn_mfma_scale_f32_32x32x64_f8f6f4(A0, q8[part], p0, 0, 0, 0, 0x7D7D7D7D, 0, 0x7B7B7B7B);
    p1 = __builtin_amdgcn_mfma_scale_f32_32x32x64_f8f6f4(A1, q8[part], p1, 0, 0, 0, 0x7D7D7D7D, 0, 0x7B7B7B7B); }
}
template <int NVB> __device__ __forceinline__ void pv8_all(f32x16* o, f32x16& osum, const char* v8, int r32, int hi, v8i_t pa) {
  { v8i_t ones;
#pragma unroll
    for (int g = 0; g < 8; ++g) ones[g] = 0x38383838;
    osum = __builtin_amdgcn_mfma_scale_f32_32x32x64_f8f6f4(pa, ones, osum, 0, 0, 0, 0x7F7F7F7F, 0, 0x7F7F7F7F); }
#pragma unroll
  for (int blk = 0; blk < NVB; ++blk) { const int d = blk * 32 + r32, sw = (d >> 2) & 3;
    const uint4 lo = *reinterpret_cast<const uint4*>(v8 + d * 64 + (((2 * hi) ^ sw) << 4)), hi4 = *reinterpret_cast<const uint4*>(v8 + d * 64 + (((2 * hi + 1) ^ sw) << 4));
    v8i_t bq; bq[0] = lo.x; bq[1] = lo.y; bq[2] = lo.z; bq[3] = lo.w; bq[4] = hi4.x; bq[5] = hi4.y; bq[6] = hi4.z; bq[7] = hi4.w;
    o[blk] = __builtin_amdgcn_mfma_scale_f32_32x32x64_f8f6f4(pa, bq, o[blk], 0, 0, 0, 0x7F7F7F7F, 0, 0x7C7C7C7C); }
}
template <int NP> __device__ __forceinline__ void k8_load(v8i_t (&kf)[NP][2], const char* Ks, int r32, int hi, int kbyte0) {
  const int sw = (r32 >> 1) & 7;
#pragma unroll
  for (int part = 0; part < NP; ++part) { const int c0 = (kbyte0 + part * 64 + 32 * hi) >> 4;
    const char* r0 = Ks + r32 * 128; const char* r1 = r0 + 32 * 128;
    const uint4 a0 = *reinterpret_cast<const uint4*>(r0 + ((c0 ^ sw) << 4)), a1 = *reinterpret_cast<const uint4*>(r0 + (((c0 + 1) ^ sw) << 4));
    const uint4 b0 = *reinterpret_cast<const uint4*>(r1 + ((c0 ^ sw) << 4)), b1 = *reinterpret_cast<const uint4*>(r1 + (((c0 + 1) ^ sw) << 4));
    kf[part][0][0] = a0.x; kf[part][0][1] = a0.y; kf[part][0][2] = a0.z; kf[part][0][3] = a0.w; kf[part][0][4] = a1.x; kf[part][0][5] = a1.y; kf[part][0][6] = a1.z; kf[part][0][7] = a1.w;
    kf[part][1][0] = b0.x; kf[part][1][1] = b0.y; kf[part][1][2] = b0.z; kf[part][1][3] = b0.w; kf[part][1][4] = b1.x; kf[part][1][5] = b1.y; kf[part][1][6] = b1.z; kf[part][1][7] = b1.w; }
}
template <int NP> __device__ __forceinline__ void qk8_mma(f32x16& p0, f32x16& p1, const v8i_t (&kf)[NP][2], const v8i_t* q8, int hi, float m_ref) {
  { const unsigned one = hi ? 0u : 0x3F80u, nm = hi ? 0u : (unsigned)f2bf(-m_ref);
    u32x4 ka = {one, 0u, 0u, 0u}, qa = {nm, 0u, 0u, 0u};
    f32x16 z;
#pragma unroll
    for (int r = 0; r < 16; ++r) z[r] = 0.f;
    p0 = __builtin_amdgcn_mfma_f32_32x32x16_bf16(*reinterpret_cast<bf16x8*>(&ka), *reinterpret_cast<bf16x8*>(&qa), z, 0, 0, 0);
    p1 = __builtin_amdgcn_mfma_f32_32x32x16_bf16(*reinterpret_cast<bf16x8*>(&ka), *reinterpret_cast<bf16x8*>(&qa), z, 0, 0, 0); }
#pragma unroll
  for (int part = 0; part < NP; ++part) {
    p0 = __builtin_amdgcn_mfma_scale_f32_32x32x64_f8f6f4(kf[part][0], q8[part], p0, 0, 0, 0, 0x7D7D7D7D, 0, 0x7B7B7B7B);
    p1 = __builtin_amdgcn_mfma_scale_f32_32x32x64_f8f6f4(kf[part][1], q8[part], p1, 0, 0, 0, 0x7D7D7D7D, 0, 0x7B7B7B7B); }
}
template <int NVB> __device__ __forceinline__ void v8_load(v8i_t (&vf)[NVB], const char* v8, int r32, int hi) {
#pragma unroll
  for (int blk = 0; blk < NVB; ++blk) { const int d = blk * 32 + r32, sw = (d >> 2) & 3;
    const uint4 lo = *reinterpret_cast<const uint4*>(v8 + d * 64 + (((2 * hi) ^ sw) << 4)), hi4 = *reinterpret_cast<const uint4*>(v8 + d * 64 + (((2 * hi + 1) ^ sw) << 4));
    vf[blk][0] = lo.x; vf[blk][1] = lo.y; vf[blk][2] = lo.z; vf[blk][3] = lo.w; vf[blk][4] = hi4.x; vf[blk][5] = hi4.y; vf[blk][6] = hi4.z; vf[blk][7] = hi4.w; }
}
template <int B0, int B1, int NVB> __device__ __forceinline__ void v8_load_range(v8i_t (&vf)[NVB], const char* v8, int r32, int hi) {
#pragma unroll
  for (int blk = B0; blk < B1; ++blk) { const int d = blk * 32 + r32, sw = (d >> 2) & 3;
    const uint4 lo = *reinterpret_cast<const uint4*>(v8 + d * 64 + (((2 * hi) ^ sw) << 4)), hi4 = *reinterpret_cast<const uint4*>(v8 + d * 64 + (((2 * hi + 1) ^ sw) << 4));
    vf[blk][0] = lo.x; vf[blk][1] = lo.y; vf[blk][2] = lo.z; vf[blk][3] = lo.w; vf[blk][4] = hi4.x; vf[blk][5] = hi4.y; vf[blk][6] = hi4.z; vf[blk][7] = hi4.w; }
}
template <int NVB> __device__ __forceinline__ void pv8_mma(f32x16* o, f32x16& osum, const v8i_t (&vf)[NVB], v8i_t pa) {
  { v8i_t ones;
#pragma unroll
    for (int g = 0; g < 8; ++g) ones[g] = 0x38383838;
    osum = __builtin_amdgcn_mfma_scale_f32_32x32x64_f8f6f4(pa, ones, osum, 0, 0, 0, 0x7F7F7F7F, 0, 0x7F7F7F7F); }
#pragma unroll
  for (int blk = 0; blk < NVB; ++blk) o[blk] = __builtin_amdgcn_mfma_scale_f32_32x32x64_f8f6f4(pa, vf[blk], o[blk], 0, 0, 0, 0x7F7F7F7F, 0, 0x7C7C7C7C);
}
__device__ __forceinline__ void v8_phase(const Params& p, char* smem, int bid, int nb) {
  char* ws = p.ws; bfr* T = (bfr*)smem; constexpr int LP = 520;
  const int tid = otid();
  for (int it = bid; it < 4 * 132 * 2; it += nb) {
    const int type = it & 1, t = (it >> 1) % 132, b = (it >> 1) / 132;
    const size_t r0 = (size_t)b * SEQA + (size_t)t * 64;
    const bfr* src = (type ? (const bfr*)(ws + OFF_RC) + (size_t)RTOT * 1024 : (const bfr*)(ws + OFF_RD) + (size_t)RTOT * 1536) + r0 * 512;
#pragma unroll
    for (int u = 0; u < 8; ++u) { const int e = tid + u * NTHR, row = e >> 6, ck = e & 63;
      *(uint4*)(T + row * LP + ck * 8) = *(const uint4*)(src + (size_t)row * 512 + ck * 8); }
    __syncthreads();
#pragma unroll
    for (int u = 0; u < 4; ++u) { const int task = tid + u * NTHR, c = task & 511, q4 = task >> 9, hh = q4 >> 1, kb = (q4 & 1) * 32;
      int w[4];
#pragma unroll
      for (int g = 0; g < 4; ++g) { float f[4];
#pragma unroll
        for (int e = 0; e < 4; ++e) f[e] = 8.f * bf2f(T[(kb + crow(4 * g + e, hh)) * LP + c]);
        int x = 0; x = __builtin_amdgcn_cvt_pk_fp8_f32(f[0], f[1], x, false); x = __builtin_amdgcn_cvt_pk_fp8_f32(f[2], f[3], x, true); w[g] = x; }
      char* dst = type ? ws + OFF_V8D + ((((size_t)(b * 4 + (c >> 7)) * 132 + t) * 128 + (c & 127)) << 6)
                       : ws + OFF_V8A + ((((size_t)(b * 8 + (c >> 6)) * 132 + t) * 64 + (c & 63)) << 6);
      *(int4*)(dst + q4 * 16) = make_int4(w[0], w[1], w[2], w[3]); }
    __syncthreads();
  }
}
extern __shared__ __attribute__((aligned(16))) char dyn_smem[];
__device__ __forceinline__ char* dyn_smem_base() { return dyn_smem; }
#ifndef PROBE_VAR
#define PROBE_VAR 0
#endif
#define PSYNC() do { if (VAR != 1) __syncthreads(); } while (0)
template <int TYPE, int VAR>
__device__ __forceinline__ void attn_item(const Params& p, char* lds, int h, int qrow0, int krow0, int NT, float lam) {
  const int bq_ = krow0 / SEQA, t0_ = (krow0 - bq_ * SEQA) >> 6;
  constexpr int NP = TYPE ? 1 : 2, NVB = TYPE ? 4 : 2;
  constexpr int STG = 16384, KOFF = 8192;
  const int tid = otid(), wid = __builtin_amdgcn_readfirstlane(tid >> 6), lane = tid & 63, r32 = lane & 31, hi = lane >> 5;
  const int map = TYPE ? (wid >> 2) : 0, wq = TYPE ? (wid & 3) : wid, grp = wid >> 2;
  char* ws = p.ws;
  const unsigned char* Q8 = TYPE ? (const unsigned char*)(ws + OFF_RC) + (size_t)(qrow0 + wq * 32 + r32) * 512 + h * 128 + map * 64 + hi * 32
                                 : (const unsigned char*)(ws + OFF_RD) + (size_t)(qrow0 + wq * 32 + r32) * 1024 + h * 128 + hi * 32;
  const unsigned char* Kh = TYPE ? (const unsigned char*)(ws + OFF_RC) + SZ512 + (size_t)krow0 * 512 + h * 128
                                 : (const unsigned char*)(ws + OFF_RD) + SZ768 + (size_t)krow0 * 1024 + h * 128;
  constexpr int LDKB = TYPE ? 512 : 1024;
  const char* v8g = TYPE ? (const char*)(ws + OFF_V8D) + (((size_t)(bq_ * 4 + h) * 132 + t0_) << 13)
                         : (const char*)(ws + OFF_V8A) + (((size_t)(bq_ * 8 + h) * 132 + t0_) << 12);
  const bfr* SG0 = (const bfr*)(ws + OFF_RB); bfr* OG = (bfr*)(ws + OFF_RA);
  const int kbyte0 = map * 64;
  PG8_LAS unsigned char* ldsA = (PG8_LAS unsigned char*)dyn_smem_base();
  float* al_l = (float*)(lds + 4 * STG) + wid * 32;
  float m_ref = 0.f; f32x16 o[NVB], osum, p0, p1; v8i_t q8[NP], pa, kf[NP][2], vf[NVB];
#pragma unroll
  for (int d = 0; d < NVB; ++d)
#pragma unroll
    for (int r = 0; r < 16; ++r) o[d][r] = 0.f;
#pragma unroll
  for (int r = 0; r < 16; ++r) osum[r] = 0.f;
#pragma unroll
  for (int g = 0; g < 8; ++g) pa[g] = 0;
  const int k8of = (8 * wid + (lane >> 3)) * LDKB + (((lane & 7) ^ (((8 * wid + (lane >> 3)) >> 1) & 7)) << 4);
  const int v8of = (16 * wid + (lane >> 2)) * 64 + (((lane & 3) ^ (((16 * wid + (lane >> 2)) >> 2) & 3)) << 4);
#define GLDS(gp, loff) __builtin_amdgcn_global_load_lds((const unsigned*)(gp), (PG8_LAS unsigned*)(ldsA + (loff)), 16, 0, 0)
#define STAGE_TILE(t, sg) do { \
    if (wid < NVB * 2) GLDS(v8g + (size_t)(t) * (NVB * 2048) + v8of, (unsigned)(sg) * STG + (unsigned)wid * 1024u); \
    GLDS(Kh + (size_t)(t) * 64 * LDKB + k8of, (unsigned)(sg) * STG + KOFF + (unsigned)wid * 1024u); } while (0)
#define BAR_L()  asm volatile("s_waitcnt lgkmcnt(0)\n\ts_barrier" ::: "memory")
#define BAR_VL() asm volatile("s_waitcnt vmcnt(0) lgkmcnt(0)\n\ts_barrier" ::: "memory")
  STAGE_TILE(0, 0); STAGE_TILE(1, 1);
#pragma unroll
  for (int part = 0; part < NP; ++part) { const uint4 x0 = *reinterpret_cast<const uint4*>(Q8 + part * 64), x1 = *reinterpret_cast<const uint4*>(Q8 + part * 64 + 16);
    q8[part][0] = x0.x; q8[part][1] = x0.y; q8[part][2] = x0.z; q8[part][3] = x0.w; q8[part][4] = x1.x; q8[part][5] = x1.y; q8[part][6] = x1.z; q8[part][7] = x1.w; }
  BAR_VL();
  k8_load<NP>(kf, lds + KOFF, r32, hi, kbyte0);
#pragma unroll
  for (int blk = 0; blk < NVB; ++blk)
#pragma unroll
    for (int g = 0; g < 8; ++g) vf[blk][g] = 0;
  if (grp == 1) BAR_L();
  for (int j = 0; j < NT; ++j) {
    if (j + 2 < NT) STAGE_TILE(j + 2, (j + 2) & 3);
    qk8_mma<NP>(p0, p1, kf, q8, hi, m_ref);
    if (j > 0) { if (VAR != 4) pv8_mma<NVB>(o, osum, vf, pa); }
    BAR_L();
    if (j + 1 < NT) k8_load<NP>(kf, lds + ((j + 1) & 3) * STG + KOFF, r32, hi, kbyte0);
    if constexpr (TYPE == 0) v8_load<NVB>(vf, lds + (j & 3) * STG, r32, hi); else v8_load_range<0, 2, NVB>(vf, lds + (j & 3) * STG, r32, hi);
    float alpha;
    { float pmax = p0[0];
#pragma unroll
      for (int r = 1; r < 16; ++r) pmax = fmaxf(pmax, p0[r]);
#pragma unroll
      for (int r = 0; r < 16; ++r) pmax = fmaxf(pmax, p1[r]);
      { auto rr = __builtin_amdgcn_permlane32_swap(__float_as_uint(pmax), __float_as_uint(pmax), false, false);
        pmax = fmaxf(__uint_as_float(rr[0]), __uint_as_float(rr[1])); }
      const bool first = (j == 0);
      if (!first && __builtin_expect(__all(pmax <= P_TOP), 1)) { alpha = 1.f; }
      else {
        const float mn = bf2f(f2bf(m_ref + (first ? pmax - P_REF : fmaxf(pmax - P_REF, 0.f))));
        const float delta = mn - m_ref;
        alpha = first ? 0.f : __builtin_amdgcn_exp2f(-delta);
        m_ref = mn;
#pragma unroll
        for (int r = 0; r < 16; ++r) { p0[r] = p0[r] - delta; p1[r] = p1[r] - delta; }
      }
      if (VAR != 3) {
#pragma unroll
      for (int r = 0; r < 16; ++r) p0[r] = __builtin_amdgcn_exp2f(p0[r]);
#pragma unroll
      for (int r = 0; r < 16; ++r) p1[r] = __builtin_amdgcn_exp2f(p1[r]);
      }
#pragma unroll
      for (int g = 0; g < 4; ++g) { int w = 0; w = __builtin_amdgcn_cvt_pk_fp8_f32(p0[4 * g], p0[4 * g + 1], w, false); w = __builtin_amdgcn_cvt_pk_fp8_f32(p0[4 * g + 2], p0[4 * g + 3], w, true); pa[g] = w; }
#pragma unroll
      for (int g = 0; g < 4; ++g) { int w = 0; w = __builtin_amdgcn_cvt_pk_fp8_f32(p1[4 * g], p1[4 * g + 1], w, false); w = __builtin_amdgcn_cvt_pk_fp8_f32(p1[4 * g + 2], p1[4 * g + 3], w, true); pa[4 + g] = w; }
    }
    if (__any(alpha < 1.f)) { if (hi == 0) al_l[r32] = alpha; asm volatile("s_waitcnt lgkmcnt(0)" ::: "memory");
#pragma unroll
      for (int r = 0; r < 16; ++r) { const float f_ = al_l[crow(r, hi)]; osum[r] *= f_;
#pragma unroll
        for (int d = 0; d < NVB; ++d) o[d][r] *= f_; } }
    if constexpr (TYPE == 1) v8_load_range<2, 4, NVB>(vf, lds + (j & 3) * STG, r32, hi);
    BAR_VL();
  }
  pv8_mma<NVB>(o, osum, vf, pa);
  if (grp == 0) BAR_L();
  float rli[16];
#pragma unroll
  for (int r = 0; r < 16; ++r) rli[r] = __builtin_amdgcn_rcpf(osum[r]);
  if constexpr (TYPE == 0) {
#pragma unroll
    for (int r = 0; r < 16; ++r) { const size_t row = (size_t)(qrow0 + wq * 32 + crow(r, hi)) * 1024;
#pragma unroll
      for (int d0 = 0; d0 < NVB; ++d0) { const size_t idx = row + h * 64 + d0 * 32 + r32; const bfr ov = f2bf(o[d0][r] * rli[r] * bf2f(SG0[idx]));
        if (VAR == 0) OG[idx] = ov; else asm volatile("" :: "v"((unsigned)ov)); } }
    __syncthreads();
  } else {
    float* xch = (float*)lds;
    __syncthreads();
    if (map == 1) {
#pragma unroll
      for (int r = 0; r < 16; ++r) { const float f = rli[r] * lam;
#pragma unroll
        for (int d0 = 0; d0 < 4; ++d0) xch[(wq * 32 + crow(r, hi)) * 128 + d0 * 32 + r32] = o[d0][r] * f; }
    }
    __syncthreads();
    if (map == 0) {
      const float* subg = p.subg;
#pragma unroll
      for (int r = 0; r < 16; ++r) { float ss = 0.f;
#pragma unroll
        for (int d0 = 0; d0 < 4; ++d0) { float v = o[d0][r] * rli[r] - xch[(wq * 32 + crow(r, hi)) * 128 + d0 * 32 + r32]; o[d0][r] = v; ss += v * v; }
        ss += __shfl_xor(ss, 16); ss += __shfl_xor(ss, 8); ss += __shfl_xor(ss, 4); ss += __shfl_xor(ss, 2); ss += __shfl_xor(ss, 1);
        const float rs = rsqrtf(ss * (1.f / 128.f) + 1e-6f) * 0.8f;
        const size_t row = (size_t)(qrow0 + wq * 32 + crow(r, hi)) * 1024;
#pragma unroll
        for (int d0 = 0; d0 < 4; ++d0) { const size_t idx = row + 512 + h * 128 + d0 * 32 + r32;
          const bfr ov = f2bf(o[d0][r] * rs * subg[d0 * 32 + r32] * bf2f(SG0[idx]));
          if (VAR == 0) OG[idx] = ov; else asm volatile("" :: "v"((unsigned)ov)); } }
    }
    __syncthreads();
  }
#undef GLDS
#undef STAGE_TILE
#undef BAR_L
#undef BAR_VL
}
template <int VAR>
__device__ __forceinline__ void attn_phase(const Params& p, char* smem, int bid, int nb) {
  const float lam = *(const float*)(p.ws + OFF_LAM);
  for (int it = bid; it < 2112; it += nb) {
    const int rd = it >> 8, j = it & 255;
    int type, h, qrow0, krow0, NT;
    if (rd < 4) { const int b = rd; type = 0; h = j & 7; qrow0 = b * SEQA + (j >> 3) * 256; krow0 = b * SEQA; NT = 132; }
    else if (rd < 8) { const int pair = (j & 7) + 8 * ((rd - 4) >> 1), b = pair >> 2, qt = 2 * (j >> 3) + ((rd - 4) & 1);
      type = 1; h = pair & 3; qrow0 = b * SEQA + qt * 128; krow0 = b * SEQA; NT = 132; }
    else if (j < 32) { const int b = j >> 3; type = 0; h = j & 7; qrow0 = b * SEQA + NLAT; krow0 = qrow0; NT = 4; }
    else if (j < 64) { const int pair = (j - 32) >> 1, b = pair >> 2, qt = (j - 32) & 1;
      type = 1; h = pair & 3; krow0 = b * SEQA + NLAT; qrow0 = krow0 + qt * 128; NT = 4; }
    else continue;
#ifndef ONLY_T1
    if (type == 0) attn_item<0, VAR>(p, smem, h, qrow0, krow0, NT, lam);
#endif
#ifndef ONLY_T0
    if (type == 1) attn_item<1, VAR>(p, smem, h, qrow0, krow0, NT, lam);
#endif
  }
}


constexpr int AT_LD = 264;
constexpr size_t SCAN_UF_OFF = 64 * AT_LD * 2;

constexpr size_t SCAN_UT_OFF = SCAN_UF_OFF + (size_t)64 * 256 * 4;
constexpr size_t SCAN_CW_OFF = SCAN_UT_OFF + (size_t)68 * 512;
constexpr size_t SCAN_LDS_END = SCAN_CW_OFF + 5 * 256 * 4;
__device__ __forceinline__ void scan0_phase(const Params& p, char* lds, int bid, int nb, int ko = 0) {
  const int tid = otid(), wid = tid >> 6, lane = tid & 63, r32 = lane & 31, hi = lane >> 5;
  char* ws = p.ws;
  const bfr* U = (const bfr*)(ws + OFF_RD);
  bfr* AT = (bfr*)lds; float* UF = (float*)(lds + SCAN_UF_OFF); const bfr* UT = (const bfr*)(lds + SCAN_UT_OFF); float* CW = (float*)(lds + SCAN_CW_OFF);
  PG8_LAS unsigned char* ldsA = (PG8_LAS unsigned char*)dyn_smem_base();
  const int nb4 = nb & ~3;
  if (bid < nb4) {
    const int cg = bid & 3, pstep = nb4 >> 2;
    const int blkl = wid >> 2, blk = cg * 2 + blkl, j0 = (wid & 3) * 32;
    const int ch = cg * 256 + wid * 32 + r32;
    float kA[2], biasA[2], biasX[2];
#pragma unroll
    for (int dir = 0; dir < 2; ++dir) { const float sp = log1pf(expf(-p.lru_l[dir * 1024 + ch]));
      kA[dir] = -8.f * sp * LOG2E; biasA[dir] = p.ga_b[dir * 1024 + ch] * -LOG2E; biasX[dir] = p.gx_b[dir * 1024 + ch] * -LOG2E; }
    for (int i = tid; i < 1280; i += NTHR) { const int j = i >> 8, cc = i & 255; CW[i] = j < 4 ? p.conv_w[j * 1024 + cg * 256 + cc] : p.conv_b[cg * 256 + cc]; }
    bf16x8 wA[8], wX[8];
#define LOADW(dir) do { const bfr* wa_ = (const bfr*)(ws + OFF_WG) + (size_t)((((dir) * 16 + blk) * 4 + (wid & 3)) * 8) * 512 + lane * 8; \
    _Pragma("unroll") for (int ks = 0; ks < 8; ++ks) { wA[ks] = *(const bf16x8*)(wa_ + ks * 512); wX[ks] = *(const bf16x8*)(wa_ + (size_t)8 * 16384 + ks * 512); } } while (0)
#define ISSUE_UT(prn_) do { const int bn_ = (prn_) / 132, cn_ = (prn_) - bn_ * 132; const int lo_ = cn_ < 128 ? 0 : NLAT, hp_ = cn_ < 128 ? NLAT : SEQA; \
    for (int i_ = wid; i_ < 34; i_ += 8) { int pp_ = cn_ * 64 + 2 * i_ + hi - 2; pp_ = pp_ < lo_ ? lo_ : (pp_ >= hp_ ? hp_ - 1 : pp_); \
      __builtin_amdgcn_global_load_lds((const unsigned*)(U + (size_t)(bn_ * SEQA + pp_) * 1024 + cg * 256 + r32 * 8), (PG8_LAS unsigned*)(ldsA + SCAN_UT_OFF + i_ * 1024), 16, 0, 0); } } while (0)
    int pr = bid >> 2;
    if (pr < 528) { ISSUE_UT(pr); LOADW(0); }
    for (; pr < 528; pr += pstep) {
      const int b = pr / 132, c = pr - b * 132;
      const int lo = c < 128 ? 0 : NLAT, hiP = c < 128 ? NLAT : SEQA;
      asm volatile("s_waitcnt vmcnt(0)" ::: "memory");
      __syncthreads();
      if (!(ko & 2)) {
        const int k8 = tid & 31;
        float w[4][8], bia[8];
#pragma unroll
        for (int j = 0; j < 4; ++j) { const float4 t0 = *(const float4*)(CW + j * 256 + k8 * 8), t1 = *(const float4*)(CW + j * 256 + k8 * 8 + 4);
          w[j][0] = t0.x; w[j][1] = t0.y; w[j][2] = t0.z; w[j][3] = t0.w; w[j][4] = t1.x; w[j][5] = t1.y; w[j][6] = t1.z; w[j][7] = t1.w; }
        { const float4 t0 = *(const float4*)(CW + 1024 + k8 * 8), t1 = *(const float4*)(CW + 1024 + k8 * 8 + 4);
          bia[0] = t0.x; bia[1] = t0.y; bia[2] = t0.z; bia[3] = t0.w; bia[4] = t1.x; bia[5] = t1.y; bia[6] = t1.z; bia[7] = t1.w; }
#pragma unroll
        for (int i = 0; i < 4; ++i) { const int t = (tid >> 5) + i * 16; const int pt = c * 64 + t;
          float acc[8];
#pragma unroll
          for (int e = 0; e < 8; ++e) acc[e] = bia[e];
#pragma unroll
          for (int j = 0; j < 4; ++j) { const int pp = pt + j - 2; const float vm = (pp >= lo && pp < hiP) ? 1.f : 0.f;
            const uint4 uu = *(const uint4*)(UT + (t + j) * 256 + k8 * 8); float f[8]; unpack8(uu, f);
#pragma unroll
            for (int e = 0; e < 8; ++e) acc[e] += (w[j][e] * vm) * f[e]; }
          u32x4 pk; pk[0] = cvtpk(acc[0], acc[1]); pk[1] = cvtpk(acc[2], acc[3]); pk[2] = cvtpk(acc[4], acc[5]); pk[3] = cvtpk(acc[6], acc[7]);
          *(u32x4*)(AT + t * AT_LD + k8 * 8) = pk;
          *(float4*)(UF + t * 256 + k8 * 8) = make_float4(acc[0], acc[1], acc[2], acc[3]);
          *(float4*)(UF + t * 256 + k8 * 8 + 4) = make_float4(acc[4], acc[5], acc[6], acc[7]); }
      }
      __syncthreads();
      const int prn = pr + pstep;
#pragma unroll
      for (int ks = 0; ks < 8; ++ks) asm volatile("" :: "v"(wA[ks]), "v"(wX[ks]));
      if (prn < 528) ISSUE_UT(prn);
      asm volatile("" ::: "memory");
#pragma unroll
      for (int dir = 0; dir < 2; ++dir) {
        f32x16 ga[2], gx[2];
#pragma unroll
        for (int mt = 0; mt < 2; ++mt)
#pragma unroll
          for (int r = 0; r < 16; ++r) { ga[mt][r] = 0.f; gx[mt][r] = 0.f; }
        const bfr* ap = AT + r32 * AT_LD + blkl * 128 + hi * 8;
        if (!(ko & 4))
#pragma unroll
        for (int ks = 0; ks < 8; ++ks) {
          bf16x8 a0 = *(const bf16x8*)(ap + ks * 16), a1 = *(const bf16x8*)(ap + 32 * AT_LD + ks * 16);
          ga[0] = __builtin_amdgcn_mfma_f32_32x32x16_bf16(a0, wA[ks], ga[0], 0, 0, 0);
          ga[1] = __builtin_amdgcn_mfma_f32_32x32x16_bf16(a1, wA[ks], ga[1], 0, 0, 0);
          gx[0] = __builtin_amdgcn_mfma_f32_32x32x16_bf16(a0, wX[ks], gx[0], 0, 0, 0);
          gx[1] = __builtin_amdgcn_mfma_f32_32x32x16_bf16(a1, wX[ks], gx[1], 0, 0, 0);
        }
        if (dir == 0) LOADW(1); else if (prn < 528) LOADW(0);
        const float kA_ = kA[dir], bA_ = biasA[dir], bX_ = biasX[dir];
#pragma unroll
        for (int mt = 0; mt < 2; ++mt) if (!(ko & 8)) {
          unsigned lap[8], bpk[8];
#pragma unroll
          for (int r2 = 0; r2 < 8; ++r2) {
            float la2[2], bv2[2];
#pragma unroll
            for (int e = 0; e < 2; ++e) { const int r = r2 * 2 + e;
              const float e1 = 1.f + __builtin_amdgcn_exp2f(fmaf(ga[mt][r], -LOG2E, bA_)), e2 = 1.f + __builtin_amdgcn_exp2f(fmaf(gx[mt][r], -LOG2E, bX_));
              const float inv = __builtin_amdgcn_rcpf(e1 * e2);
              const float rr = e2 * inv, ii = e1 * inv;
              const float la = kA_ * rr;
              const float a = __builtin_amdgcn_exp2f(la);
              const float uc = UF[(mt * 32 + crow(r, hi)) * 256 + wid * 32 + r32];
              const float bv = __builtin_amdgcn_sqrtf(fmaxf(1.f - a * a, 0.f)) * ii * uc;
              ga[mt][r] = a; gx[mt][r] = bv; la2[e] = la; bv2[e] = bv; }
            lap[r2] = cvtpk(la2[0], la2[1]); bpk[r2] = cvtpk(bv2[0], bv2[1]);
          }
          if (c < 128 && !(ko & 1)) {
            char* sab = ws + OFF_SAB + ((size_t)(((b * 128 + c) * 4 + cg) * 2 + dir) * 8) * 8192 + (size_t)tid * 16;
            *(u32x4*)(sab + (mt * 2 + 0) * 8192) = u32x4{lap[0], lap[1], lap[2], lap[3]};
            *(u32x4*)(sab + (mt * 2 + 1) * 8192) = u32x4{lap[4], lap[5], lap[6], lap[7]};
            *(u32x4*)(sab + (4 + mt * 2 + 0) * 8192) = u32x4{bpk[0], bpk[1], bpk[2], bpk[3]};
            *(u32x4*)(sab + (4 + mt * 2 + 1) * 8192) = u32x4{bpk[4], bpk[5], bpk[6], bpk[7]};
          }
        }
        float sA[8], sB[8];
#pragma unroll
        for (int sgi = 0; sgi < 8; ++sgi) { const int mt = sgi >> 2, g = sgi & 3; float A = 1.f, Bv = 0.f;
#pragma unroll
          for (int e = 0; e < 4; ++e) { const int r = g * 4 + (dir ? 3 - e : e); A *= ga[mt][r]; Bv = ga[mt][r] * Bv + gx[mt][r]; }
          sA[sgi] = A; sB[sgi] = Bv; }
        const bool ownFirst = (dir == 0) == (hi == 0);
        float st = 0.f, stA = 1.f;
        if (!(ko & 16))
#pragma unroll
        for (int q = 0; q < 8; ++q) { const int sgi = dir ? 7 - q : q;
          const float oA = sA[sgi], oB = sB[sgi];
          const float pA = __shfl_xor(oA, 32), pB = __shfl_xor(oB, 32);
          const float fA = ownFirst ? oA : pA, fB = ownFirst ? oB : pB, sA2 = ownFirst ? pA : oA, sB2 = ownFirst ? pB : oB;
          const float A8 = fA * sA2, B8 = sA2 * fB + sB2;
          st = A8 * st + B8; stA *= A8;
        }
        if (hi == 0) {
          const size_t ci = ((size_t)((dir * 4 + b) * 132 + c) * 1024 + ch) * 4;
          *(float*)(ws + OFF_CA + ci) = stA; *(float*)(ws + OFF_CB + ci) = st;
        }
      }
    }
#undef LOADW
#undef ISSUE_UT
  }
  __syncthreads();
}
__device__ __forceinline__ void scan_apply_item(const Params& p, char* lds, int b, int c, int cg, int par) {
  const int tid = otid(), wid = tid >> 6, lane = tid & 63, r32 = lane & 31, hi = lane >> 5;
  char* ws = p.ws;
  const bfr* SG1 = (const bfr*)(ws + OFF_RD) + (size_t)RTOT * 1024;
  bfr* AT = (bfr*)(lds + par * (64 * AT_LD * 2));
  const int row0 = b * SEQA + c * 64;
  const int ch = cg * 256 + wid * 32 + r32;
  const char* sab = ws + OFF_SAB + ((size_t)(((b * 128 + c) * 4 + cg) * 2) * 8) * 8192 + (size_t)tid * 16;
  u32x4 pc[2][8];
#pragma unroll
  for (int dir = 0; dir < 2; ++dir)
#pragma unroll
    for (int k = 0; k < 8; ++k) pc[dir][k] = *(const u32x4*)(sab + (size_t)(dir * 8 + k) * 8192);
  float hin[2];
#pragma unroll
  for (int dir = 0; dir < 2; ++dir) hin[dir] = *(const float*)(ws + OFF_HIN + ((size_t)((dir * 4 + b) * 132 + c) * 1024 + ch) * 4);
  const int k8 = tid & 31, chh = cg * 256 + k8 * 8;
  uint4 gv[4];
#pragma unroll
  for (int i = 0; i < 4; ++i) gv[i] = *(const uint4*)(SG1 + (size_t)(row0 + (tid >> 5) + i * 16) * 1024 + chh);
  float hsum[2][16];
#pragma unroll
  for (int dir = 0; dir < 2; ++dir) {
    float ga[2][16], gx[2][16];
#pragma unroll
    for (int mt = 0; mt < 2; ++mt)
#pragma unroll
      for (int q = 0; q < 8; ++q) { const unsigned wl = pc[dir][mt * 2 + (q >> 2)][q & 3], wb = pc[dir][4 + mt * 2 + (q >> 2)][q & 3];
        ga[mt][2 * q] = __builtin_amdgcn_exp2f(__uint_as_float(wl << 16)); ga[mt][2 * q + 1] = __builtin_amdgcn_exp2f(__uint_as_float(wl & 0xffff0000u));
        gx[mt][2 * q] = __uint_as_float(wb << 16); gx[mt][2 * q + 1] = __uint_as_float(wb & 0xffff0000u); }
    float sA[8], sB[8];
#pragma unroll
    for (int sgi = 0; sgi < 8; ++sgi) { const int mt = sgi >> 2, g = sgi & 3; float A = 1.f, Bv = 0.f;
#pragma unroll
      for (int e = 0; e < 4; ++e) { const int r = g * 4 + (dir ? 3 - e : e); A *= ga[mt][r]; Bv = ga[mt][r] * Bv + gx[mt][r]; }
      sA[sgi] = A; sB[sgi] = Bv; }
    const bool ownFirst = (dir == 0) == (hi == 0);
    float st = hin[dir];
#pragma unroll
    for (int q = 0; q < 8; ++q) { const int sgi = dir ? 7 - q : q;
      const float oA = sA[sgi], oB = sB[sgi];
      const float pA = __shfl_xor(oA, 32), pB = __shfl_xor(oB, 32);
      const float fA = ownFirst ? oA : pA, fB = ownFirst ? oB : pB, sA2 = ownFirst ? pA : oA, sB2 = ownFirst ? pB : oB;
      const float A8 = fA * sA2, B8 = sA2 * fB + sB2;
      float hv = ownFirst ? st : fA * st + fB;
      const int mt = sgi >> 2, g = sgi & 3;
#pragma unroll
      for (int e = 0; e < 4; ++e) { const int r = g * 4 + (dir ? 3 - e : e); hv = ga[mt][r] * hv + gx[mt][r];
        if (dir == 0) hsum[mt][r] = hv; else hsum[mt][r] += hv; }
      st = A8 * st + B8;
    }
  }
#pragma unroll
  for (int mt = 0; mt < 2; ++mt)
#pragma unroll
    for (int r = 0; r < 16; ++r) AT[(mt * 32 + crow(r, hi)) * AT_LD + wid * 32 + r32] = f2bf(hsum[mt][r]);
  __syncthreads();
  bfr* HG = (bfr*)(ws + OFF_RD);
#pragma unroll
  for (int i = 0; i < 4; ++i) { const int t = (tid >> 5) + i * 16;
    uint4 hv = *(const uint4*)(AT + t * AT_LD + k8 * 8);
    float hf[8], gf[8]; unpack8(hv, hf); unpack8(gv[i], gf);
    u32x4 pk; pk[0] = cvtpk(hf[0] * gf[0], hf[1] * gf[1]); pk[1] = cvtpk(hf[2] * gf[2], hf[3] * gf[3]);
    pk[2] = cvtpk(hf[4] * gf[4], hf[5] * gf[5]); pk[3] = cvtpk(hf[6] * gf[6], hf[7] * gf[7]);
    *(u32x4*)(HG + ((size_t)(b * NLAT + c * 64 + t)) * 1024 + chh) = pk; }
}
__device__ __forceinline__ void scan_apply_phase(const Params& p, char* smem, int bid, int nb) {
  int par = 0;
  for (int it = bid; it < 4 * 128 * 4; it += nb, par ^= 1) { const int cg = it & 3, t2 = it >> 2, c = t2 & 127, b = t2 >> 7; scan_apply_item(p, smem, b, c, cg, par); }
  __syncthreads();
}
__device__ __forceinline__ void carry_phase(const Params& p, int bid, int nb) {
  char* ws = p.ws;
  for (int id = bid * NTHR + otid(); id < 8192; id += nb * NTHR) {
    const int ch = id & 1023, db = id >> 10, dir = db >> 2;
    const float* CA = (const float*)(ws + OFF_CA) + (size_t)db * 132 * 1024 + ch; const float* CB = (const float*)(ws + OFF_CB) + (size_t)db * 132 * 1024 + ch;
    float* HIN = (float*)(ws + OFF_HIN) + (size_t)db * 132 * 1024 + ch;
    float h = 0.f;
    for (int s0 = 0; s0 < 132; s0 += 12) {
      float a[12], bb[12];
#pragma unroll
      for (int u = 0; u < 12; ++u) { const int s = s0 + u; const int c = dir ? 131 - s : (s < 4 ? 128 + s : s - 4); a[u] = CA[(size_t)c * 1024]; bb[u] = CB[(size_t)c * 1024]; }
#pragma unroll
      for (int u = 0; u < 12; ++u) { const int s = s0 + u; const int c = dir ? 131 - s : (s < 4 ? 128 + s : s - 4); HIN[(size_t)c * 1024] = h; h = a[u] * h + bb[u]; }
    }
  }
}

__device__ __forceinline__ float ld_agent_f32(const float* p) { return __hip_atomic_load(p, __ATOMIC_RELAXED, __HIP_MEMORY_SCOPE_AGENT); }
__device__ __forceinline__ void mod_phase(const Params& p, char* smem, int bid, int nb) {
  float* sc = (float*)smem; float* red = sc + 5 * 1024;
  float* mod = (float*)(p.ws + OFF_MOD);
  const int tid = otid(), kg = tid >> 5, col = tid & 31;
  for (int it = bid; it < 192; it += nb) {
    const int l = it / 96, j0 = (it % 96) * 32;
    const float* w = p.ada_w + (size_t)l * 1024 * 3072 + (size_t)(kg * 64) * 3072 + j0 + col;
    float wv[64];
#pragma unroll
    for (int k = 0; k < 64; ++k) wv[k] = w[(size_t)k * 3072];
    for (int e = tid; e < 5120; e += NTHR) { const int mr = e >> 10, k = e & 1023; sc[e] = silu_f(mr < 4 ? p.c[mr * 1024 + k] : p.c_ctx[k]); }
    __syncthreads();
    float acc[5] = {0.f, 0.f, 0.f, 0.f, 0.f};
#pragma unroll
    for (int k = 0; k < 64; ++k) {
#pragma unroll
      for (int mr = 0; mr < 5; ++mr) acc[mr] += sc[mr * 1024 + kg * 64 + k] * wv[k]; }
#pragma unroll
    for (int mr = 0; mr < 5; ++mr) red[(kg * 5 + mr) * 32 + col] = acc[mr];
    __syncthreads();
    if (tid < 160) { const int mr = tid >> 5; float sum = 0.f;
#pragma unroll
      for (int g = 0; g < 16; ++g) sum += red[(g * 5 + mr) * 32 + col];
      mod[(l * 5 + mr) * 3072 + j0 + col] = sum + p.ada_b[l * 3072 + j0 + col]; }
    __syncthreads();
  }
  if (bid == nb - 1 && tid == 0) { float s1 = 0, s2 = 0;
    for (int i = 0; i < 64; ++i) { s1 += p.lq1[i] * p.lk1[i]; s2 += p.lq2[i] * p.lk2[i]; }
    *(float*)(p.ws + OFF_LAM) = expf(s1) - expf(s2) + 0.2f; }
}
__device__ __forceinline__ void modulate_phase(const Params& p, int bid, int nb) {
  const float* mod = (const float*)(p.ws + OFF_MOD); bfr* XM = (bfr*)(p.ws + OFF_RA);
  for (size_t idx = (size_t)bid * NTHR + otid(); idx < (size_t)RTOT * 256; idx += (size_t)nb * NTHR) {
    const int r = (int)(idx >> 8), c4 = (int)(idx & 255) * 4;
    const float* src = xrow(p.x, p.ctx, r) + c4; const int mr = modrow(r);
    const float* sh = mod + mr * 3072 + c4; const float* scp = sh + 1024;
    const float4 v = *(const float4*)src, s4 = *(const float4*)sh, c4v = *(const float4*)scp;
    uint2 o; o.x = cvtpk(v.x * (1.f + c4v.x) + s4.x, v.y * (1.f + c4v.y) + s4.y); o.y = cvtpk(v.z * (1.f + c4v.z) + s4.z, v.w * (1.f + c4v.w) + s4.w);
    *(uint2*)(XM + (size_t)r * 1024 + c4) = o;
  }
}
template <int LAYER>
__device__ __forceinline__ void ln_phase(const Params& p, int bid, int nb) {
  const float* mod = (const float*)(p.ws + OFF_MOD);
  const int lane = otid() & 63, wv = otid() >> 6;
  const int nrows = LAYER ? B_ * NLAT : RTOT;
  const float* lng = p.ln_g + LAYER * 1024; const float* lnb = p.ln_b + LAYER * 1024;
  const int stride = nb * 8;
  for (int r0 = bid * 8 + wv; r0 < nrows; r0 += 2 * stride) {
    float v[2][16]; float s[2]; int mrs[2], pps[2]; float* orows[2]; int rr[2]; bool ok[2];
#pragma unroll
    for (int u = 0; u < 2; ++u) {
      int r = r0 + u * stride; ok[u] = r < nrows; if (!ok[u]) r = r0; rr[u] = r;
      int b, pp, mr; const float* xin; const bfr* Y; float* orow;
      if (LAYER == 0) { b = r / SEQA; pp = r - b * SEQA; mr = pp < NLAT ? b : 4; xin = xrow(p.x, p.ctx, r); Y = (const bfr*)(p.ws + OFF_RC) + (size_t)r * 1024;
        orow = p.out + ((size_t)(b * NLAT + (pp < NLAT ? pp : 0))) * 1024; }
      else { b = r / NLAT; pp = 0; mr = b; orow = p.out + (size_t)r * 1024; xin = orow; Y = (const bfr*)(p.ws + OFF_RB) + (size_t)r * 1024; }
      mrs[u] = mr; pps[u] = pp; orows[u] = orow;
      const float* g = mod + (LAYER * 5 + mr) * 3072 + 2048;
      float sacc = 0.f;
#pragma unroll
      for (int i = 0; i < 4; ++i) { const int c = i * 256 + lane * 4;
        const float4 xv = *(const float4*)(xin + c), gv = *(const float4*)(g + c); const uint2 yv = *(const uint2*)(Y + c);
        v[u][i * 4 + 0] = ALPHA * xv.x + gv.x * __uint_as_float(yv.x << 16); v[u][i * 4 + 1] = ALPHA * xv.y + gv.y * __uint_as_float(yv.x & 0xffff0000u);
        v[u][i * 4 + 2] = ALPHA * xv.z + gv.z * __uint_as_float(yv.y << 16); v[u][i * 4 + 3] = ALPHA * xv.w + gv.w * __uint_as_float(yv.y & 0xffff0000u);
        sacc += v[u][i * 4] + v[u][i * 4 + 1] + v[u][i * 4 + 2] + v[u][i * 4 + 3]; }
      s[u] = sacc;
    }
#pragma unroll
    for (int u = 0; u < 2; ++u) {
      float su = s[u];
      for (int o = 32; o; o >>= 1) su += __shfl_xor(su, o);
      const float mu = su * (1.f / 1024.f); float q = 0.f;
#pragma unroll
      for (int i = 0; i < 16; ++i) { const float d = v[u][i] - mu; q += d * d; }
      for (int o = 32; o; o >>= 1) q += __shfl_xor(q, o);
      const float rs = rsqrtf(q * (1.f / 1024.f) + 1e-6f);
      const float* sh1 = mod + (5 + mrs[u]) * 3072; const float* sc1 = sh1 + 1024;
      if (ok[u]) {
#pragma unroll
        for (int i = 0; i < 4; ++i) { const int c = i * 256 + lane * 4;
          const float4 gg = *(const float4*)(lng + c), bb = *(const float4*)(lnb + c);
          float4 y; y.x = (v[u][i * 4] - mu) * rs * gg.x + bb.x; y.y = (v[u][i * 4 + 1] - mu) * rs * gg.y + bb.y;
          y.z = (v[u][i * 4 + 2] - mu) * rs * gg.z + bb.z; y.w = (v[u][i * 4 + 3] - mu) * rs * gg.w + bb.w;
          if (LAYER == 1 || pps[u] < NLAT) *(float4*)(orows[u] + c) = y;
          if (LAYER == 0) { const float4 s1 = *(const float4*)(sh1 + c), c1 = *(const float4*)(sc1 + c);
            uint2 o; o.x = cvtpk(y.x * (1.f + c1.x) + s1.x, y.y * (1.f + c1.y) + s1.y); o.y = cvtpk(y.z * (1.f + c1.z) + s1.z, y.w * (1.f + c1.w) + s1.w);
            *(uint2*)((bfr*)(p.ws + OFF_RA) + (size_t)rr[u] * 1024 + c) = o; } }
      }
    }
  }
}

constexpr size_t OFF_BAR = 131072;
#define XB_TMO      128
#define XB_XCNT(j)  (256  + 64 * (j))
#define XB_XSUB(j)  (1280 + 64 * (j))
#define XB_XGEN(j)  (2304 + 64 * (j))
#define XB_TOP      3328
#define XB_TOPGEN   3392
#define XCD_BAR_WORDS 3456
#define XB_SPIN_CAP (1u << 22)
#define LAS __attribute__((address_space(3)))
__device__ __forceinline__ unsigned xb_ld(unsigned* p)              { return __hip_atomic_load(p, __ATOMIC_RELAXED, __HIP_MEMORY_SCOPE_AGENT); }
__device__ __forceinline__ unsigned xb_add(unsigned* p, unsigned v) { return __hip_atomic_fetch_add(p, v, __ATOMIC_RELAXED, __HIP_MEMORY_SCOPE_AGENT); }
__device__ __forceinline__ unsigned xb_xcc_id() { return (unsigned)__builtin_amdgcn_s_getreg((3 << 11) | 20) & 0xFu; }
#define XB_SPIN(cond, bar) do { unsigned _sp = 0; while (cond) { __builtin_amdgcn_s_sleep(1); \
    if ((++_sp & 255u) == 0u) { if (xb_ld(&(bar)[XB_TMO])) break; if (_sp > XB_SPIN_CAP) { atomicAdd(&(bar)[XB_TMO], 1u); break; } } } } while (0)
struct XcdBarrier { unsigned* bar; unsigned x; volatile LAS unsigned* st; };
__device__ __forceinline__ XcdBarrier xcd_barrier_post(unsigned* bar, volatile LAS unsigned* st) {
  XcdBarrier b; b.bar = bar; b.x = xb_xcc_id(); b.st = st;
  if (threadIdx.x == 0) (void)xb_add(&bar[XB_XCNT(b.x)], 1u);
  return b;
}
__device__ __forceinline__ void xcd_barrier_complete(unsigned* bar, unsigned x, unsigned& nloc, unsigned& nx) {
  const unsigned G = gridDim.x * gridDim.y * gridDim.z;
  unsigned sum, cnt, mine, sp = 0u;
  for (;;) {
    sum = 0u; cnt = 0u; mine = 0u;
#pragma unroll
    for (unsigned j = 0; j < 16; ++j) { const unsigned c = xb_ld(&bar[XB_XCNT(j)]); sum += c; cnt += (c > 0u) ? 1u : 0u; mine = (j == x) ? c : mine; }
    if (sum == G) break;
    __builtin_amdgcn_s_sleep(1);
    if ((++sp & 255u) == 0u) { if (xb_ld(&bar[XB_TMO])) break; if (sp > XB_SPIN_CAP) { atomicAdd(&bar[XB_TMO], 1u); break; } }
  }
  nloc = mine > 0u ? mine : 1u; nx = cnt > 0u ? cnt : 1u;
}
__device__ __forceinline__ void xcd_barrier(const XcdBarrier& b) {
  asm volatile("s_waitcnt vmcnt(0)" ::: "memory");
  __syncthreads();
  if (threadIdx.x == 0) {
    unsigned* bar = b.bar;
    __builtin_amdgcn_s_waitcnt(0);
    unsigned nloc = b.st[0], nx = b.st[1];
    if (nloc == 0u) { xcd_barrier_complete(bar, b.x, nloc, nx); b.st[0] = nloc; b.st[1] = nx; }
    const unsigned old = xb_add(&bar[XB_XSUB(b.x)], 1u);
    const unsigned gen = old / nloc;
    if (old + 1u == (gen + 1u) * nloc) {
      __builtin_amdgcn_fence(__ATOMIC_RELEASE, "agent");
      asm volatile("s_waitcnt vmcnt(0)" ::: "memory");
      const unsigned og = xb_add(&bar[XB_TOP], 1u);
      const unsigned tg = og / nx;
      if (og + 1u == (tg + 1u) * nx) xb_add(&bar[XB_TOPGEN], 1u);
      else XB_SPIN(xb_ld(&bar[XB_TOPGEN]) == tg, bar);
      __builtin_amdgcn_fence(__ATOMIC_ACQUIRE, "agent");
      xb_add(&bar[XB_XGEN(b.x)], 1u);
      asm volatile("s_waitcnt vmcnt(0)" ::: "memory");
    } else {
      XB_SPIN(xb_ld(&bar[XB_XGEN(b.x)]) == gen, bar);
      __builtin_amdgcn_fence(__ATOMIC_ACQUIRE, "agent");
      asm volatile("s_waitcnt vmcnt(0)" ::: "memory");
    }
  }
  __syncthreads();
}

namespace cg = cooperative_groups;
constexpr size_t XST_OFF = SCAN_LDS_END > SMEM_BYTES ? SCAN_LDS_END : SMEM_BYTES;
constexpr size_t SMEM_TOTAL = XST_OFF + 16;
__global__ __launch_bounds__(512, 2) void fwd_megakernel(Params p) {
  cg::grid_group grid = cg::this_grid();
  const int bid = blockIdx.x, nb = gridDim.x;
  char* smem = dyn_smem; char* ws = p.ws;
  PG8_LAS unsigned char* glds = (PG8_LAS unsigned char*)dyn_smem;
  volatile LAS unsigned* xst = (volatile LAS unsigned*)(smem + XST_OFF);
  if (threadIdx.x == 0) { xst[0] = 0u; xst[1] = 0u; }
  __syncthreads();
  const XcdBarrier xb = xcd_barrier_post((unsigned*)(ws + OFF_BAR), xst);
#ifndef PROBE_DOUBLE
#define PROBE_DOUBLE -1
#endif
#ifndef PROBE_REPS
#define PROBE_REPS 2
#endif
#define REP(n) for (int rep_ = 0; rep_ < ((PROBE_DOUBLE == (n)) ? PROBE_REPS : 1); ++rep_)
  REP(0) { mod_phase(p, smem, bid, nb);
  prep_phase(p, smem, (bid + nb - 192) % nb, nb); }
  grid.sync();
  REP(1) modulate_phase(p, bid, nb);
  xcd_barrier(xb);
  REP(2) { pg8::EZ e{}; e.ws = ws; pg8::StaticOrder S; S.init(RTOT, 3328, nb, bid);
    pg8::gemm_phase<pg8::EZ, pg8::StaticOrder, false>(glds, pg8::Gemm{(const bfr*)(ws + OFF_RA), (const bfr*)(ws + OFF_WIN0), RTOT, 3328, 1024}, S, e, nullptr); }
  xcd_barrier(xb);
  REP(3) { { pg8::EQ e{}; e.ws = ws; pg8::StaticOrder S; S.init(RTOT, 768, nb, bid);
      pg8::gemm_phase<pg8::EQ, pg8::StaticOrder, false>(glds, pg8::Gemm{(const bfr*)(ws + OFF_RE), (const bfr*)(ws + OFF_WUQ), RTOT, 768, 384}, S, e, nullptr); }
    { pg8::EKV e{}; e.ws = ws; pg8::StaticOrder S; S.init(RTOT, 1024, nb, (bid + 140) % nb);
      pg8::gemm_phase<pg8::EKV, pg8::StaticOrder, false>(glds, pg8::Gemm{(const bfr*)(ws + OFF_RE) + (size_t)RTOT * 384, (const bfr*)(ws + OFF_WUKV), RTOT, 1024, 256}, S, e, nullptr); } }
  xcd_barrier(xb);
  v8_phase(p, smem, bid, nb);
  xcd_barrier(xb);
  attn_phase<0>(p, smem, bid, nb);
#if PROBE_DOUBLE == 4
  xcd_barrier(xb);
  attn_phase<PROBE_VAR>(p, smem, bid, nb);
#endif
  xcd_barrier(xb);
  REP(5) { pg8::EStore e{}; e.C = (bfr*)(ws + OFF_RC); e.ldc = 1024; pg8::StaticOrder S; S.init(RTOT, 1024, nb, bid);
    pg8::gemm_phase<pg8::EStore, pg8::StaticOrder, false>(glds, pg8::Gemm{(const bfr*)(ws + OFF_RA), (const bfr*)(ws + OFF_WOUT0), RTOT, 1024, 1024}, S, e, nullptr); }
  xcd_barrier(xb);
  REP(6) ln_phase<0>(p, bid, nb);
  xcd_barrier(xb);
  REP(7) { pg8::EUG e{}; e.U = (bfr*)(ws + OFF_RD); e.SG1 = e.U + (size_t)RTOT * 1024; pg8::StaticOrder S; S.init(RTOT, 2048, nb, bid);
    pg8::gemm_phase<pg8::EUG, pg8::StaticOrder, false>(glds, pg8::Gemm{(const bfr*)(ws + OFF_RA), (const bfr*)(ws + OFF_WIN1), RTOT, 2048, 1024}, S, e, nullptr); }
  xcd_barrier(xb);
  #ifndef PROBE_KO
#define PROBE_KO 0
#endif
  REP(8) scan0_phase(p, smem, bid, nb, (rep_ < PROBE_REPS - 1 && PROBE_DOUBLE == 8) ? PROBE_KO : 0);
  xcd_barrier(xb);
  REP(9) carry_phase(p, bid, nb);
  xcd_barrier(xb);
  REP(10) scan_apply_phase(p, smem, bid, nb);
  xcd_barrier(xb);
  REP(11) { pg8::EStore e{}; e.C = (bfr*)(ws + OFF_RB); e.ldc = 1024; pg8::StaticOrder S; S.init(B_ * NLAT, 1024, nb, bid);
    pg8::gemm_phase<pg8::EStore, pg8::StaticOrder, false>(glds, pg8::Gemm{(const bfr*)(ws + OFF_RD), (const bfr*)(ws + OFF_WOUT1), B_ * NLAT, 1024, 1024}, S, e, nullptr); }
  xcd_barrier(xb);
  ln_phase<1>(p, bid, nb);
}

extern "C" void kernel_launch(void* const* d_in, const int* in_sizes, int n_in, void* d_out, int out_size, void* d_ws, size_t ws_size, hipStream_t stream) {
  Params P{};
  { const float** pp = (const float**)&P; for (int i = 0; i < 28; ++i) pp[i] = (const float*)d_in[i]; }
  P.out = (float*)d_out; P.ws = (char*)d_ws;
  if (ws_size < WS_END || n_in < 28) return;
  static int grid_blocks = 0;
  if (!grid_blocks) {
    (void)hipFuncSetAttribute((const void*)fwd_megakernel, hipFuncAttributeMaxDynamicSharedMemorySize, (int)SMEM_TOTAL);
    int dev = 0, cus = 0, per_cu = 0;
    (void)hipGetDevice(&dev);
    (void)hipDeviceGetAttribute(&cus, hipDeviceAttributeMultiprocessorCount, dev);
    (void)hipOccupancyMaxActiveBlocksPerMultiprocessor(&per_cu, (const void*)fwd_megakernel, NTHR, SMEM_TOTAL);
    if (per_cu > 1) per_cu = 1;
    grid_blocks = cus * per_cu;
    if (grid_blocks <= 0) grid_blocks = 256;
  }
  (void)hipMemsetAsync((char*)d_ws + OFF_BAR, 0, XCD_BAR_WORDS * 4, stream);
  void* args[] = {&P};
  (void)hipLaunchCooperativeKernel((const void*)fwd_megakernel, dim3(grid_blocks), dim3(NTHR), args, SMEM_TOTAL, stream);
}
```

```cpp
#include <hip/hip_runtime.h>
#include <type_traits>
#include <hip/hip_bf16.h>
#include <hip/hip_cooperative_groups.h>
#include <stdint.h>

typedef unsigned short bfr;

constexpr int B_ = 4, NLAT = 8192, NCTX = 256, SEQA = NLAT + NCTX, RTOT = B_ * SEQA, DM = 1024;
constexpr float ALPHA = 1.4142135623730951f;
constexpr float LOG2E = 1.4426950408889634f;
constexpr float QSC_A = 0.10206207261596577f * LOG2E;
constexpr float QSC_D = 0.125f * LOG2E;

constexpr size_t SZ1024 = (size_t)RTOT * 1024 * 2;
constexpr size_t SZ512  = (size_t)RTOT * 512 * 2;
constexpr size_t SZ768  = (size_t)RTOT * 768 * 2;
constexpr size_t OFF_MOD = 0;
constexpr size_t OFF_LAM = 122880;
constexpr size_t OFF_RA = (size_t)24 << 20;
constexpr size_t OFF_RB = OFF_RA + SZ1024;
constexpr size_t OFF_RC = OFF_RB + SZ1024;
constexpr size_t OFF_RE = OFF_RC + 3 * SZ512;
constexpr size_t OFF_RD = OFF_RE + SZ1024;
constexpr size_t CARRY_SZ = (size_t)2 * 4 * 132 * 1024 * 4;
constexpr size_t OFF_CA = OFF_RD + 2 * SZ1024, OFF_CB = OFF_CA + CARRY_SZ, OFF_HIN = OFF_CB + CARRY_SZ;
constexpr size_t OFF_X1B = OFF_HIN + CARRY_SZ;
constexpr size_t WS_END = OFF_X1B + (size_t)16384 * 2048;
constexpr size_t OFF_SAB = OFF_RA;
static_assert(OFF_SAB + (size_t)2048 * 131072 <= OFF_RD, "SAB overflows into U/SG1");
constexpr size_t OFF_X1A = OFF_SAB + (size_t)2048 * 131072;
static_assert(OFF_X1A + (size_t)16384 * 2048 <= OFF_RD, "x1 fragment A overflows into U/SG1");

__device__ __forceinline__ float bf2f(bfr h) { return __uint_as_float(((unsigned)h) << 16); }
__device__ __forceinline__ bfr f2bf(float f) { unsigned u = __float_as_uint(f); u += 0x7fffu + ((u >> 16) & 1u); return (bfr)(u >> 16); }
__device__ __forceinline__ float silu_f(float x) { return x / (1.f + expf(-x)); }
__device__ __forceinline__ float silu_fast(float x) { return x * __builtin_amdgcn_rcpf(1.f + __builtin_amdgcn_exp2f(x * -LOG2E)); }
__device__ __forceinline__ float sigmoid_f(float x) { return 1.f / (1.f + expf(-x)); }
__device__ __forceinline__ const float* xrow(const float* x, const float* ctx, int r) {
  int b = r / SEQA, p = r - b * SEQA;
  return p < NLAT ? x + ((size_t)(b * NLAT + p)) * DM : ctx + ((size_t)(b * NCTX + (p - NLAT))) * DM;
}
__device__ __forceinline__ int modrow(int r) { int b = r / SEQA, p = r - b * SEQA; return p < NLAT ? b : 4; }

__device__ __forceinline__ void unpack8(uint4 u, float* f) {
  f[0] = __uint_as_float(u.x << 16); f[1] = __uint_as_float(u.x & 0xffff0000u);
  f[2] = __uint_as_float(u.y << 16); f[3] = __uint_as_float(u.y & 0xffff0000u);
  f[4] = __uint_as_float(u.z << 16); f[5] = __uint_as_float(u.z & 0xffff0000u);
  f[6] = __uint_as_float(u.w << 16); f[7] = __uint_as_float(u.w & 0xffff0000u);
}
using bf16x8 = __attribute__((ext_vector_type(8))) short;
using s16x4  = __attribute__((ext_vector_type(4))) short;
using f32x16 = __attribute__((ext_vector_type(16))) float;
using u32x4  = __attribute__((ext_vector_type(4))) unsigned;
constexpr int NTHR = 512;
constexpr size_t OFF_ROPED = (size_t)1 << 20;
constexpr size_t OFF_ROPEA = (size_t)3 << 20;
constexpr size_t OFF_WT    = (size_t)4 << 20;
constexpr size_t OFF_WIN0  = OFF_WT;
constexpr size_t OFF_WUQ   = OFF_WIN0 + (size_t)3328 * 1024 * 2;
constexpr size_t OFF_WUKV  = OFF_WUQ + (size_t)768 * 384 * 2;
constexpr size_t OFF_WOUT0 = OFF_WUKV + (size_t)1024 * 256 * 2;
constexpr size_t OFF_WIN1  = OFF_WOUT0 + (size_t)1024 * 1024 * 2;
constexpr size_t OFF_WG    = OFF_WIN1 + (size_t)2048 * 1024 * 2;
constexpr size_t OFF_WOUT1 = OFF_WG + (size_t)32 * 128 * 128 * 2;
static_assert(OFF_WOUT1 + (size_t)1024 * 1024 * 2 <= OFF_RA, "weights overflow");
constexpr size_t SMEM_BYTES = 131072;
constexpr size_t OFF_PSQ = OFF_RE + ((size_t)48 << 20);
constexpr size_t OFF_V8A = OFF_RE;
constexpr size_t OFF_V8D = OFF_RE + ((size_t)20 << 20);

__device__ __forceinline__ int otid() { int t = threadIdx.x; asm volatile("" : "+v"(t)); return t; }
__device__ __forceinline__ int crow(int r, int hi) { return (r & 3) + 8 * (r >> 2) + 4 * hi; }

struct Params {
  const float *x, *c, *ctx, *c_ctx, *ada_w, *ada_b, *ln_g, *ln_b, *e_w_in, *e_qg, *e_w_uq, *e_kvg, *e_w_ukv, *lq1, *lk1, *lq2, *lk2, *subg, *e_w_out,
      *o_w_in, *conv_w, *conv_b, *ga_w, *ga_b, *gx_w, *gx_b, *lru_l, *o_w_out;
  float* out; char* ws;
};

__device__ __forceinline__ int colmap(int MODE, int nd) {
  if (MODE == 0) return nd;
  if (MODE == 1) {
    if (nd < 1024) { const int base = nd < 512 ? 672 : 1184; const int x = nd & 511, tl = x >> 8, y = x & 255, bj = y >> 7, g = (y >> 5) & 3, i = y & 31;
      return base + (tl * 4 + g) * 64 + bj * 32 + i; }
    if (nd < 1536) return 1696 + (nd - 1024);
    if (nd < 2560) return 2208 + (nd - 1536);
    if (nd < 2816) return nd - 2560;
    if (nd < 2944) return 256 + (nd - 2816);
    if (nd < 3072) return 384 + (nd - 2944);
    const int x = nd - 3072;
    if (x < 64) return 512 + x;
    if (x < 80) return 640 + (x - 64);
    if (x < 128) return -1;
    if (x < 192) return 576 + (x - 128);
    if (x < 208) return 656 + (x - 192);
    return -1;
  }
  if (nd < 512) return (nd >> 6) * 96 + (nd & 63);
  if (nd < 640) return ((nd - 512) >> 4) * 96 + 64 + ((nd - 512) & 15);
  return ((nd - 640) >> 4) * 96 + 80 + ((nd - 640) & 15);
}
template <int MODE>
__device__ __forceinline__ void wt_convert(const float* __restrict__ src, int K, int ldsrc, int Nd, bfr* __restrict__ dst, const float* __restrict__ kscale,
                           float* lds, int bid, int nb) {
  const int tid = otid(), tk = K >> 6, tn = Nd >> 6;
  const int j = tid & 63, i0 = tid >> 6;
  float v[8];
  auto load_tile = [&](int t, float (&w)[8]) {
    const int k0 = (t % tk) << 6, n0 = (t / tk) << 6;
    const int ns = colmap(MODE, n0 + j);
#pragma unroll
    for (int u = 0; u < 8; ++u) w[u] = ns >= 0 ? src[(size_t)(k0 + i0 + 8 * u) * ldsrc + ns] : 0.f;
    if (kscale) {
#pragma unroll
      for (int u = 0; u < 8; ++u) w[u] *= kscale[k0 + i0 + 8 * u]; } };
  int t = bid;
  if (t < tk * tn) load_tile(t, v);
  for (; t < tk * tn; t += nb) {
    const int k0 = (t % tk) << 6, n0 = (t / tk) << 6;
#pragma unroll
    for (int u = 0; u < 8; ++u) lds[j * 65 + i0 + 8 * u] = v[u];
    if (t + nb < tk * tn) load_tile(t + nb, v);
    __syncthreads();
#pragma unroll
    for (int u = 0; u < 8; ++u) dst[(size_t)(n0 + i0 + 8 * u) * K + k0 + j] = f2bf(lds[(i0 + 8 * u) * 65 + j]);
    __syncthreads();
  }
}
__device__ __forceinline__ void prep_phase(const Params& p, char* smem, int bid, int nb) {
  float* lds = (float*)smem; char* ws = p.ws;
  wt_convert<1>(p.e_w_in, 1024, 3232, 3328, (bfr*)(ws + OFF_WIN0), nullptr, lds, bid, nb);
  wt_convert<2>(p.e_w_uq, 384, 768, 768, (bfr*)(ws + OFF_WUQ), p.e_qg, lds, bid, nb);
  wt_convert<0>(p.e_w_ukv, 256, 1024, 1024, (bfr*)(ws + OFF_WUKV), p.e_kvg, lds, bid, nb);
  wt_convert<0>(p.e_w_out, 1024, 1024, 1024, (bfr*)(ws + OFF_WOUT0), nullptr, lds, bid, nb);
  float2* rd = (float2*)(ws + OFF_ROPED); float2* ra = (float2*)(ws + OFF_ROPEA);
  for (int e = bid * NTHR + otid(); e < 8192 * 32; e += nb * NTHR) { int pos = e >> 5, i = e & 31;
    float pp = (i < 16) ? (float)(pos >> 6) : (float)(pos & 63); float fr = powf(10000.f, -(float)(i & 15) / 16.f);
    float sn, cs; sincosf(pp * fr, &sn, &cs); rd[e] = make_float2(cs, sn); }
  for (int e = bid * NTHR + otid(); e < 8192 * 16; e += nb * NTHR) { int pos = e >> 4, i = e & 15;
    float pp = (i < 8) ? (float)(pos >> 6) : (float)(pos & 63); float fr = powf(10000.f, -(float)(i & 7) / 8.f);
    float sn, cs; sincosf(pp * fr, &sn, &cs); ra[e] = make_float2(cs, sn); }
}
__device__ __forceinline__ void prep_late(const Params& p, char* smem, int bid, int nb) {
  float* lds = (float*)smem; char* ws = p.ws;
  wt_convert<0>(p.o_w_in, 1024, 2048, 2048, (bfr*)(ws + OFF_WIN1), nullptr, lds, bid, nb);
  wt_convert<0>(p.o_w_out, 1024, 1024, 1024, (bfr*)(ws + OFF_WOUT1), nullptr, lds, bid, nb);
  { bfr* wg = (bfr*)(ws + OFF_WG);
    for (int d = bid * NTHR + otid(); d < 32 * 16384; d += nb * NTHR) {
      const int i = d & 7, lane = (d >> 3) & 63, ks = (d >> 9) & 7, jt = (d >> 12) & 3, blk = (d >> 14) & 7, gate = (d >> 17) & 1, dir = d >> 18;
      const int n = jt * 32 + (lane & 31), k = ks * 16 + (lane >> 5) * 8 + i;
      wg[d] = f2bf(-LOG2E * ((gate ? p.gx_w : p.ga_w) + ((size_t)dir * 8 + blk) * 128 * 128)[k * 128 + n]); } }
}

namespace pg8 {
#define PG8_LAS __attribute__((address_space(3)))
typedef unsigned short bf16_t;
typedef short bf16x8 __attribute__((ext_vector_type(8)));
typedef float f32x4 __attribute__((ext_vector_type(4)));
typedef unsigned u32x4 __attribute__((ext_vector_type(4)));
constexpr int BM = 256, BK = 64, HALF = 128, HTB = HALF * BK * 2  , STAGE_BYTES = 8 * HTB, NXCD = 8, WGM = 8;

__host__ __device__ __forceinline__ int lds_byte(int r, int c) { const int st = (r >> 4) * 2 + (c >> 5), rr = r & 15, cc = c & 31, ob = rr * 64 + cc * 2; return st * 1024 + (ob ^ (((ob >> 9) & 1) << 5)); }
__host__ __device__ __forceinline__ void stage_rc(int b, int& R, int& C) { const int st = b / 1024, sb = b % 1024, swz = sb ^ (((sb >> 9) & 1) << 5); R = (st >> 1) * 16 + swz / 64; C = (st & 1) * 32 + (swz % 64) / 2; }
__host__ __device__ __forceinline__ int perm32(int rho) { const int n = rho >> 4, i = rho & 15; return 8 * (i >> 2) + 4 * n + (i & 3); }

struct Unit { int pm, pn; };
struct Gemm { const bf16_t* A; const bf16_t* Bt; int M, N, K; };

struct StaticOrder {
    int nM, nN, nwg, G, c;
    __host__ __device__ void init(int M, int N, int G_, int c_) { nM = M / BM; nN = N / BM; nwg = nM * nN; G = G_; c = c_; }
    __host__ __device__ bool next(int i, Unit& u) const {
        const long L = (long)i * G + c; if (L >= nwg) return false;
        int wgid = (int)L; { const int q = nwg / NXCD, r = nwg % NXCD, xcd = wgid % NXCD, off = wgid / NXCD; wgid = (xcd < r ? xcd * (q + 1) : r * (q + 1) + (xcd - r) * q) + off; }
        const int nig = WGM * nN, gid = wgid / nig, fm = gid * WGM, gsz = (nM - fm) < WGM ? (nM - fm) : WGM;
        u.pm = fm + ((wgid % nig) % gsz); u.pn = (wgid % nig) / gsz; return true;
    }
    __device__ __forceinline__ void a_ready(const Unit&) const {}
    __device__ __forceinline__ void done(const Unit&) const {}
};

struct LatentOrder : StaticOrder {
    __host__ __device__ void init(int N, int G_, int c_) { StaticOrder::init(128 * BM, N, G_, c_); }
    __host__ __device__ bool next(int i, Unit& u) const { if (!StaticOrder::next(i, u)) return false; u.pm += u.pm >> 5; return true; }
};

__device__ __forceinline__ unsigned cvt_pk_bf16(float lo, float hi) { unsigned r; asm volatile("v_cvt_pk_bf16_f32 %0, %1, %2" : "=v"(r) : "v"(lo), "v"(hi)); return r; }
__device__ __forceinline__ u32x4 pack8(const float* v) { u32x4 w; w.x = cvt_pk_bf16(v[0], v[1]); w.y = cvt_pk_bf16(v[2], v[3]); w.z = cvt_pk_bf16(v[4], v[5]); w.w = cvt_pk_bf16(v[6], v[7]); return w; }
__device__ __forceinline__ uint2 pack8_fp8(const float* v, float sc) {
  int a = 0, b = 0;
  a = __builtin_amdgcn_cvt_pk_fp8_f32(v[0] * sc, v[1] * sc, a, false); a = __builtin_amdgcn_cvt_pk_fp8_f32(v[2] * sc, v[3] * sc, a, true);
  b = __builtin_amdgcn_cvt_pk_fp8_f32(v[4] * sc, v[5] * sc, b, false); b = __builtin_amdgcn_cvt_pk_fp8_f32(v[6] * sc, v[7] * sc, b, true);
  return make_uint2((unsigned)a, (unsigned)b); }
constexpr float Q8S = 16.f, K8S = 4.f;
__device__ __forceinline__ void get8(const f32x4 (&a)[2], float* v) { v[0] = a[0][0]; v[1] = a[0][1]; v[2] = a[0][2]; v[3] = a[0][3]; v[4] = a[1][0]; v[5] = a[1][1]; v[6] = a[1][2]; v[7] = a[1][3]; }
__device__ __forceinline__ void rope8(float* x1, float* x2, const float2* tab, bool lat, float sc) {
  float cs[8], sn[8];
  if (lat) { const float4* t4 = (const float4*)tab;
#pragma unroll
    for (int i = 0; i < 4; ++i) { const float4 t = t4[i]; cs[2 * i] = t.x; sn[2 * i] = t.y; cs[2 * i + 1] = t.z; sn[2 * i + 1] = t.w; } }
  else {
#pragma unroll
    for (int i = 0; i < 8; ++i) { cs[i] = 1.f; sn[i] = 0.f; } }
#pragma unroll
  for (int i = 0; i < 8; ++i) { const float a = x1[i], b = x2[i]; x1[i] = (a * cs[i] - b * sn[i]) * sc; x2[i] = (b * cs[i] + a * sn[i]) * sc; }
}
struct EStore { static constexpr bool PERM = true, AFTER_DRAIN = false; bf16_t* C; int ldc;
  __device__ __forceinline__ void operator()(const f32x4 (&acc)[2][2][4][2], const Unit& u, int wr, int wc, int fr_, int fq_) const {
    int fr = fr_, fq = fq_; asm volatile("" : "+v"(fr), "+v"(fq));
    const int row0 = u.pm * BM + wr * 64 + fr, col0 = u.pn * BM + wc * 32 + 8 * fq;
#pragma unroll
    for (int ai = 0; ai < 2; ++ai)
#pragma unroll
      for (int m = 0; m < 4; ++m) { bf16_t* rowp = C + (size_t)(row0 + ai * HALF + m * 16) * ldc + col0;
#pragma unroll
        for (int bj = 0; bj < 2; ++bj) { float v[8]; get8(acc[ai][bj][m], v); *(u32x4*)(rowp + bj * HALF) = pack8(v); } }
  } };
struct EUG { static constexpr bool PERM = true, AFTER_DRAIN = false; bf16_t *U, *SG1;
  __device__ __forceinline__ void operator()(const f32x4 (&acc)[2][2][4][2], const Unit& u, int wr, int wc, int fr_, int fq_) const {
    int fr = fr_, fq = fq_; asm volatile("" : "+v"(fr), "+v"(fq));
    const bool g = u.pn >= 4; bf16_t* C = g ? SG1 : U;
    const int row0 = u.pm * BM + wr * 64 + fr, col0 = (u.pn & 3) * BM + wc * 32 + 8 * fq;
#pragma unroll
    for (int ai = 0; ai < 2; ++ai)
#pragma unroll
      for (int m = 0; m < 4; ++m) { bf16_t* rowp = C + (size_t)(row0 + ai * HALF + m * 16) * 1024 + col0;
#pragma unroll
        for (int bj = 0; bj < 2; ++bj) { float v[8]; get8(acc[ai][bj][m], v);
          if (g) {
#pragma unroll
            for (int i = 0; i < 8; ++i) v[i] = silu_fast(v[i]); }
          *(u32x4*)(rowp + bj * HALF) = pack8(v); } }
  } };
struct EZ { static constexpr bool PERM = true, AFTER_DRAIN = false; char* ws;
  __device__ __forceinline__ void operator()(const f32x4 (&acc)[2][2][4][2], const Unit& u, int wr, int wc, int fr_, int fq_) const {
    int fr = fr_, fq = fq_; asm volatile("" : "+v"(fr), "+v"(fq));
    const int pn = u.pn, row0 = u.pm * BM + wr * 64 + fr, p00 = (u.pm * BM) % SEQA + wr * 64 + fr; const bool lat = ((u.pm * BM) % SEQA) < NLAT;
    const int c8 = wc * 32 + 8 * fq;
    if (pn < 4) {
      unsigned char* C = (unsigned char*)(ws + OFF_RC) + (pn >= 2 ? SZ512 : 0); const float sc = pn < 2 ? QSC_D * Q8S : K8S;
      const int tcol = ((pn & 1) * 4 + wc) * 64 + 8 * fq; const float2* rd = (const float2*)(ws + OFF_ROPED) + 8 * fq;
#pragma unroll
      for (int ai = 0; ai < 2; ++ai)
#pragma unroll
        for (int m = 0; m < 4; ++m) { const int ro = ai * HALF + m * 16; float x1[8], x2[8]; get8(acc[ai][0][m], x1); get8(acc[ai][1][m], x2);
          rope8(x1, x2, rd + (size_t)(p00 + ro) * 32, lat, sc);
          unsigned char* d = C + (size_t)(row0 + ro) * 512 + tcol; *(uint2*)d = pack8_fp8(x1, 1.f); *(uint2*)(d + 32) = pack8_fp8(x2, 1.f); }
    } else if (pn < 6) {
      bf16_t* C = (bf16_t*)(ws + OFF_RC) + (size_t)RTOT * 1024 + (pn - 4) * BM + c8;
#pragma unroll
      for (int ai = 0; ai < 2; ++ai)
#pragma unroll
        for (int m = 0; m < 4; ++m)
#pragma unroll
          for (int bj = 0; bj < 2; ++bj) { float v[8]; get8(acc[ai][bj][m], v); *(u32x4*)(C + (size_t)(row0 + ai * HALF + m * 16) * 512 + bj * HALF) = pack8(v); }
    } else if (pn < 10) {
      bf16_t* C = (bf16_t*)(ws + OFF_RB) + (pn - 6) * BM + c8;
#pragma unroll
      for (int ai = 0; ai < 2; ++ai)
#pragma unroll
        for (int m = 0; m < 4; ++m)
#pragma unroll
          for (int bj = 0; bj < 2; ++bj) { float v[8]; get8(acc[ai][bj][m], v);
#pragma unroll
            for (int i = 0; i < 8; ++i) v[i] = silu_fast(v[i]);
            *(u32x4*)(C + (size_t)(row0 + ai * HALF + m * 16) * 1024 + bj * HALF) = pack8(v); }
    } else {
      bf16_t* Zq = (bf16_t*)(ws + OFF_RE); bf16_t* Zkv = Zq + (size_t)RTOT * 384; float* PSQ = (float*)(ws + OFF_PSQ);
#pragma unroll
      for (int ai = 0; ai < 2; ++ai)
#pragma unroll
        for (int m = 0; m < 4; ++m) { const int ro = ai * HALF + m * 16; const size_t row = (size_t)(row0 + ro);
#pragma unroll
          for (int bj = 0; bj < 2; ++bj) { float v[8]; get8(acc[ai][bj][m], v);
            bf16_t* d = nullptr;
            if (pn == 10) d = Zq + row * 384 + bj * HALF + c8;
            else if (pn == 11) d = bj ? Zkv + row * 256 + c8 : Zq + row * 384 + 256 + c8;
            else if (wc < 2) d = Zkv + row * 256 + (bj ? 192 : 128) + c8;
            if (d) { *(u32x4*)d = pack8(v);
              float ss = 0.f;
#pragma unroll
              for (int i = 0; i < 8; ++i) ss += v[i] * v[i];
              ss += __shfl_xor(ss, 16); ss += __shfl_xor(ss, 32);
              if (fq == 0) PSQ[row * 24 + (pn - 10) * 8 + bj * 4 + wc] = ss; } }
          if (pn == 12 && wc == 2 && fq < 2) { float x1[8], x2[8]; get8(acc[ai][0][m], x1); get8(acc[ai][1][m], x2);
            rope8(x1, x2, (const float2*)(ws + OFF_ROPEA) + (size_t)(p00 + ro) * 16 + 8 * fq, lat, K8S);
            const uint2 o1 = pack8_fp8(x1, 1.f), o2 = pack8_fp8(x2, 1.f); unsigned char* ka = (unsigned char*)(ws + OFF_RD) + SZ768 + row * 1024 + 64 + 8 * fq;
#pragma unroll
            for (int h = 0; h < 8; ++h) { *(uint2*)(ka + h * 128) = o1; *(uint2*)(ka + h * 128 + 16) = o2;
              *(uint4*)(ka + h * 128 + 32 - 8 * fq + 16 * fq) = make_uint4(0u, 0u, 0u, 0u); } } }
    }
  } };
struct EQ { static constexpr bool PERM = true, AFTER_DRAIN = false; char* ws;
  __device__ __forceinline__ void operator()(const f32x4 (&acc)[2][2][4][2], const Unit& u, int wr, int wc, int fr_, int fq_) const {
    int fr = fr_, fq = fq_; asm volatile("" : "+v"(fr), "+v"(fq));
    const int pn = u.pn, row0 = u.pm * BM + wr * 64 + fr, p00 = (u.pm * BM) % SEQA + wr * 64 + fr; const bool lat = ((u.pm * BM) % SEQA) < NLAT;
    unsigned char* Q8 = (unsigned char*)(ws + OFF_RD); const float* PSQ = (const float*)(ws + OFF_PSQ);
#pragma unroll
    for (int ai = 0; ai < 2; ++ai)
#pragma unroll
      for (int m = 0; m < 4; ++m) { const int ro = ai * HALF + m * 16; const size_t row = (size_t)(row0 + ro);
        const float4* ps = (const float4*)(PSQ + row * 24); const float4 s0 = ps[0], s1 = ps[1], s2 = ps[2];
        const float rq = rsqrtf((s0.x + s0.y + s0.z + s0.w + s1.x + s1.y + s1.z + s1.w + s2.x + s2.y + s2.z + s2.w) * (1.f / 384.f) + 1e-6f) * QSC_A;
        if (pn < 2) {
#pragma unroll
          for (int bj = 0; bj < 2; ++bj) { float v[8]; get8(acc[ai][bj][m], v);
#pragma unroll
            for (int i = 0; i < 8; ++i) v[i] *= rq;
            const int col = pn * BM + bj * HALF + wc * 32 + 8 * fq; *(uint2*)(Q8 + row * 1024 + (col >> 6) * 128 + (col & 63)) = pack8_fp8(v, Q8S); }
        } else { float x1[8], x2[8]; get8(acc[ai][0][m], x1); get8(acc[ai][1][m], x2);
          const int idx = wc * 32 + 8 * fq, h = idx >> 4, i0 = idx & 15;
          rope8(x1, x2, (const float2*)(ws + OFF_ROPEA) + (size_t)(p00 + ro) * 16 + i0, lat, rq);
          unsigned char* d = Q8 + row * 1024 + h * 128 + 64 + i0; *(uint2*)d = pack8_fp8(x1, Q8S); *(uint2*)(d + 16) = pack8_fp8(x2, Q8S);
          *(uint4*)(Q8 + row * 1024 + h * 128 + 96 + 2 * i0) = make_uint4(0u, 0u, 0u, 0u); } }
  } };
struct EKV { static constexpr bool PERM = true, AFTER_DRAIN = false; char* ws;
  __device__ __forceinline__ void operator()(const f32x4 (&acc)[2][2][4][2], const Unit& u, int wr, int wc, int fr_, int fq_) const {
    int fr = fr_, fq = fq_; asm volatile("" : "+v"(fr), "+v"(fq));
    const int pn = u.pn, row0 = u.pm * BM + wr * 64 + fr, c8 = wc * 32 + 8 * fq;
    unsigned char* K8 = (unsigned char*)(ws + OFF_RD) + SZ768; bf16_t* VA = (bf16_t*)(ws + OFF_RD) + (size_t)RTOT * 1536; const float* PSQ = (const float*)(ws + OFF_PSQ);
#pragma unroll
    for (int ai = 0; ai < 2; ++ai)
#pragma unroll
      for (int m = 0; m < 4; ++m) { const size_t row = (size_t)(row0 + ai * HALF + m * 16);
        const float4 s0 = *(const float4*)(PSQ + row * 24 + 12); const float2 s1 = *(const float2*)(PSQ + row * 24 + 16), s2 = *(const float2*)(PSQ + row * 24 + 20);
        const float rk = rsqrtf((s0.x + s0.y + s0.z + s0.w + s1.x + s1.y + s2.x + s2.y) * (1.f / 256.f) + 1e-6f);
#pragma unroll
        for (int bj = 0; bj < 2; ++bj) { float v[8]; get8(acc[ai][bj][m], v);
#pragma unroll
          for (int i = 0; i < 8; ++i) v[i] *= rk;
          const int h = pn * 2 + bj;
          if (c8 < 64) *(uint2*)(K8 + row * 1024 + h * 128 + c8) = pack8_fp8(v, K8S);
          else *(u32x4*)(VA + row * 512 + h * 64 + (c8 - 64)) = pack8(v); } }
  } };

template <class Epi, class Sched, bool STAMP = false>
__device__ __forceinline__ void gemm_phase(PG8_LAS unsigned char* lds, const Gemm g, const Sched& S, const Epi& E, unsigned long long* stamps) {
    const int tid = otid(), wid = __builtin_amdgcn_readfirstlane(tid >> 6), lane = tid & 63, wr = wid >> 2, wc = wid & 3, fr = lane & 15, fq = lane >> 4;
    int K_ = g.K; asm volatile("" : "+s"(K_));
    const int K = K_, nt = K / BK;
    int ts_lo = 0, ts_hi = 0, nts = 0; const unsigned long long rt_entry = STAMP ? (unsigned long long)wall_clock64() : 0ull;
#define PG8_STAMP() do { if (STAMP && wid == 0 && nts < 64) { const unsigned long long _c = (unsigned long long)clock64(); \
        ts_lo = (lane == nts) ? (int)(unsigned)_c : ts_lo; ts_hi = (lane == nts) ? (int)(unsigned)(_c >> 32) : ts_hi; ++nts; } } while (0)
    PG8_STAMP();
    unsigned voffA[2], voffB[2];
#pragma unroll
    for (int i = 0; i < 2; ++i) { int R, C; stage_rc(tid * 16 + i * 8192, R, C); const int Rb = Epi::PERM ? ((R & ~31) + perm32(R & 31)) : R;
        voffA[i] = (unsigned)(R * K + C) * 2u; voffB[i] = (unsigned)(Rb * K + C) * 2u; }
    const size_t kstep = (size_t)(BK * 2);
    const size_t hstep = (size_t)HALF * K * 2;
    const size_t tstep = 2 * hstep;
    const unsigned ldsw = (unsigned)wid * 1024u;
    const int aoff = lds_byte(wr * 64 + fr, fq * 8), boff = lds_byte(wc * 32 + fr, fq * 8);
#define PG8_SA(b, h) (((b) * 2 + (h)) * HTB)
#define PG8_SB(b, h) ((4 + (b) * 2 + (h)) * HTB)
#define PG8_STAGE(bufoff, gbase, voff) do { _Pragma("unroll") for (int _i = 0; _i < 2; ++_i) \
        __builtin_amdgcn_global_load_lds((const unsigned*)((const char*)(gbase) + (voff)[_i]), (PG8_LAS unsigned*)(lds + (bufoff) + ldsw + _i * 8192), 16, 0, 0); } while (0)
#define PG8_LDA(dst, b, h) do { _Pragma("unroll") for (int m = 0; m < 4; ++m) _Pragma("unroll") for (int k = 0; k < 2; ++k) dst[m][k] = *(const PG8_LAS bf16x8*)(lds + PG8_SA(b, h) + aoff + m * 2048 + k * 1024); } while (0)
#define PG8_LDB(dst, b, h) do { _Pragma("unroll") for (int n = 0; n < 2; ++n) _Pragma("unroll") for (int k = 0; k < 2; ++k) dst[n][k] = *(const PG8_LAS bf16x8*)(lds + PG8_SB(b, h) + boff + n * 2048 + k * 1024); } while (0)
#define PG8_MMA(ai, bj, At, Bt) do { __builtin_amdgcn_s_setprio(1); _Pragma("unroll") for (int m = 0; m < 4; ++m) _Pragma("unroll") for (int n = 0; n < 2; ++n) _Pragma("unroll") for (int k = 0; k < 2; ++k) \
        acc[ai][bj][m][n] = __builtin_amdgcn_mfma_f32_16x16x32_bf16(Bt[n][k], At[m][k], acc[ai][bj][m][n], 0, 0, 0); __builtin_amdgcn_s_setprio(0); } while (0)
#define PG8_WAIT_V(n) asm volatile("s_waitcnt vmcnt(" #n ")" ::: "memory")
#define PG8_WAIT_L(n) asm volatile("s_waitcnt lgkmcnt(" #n ")" ::: "memory")
#define PG8_BAR __builtin_amdgcn_s_barrier()
#define PG8_SCHED __builtin_amdgcn_sched_barrier(0)
    Unit cur, nxt; int ui = 0;
    if (!S.next(0, cur)) return;
    f32x4 acc[2][2][4][2];
#pragma unroll
    for (int a = 0; a < 2; ++a)
#pragma unroll
        for (int b = 0; b < 2; ++b)
#pragma unroll
            for (int m = 0; m < 4; ++m)
#pragma unroll
                for (int n = 0; n < 2; ++n) acc[a][b][m][n] = (f32x4){0.f, 0.f, 0.f, 0.f};
    bf16x8 At[4][2], B0[2][2], B1[2][2];
    const char* cA = (const char*)g.A + (size_t)cur.pm * tstep; const char* cB = (const char*)g.Bt + (size_t)cur.pn * tstep;
    S.a_ready(cur);
    PG8_STAGE(PG8_SB(0, 0), cB, voffB); PG8_STAGE(PG8_SA(0, 0), cA, voffA); PG8_STAGE(PG8_SB(0, 1), cB + hstep, voffB); PG8_STAGE(PG8_SA(0, 1), cA + hstep, voffA);
    if (wr == 1) PG8_BAR;
    PG8_WAIT_V(4); PG8_BAR;
    PG8_STAGE(PG8_SB(1, 0), cB + kstep, voffB); PG8_STAGE(PG8_SA(1, 0), cA + kstep, voffA); PG8_STAGE(PG8_SB(1, 1), cB + hstep + kstep, voffB);
    PG8_WAIT_V(6); PG8_BAR;
    PG8_STAMP();
    for (;;) {
        const bool has_next = S.next(ui + 1, nxt);
        const char* nA = has_next ? (const char*)g.A + (size_t)nxt.pm * tstep : cA; const char* nB = has_next ? (const char*)g.Bt + (size_t)nxt.pn * tstep : cB;
        for (int t = 0; t < nt; t += 2) {
            const bool last = (t == nt - 2);
            const char* a1 = cA + (size_t)(t + 1) * kstep;
            const char* a2 = last ? nA : cA + (size_t)(t + 2) * kstep; const char* b2 = last ? nB : cB + (size_t)(t + 2) * kstep;
            const char* a3 = a2 + kstep; const char* b3 = b2 + kstep;
            if (last && has_next) S.a_ready(nxt);
            PG8_LDB(B0, 0, 0); PG8_SCHED; PG8_LDA(At, 0, 0); PG8_STAGE(PG8_SA(1, 1), a1 + hstep, voffA);
            PG8_WAIT_L(8); PG8_BAR; PG8_WAIT_L(0); PG8_MMA(0, 0, At, B0); PG8_BAR; PG8_SCHED;
            PG8_LDB(B1, 0, 1); PG8_STAGE(PG8_SB(0, 0), b2, voffB);
            PG8_BAR; PG8_WAIT_L(0); PG8_MMA(0, 1, At, B1); PG8_BAR;
            PG8_LDA(At, 0, 1); PG8_STAGE(PG8_SA(0, 0), a2, voffA);
            PG8_BAR; PG8_WAIT_L(0); PG8_MMA(1, 0, At, B0); PG8_BAR; PG8_SCHED;
            PG8_STAGE(PG8_SB(0, 1), b2 + hstep, voffB);
            PG8_WAIT_V(6); PG8_BAR; PG8_MMA(1, 1, At, B1); PG8_BAR;
            PG8_LDB(B0, 1, 0); PG8_SCHED; PG8_LDA(At, 1, 0); PG8_STAGE(PG8_SA(0, 1), a2 + hstep, voffA);
            PG8_WAIT_L(8); PG8_BAR; PG8_WAIT_L(0); PG8_MMA(0, 0, At, B0); PG8_BAR; PG8_SCHED;
            PG8_LDB(B1, 1, 1); PG8_STAGE(PG8_SB(1, 0), b3, voffB);
            PG8_BAR; PG8_WAIT_L(0); PG8_MMA(0, 1, At, B1); PG8_BAR;
            PG8_LDA(At, 1, 1); PG8_STAGE(PG8_SA(1, 0), a3, voffA);
            PG8_BAR; PG8_WAIT_L(0); PG8_MMA(1, 0, At, B0); PG8_BAR; PG8_SCHED;
            PG8_STAGE(PG8_SB(1, 1), b3 + hstep, voffB);
            PG8_WAIT_V(6); PG8_BAR; PG8_MMA(1, 1, At, B1); PG8_BAR;
        }
        PG8_STAMP();
        if constexpr (!Epi::AFTER_DRAIN) { E(acc, cur, wr, wc, fr, fq); S.done(cur); }
        PG8_STAMP();
        if (!has_next) break;
#pragma unroll
        for (int a = 0; a < 2; ++a)
#pragma unroll
            for (int b = 0; b < 2; ++b)
#pragma unroll
                for (int m = 0; m < 4; ++m)
#pragma unroll
                    for (int n = 0; n < 2; ++n) acc[a][b][m][n] = (f32x4){0.f, 0.f, 0.f, 0.f};
        cur = nxt; cA = nA; cB = nB; ++ui;
    }
    PG8_WAIT_V(0);
    if (wr == 0) PG8_BAR;
    PG8_BAR;
    if constexpr (Epi::AFTER_DRAIN) { E.fused(acc, cur, wr, wc, fr, fq, lds, wid, lane); S.done(cur); }
    PG8_STAMP();
    if (STAMP && wid == 0) { stamps[lane] = lane < nts ? (((unsigned long long)(unsigned)ts_hi << 32) | (unsigned)ts_lo) : 0ull;
        if (lane == 62) stamps[62] = rt_entry; if (lane == 63) stamps[63] = (unsigned long long)wall_clock64(); }
#undef PG8_STAMP
#undef PG8_SA
#undef PG8_SB
#undef PG8_STAGE
#undef PG8_LDA
#undef PG8_LDB
#undef PG8_MMA
#undef PG8_WAIT_V
#undef PG8_WAIT_L
#undef PG8_BAR
#undef PG8_SCHED
}
}

constexpr int SHM_KV = 64 * 256;
#ifndef ATT_AUG
#define ATT_AUG 1
#endif
constexpr float THR2 = 11.5f;
#define KSWZ(row, colB) ((row) * 256 + ((colB) ^ (((row) & 15) << 4)))
#define SBAR() __builtin_amdgcn_sched_barrier(0)
__device__ __forceinline__ unsigned cvtpk(float lo, float hi) { unsigned r; asm volatile("v_cvt_pk_bf16_f32 %0, %1, %2" : "=v"(r) : "v"(lo), "v"(hi)); return r; }
constexpr float P_TOP = 8.f, P_REF = 2.f;
typedef int v8i_t __attribute__((ext_vector_type(8)));
template <bool FIRST, int VAR, bool ALLEXP = false>
__device__ __forceinline__ void partialSM(f32x16& p0, f32x16& p1, float& m_ref, float& alpha) {
  if (VAR == 3) { alpha = 1.f; return; }
  float pmax = p0[0];
#pragma unroll
  for (int r = 1; r < 16; ++r) pmax = fmaxf(pmax, p0[r]);
#pragma unroll
  for (int r = 0; r < 16; ++r) pmax = fmaxf(pmax, p1[r]);
  { auto rr = __builtin_amdgcn_permlane32_swap(__float_as_uint(pmax), __float_as_uint(pmax), false, false);
    pmax = fmaxf(__uint_as_float(rr[0]), __uint_as_float(rr[1])); }
  if (!FIRST && __builtin_expect(__all(pmax <= P_TOP), 1)) { alpha = 1.f; }
  else {
    const float mn = bf2f(f2bf(m_ref + (FIRST ? pmax - P_REF : fmaxf(pmax - P_REF, 0.f))));
    const float delta = mn - m_ref;
    alpha = FIRST ? 0.f : __builtin_amdgcn_exp2f(-delta);
    m_ref = mn;
#pragma unroll
    for (int r = 0; r < 16; ++r) p0[r] = p0[r] - delta;
#pragma unroll
    for (int r = 0; r < 16; ++r) p1[r] = p1[r] - delta;
  }
#pragma unroll
  for (int r = 0; r < 16; ++r) p0[r] = __builtin_amdgcn_exp2f(p0[r]);
  if (ALLEXP) {
#pragma unroll
    for (int r = 0; r < 16; ++r) p1[r] = __builtin_amdgcn_exp2f(p1[r]);
  }
}
template <int VAR, bool ALLEXP = false>
__device__ __forceinline__ void finishSM(f32x16& p0, f32x16& p1, v8i_t& pa) {
  if (VAR != 3 && !ALLEXP) {
#pragma unroll
  for (int r = 0; r < 16; ++r) p1[r] = __builtin_amdgcn_exp2f(p1[r]);
  }
#pragma unroll
  for (int g = 0; g < 4; ++g) { int w = 0; w = __builtin_amdgcn_cvt_pk_fp8_f32(p0[4 * g], p0[4 * g + 1], w, false); w = __builtin_amdgcn_cvt_pk_fp8_f32(p0[4 * g + 2], p0[4 * g + 3], w, true); pa[g] = w; }
#pragma unroll
  for (int g = 0; g < 4; ++g) { int w = 0; w = __builtin_amdgcn_cvt_pk_fp8_f32(p1[4 * g], p1[4 * g + 1], w, false); w = __builtin_amdgcn_cvt_pk_fp8_f32(p1[4 * g + 2], p1[4 * g + 3], w, true); pa[4 + g] = w; }
}
template <int NP>
__device__ __forceinline__ void qkt8(f32x16& p0, f32x16& p1, const char* Ks, const v8i_t* q8, int r32, int hi, int kbyte0, float m_ref) {
  { const unsigned one = hi ? 0u : 0x3F80u, nm = hi ? 0u : (unsigned)f2bf(-m_ref);
    u32x4 ka = {one, 0u, 0u, 0u}, qa = {nm, 0u, 0u, 0u};
    f32x16 z;
#pragma unroll
    for (int r = 0; r < 16; ++r) z[r] = 0.f;
    p0 = __builtin_amdgcn_mfma_f32_32x32x16_bf16(*reinterpret_cast<bf16x8*>(&ka), *reinterpret_cast<bf16x8*>(&qa), z, 0, 0, 0);
    p1 = __builtin_amdgcn_mfma_f32_32x32x16_bf16(*reinterpret_cast<bf16x8*>(&ka), *reinterpret_cast<bf16x8*>(&qa), z, 0, 0, 0); }
  const int sw = (r32 >> 1) & 7;
#pragma unroll
  for (int part = 0; part < NP; ++part) { const int c0 = (kbyte0 + part * 64 + 32 * hi) >> 4;
    const char* r0 = Ks + r32 * 128; const char* r1 = r0 + 32 * 128;
    const uint4 a0 = *reinterpret_cast<const uint4*>(r0 + ((c0 ^ sw) << 4)), a1 = *reinterpret_cast<const uint4*>(r0 + (((c0 + 1) ^ sw) << 4));
    const uint4 b0 = *reinterpret_cast<const uint4*>(r1 + ((c0 ^ sw) << 4)), b1 = *reinterpret_cast<const uint4*>(r1 + (((c0 + 1) ^ sw) << 4));
    v8i_t A0, A1; A0[0] = a0.x; A0[1] = a0.y; A0[2] = a0.z; A0[3] = a0.w; A0[4] = a1.x; A0[5] = a1.y; A0[6] = a1.z; A0[7] = a1.w;
    A1[0] = b0.x; A1[1] = b0.y; A1[2] = b0.z; A1[3] = b0.w; A1[4] = b1.x; A1[5] = b1.y; A1[6] = b1.z; A1[7] = b1.w;
    p0 = __builtin_amdgcn_mfma_scale_f32_32x32x64_f8f6f4(A0, q8[part], p0, 0, 0, 0, 0x7D7D7D7D, 0, 0x7B7B7B7B);
    p1 = __builtin_amdgcn_mfma_scale_f32_32x32x64_f8f6f4(A1, q8[part], p1, 0, 0, 0, 0x7D7D7D7D, 0, 0x7B7B7B7B); }
}
template <int NVB> __device__ __forceinline__ void pv8_all(f32x16* o, f32x16& osum, const char* v8, int r32, int hi, v8i_t pa) {
  { v8i_t ones;
#pragma unroll
    for (int g = 0; g < 8; ++g) ones[g] = 0x38383838;
    osum = __builtin_amdgcn_mfma_scale_f32_32x32x64_f8f6f4(pa, ones, osum, 0, 0, 0, 0x7F7F7F7F, 0, 0x7F7F7F7F); }
#pragma unroll
  for (int blk = 0; blk < NVB; ++blk) { const int d = blk * 32 + r32, sw = (d >> 2) & 3;
    const uint4 lo = *reinterpret_cast<const uint4*>(v8 + d * 64 + (((2 * hi) ^ sw) << 4)), hi4 = *reinterpret_cast<const uint4*>(v8 + d * 64 + (((2 * hi + 1) ^ sw) << 4));
    v8i_t bq; bq[0] = lo.x; bq[1] = lo.y; bq[2] = lo.z; bq[3] = lo.w; bq[4] = hi4.x; bq[5] = hi4.y; bq[6] = hi4.z; bq[7] = hi4.w;
    o[blk] = __builtin_amdgcn_mfma_scale_f32_32x32x64_f8f6f4(pa, bq, o[blk], 0, 0, 0, 0x7F7F7F7F, 0, 0x7C7C7C7C); }
}
template <int NP> __device__ __forceinline__ void k8_load(v8i_t (&kf)[NP][2], const char* Ks, int r32, int hi, int kbyte0) {
  const int sw = (r32 >> 1) & 7;
#pragma unroll
  for (int part = 0; part < NP; ++part) { const int c0 = (kbyte0 + part * 64 + 32 * hi) >> 4;
    const char* r0 = Ks + r32 * 128; const char* r1 = r0 + 32 * 128;
    const u32x4 a0 = *reinterpret_cast<const u32x4*>(r0 + ((c0 ^ sw) << 4)), a1 = *reinterpret_cast<const u32x4*>(r0 + (((c0 + 1) ^ sw) << 4));
    const u32x4 b0 = *reinterpret_cast<const u32x4*>(r1 + ((c0 ^ sw) << 4)), b1 = *reinterpret_cast<const u32x4*>(r1 + (((c0 + 1) ^ sw) << 4));
    kf[part][0][0] = a0.x; kf[part][0][1] = a0.y; kf[part][0][2] = a0.z; kf[part][0][3] = a0.w; kf[part][0][4] = a1.x; kf[part][0][5] = a1.y; kf[part][0][6] = a1.z; kf[part][0][7] = a1.w;
    kf[part][1][0] = b0.x; kf[part][1][1] = b0.y; kf[part][1][2] = b0.z; kf[part][1][3] = b0.w; kf[part][1][4] = b1.x; kf[part][1][5] = b1.y; kf[part][1][6] = b1.z; kf[part][1][7] = b1.w; }
}
template <int NP, bool SKIP = false> __device__ __forceinline__ void qk8_mma(f32x16& p0, f32x16& p1, const v8i_t (&kf)[NP][2], const v8i_t* q8, int hi, u32x4 qa) {
  { const unsigned one = hi ? 0u : 0x3F80u;
    u32x4 ka = {one, 0u, 0u, 0u};
    f32x16 z;
#pragma unroll
    for (int r = 0; r < 16; ++r) z[r] = 0.f;
    p0 = __builtin_amdgcn_mfma_f32_32x32x16_bf16(*reinterpret_cast<bf16x8*>(&ka), *reinterpret_cast<bf16x8*>(&qa), z, 0, 0, 0);
    p1 = __builtin_amdgcn_mfma_f32_32x32x16_bf16(*reinterpret_cast<bf16x8*>(&ka), *reinterpret_cast<bf16x8*>(&qa), z, 0, 0, 0); }
#pragma unroll
  for (int part = 0; part < NP; ++part) {
    if constexpr (SKIP) { v8i_t t0 = kf[part][0], t1 = kf[part][1]; asm volatile("" :: "v"(t0), "v"(t1)); }
    else {
    p0 = __builtin_amdgcn_mfma_scale_f32_32x32x64_f8f6f4(kf[part][0], q8[part], p0, 0, 0, 0, 0x7D7D7D7D, 0, 0x7B7B7B7B);
    p1 = __builtin_amdgcn_mfma_scale_f32_32x32x64_f8f6f4(kf[part][1], q8[part], p1, 0, 0, 0, 0x7D7D7D7D, 0, 0x7B7B7B7B); } }
}
template <int NP, int H> __device__ __forceinline__ void qk8_mma_half(f32x16& ph, const v8i_t (&kf)[NP][2], const v8i_t* q8, int hi, u32x4 qa) {
  { const unsigned one = hi ? 0u : 0x3F80u;
    u32x4 ka = {one, 0u, 0u, 0u};
    f32x16 z;
#pragma unroll
    for (int r = 0; r < 16; ++r) z[r] = 0.f;
    ph = __builtin_amdgcn_mfma_f32_32x32x16_bf16(*reinterpret_cast<bf16x8*>(&ka), *reinterpret_cast<bf16x8*>(&qa), z, 0, 0, 0); }
#pragma unroll
  for (int part = 0; part < NP; ++part)
    ph = __builtin_amdgcn_mfma_scale_f32_32x32x64_f8f6f4(kf[part][H], q8[part], ph, 0, 0, 0, 0x7D7D7D7D, 0, 0x7B7B7B7B);
}
template <int NVB> __device__ __forceinline__ void v8_load(v8i_t (&vf)[NVB], const char* v8, int r32, int hi) {
#pragma unroll
  for (int blk = 0; blk < NVB; ++blk) { const int d = blk * 32 + r32, sw = (d >> 2) & 3;
    const u32x4 lo = *reinterpret_cast<const u32x4*>(v8 + d * 64 + (((2 * hi) ^ sw) << 4)), hi4 = *reinterpret_cast<const u32x4*>(v8 + d * 64 + (((2 * hi + 1) ^ sw) << 4));
    vf[blk][0] = lo.x; vf[blk][1] = lo.y; vf[blk][2] = lo.z; vf[blk][3] = lo.w; vf[blk][4] = hi4.x; vf[blk][5] = hi4.y; vf[blk][6] = hi4.z; vf[blk][7] = hi4.w; }
}
template <int B0, int B1, int NVB> __device__ __forceinline__ void v8_load_range(v8i_t (&vf)[NVB], const char* v8, int r32, int hi) {
#pragma unroll
  for (int blk = B0; blk < B1; ++blk) { const int d = blk * 32 + r32, sw = (d >> 2) & 3;
    const u32x4 lo = *reinterpret_cast<const u32x4*>(v8 + d * 64 + (((2 * hi) ^ sw) << 4)), hi4 = *reinterpret_cast<const u32x4*>(v8 + d * 64 + (((2 * hi + 1) ^ sw) << 4));
    vf[blk][0] = lo.x; vf[blk][1] = lo.y; vf[blk][2] = lo.z; vf[blk][3] = lo.w; vf[blk][4] = hi4.x; vf[blk][5] = hi4.y; vf[blk][6] = hi4.z; vf[blk][7] = hi4.w; }
}
template <int NVB> __device__ __forceinline__ void pv8_mma(f32x16* o, f32x16& osum, const v8i_t (&vf)[NVB], v8i_t pa) {
  { v8i_t ones;
#pragma unroll
    for (int g = 0; g < 8; ++g) ones[g] = 0x38383838;
    osum = __builtin_amdgcn_mfma_scale_f32_32x32x64_f8f6f4(pa, ones, osum, 0, 0, 0, 0x7F7F7F7F, 0, 0x7F7F7F7F); }
#pragma unroll
  for (int blk = 0; blk < NVB; ++blk) o[blk] = __builtin_amdgcn_mfma_scale_f32_32x32x64_f8f6f4(pa, vf[blk], o[blk], 0, 0, 0, 0x7F7F7F7F, 0, 0x7C7C7C7C);
}
__device__ __forceinline__ void v8_phase(const Params& p, char* smem, int bid, int nb) {
  char* ws = p.ws; bfr* T = (bfr*)smem; constexpr int LP = 520;
  const int tid = otid();
  u32x4 l0, l1, l2, l3, l4, l5, l6, l7;
#define V8_SRC(it_) (((it_) & 1 ? (const bfr*)(ws + OFF_RC) + (size_t)RTOT * 1024 : (const bfr*)(ws + OFF_RD) + (size_t)RTOT * 1536) + ((size_t)(((it_) >> 1) / 132) * SEQA + (size_t)(((it_) >> 1) % 132) * 64) * 512)
#define V8_LD(src_) do { const bfr* q_ = (src_) + (size_t)(tid >> 6) * 512 + (tid & 63) * 8; \
    l0 = *(const u32x4*)(q_); l1 = *(const u32x4*)(q_ + 8 * 512); l2 = *(const u32x4*)(q_ + 16 * 512); l3 = *(const u32x4*)(q_ + 24 * 512); \
    l4 = *(const u32x4*)(q_ + 32 * 512); l5 = *(const u32x4*)(q_ + 40 * 512); l6 = *(const u32x4*)(q_ + 48 * 512); l7 = *(const u32x4*)(q_ + 56 * 512); } while (0)
  int it = bid;
  if (it < 4 * 132 * 2) V8_LD(V8_SRC(it));
  for (; it < 4 * 132 * 2; it += nb) {
    const int type = it & 1, t = (it >> 1) % 132, b = (it >> 1) / 132;
    { bfr* d_ = T + (tid >> 6) * LP + (tid & 63) * 8;
      *(u32x4*)(d_) = l0; *(u32x4*)(d_ + 8 * LP) = l1; *(u32x4*)(d_ + 16 * LP) = l2; *(u32x4*)(d_ + 24 * LP) = l3;
      *(u32x4*)(d_ + 32 * LP) = l4; *(u32x4*)(d_ + 40 * LP) = l5; *(u32x4*)(d_ + 48 * LP) = l6; *(u32x4*)(d_ + 56 * LP) = l7; }
    if (it + nb < 4 * 132 * 2) V8_LD(V8_SRC(it + nb));
    __syncthreads();
#pragma unroll
    for (int u = 0; u < 4; ++u) { const int task = tid + u * NTHR, c = task & 511, q4 = task >> 9, hh = q4 >> 1, kb = (q4 & 1) * 32;
      int w[4];
#pragma unroll
      for (int g = 0; g < 4; ++g) { float f[4];
#pragma unroll
        for (int e = 0; e < 4; ++e) f[e] = 8.f * bf2f(T[(kb + crow(4 * g + e, hh)) * LP + c]);
        int x = 0; x = __builtin_amdgcn_cvt_pk_fp8_f32(f[0], f[1], x, false); x = __builtin_amdgcn_cvt_pk_fp8_f32(f[2], f[3], x, true); w[g] = x; }
      char* dst = type ? ws + OFF_V8D + ((((size_t)(b * 4 + (c >> 7)) * 132 + t) * 128 + (c & 127)) << 6)
                       : ws + OFF_V8A + ((((size_t)(b * 8 + (c >> 6)) * 132 + t) * 64 + (c & 63)) << 6);
      *(int4*)(dst + q4 * 16) = make_int4(w[0], w[1], w[2], w[3]); }
    __syncthreads();
  }
#undef V8_SRC
#undef V8_LD
}
extern __shared__ __attribute__((aligned(16))) char dyn_smem[];
__device__ __forceinline__ char* dyn_smem_base() { return dyn_smem; }
#ifndef PROBE_VAR
#define PROBE_VAR 0
#endif
#define PSYNC() do { if (VAR != 1) __syncthreads(); } while (0)
template <int TYPE, int VAR>
__device__ __forceinline__ void attn_item(const Params& p, char* lds, int h, int qrow0, int krow0, int NT, float lam) {
  const int bq_ = krow0 / SEQA, t0_ = (krow0 - bq_ * SEQA) >> 6;
  constexpr int NP = TYPE ? 1 : 2, NVB = TYPE ? 4 : 2;
  constexpr int STG = 16384, KOFF = 8192;
  const int tid = otid(), wid = __builtin_amdgcn_readfirstlane(tid >> 6), lane = tid & 63, r32 = lane & 31, hi = lane >> 5;
  const int map = TYPE ? (wid >> 2) : 0, wq = TYPE ? (wid & 3) : wid, grp = wid >> 2;
  char* ws = p.ws;
  const unsigned char* Q8 = TYPE ? (const unsigned char*)(ws + OFF_RC) + (size_t)(qrow0 + wq * 32 + r32) * 512 + h * 128 + map * 64 + hi * 32
                                 : (const unsigned char*)(ws + OFF_RD) + (size_t)(qrow0 + wq * 32 + r32) * 1024 + h * 128 + hi * 32;
  const unsigned char* Kh = TYPE ? (const unsigned char*)(ws + OFF_RC) + SZ512 + (size_t)krow0 * 512 + h * 128
                                 : (const unsigned char*)(ws + OFF_RD) + SZ768 + (size_t)krow0 * 1024 + h * 128;
  constexpr int LDKB = TYPE ? 512 : 1024;
  const char* v8g = TYPE ? (const char*)(ws + OFF_V8D) + (((size_t)(bq_ * 4 + h) * 132 + t0_) << 13)
                         : (const char*)(ws + OFF_V8A) + (((size_t)(bq_ * 8 + h) * 132 + t0_) << 12);
  const bfr* SG0 = (const bfr*)(ws + OFF_RB); bfr* OG = (bfr*)(ws + OFF_RA);
  const int kbyte0 = map * 64;
  PG8_LAS unsigned char* ldsA = (PG8_LAS unsigned char*)dyn_smem_base();
  float* al_l = (float*)(lds + 4 * STG) + wid * 32;
  float m_ref = 0.f; f32x16 o[NVB], osum, p0, p1; v8i_t q8[NP], pa, kf[NP][2], vf[NVB];
  u32x4 qaug = {0u, 0u, 0u, 0u};
#pragma unroll
  for (int d = 0; d < NVB; ++d)
#pragma unroll
    for (int r = 0; r < 16; ++r) o[d][r] = 0.f;
#pragma unroll
  for (int r = 0; r < 16; ++r) osum[r] = 0.f;
#pragma unroll
  for (int g = 0; g < 8; ++g) pa[g] = 0;
  const int k8of = (8 * wid + (lane >> 3)) * LDKB + (((lane & 7) ^ (((8 * wid + (lane >> 3)) >> 1) & 7)) << 4);
  const int v8of = (16 * wid + (lane >> 2)) * 64 + (((lane & 3) ^ (((16 * wid + (lane >> 2)) >> 2) & 3)) << 4);
#define GLDS(gp, loff) __builtin_amdgcn_global_load_lds((const unsigned*)(gp), (PG8_LAS unsigned*)(ldsA + (loff)), 16, 0, 0)
#define STAGE_TILE(t, sg) do { \
    if (wid < NVB * 2) GLDS(v8g + (size_t)(t) * (NVB * 2048) + v8of, (unsigned)(sg) * STG + (unsigned)wid * 1024u); \
    GLDS(Kh + (size_t)(t) * 64 * LDKB + k8of, (unsigned)(sg) * STG + KOFF + (unsigned)wid * 1024u); } while (0)
#define STAGE_TILE_G0(t, sg) do { \
    GLDS(v8g + (size_t)(t) * (NVB * 2048) + v8of, (unsigned)(sg) * STG + (unsigned)wid * 1024u); \
    if (NVB == 4) GLDS(v8g + (size_t)(t) * (NVB * 2048) + v8of + 4096, (unsigned)(sg) * STG + (unsigned)(wid + 4) * 1024u); \
    GLDS(Kh + (size_t)(t) * 64 * LDKB + k8of, (unsigned)(sg) * STG + KOFF + (unsigned)wid * 1024u); \
    GLDS(Kh + (size_t)(t) * 64 * LDKB + k8of + 32 * LDKB, (unsigned)(sg) * STG + KOFF + (unsigned)(wid + 4) * 1024u); } while (0)
#define BAR_LV(last) do { SBAR(); if (grp == 0) { if (last) asm volatile("s_waitcnt vmcnt(0) lgkmcnt(0)\n\ts_barrier" ::: "memory"); \
      else if (NVB == 4) asm volatile("s_waitcnt vmcnt(4) lgkmcnt(0)\n\ts_barrier" ::: "memory"); else asm volatile("s_waitcnt vmcnt(3) lgkmcnt(0)\n\ts_barrier" ::: "memory"); } \
    else asm volatile("s_waitcnt lgkmcnt(0)\n\ts_barrier" ::: "memory"); SBAR(); } while (0)
#define BAR_L()  do { SBAR(); asm volatile("s_waitcnt lgkmcnt(0)\n\ts_barrier" ::: "memory"); SBAR(); } while (0)
#define BAR_VL() do { SBAR(); asm volatile("s_waitcnt vmcnt(0) lgkmcnt(0)\n\ts_barrier" ::: "memory"); SBAR(); } while (0)
#define FINISH_P1() do { if (VAR != 3) { _Pragma("unroll") for (int r = 0; r < 16; ++r) p1[r] = __builtin_amdgcn_exp2f(p1[r]); } \
    _Pragma("unroll") for (int g = 0; g < 4; ++g) { int w = pa[4 + g]; w = __builtin_amdgcn_cvt_pk_fp8_f32(p1[4 * g], p1[4 * g + 1], w, false); w = __builtin_amdgcn_cvt_pk_fp8_f32(p1[4 * g + 2], p1[4 * g + 3], w, true); pa[4 + g] = w; } \
    asm volatile("" : "+v"(pa)); } while (0)
  STAGE_TILE(0, 0); STAGE_TILE(1, 1); STAGE_TILE(2, 2);
#pragma unroll
  for (int part = 0; part < NP; ++part) { const uint4 x0 = *reinterpret_cast<const uint4*>(Q8 + part * 64), x1 = *reinterpret_cast<const uint4*>(Q8 + part * 64 + 16);
    q8[part][0] = x0.x; q8[part][1] = x0.y; q8[part][2] = x0.z; q8[part][3] = x0.w; q8[part][4] = x1.x; q8[part][5] = x1.y; q8[part][6] = x1.z; q8[part][7] = x1.w; }
  BAR_VL();
  k8_load<NP>(kf, lds + KOFF, r32, hi, kbyte0);
#pragma unroll
  for (int blk = 0; blk < NVB; ++blk)
#pragma unroll
    for (int g = 0; g < 8; ++g) vf[blk][g] = 0;
  if (grp == 1) BAR_L();
  auto tile_step = [&](auto SC, const int j) __attribute__((always_inline)) {
    constexpr int S = decltype(SC)::value;
    qk8_mma_half<NP, 0>(p0, kf, q8, hi, qaug);
    asm volatile("" : "+v"(p0));
    SBAR();
    if (j > 0) FINISH_P1();
    SBAR();
    qk8_mma_half<NP, 1>(p1, kf, q8, hi, qaug);
    asm volatile("" : "+v"(p1));
    if (j > 0) { if (VAR != 4 && VAR != 5) { pv8_mma<NVB>(o, osum, vf, pa);
        asm volatile("" : "+v"(osum));
#pragma unroll
        for (int blk = 0; blk < NVB; ++blk) asm volatile("" : "+v"(o[blk])); }
      if (VAR == 5) { asm volatile("" :: "v"(pa));
#pragma unroll
        for (int blk = 0; blk < NVB; ++blk) asm volatile("" :: "v"(vf[blk])); } }
    BAR_LV(j + 2 >= NT);
    if (j + 1 < NT) k8_load<NP>(kf, lds + ((S + 1) & 3) * STG + KOFF, r32, hi, kbyte0);
    v8_load<NVB>(vf, lds + S * STG, r32, hi);
    if (grp == 0 && j + 3 < NT) STAGE_TILE_G0(j + 3, (S + 3) & 3);
    float alpha;
    { float pmax = p0[0];
      if (VAR != 7) {
#pragma unroll
      for (int r = 1; r < 16; ++r) pmax = fmaxf(pmax, p0[r]);
#pragma unroll
      for (int r = 0; r < 16; ++r) pmax = fmaxf(pmax, p1[r]);
      }
      { auto rr = __builtin_amdgcn_permlane32_swap(__float_as_uint(pmax), __float_as_uint(pmax), false, false);
        pmax = fmaxf(__uint_as_float(rr[0]), __uint_as_float(rr[1])); }
      const bool first = (j == 0);
      if (!first && __builtin_expect(__all(pmax <= P_TOP), 1)) { alpha = 1.f; }
      else {
        const float mn = bf2f(f2bf(m_ref + (first ? pmax - P_REF : fmaxf(pmax - P_REF, 0.f))));
        const float delta = mn - m_ref;
        alpha = first ? 0.f : __builtin_amdgcn_exp2f(-delta);
        m_ref = mn; qaug[0] = hi ? 0u : (unsigned)f2bf(-mn);
#pragma unroll
        for (int r = 0; r < 16; ++r) { p0[r] = p0[r] - delta; p1[r] = p1[r] - delta; }
        if (hi == 0) al_l[r32] = alpha; asm volatile("s_waitcnt lgkmcnt(0)" ::: "memory");
#pragma unroll
        for (int r = 0; r < 16; ++r) { const float f_ = al_l[crow(r, hi)]; osum[r] *= f_;
#pragma unroll
          for (int d = 0; d < NVB; ++d) o[d][r] *= f_; }
      }
      if (VAR != 3) {
#pragma unroll
      for (int r = 0; r < 16; ++r) p0[r] = __builtin_amdgcn_exp2f(p0[r]);
      }
#pragma unroll
      for (int g = 0; g < 4; ++g) { int w = pa[g]; w = __builtin_amdgcn_cvt_pk_fp8_f32(p0[4 * g], p0[4 * g + 1], w, false); w = __builtin_amdgcn_cvt_pk_fp8_f32(p0[4 * g + 2], p0[4 * g + 3], w, true); pa[g] = w; }
    }
    BAR_L();
    };
  for (int jb = 0; jb < NT; jb += 4) {
    tile_step(std::integral_constant<int, 0>{}, jb); tile_step(std::integral_constant<int, 1>{}, jb + 1);
    tile_step(std::integral_constant<int, 2>{}, jb + 2); tile_step(std::integral_constant<int, 3>{}, jb + 3);
  }
  const int erow = lane >> 1, ehf = lane & 1;
  constexpr int ECOLS = TYPE ? 64 : 32;
  const size_t gidx = (size_t)(qrow0 + wq * 32 + erow) * 1024 + (TYPE ? 512 + h * 128 : h * 64) + ehf * ECOLS;
  uint4 gv[ECOLS / 8];
  if (TYPE == 0 || map == 0) {
#pragma unroll
    for (int k = 0; k < ECOLS / 8; ++k) gv[k] = *(const uint4*)(SG0 + gidx + 8 * k);
  }
  FINISH_P1();
  pv8_mma<NVB>(o, osum, vf, pa);
  if (grp == 0) BAR_L();
  float rli[16];
#pragma unroll
  for (int r = 0; r < 16; ++r) rli[r] = __builtin_amdgcn_rcpf(osum[r]);
  if constexpr (TYPE == 0) {
    float* st = (float*)(lds + wid * 8704);
#pragma unroll
    for (int r = 0; r < 16; ++r)
#pragma unroll
      for (int d0 = 0; d0 < NVB; ++d0) st[crow(r, hi) * 68 + d0 * 32 + r32] = o[d0][r] * rli[r];
    asm volatile("s_waitcnt lgkmcnt(0)" ::: "memory");
    const float* sp = st + erow * 68 + ehf * 32;
#pragma unroll
    for (int k = 0; k < 4; ++k) { const float4 a = *(const float4*)(sp + 8 * k), b = *(const float4*)(sp + 8 * k + 4); float gf[8]; unpack8(gv[k], gf);
      u32x4 ov; ov[0] = cvtpk(a.x * gf[0], a.y * gf[1]); ov[1] = cvtpk(a.z * gf[2], a.w * gf[3]); ov[2] = cvtpk(b.x * gf[4], b.y * gf[5]); ov[3] = cvtpk(b.z * gf[6], b.w * gf[7]);
      if (VAR == 0) *(u32x4*)(OG + gidx + 8 * k) = ov; else asm volatile("" :: "v"(ov)); }
    __syncthreads();
  } else {
    float* xch = (float*)lds;
    __syncthreads();
    if (map == 1) {
#pragma unroll
      for (int r = 0; r < 16; ++r) { const float f = rli[r] * lam;
#pragma unroll
        for (int d0 = 0; d0 < 4; ++d0) xch[(wq * 32 + crow(r, hi)) * 128 + d0 * 32 + r32] = o[d0][r] * f; }
    }
    __syncthreads();
    if (map == 0) {
      float* st = (float*)(lds + 65536 + wq * 16896);
#pragma unroll
      for (int r = 0; r < 16; ++r)
#pragma unroll
        for (int d0 = 0; d0 < 4; ++d0) st[crow(r, hi) * 132 + d0 * 32 + r32] = o[d0][r] * rli[r] - xch[(wq * 32 + crow(r, hi)) * 128 + d0 * 32 + r32];
      asm volatile("s_waitcnt lgkmcnt(0)" ::: "memory");
      const float* sp = st + erow * 132 + ehf * 64;
      float4 vv[16];
#pragma unroll
      for (int k = 0; k < 16; ++k) vv[k] = *(const float4*)(sp + 4 * k);
      float ss = 0.f;
#pragma unroll
      for (int k = 0; k < 16; ++k) ss += vv[k].x * vv[k].x + vv[k].y * vv[k].y + vv[k].z * vv[k].z + vv[k].w * vv[k].w;
      ss += __shfl_xor(ss, 1);
      const float rs = rsqrtf(ss * (1.f / 128.f) + 1e-6f) * 0.8f;
      const float* subg = p.subg + ehf * 64;
#pragma unroll
      for (int k = 0; k < 8; ++k) { const float4 s0 = *(const float4*)(subg + 8 * k), s1 = *(const float4*)(subg + 8 * k + 4); float gf[8]; unpack8(gv[k], gf);
        const float4 a = vv[2 * k], b = vv[2 * k + 1];
        u32x4 ov; ov[0] = cvtpk(a.x * rs * s0.x * gf[0], a.y * rs * s0.y * gf[1]); ov[1] = cvtpk(a.z * rs * s0.z * gf[2], a.w * rs * s0.w * gf[3]);
        ov[2] = cvtpk(b.x * rs * s1.x * gf[4], b.y * rs * s1.y * gf[5]); ov[3] = cvtpk(b.z * rs * s1.z * gf[6], b.w * rs * s1.w * gf[7]);
        if (VAR == 0) *(u32x4*)(OG + gidx + 8 * k) = ov; else asm volatile("" :: "v"(ov)); }
    }
    __syncthreads();
  }
#undef GLDS
#undef STAGE_TILE
#undef STAGE_TILE_G0
#undef BAR_LV
#undef BAR_L
#undef BAR_VL
#undef FINISH_P1
}
template <int VAR>
__device__ __forceinline__ void attn_phase(const Params& p, char* smem, int bid, int nb) {
  const float lam = *(const float*)(p.ws + OFF_LAM);
  for (int it = bid; it < 2112; it += nb) {
    const int rd = it >> 8, j = it & 255;
    int type, h, qrow0, krow0, NT;
    if (rd < 4) { const int b = rd; type = 0; h = j & 7; qrow0 = b * SEQA + (j >> 3) * 256; krow0 = b * SEQA; NT = 132; }
    else if (rd < 8) { const int pair = (j & 7) + 8 * ((rd - 4) >> 1), b = pair >> 2, qt = 2 * (j >> 3) + ((rd - 4) & 1);
      type = 1; h = pair & 3; qrow0 = b * SEQA + qt * 128; krow0 = b * SEQA; NT = 132; }
    else if (j < 32) { const int b = j >> 3; type = 0; h = j & 7; qrow0 = b * SEQA + NLAT; krow0 = qrow0; NT = 4; }
    else if (j < 64) { const int pair = (j - 32) >> 1, b = pair >> 2, qt = (j - 32) & 1;
      type = 1; h = pair & 3; krow0 = b * SEQA + NLAT; qrow0 = krow0 + qt * 128; NT = 4; }
    else continue;
#ifndef ONLY_T1
    if (type == 0) attn_item<0, VAR>(p, smem, h, qrow0, krow0, NT, lam);
#endif
#ifndef ONLY_T0
    if (type == 1) attn_item<1, VAR>(p, smem, h, qrow0, krow0, NT, lam);
#endif
  }
}


constexpr int AT_LD = 264;
constexpr size_t SCAN_UF_OFF = 64 * AT_LD * 2;

constexpr size_t SCAN_UT_OFF = SCAN_UF_OFF + (size_t)64 * 256 * 4;
constexpr size_t SCAN_CW_OFF = SCAN_UT_OFF + (size_t)68 * 512;
constexpr size_t SCAN_LDS_END = SCAN_CW_OFF + 5 * 256 * 4;
__device__ __forceinline__ void scan0_phase(const Params& p, char* lds, int bid, int nb, int ko = 0) {
  const int tid = otid(), wid = tid >> 6, lane = tid & 63, r32 = lane & 31, hi = lane >> 5;
  char* ws = p.ws;
  const bfr* U = (const bfr*)(ws + OFF_RD);
  bfr* AT = (bfr*)lds; float* UF = (float*)(lds + SCAN_UF_OFF); const bfr* UT = (const bfr*)(lds + SCAN_UT_OFF); float* CW = (float*)(lds + SCAN_CW_OFF);
  PG8_LAS unsigned char* ldsA = (PG8_LAS unsigned char*)dyn_smem_base();
  const int nb4 = nb & ~3;
  if (bid < nb4) {
    const int cg = bid & 3, pstep = nb4 >> 2;
    const int blkl = wid >> 2, blk = cg * 2 + blkl, j0 = (wid & 3) * 32;
    const int ch = cg * 256 + wid * 32 + r32;
    float kA[2], biasA[2], biasX[2];
#pragma unroll
    for (int dir = 0; dir < 2; ++dir) { const float sp = log1pf(expf(-p.lru_l[dir * 1024 + ch]));
      kA[dir] = -8.f * sp * LOG2E; biasA[dir] = exp2f(p.ga_b[dir * 1024 + ch] * -LOG2E); biasX[dir] = exp2f(p.gx_b[dir * 1024 + ch] * -LOG2E); }
    for (int i = tid; i < 1280; i += NTHR) { const int j = i >> 8, cc = i & 255; CW[i] = j < 4 ? p.conv_w[j * 1024 + cg * 256 + cc] : p.conv_b[cg * 256 + cc]; }
    bf16x8 wA[8], wX[8];
#define LOADW(dir) do { const bfr* wa_ = (const bfr*)(ws + OFF_WG) + (size_t)((((dir) * 16 + blk) * 4 + (wid & 3)) * 8) * 512 + lane * 8; \
    _Pragma("unroll") for (int ks = 0; ks < 8; ++ks) { wA[ks] = *(const bf16x8*)(wa_ + ks * 512); wX[ks] = *(const bf16x8*)(wa_ + (size_t)8 * 16384 + ks * 512); } } while (0)
#define ISSUE_UT(prn_) do { const int bn_ = (prn_) / 132, cn_ = (prn_) - bn_ * 132; const int lo_ = cn_ < 128 ? 0 : NLAT, hp_ = cn_ < 128 ? NLAT : SEQA; \
    for (int i_ = wid; i_ < 34; i_ += 8) { int pp_ = cn_ * 64 + 2 * i_ + hi - 2; pp_ = pp_ < lo_ ? lo_ : (pp_ >= hp_ ? hp_ - 1 : pp_); \
      __builtin_amdgcn_global_load_lds((const unsigned*)(U + (size_t)(bn_ * SEQA + pp_) * 1024 + cg * 256 + r32 * 8), (PG8_LAS unsigned*)(ldsA + SCAN_UT_OFF + i_ * 1024), 16, 0, 0); } } while (0)
    int pr = bid >> 2;
    if (pr < 528) { ISSUE_UT(pr); LOADW(0); }
    for (; pr < 528; pr += pstep) {
      const int b = pr / 132, c = pr - b * 132;
      const int lo = c < 128 ? 0 : NLAT, hiP = c < 128 ? NLAT : SEQA;
      asm volatile("s_waitcnt vmcnt(0)" ::: "memory");
      __syncthreads();
      if (!(ko & 2)) {
        const int k8 = tid & 31;
        float w[4][8], bia[8];
#pragma unroll
        for (int j = 0; j < 4; ++j) { const float4 t0 = *(const float4*)(CW + j * 256 + k8 * 8), t1 = *(const float4*)(CW + j * 256 + k8 * 8 + 4);
          w[j][0] = t0.x; w[j][1] = t0.y; w[j][2] = t0.z; w[j][3] = t0.w; w[j][4] = t1.x; w[j][5] = t1.y; w[j][6] = t1.z; w[j][7] = t1.w; }
        { const float4 t0 = *(const float4*)(CW + 1024 + k8 * 8), t1 = *(const float4*)(CW + 1024 + k8 * 8 + 4);
          bia[0] = t0.x; bia[1] = t0.y; bia[2] = t0.z; bia[3] = t0.w; bia[4] = t1.x; bia[5] = t1.y; bia[6] = t1.z; bia[7] = t1.w; }
#pragma unroll
        for (int i = 0; i < 4; ++i) { const int t = (tid >> 5) + i * 16; const int pt = c * 64 + t;
          float acc[8];
#pragma unroll
          for (int e = 0; e < 8; ++e) acc[e] = bia[e];
#pragma unroll
          for (int j = 0; j < 4; ++j) { const int pp = pt + j - 2; const float vm = (pp >= lo && pp < hiP) ? 1.f : 0.f;
            const uint4 uu = *(const uint4*)(UT + (t + j) * 256 + k8 * 8); float f[8]; unpack8(uu, f);
#pragma unroll
            for (int e = 0; e < 8; ++e) acc[e] += (w[j][e] * vm) * f[e]; }
          u32x4 pk; pk[0] = cvtpk(acc[0], acc[1]); pk[1] = cvtpk(acc[2], acc[3]); pk[2] = cvtpk(acc[4], acc[5]); pk[3] = cvtpk(acc[6], acc[7]);
          *(u32x4*)(AT + t * AT_LD + k8 * 8) = pk;
          *(float4*)(UF + t * 256 + k8 * 8) = make_float4(acc[0], acc[1], acc[2], acc[3]);
          *(float4*)(UF + t * 256 + k8 * 8 + 4) = make_float4(acc[4], acc[5], acc[6], acc[7]); }
      }
      __syncthreads();
      const int prn = pr + pstep;
#pragma unroll
      for (int ks = 0; ks < 8; ++ks) asm volatile("" :: "v"(wA[ks]), "v"(wX[ks]));
      if (prn < 528) ISSUE_UT(prn);
      asm volatile("" ::: "memory");
#pragma unroll
      for (int dir = 0; dir < 2; ++dir) {
        f32x16 ga[2], gx[2];
#pragma unroll
        for (int mt = 0; mt < 2; ++mt)
#pragma unroll
          for (int r = 0; r < 16; ++r) { ga[mt][r] = 0.f; gx[mt][r] = 0.f; }
        const bfr* ap = AT + r32 * AT_LD + blkl * 128 + hi * 8;
        if (!(ko & 4))
#pragma unroll
        for (int ks = 0; ks < 8; ++ks) {
          bf16x8 a0 = *(const bf16x8*)(ap + ks * 16), a1 = *(const bf16x8*)(ap + 32 * AT_LD + ks * 16);
          ga[0] = __builtin_amdgcn_mfma_f32_32x32x16_bf16(a0, wA[ks], ga[0], 0, 0, 0);
          ga[1] = __builtin_amdgcn_mfma_f32_32x32x16_bf16(a1, wA[ks], ga[1], 0, 0, 0);
          gx[0] = __builtin_amdgcn_mfma_f32_32x32x16_bf16(a0, wX[ks], gx[0], 0, 0, 0);
          gx[1] = __builtin_amdgcn_mfma_f32_32x32x16_bf16(a1, wX[ks], gx[1], 0, 0, 0);
        }
        if (dir == 0) LOADW(1); else if (prn < 528) LOADW(0);
        const float kA_ = kA[dir], bA_ = biasA[dir], bX_ = biasX[dir];
#pragma unroll
        for (int mt = 0; mt < 2; ++mt) if (!(ko & 8)) {
          unsigned lap[8], bpk[8];
#pragma unroll
          for (int r2 = 0; r2 < 8; ++r2) {
            float la2[2], bv2[2];
#pragma unroll
            for (int e = 0; e < 2; ++e) { const int r = r2 * 2 + e;
              const float rr = __builtin_amdgcn_rcpf(fmaf(__builtin_amdgcn_exp2f(ga[mt][r]), bA_, 1.f)), ii = __builtin_amdgcn_rcpf(fmaf(__builtin_amdgcn_exp2f(gx[mt][r]), bX_, 1.f));
              const float la = kA_ * rr;
              const float a = __builtin_amdgcn_exp2f(la);
              const float uc = UF[(mt * 32 + crow(r, hi)) * 256 + wid * 32 + r32];
              const float bv = __builtin_amdgcn_sqrtf(__builtin_fabsf(fmaf(-a, a, 1.f))) * (ii * uc);
              ga[mt][r] = a; gx[mt][r] = bv; la2[e] = la; bv2[e] = bv; }
            lap[r2] = cvtpk(la2[0], la2[1]); bpk[r2] = cvtpk(bv2[0], bv2[1]);
          }
          if (c < 128 && !(ko & 1)) {
            char* sab = ws + OFF_SAB + ((size_t)(((b * 128 + c) * 4 + cg) * 2 + dir) * 8) * 8192 + (size_t)tid * 16;
            *(u32x4*)(sab + (mt * 2 + 0) * 8192) = u32x4{lap[0], lap[1], lap[2], lap[3]};
            *(u32x4*)(sab + (mt * 2 + 1) * 8192) = u32x4{lap[4], lap[5], lap[6], lap[7]};
            *(u32x4*)(sab + (4 + mt * 2 + 0) * 8192) = u32x4{bpk[0], bpk[1], bpk[2], bpk[3]};
            *(u32x4*)(sab + (4 + mt * 2 + 1) * 8192) = u32x4{bpk[4], bpk[5], bpk[6], bpk[7]};
          }
        }
        float sA[8], sB[8];
#pragma unroll
        for (int sgi = 0; sgi < 8; ++sgi) { const int mt = sgi >> 2, g = sgi & 3; float A = 1.f, Bv = 0.f;
#pragma unroll
          for (int e = 0; e < 4; ++e) { const int r = g * 4 + (dir ? 3 - e : e); A *= ga[mt][r]; Bv = ga[mt][r] * Bv + gx[mt][r]; }
          sA[sgi] = A; sB[sgi] = Bv; }
        const bool ownFirst = (dir == 0) == (hi == 0);
        float st = 0.f, stA = 1.f;
        if (!(ko & 16))
#pragma unroll
        for (int q = 0; q < 8; ++q) { const int sgi = dir ? 7 - q : q;
          const float oA = sA[sgi], oB = sB[sgi];
          const float pA = __shfl_xor(oA, 32), pB = __shfl_xor(oB, 32);
          const float fA = ownFirst ? oA : pA, fB = ownFirst ? oB : pB, sA2 = ownFirst ? pA : oA, sB2 = ownFirst ? pB : oB;
          const float A8 = fA * sA2, B8 = sA2 * fB + sB2;
          st = A8 * st + B8; stA *= A8;
        }
        if (hi == 0) {
          const size_t ci = ((size_t)((dir * 4 + b) * 132 + c) * 1024 + ch) * 4;
          *(float*)(ws + OFF_CA + ci) = stA; *(float*)(ws + OFF_CB + ci) = st;
        }
      }
    }
#undef LOADW
#undef ISSUE_UT
  }
  __syncthreads();
}
__device__ __forceinline__ void scan_apply_item(const Params& p, char* lds, int b, int c, int cg, int par) {
  const int tid = otid(), wid = tid >> 6, lane = tid & 63, r32 = lane & 31, hi = lane >> 5;
  char* ws = p.ws;
  const bfr* SG1 = (const bfr*)(ws + OFF_RD) + (size_t)RTOT * 1024;
  bfr* AT = (bfr*)(lds + par * (64 * AT_LD * 2));
  const int row0 = b * SEQA + c * 64;
  const int ch = cg * 256 + wid * 32 + r32;
  const char* sab = ws + OFF_SAB + ((size_t)(((b * 128 + c) * 4 + cg) * 2) * 8) * 8192 + (size_t)tid * 16;
  u32x4 pc[2][8];
#pragma unroll
  for (int dir = 0; dir < 2; ++dir)
#pragma unroll
    for (int k = 0; k < 8; ++k) pc[dir][k] = *(const u32x4*)(sab + (size_t)(dir * 8 + k) * 8192);
  float hin[2];
#pragma unroll
  for (int dir = 0; dir < 2; ++dir) hin[dir] = *(const float*)(ws + OFF_HIN + ((size_t)((dir * 4 + b) * 132 + c) * 1024 + ch) * 4);
  const int k8 = tid & 31, chh = cg * 256 + k8 * 8;
  uint4 gv[4];
#pragma unroll
  for (int i = 0; i < 4; ++i) gv[i] = *(const uint4*)(SG1 + (size_t)(row0 + (tid >> 5) + i * 16) * 1024 + chh);
  float hsum[2][16];
#pragma unroll
  for (int dir = 0; dir < 2; ++dir) {
    float ga[2][16], gx[2][16];
#pragma unroll
    for (int mt = 0; mt < 2; ++mt)
#pragma unroll
      for (int q = 0; q < 8; ++q) { const unsigned wl = pc[dir][mt * 2 + (q >> 2)][q & 3], wb = pc[dir][4 + mt * 2 + (q >> 2)][q & 3];
        ga[mt][2 * q] = __builtin_amdgcn_exp2f(__uint_as_float(wl << 16)); ga[mt][2 * q + 1] = __builtin_amdgcn_exp2f(__uint_as_float(wl & 0xffff0000u));
        gx[mt][2 * q] = __uint_as_float(wb << 16); gx[mt][2 * q + 1] = __uint_as_float(wb & 0xffff0000u); }
    float sA[8], sB[8];
#pragma unroll
    for (int sgi = 0; sgi < 8; ++sgi) { const int mt = sgi >> 2, g = sgi & 3; float A = 1.f, Bv = 0.f;
#pragma unroll
      for (int e = 0; e < 4; ++e) { const int r = g * 4 + (dir ? 3 - e : e); A *= ga[mt][r]; Bv = ga[mt][r] * Bv + gx[mt][r]; }
      sA[sgi] = A; sB[sgi] = Bv; }
    const bool ownFirst = (dir == 0) == (hi == 0);
    float st = hin[dir];
#pragma unroll
    for (int q = 0; q < 8; ++q) { const int sgi = dir ? 7 - q : q;
      const float oA = sA[sgi], oB = sB[sgi];
      const float pA = __shfl_xor(oA, 32), pB = __shfl_xor(oB, 32);
      const float fA = ownFirst ? oA : pA, fB = ownFirst ? oB : pB, sA2 = ownFirst ? pA : oA, sB2 = ownFirst ? pB : oB;
      const float A8 = fA * sA2, B8 = sA2 * fB + sB2;
      float hv = ownFirst ? st : fA * st + fB;
      const int mt = sgi >> 2, g = sgi & 3;
#pragma unroll
      for (int e = 0; e < 4; ++e) { const int r = g * 4 + (dir ? 3 - e : e); hv = ga[mt][r] * hv + gx[mt][r];
        if (dir == 0) hsum[mt][r] = hv; else hsum[mt][r] += hv; }
      st = A8 * st + B8;
    }
  }
#pragma unroll
  for (int mt = 0; mt < 2; ++mt)
#pragma unroll
    for (int r = 0; r < 16; ++r) AT[(mt * 32 + crow(r, hi)) * AT_LD + wid * 32 + r32] = f2bf(hsum[mt][r]);
  __syncthreads();
  bfr* HG = (bfr*)(ws + OFF_RD);
#pragma unroll
  for (int i = 0; i < 4; ++i) { const int t = (tid >> 5) + i * 16;
    uint4 hv = *(const uint4*)(AT + t * AT_LD + k8 * 8);
    float hf[8], gf[8]; unpack8(hv, hf); unpack8(gv[i], gf);
    u32x4 pk; pk[0] = cvtpk(hf[0] * gf[0], hf[1] * gf[1]); pk[1] = cvtpk(hf[2] * gf[2], hf[3] * gf[3]);
    pk[2] = cvtpk(hf[4] * gf[4], hf[5] * gf[5]); pk[3] = cvtpk(hf[6] * gf[6], hf[7] * gf[7]);
    *(u32x4*)(HG + ((size_t)(b * NLAT + c * 64 + t)) * 1024 + chh) = pk; }
}
__device__ __forceinline__ void scan_apply_phase(const Params& p, char* smem, int bid, int nb) {
  int par = 0;
  for (int it = bid; it < 4 * 128 * 4; it += nb, par ^= 1) { const int cg = it & 3, t2 = it >> 2, c = t2 & 127, b = t2 >> 7; scan_apply_item(p, smem, b, c, cg, par); }
  __syncthreads();
}
__device__ __forceinline__ void carry_phase(const Params& p, int bid, int nb) {
  char* ws = p.ws;
  for (int id = bid * NTHR + otid(); id < 8192; id += nb * NTHR) {
    const int ch = id & 1023, db = id >> 10, dir = db >> 2;
    const float* CA = (const float*)(ws + OFF_CA) + (size_t)db * 132 * 1024 + ch; const float* CB = (const float*)(ws + OFF_CB) + (size_t)db * 132 * 1024 + ch;
    float* HIN = (float*)(ws + OFF_HIN) + (size_t)db * 132 * 1024 + ch;
    float h = 0.f;
    for (int s0 = 0; s0 < 132; s0 += 44) {
      float a[44], bb[44];
#pragma unroll
      for (int u = 0; u < 44; ++u) { const int s = s0 + u; const int c = dir ? 131 - s : (s < 4 ? 128 + s : s - 4); a[u] = CA[(size_t)c * 1024]; bb[u] = CB[(size_t)c * 1024]; }
#pragma unroll
      for (int u = 0; u < 44; ++u) { const int s = s0 + u; const int c = dir ? 131 - s : (s < 4 ? 128 + s : s - 4); HIN[(size_t)c * 1024] = h; h = a[u] * h + bb[u]; }
    }
  }
}

__device__ __forceinline__ float ld_agent_f32(const float* p) { return __hip_atomic_load(p, __ATOMIC_RELAXED, __HIP_MEMORY_SCOPE_AGENT); }
__device__ __forceinline__ void mod_phase(const Params& p, char* smem, int bid, int nb) {
  float* sc = (float*)smem; float* red = sc + 5 * 1024;
  float* mod = (float*)(p.ws + OFF_MOD);
  const int tid = otid(), kg = tid >> 5, col = tid & 31;
  for (int it = bid; it < 192; it += nb) {
    const int l = it / 96, j0 = (it % 96) * 32;
    const float* w = p.ada_w + (size_t)l * 1024 * 3072 + (size_t)(kg * 64) * 3072 + j0 + col;
    float wv[64];
#pragma unroll
    for (int k = 0; k < 64; ++k) wv[k] = w[(size_t)k * 3072];
    for (int e = tid; e < 5120; e += NTHR) { const int mr = e >> 10, k = e & 1023; sc[e] = silu_f(mr < 4 ? p.c[mr * 1024 + k] : p.c_ctx[k]); }
    __syncthreads();
    float acc[5] = {0.f, 0.f, 0.f, 0.f, 0.f};
#pragma unroll
    for (int k = 0; k < 64; ++k) {
#pragma unroll
      for (int mr = 0; mr < 5; ++mr) acc[mr] += sc[mr * 1024 + kg * 64 + k] * wv[k]; }
#pragma unroll
    for (int mr = 0; mr < 5; ++mr) red[(kg * 5 + mr) * 32 + col] = acc[mr];
    __syncthreads();
    if (tid < 160) { const int mr = tid >> 5; float sum = 0.f;
#pragma unroll
      for (int g = 0; g < 16; ++g) sum += red[(g * 5 + mr) * 32 + col];
      mod[(l * 5 + mr) * 3072 + j0 + col] = sum + p.ada_b[l * 3072 + j0 + col]; }
    __syncthreads();
  }
  if (bid == nb - 1 && tid == 0) { float s1 = 0, s2 = 0;
    for (int i = 0; i < 64; ++i) { s1 += p.lq1[i] * p.lk1[i]; s2 += p.lq2[i] * p.lk2[i]; }
    *(float*)(p.ws + OFF_LAM) = expf(s1) - expf(s2) + 0.2f; }
}
__device__ __forceinline__ void modulate_phase(const Params& p, int bid, int nb) {
  const float* mod = (const float*)(p.ws + OFF_MOD); bfr* XM = (bfr*)(p.ws + OFF_RA);
  const int lane = otid() & 63, wv = otid() >> 6;
  float shc[16], scc[16]; int mr_c = -1;
#pragma unroll
  for (int i = 0; i < 16; ++i) { shc[i] = 0.f; scc[i] = 0.f; }
  for (int r0 = (bid * 8 + wv) * 2; r0 < RTOT; r0 += nb * 16) {
    const int mr = modrow(r0);
    if (mr != mr_c) { mr_c = mr; const float* sh = mod + mr * 3072; const float* scp = sh + 1024;
#pragma unroll
      for (int i = 0; i < 4; ++i) { const int c = i * 256 + lane * 4; const float4 a = *(const float4*)(sh + c), b = *(const float4*)(scp + c);
        shc[4 * i] = a.x; shc[4 * i + 1] = a.y; shc[4 * i + 2] = a.z; shc[4 * i + 3] = a.w;
        scc[4 * i] = 1.f + b.x; scc[4 * i + 1] = 1.f + b.y; scc[4 * i + 2] = 1.f + b.z; scc[4 * i + 3] = 1.f + b.w; } }
    float4 xv[2][4];
#pragma unroll
    for (int u = 0; u < 2; ++u) { const float* src = xrow(p.x, p.ctx, r0 + u);
#pragma unroll
      for (int i = 0; i < 4; ++i) xv[u][i] = *(const float4*)(src + i * 256 + lane * 4); }
#pragma unroll
    for (int u = 0; u < 2; ++u)
#pragma unroll
      for (int i = 0; i < 4; ++i) { const float4 v = xv[u][i];
        uint2 o; o.x = cvtpk(v.x * scc[4 * i] + shc[4 * i], v.y * scc[4 * i + 1] + shc[4 * i + 1]); o.y = cvtpk(v.z * scc[4 * i + 2] + shc[4 * i + 2], v.w * scc[4 * i + 3] + shc[4 * i + 3]);
        *(uint2*)(XM + (size_t)(r0 + u) * 1024 + i * 256 + lane * 4) = o; }
  }
}
template <int LAYER>
__device__ __forceinline__ void ln_phase(const Params& p, int bid, int nb) {
  const float* mod = (const float*)(p.ws + OFF_MOD);
  const int lane = otid() & 63, wv = otid() >> 6;
  const int nrows = LAYER ? B_ * NLAT : RTOT;
  const float* lng = p.ln_g + LAYER * 1024; const float* lnb = p.ln_b + LAYER * 1024;
  float gl[16], bl[16], gm[16], s1c[16], c1c[16]; int mr_c = -1;
#pragma unroll
  for (int i = 0; i < 4; ++i) { const int c = i * 256 + lane * 4; const float4 a = *(const float4*)(lng + c), b = *(const float4*)(lnb + c);
    gl[4 * i] = a.x; gl[4 * i + 1] = a.y; gl[4 * i + 2] = a.z; gl[4 * i + 3] = a.w; bl[4 * i] = b.x; bl[4 * i + 1] = b.y; bl[4 * i + 2] = b.z; bl[4 * i + 3] = b.w; }
#pragma unroll
  for (int i = 0; i < 16; ++i) { gm[i] = 0.f; s1c[i] = 0.f; c1c[i] = 0.f; }
  for (int r0 = (bid * 8 + wv) * 2; r0 < nrows; r0 += nb * 16) {
    int b0, pp0, mr;
    if (LAYER == 0) { b0 = r0 / SEQA; pp0 = r0 - b0 * SEQA; mr = pp0 < NLAT ? b0 : 4; } else { b0 = r0 / NLAT; pp0 = 0; mr = b0; }
    if (mr != mr_c) { mr_c = mr;
      const float* g = mod + (LAYER * 5 + mr) * 3072 + 2048; const float* sh1 = mod + (5 + mr) * 3072; const float* sc1 = sh1 + 1024;
#pragma unroll
      for (int i = 0; i < 4; ++i) { const int c = i * 256 + lane * 4; const float4 a = *(const float4*)(g + c);
        gm[4 * i] = a.x; gm[4 * i + 1] = a.y; gm[4 * i + 2] = a.z; gm[4 * i + 3] = a.w;
        if (LAYER == 0) { const float4 s1 = *(const float4*)(sh1 + c), c1 = *(const float4*)(sc1 + c);
          s1c[4 * i] = s1.x; s1c[4 * i + 1] = s1.y; s1c[4 * i + 2] = s1.z; s1c[4 * i + 3] = s1.w;
          c1c[4 * i] = 1.f + c1.x; c1c[4 * i + 1] = 1.f + c1.y; c1c[4 * i + 2] = 1.f + c1.z; c1c[4 * i + 3] = 1.f + c1.w; } } }
    float v[2][16], su[2], sq[2];
#pragma unroll
    for (int u = 0; u < 2; ++u) {
      const int r = r0 + u;
      const float* xin; const bfr* Y;
      if (LAYER == 0) { xin = xrow(p.x, p.ctx, r); Y = (const bfr*)(p.ws + OFF_RC) + (size_t)r * 1024; }
      else { xin = (const float*)(r < 16384 ? (const bfr*)(p.ws + OFF_X1A) + (size_t)r * 1024 : (const bfr*)(p.ws + OFF_X1B) + (size_t)(r - 16384) * 1024); Y = (const bfr*)(p.ws + OFF_RB) + (size_t)r * 1024; }
      float sa = 0.f, qa = 0.f;
#pragma unroll
      for (int i = 0; i < 4; ++i) { const int c = i * 256 + lane * 4;
        float4 xv; const uint2 yv = *(const uint2*)(Y + c);
        if (LAYER == 0) xv = *(const float4*)(xin + c);
        else { const uint2 xb = *(const uint2*)((const bfr*)xin + c); xv.x = __uint_as_float(xb.x << 16); xv.y = __uint_as_float(xb.x & 0xffff0000u); xv.z = __uint_as_float(xb.y << 16); xv.w = __uint_as_float(xb.y & 0xffff0000u); }
        v[u][i * 4 + 0] = ALPHA * xv.x + gm[i * 4] * __uint_as_float(yv.x << 16); v[u][i * 4 + 1] = ALPHA * xv.y + gm[i * 4 + 1] * __uint_as_float(yv.x & 0xffff0000u);
        v[u][i * 4 + 2] = ALPHA * xv.z + gm[i * 4 + 2] * __uint_as_float(yv.y << 16); v[u][i * 4 + 3] = ALPHA * xv.w + gm[i * 4 + 3] * __uint_as_float(yv.y & 0xffff0000u); }
#pragma unroll
      for (int i = 0; i < 16; ++i) { sa += v[u][i]; qa += v[u][i] * v[u][i]; }
      su[u] = sa; sq[u] = qa;
    }
    for (int o = 32; o; o >>= 1) { su[0] += __shfl_xor(su[0], o); sq[0] += __shfl_xor(sq[0], o); su[1] += __shfl_xor(su[1], o); sq[1] += __shfl_xor(sq[1], o); }
#pragma unroll
    for (int u = 0; u < 2; ++u) {
      const int r = r0 + u;
      const float mu = su[u] * (1.f / 1024.f);
      const float rs = rsqrtf(fmaxf(sq[u] * (1.f / 1024.f) - mu * mu, 0.f) + 1e-6f);
      float* orow; bool wx1 = true;
      if (LAYER == 0) { const int pp = pp0 + u; wx1 = pp < NLAT; const int lr = b0 * NLAT + (wx1 ? pp : 0);
        orow = (float*)(lr < 16384 ? (bfr*)(p.ws + OFF_X1A) + (size_t)lr * 1024 : (bfr*)(p.ws + OFF_X1B) + (size_t)(lr - 16384) * 1024); }
      else orow = p.out + (size_t)r * 1024;
#pragma unroll
      for (int i = 0; i < 4; ++i) { const int c = i * 256 + lane * 4;
        float4 y; y.x = (v[u][i * 4] - mu) * rs * gl[i * 4] + bl[i * 4]; y.y = (v[u][i * 4 + 1] - mu) * rs * gl[i * 4 + 1] + bl[i * 4 + 1];
        y.z = (v[u][i * 4 + 2] - mu) * rs * gl[i * 4 + 2] + bl[i * 4 + 2]; y.w = (v[u][i * 4 + 3] - mu) * rs * gl[i * 4 + 3] + bl[i * 4 + 3];
        if (LAYER == 1) *(float4*)(orow + c) = y;
        else if (wx1) { uint2 xo; xo.x = cvtpk(y.x, y.y); xo.y = cvtpk(y.z, y.w); *(uint2*)((bfr*)orow + c) = xo; }
        if (LAYER == 0) {
          uint2 o; o.x = cvtpk(y.x * c1c[i * 4] + s1c[i * 4], y.y * c1c[i * 4 + 1] + s1c[i * 4 + 1]); o.y = cvtpk(y.z * c1c[i * 4 + 2] + s1c[i * 4 + 2], y.w * c1c[i * 4 + 3] + s1c[i * 4 + 3]);
          *(uint2*)((bfr*)(p.ws + OFF_RA) + (size_t)r * 1024 + c) = o; } }
    }
  }
}

constexpr size_t OFF_BAR = 131072;
#define XB_TMO      128
#define XB_XCNT(j)  (256  + 64 * (j))
#define XB_XSUB(j)  (1280 + 64 * (j))
#define XB_XGEN(j)  (2304 + 64 * (j))
#define XB_TOP      3328
#define XB_TOPGEN   3392
#define XCD_BAR_WORDS 3456
#define XB_SPIN_CAP (1u << 22)
#define LAS __attribute__((address_space(3)))
__device__ __forceinline__ unsigned xb_ld(unsigned* p)              { return __hip_atomic_load(p, __ATOMIC_RELAXED, __HIP_MEMORY_SCOPE_AGENT); }
__device__ __forceinline__ unsigned xb_add(unsigned* p, unsigned v) { return __hip_atomic_fetch_add(p, v, __ATOMIC_RELAXED, __HIP_MEMORY_SCOPE_AGENT); }
__device__ __forceinline__ unsigned xb_xcc_id() { return (unsigned)__builtin_amdgcn_s_getreg((3 << 11) | 20) & 0xFu; }
#define XB_SPIN(cond, bar) do { unsigned _sp = 0; while (cond) { __builtin_amdgcn_s_sleep(1); \
    if ((++_sp & 255u) == 0u) { if (xb_ld(&(bar)[XB_TMO])) break; if (_sp > XB_SPIN_CAP) { atomicAdd(&(bar)[XB_TMO], 1u); break; } } } } while (0)
struct XcdBarrier { unsigned* bar; unsigned x; volatile LAS unsigned* st; };
__device__ __forceinline__ XcdBarrier xcd_barrier_post(unsigned* bar, volatile LAS unsigned* st) {
  XcdBarrier b; b.bar = bar; b.x = xb_xcc_id(); b.st = st;
  if (threadIdx.x == 0) (void)xb_add(&bar[XB_XCNT(b.x)], 1u);
  return b;
}
__device__ __forceinline__ void xcd_barrier_complete(unsigned* bar, unsigned x, unsigned& nloc, unsigned& nx) {
  const unsigned G = gridDim.x * gridDim.y * gridDim.z;
  unsigned sum, cnt, mine, sp = 0u;
  for (;;) {
    sum = 0u; cnt = 0u; mine = 0u;
#pragma unroll
    for (unsigned j = 0; j < 16; ++j) { const unsigned c = xb_ld(&bar[XB_XCNT(j)]); sum += c; cnt += (c > 0u) ? 1u : 0u; mine = (j == x) ? c : mine; }
    if (sum == G) break;
    __builtin_amdgcn_s_sleep(1);
    if ((++sp & 255u) == 0u) { if (xb_ld(&bar[XB_TMO])) break; if (sp > XB_SPIN_CAP) { atomicAdd(&bar[XB_TMO], 1u); break; } }
  }
  nloc = mine > 0u ? mine : 1u; nx = cnt > 0u ? cnt : 1u;
}
__device__ __forceinline__ void xcd_barrier(const XcdBarrier& b) {
  asm volatile("s_waitcnt vmcnt(0)" ::: "memory");
  __syncthreads();
  if (threadIdx.x == 0) {
    unsigned* bar = b.bar;
    __builtin_amdgcn_s_waitcnt(0);
    unsigned nloc = b.st[0], nx = b.st[1];
    if (nloc == 0u) { xcd_barrier_complete(bar, b.x, nloc, nx); b.st[0] = nloc; b.st[1] = nx; }
    const unsigned old = xb_add(&bar[XB_XSUB(b.x)], 1u);
    const unsigned gen = old / nloc;
    if (old + 1u == (gen + 1u) * nloc) {
      __builtin_amdgcn_fence(__ATOMIC_RELEASE, "agent");
      asm volatile("s_waitcnt vmcnt(0)" ::: "memory");
      const unsigned og = xb_add(&bar[XB_TOP], 1u);
      const unsigned tg = og / nx;
      if (og + 1u == (tg + 1u) * nx) xb_add(&bar[XB_TOPGEN], 1u);
      else XB_SPIN(xb_ld(&bar[XB_TOPGEN]) == tg, bar);
      __builtin_amdgcn_fence(__ATOMIC_ACQUIRE, "agent");
      xb_add(&bar[XB_XGEN(b.x)], 1u);
      asm volatile("s_waitcnt vmcnt(0)" ::: "memory");
    } else {
      XB_SPIN(xb_ld(&bar[XB_XGEN(b.x)]) == gen, bar);
      __builtin_amdgcn_fence(__ATOMIC_ACQUIRE, "agent");
      asm volatile("s_waitcnt vmcnt(0)" ::: "memory");
    }
  }
  __syncthreads();
}

__device__ __forceinline__ void ctx_gemm(const bfr* A, const bfr* Bt, bfr* C, int ntc, char* smem, int bid, int nb) {
  const int tid = otid(), wid = tid >> 6, lane = tid & 63, r32 = lane & 31, hi = lane >> 5;
  constexpr int LDT = 136;
  bfr* As = (bfr*)smem; bfr* Bs = As + 2 * 64 * LDT; float* red = (float*)(smem + 4 * 64 * LDT * 2);
  const int lr = tid >> 3, seg = tid & 7;
  for (int t = bid; t < 16 * ntc; t += nb) {
    const int rt = t / ntc, ct = t - rt * ntc, sub = wid & 3, kh = wid >> 2;
    const int crl = rt * 64 + lr;
    const bfr* ag = A + (size_t)((crl >> 8) * SEQA + NLAT + (crl & 255)) * 1024 + seg * 16;
    const bfr* bg = Bt + (size_t)(ct * 64 + lr) * 1024 + seg * 16;
    u32x4 av[8][2], bv8[8][2];
#pragma unroll
    for (int ch = 0; ch < 8; ++ch) { av[ch][0] = *(const u32x4*)(ag + ch * 128); av[ch][1] = *(const u32x4*)(ag + ch * 128 + 8);
      bv8[ch][0] = *(const u32x4*)(bg + ch * 128); bv8[ch][1] = *(const u32x4*)(bg + ch * 128 + 8); }
    f32x16 acc;
#pragma unroll
    for (int r = 0; r < 16; ++r) acc[r] = 0.f;
    const int arow = (sub & 1) * 32 + r32, bcol = (sub >> 1) * 32 + r32;
#pragma unroll
    for (int ch = 0; ch < 8; ++ch) {
      bfr* Ab = As + (ch & 1) * 64 * LDT; bfr* Bb = Bs + (ch & 1) * 64 * LDT;
      *(u32x4*)(Ab + lr * LDT + seg * 16) = av[ch][0]; *(u32x4*)(Ab + lr * LDT + seg * 16 + 8) = av[ch][1];
      *(u32x4*)(Bb + lr * LDT + seg * 16) = bv8[ch][0]; *(u32x4*)(Bb + lr * LDT + seg * 16 + 8) = bv8[ch][1];
      __syncthreads();
#pragma unroll
      for (int st = 0; st < 4; ++st) {
        const bf16x8 af = *(const bf16x8*)(Ab + arow * LDT + kh * 64 + st * 16 + hi * 8), bv = *(const bf16x8*)(Bb + bcol * LDT + kh * 64 + st * 16 + hi * 8);
        acc = __builtin_amdgcn_mfma_f32_32x32x16_bf16(af, bv, acc, 0, 0, 0); }
    }
    if (kh == 1) {
#pragma unroll
      for (int r = 0; r < 16; ++r) red[(sub * 16 + r) * 64 + lane] = acc[r];
    }
    __syncthreads();
    if (kh == 0) {
      const int cr0 = rt * 64 + (sub & 1) * 32, c0 = ct * 64 + (sub >> 1) * 32;
#pragma unroll
      for (int r = 0; r < 16; ++r) { const int crr = cr0 + crow(r, hi), urr = (crr >> 8) * SEQA + NLAT + (crr & 255);
        C[(size_t)urr * 1024 + c0 + r32] = f2bf(acc[r] + red[(sub * 16 + r) * 64 + lane]); }
    }
    __syncthreads();
  }
}

namespace cg = cooperative_groups;
constexpr size_t XST_OFF = SCAN_LDS_END > SMEM_BYTES ? SCAN_LDS_END : SMEM_BYTES;
constexpr size_t SMEM_TOTAL = XST_OFF + 16;
__global__ __launch_bounds__(512, 2) void fwd_megakernel(Params p) {
  cg::grid_group grid = cg::this_grid();
  const int bid = blockIdx.x, nb = gridDim.x;
  char* smem = dyn_smem; char* ws = p.ws;
  PG8_LAS unsigned char* glds = (PG8_LAS unsigned char*)dyn_smem;
  volatile LAS unsigned* xst = (volatile LAS unsigned*)(smem + XST_OFF);
  if (threadIdx.x == 0) { xst[0] = 0u; xst[1] = 0u; }
  __syncthreads();
  const XcdBarrier xb = xcd_barrier_post((unsigned*)(ws + OFF_BAR), xst);
#ifndef PROBE_DOUBLE
#define PROBE_DOUBLE -1
#endif
#ifndef PROBE_REPS
#define PROBE_REPS 2
#endif
#define REP(n) for (int rep_ = 0; rep_ < ((PROBE_DOUBLE == (n)) ? PROBE_REPS : 1); ++rep_)
#ifdef PROBE_CLK
  unsigned long long clk_c0 = 0, clk_r0 = 0, clk_c1 = 0, clk_r1 = 1;
#define CLK_BEGIN(n) do { if (PROBE_CLK == (n)) { clk_c0 = __builtin_amdgcn_s_memtime(); clk_r0 = __builtin_amdgcn_s_memrealtime(); } } while (0)
#define CLK_END(n) do { if (PROBE_CLK == (n)) { clk_c1 = __builtin_amdgcn_s_memtime(); clk_r1 = __builtin_amdgcn_s_memrealtime(); } } while (0)
#else
#define CLK_BEGIN(n) do {} while (0)
#define CLK_END(n) do {} while (0)
#endif
#ifdef PROBE_MFMA
  { v8i_t a8, b8; bf16x8 ab, bb;
#pragma unroll
    for (int g = 0; g < 8; ++g) { a8[g] = 0x38383838 + (int)threadIdx.x; b8[g] = 0x30303030 + g; }
#pragma unroll
    for (int g = 0; g < 8; ++g) { ab[g] = (__bf16)1.0f; bb[g] = (__bf16)0.5f; }
    f32x16 c0, c1, c2, c3;
#pragma unroll
    for (int r = 0; r < 16; ++r) { c0[r] = 0.f; c1[r] = 0.f; c2[r] = 0.f; c3[r] = 0.f; }
    for (int i = 0; i < PROBE_MFMA; ++i) {
#if PROBE_MFMA_KIND == 0
      c0 = __builtin_amdgcn_mfma_scale_f32_32x32x64_f8f6f4(a8, b8, c0, 0, 0, 0, 0x7F7F7F7F, 0, 0x7F7F7F7F);
      c1 = __builtin_amdgcn_mfma_scale_f32_32x32x64_f8f6f4(a8, b8, c1, 0, 0, 0, 0x7F7F7F7F, 0, 0x7F7F7F7F);
      c2 = __builtin_amdgcn_mfma_scale_f32_32x32x64_f8f6f4(a8, b8, c2, 0, 0, 0, 0x7F7F7F7F, 0, 0x7F7F7F7F);
      c3 = __builtin_amdgcn_mfma_scale_f32_32x32x64_f8f6f4(a8, b8, c3, 0, 0, 0, 0x7F7F7F7F, 0, 0x7F7F7F7F);
#elif PROBE_MFMA_KIND == 1
      c0 = __builtin_amdgcn_mfma_f32_32x32x16_bf16(ab, bb, c0, 0, 0, 0);
      c1 = __builtin_amdgcn_mfma_f32_32x32x16_bf16(ab, bb, c1, 0, 0, 0);
      c2 = __builtin_amdgcn_mfma_f32_32x32x16_bf16(ab, bb, c2, 0, 0, 0);
      c3 = __builtin_amdgcn_mfma_f32_32x32x16_bf16(ab, bb, c3, 0, 0, 0);
#else
      c0 = __builtin_amdgcn_mfma_scale_f32_32x32x64_f8f6f4(a8, b8, c0, 0, 0, 0, 0x7D7D7D7D, 0, 0x7B7B7B7B);
      c1 = __builtin_amdgcn_mfma_scale_f32_32x32x64_f8f6f4(a8, b8, c1, 0, 0, 0, 0x7D7D7D7D, 0, 0x7B7B7B7B);
      c2 = __builtin_amdgcn_mfma_scale_f32_32x32x64_f8f6f4(a8, b8, c2, 0, 0, 0, 0x7D7D7D7D, 0, 0x7B7B7B7B);
      c3 = __builtin_amdgcn_mfma_scale_f32_32x32x64_f8f6f4(a8, b8, c3, 0, 0, 0, 0x7D7D7D7D, 0, 0x7B7B7B7B);
#endif
      asm volatile("" : "+v"(a8), "+v"(b8)); }
    if (c0[0] + c1[1] + c2[2] + c3[3] == 12345.678f) p.out[0] = 1.f; }
#endif
  REP(0) { mod_phase(p, smem, bid, nb);
  prep_phase(p, smem, (bid + nb - 192) % nb, nb); }
  grid.sync();
  REP(1) modulate_phase(p, bid, nb);
  xcd_barrier(xb);
  CLK_BEGIN(2);
  REP(2) { pg8::EZ e{}; e.ws = ws; pg8::StaticOrder S; S.init(RTOT, 3328, nb, bid);
    pg8::gemm_phase<pg8::EZ, pg8::StaticOrder, false>(glds, pg8::Gemm{(const bfr*)(ws + OFF_RA), (const bfr*)(ws + OFF_WIN0), RTOT, 3328, 1024}, S, e, nullptr);
    { const int nfull = (132 * 13) % nb;
      __syncthreads();
      if (nfull == 0) prep_late(p, smem, bid, nb); else if (bid >= nfull) prep_late(p, smem, bid - nfull, nb - nfull); } }
  CLK_END(2);
  xcd_barrier(xb);
  REP(3) { { pg8::EQ e{}; e.ws = ws; pg8::StaticOrder S; S.init(RTOT, 768, nb, bid);
      pg8::gemm_phase<pg8::EQ, pg8::StaticOrder, false>(glds, pg8::Gemm{(const bfr*)(ws + OFF_RE), (const bfr*)(ws + OFF_WUQ), RTOT, 768, 384}, S, e, nullptr); }
    { pg8::EKV e{}; e.ws = ws; pg8::StaticOrder S; S.init(RTOT, 1024, nb, (bid + 116) % nb);
      pg8::gemm_phase<pg8::EKV, pg8::StaticOrder, false>(glds, pg8::Gemm{(const bfr*)(ws + OFF_RE) + (size_t)RTOT * 384, (const bfr*)(ws + OFF_WUKV), RTOT, 1024, 256}, S, e, nullptr); } }
  xcd_barrier(xb);
  v8_phase(p, smem, bid, nb);
  xcd_barrier(xb);
  CLK_BEGIN(4);
  attn_phase<0>(p, smem, bid, nb);
  CLK_END(4);
#if PROBE_DOUBLE == 4
  xcd_barrier(xb);
  attn_phase<PROBE_VAR>(p, smem, bid, nb);
#endif
  xcd_barrier(xb);
  REP(5) { pg8::EStore e{}; e.C = (bfr*)(ws + OFF_RC); e.ldc = 1024; pg8::LatentOrder S; S.init(1024, nb, bid);
    pg8::gemm_phase<pg8::EStore, pg8::LatentOrder, false>(glds, pg8::Gemm{(const bfr*)(ws + OFF_RA), (const bfr*)(ws + OFF_WOUT0), RTOT, 1024, 1024}, S, e, nullptr);
    __syncthreads();
    ctx_gemm((const bfr*)(ws + OFF_RA), (const bfr*)(ws + OFF_WOUT0), (bfr*)(ws + OFF_RC), 16, smem, bid, nb); }
  xcd_barrier(xb);
  CLK_BEGIN(6);
  REP(6) ln_phase<0>(p, bid, nb);
  CLK_END(6);
  xcd_barrier(xb);
  CLK_BEGIN(7);
  REP(7) { pg8::EUG e{}; e.U = (bfr*)(ws + OFF_RD); e.SG1 = e.U + (size_t)RTOT * 1024; pg8::LatentOrder S; S.init(2048, nb, bid);
    pg8::gemm_phase<pg8::EUG, pg8::LatentOrder, false>(glds, pg8::Gemm{(const bfr*)(ws + OFF_RA), (const bfr*)(ws + OFF_WIN1), RTOT, 2048, 1024}, S, e, nullptr);
    __syncthreads();
    ctx_gemm((const bfr*)(ws + OFF_RA), (const bfr*)(ws + OFF_WIN1), (bfr*)(ws + OFF_RD), 16, smem, bid, nb); }
  xcd_barrier(xb);
  #ifndef PROBE_KO
#define PROBE_KO 0
#endif
  CLK_END(7);
  CLK_BEGIN(8);
  REP(8) scan0_phase(p, smem, bid, nb, (rep_ < PROBE_REPS - 1 && PROBE_DOUBLE == 8) ? PROBE_KO : 0);
  xcd_barrier(xb);
  CLK_END(8);
  REP(9) carry_phase(p, bid, nb);
#ifdef PROBE_BAR
  for (int i_ = 0; i_ < PROBE_BAR; ++i_) xcd_barrier(xb);
#endif
  xcd_barrier(xb);
  REP(10) scan_apply_phase(p, smem, bid, nb);
  xcd_barrier(xb);
  REP(11) { pg8::EStore e{}; e.C = (bfr*)(ws + OFF_RB); e.ldc = 1024; pg8::StaticOrder S; S.init(B_ * NLAT, 1024, nb, bid);
    pg8::gemm_phase<pg8::EStore, pg8::StaticOrder, false>(glds, pg8::Gemm{(const bfr*)(ws + OFF_RD), (const bfr*)(ws + OFF_WOUT1), B_ * NLAT, 1024, 1024}, S, e, nullptr); }
  xcd_barrier(xb);
  ln_phase<1>(p, bid, nb);
#ifdef PROBE_CLK
  if (bid == 0 && threadIdx.x == 0) { const unsigned long long ticks = (clk_c1 - clk_c0) * 10000ull / (clk_r1 - clk_r0);
    const unsigned long long t0 = __builtin_amdgcn_s_memrealtime(); while (__builtin_amdgcn_s_memrealtime() - t0 < ticks) __builtin_amdgcn_s_sleep(8); }
#endif
}

extern "C" void kernel_launch(void* const* d_in, const int* in_sizes, int n_in, void* d_out, int out_size, void* d_ws, size_t ws_size, hipStream_t stream) {
  Params P{};
  { const float** pp = (const float**)&P; for (int i = 0; i < 28; ++i) pp[i] = (const float*)d_in[i]; }
  P.out = (float*)d_out; P.ws = (char*)d_ws;
  if (ws_size < WS_END || n_in < 28) return;
  static int grid_blocks = 0;
  if (!grid_blocks) {
    (void)hipFuncSetAttribute((const void*)fwd_megakernel, hipFuncAttributeMaxDynamicSharedMemorySize, (int)SMEM_TOTAL);
    int dev = 0, cus = 0, per_cu = 0;
    (void)hipGetDevice(&dev);
    (void)hipDeviceGetAttribute(&cus, hipDeviceAttributeMultiprocessorCount, dev);
    (void)hipOccupancyMaxActiveBlocksPerMultiprocessor(&per_cu, (const void*)fwd_megakernel, NTHR, SMEM_TOTAL);
    if (per_cu > 1) per_cu = 1;
    grid_blocks = cus * per_cu;
    if (grid_blocks <= 0) grid_blocks = 256;
  }
  (void)hipMemsetAsync((char*)d_ws + OFF_BAR, 0, XCD_BAR_WORDS * 4, stream);
  void* args[] = {&P};
  (void)hipLaunchCooperativeKernel((const void*)fwd_megakernel, dim3(grid_blocks), dim3(NTHR), args, SMEM_TOTAL, stream);
}
```
